# Optimizing an MI355X kernel written in HIP

```python
import math
import jax
import jax.numpy as jnp
from jax import lax
import numpy as np

D_MODEL = 2048
BATCH = 4
SEQ = 2048
DEPTH = 2

GRID_W = 64
CTX_LEN = 256
MIX_WIDTH = D_MODEL
GROUP_WIDTH = MIX_WIDTH // 4
HEAD_DIM = 64
ROPE_BASE = 10000.0
EPS = 1e-6
NEG_INF = -1e30

POOL_WINDOWS = (2, 4, 8, 16)
POOL_GROUPS = 4
POOL_GROUP_DIM = GROUP_WIDTH // POOL_GROUPS

DIFF_HEADS = GROUP_WIDTH // (2 * HEAD_DIM)
Q_BLOCK = 128

SGU_CHUNK = 128
SGU_GROUPS = 4
SGU_GROUP_DIM = GROUP_WIDTH // SGU_GROUPS

WIN_HEADS = GROUP_WIDTH // HEAD_DIM
WIN_KV_HEADS = 2
WIN_REP = WIN_HEADS // WIN_KV_HEADS
WINDOW = 128
WIN_BLOCK = 128

IN_SIZES = (GROUP_WIDTH, GROUP_WIDTH, GROUP_WIDTH, GROUP_WIDTH, 2 * GROUP_WIDTH,
            WIN_HEADS * HEAD_DIM, WIN_KV_HEADS * HEAD_DIM, WIN_KV_HEADS * HEAD_DIM)
IN_COLS = 6 * GROUP_WIDTH + WIN_HEADS * HEAD_DIM + 2 * WIN_KV_HEADS * HEAD_DIM

D_FF = 5632
N_EXPERTS = 8
TOP_K = 2
N_DENSE = (DEPTH + 1) // 2
N_MOE = DEPTH // 2

kernel_name = "hybrid_diffusion_parallel_mixers_ctx_prefix"


def _rmsnorm(x, g):
    xf = x.astype(jnp.float32)
    y = xf * lax.rsqrt(jnp.mean(xf * xf, axis=-1, keepdims=True) + EPS)
    return (y * g.astype(jnp.float32)).astype(x.dtype)


def _layernorm(x, g, b):
    xf = x.astype(jnp.float32)
    mu = jnp.mean(xf, axis=-1, keepdims=True)
    var = jnp.mean(jnp.square(xf - mu), axis=-1, keepdims=True)
    y = (xf - mu) * lax.rsqrt(var + EPS) * g.astype(jnp.float32) + b.astype(jnp.float32)
    return y.astype(x.dtype)


def _modulate(x, g, shift, scale):
    return _rmsnorm(x, g) * (1 + scale) + shift


def _axial_rope(length, dim):
    n_rows = length // GRID_W
    rows = jnp.repeat(jnp.arange(n_rows, dtype=jnp.float32), GRID_W)
    cols = jnp.tile(jnp.arange(GRID_W, dtype=jnp.float32), n_rows)
    n_freq = dim // 4
    inv_freq = ROPE_BASE ** (-jnp.arange(n_freq, dtype=jnp.float32) / n_freq)
    ang = jnp.concatenate([rows[:, None] * inv_freq, cols[:, None] * inv_freq], axis=-1)
    return jnp.cos(ang), jnp.sin(ang)


def _apply_rope(x, cos, sin):
    bshape = (cos.shape[0],) + (1,) * (x.ndim - 3) + (cos.shape[1],)
    cos = cos.reshape(bshape)
    sin = sin.reshape(bshape)
    x1, x2 = jnp.split(x.astype(jnp.float32), 2, axis=-1)
    return jnp.concatenate([x1 * cos - x2 * sin, x1 * sin + x2 * cos], axis=-1).astype(x.dtype)


def _split_in(p):
    outs, start = [], 0
    for size in IN_SIZES:
        outs.append(p[..., start:start + size])
        start += size
    return outs


def _pool_mix(a, w, scale):
    B, T, _ = a.shape
    af = a.astype(jnp.float32)
    csum = jnp.concatenate([jnp.zeros_like(af[:, :1]), jnp.cumsum(af, axis=1)], axis=1)
    t = jnp.arange(T)
    pooled = []
    for g, win in enumerate(POOL_WINDOWS):
        lo = jnp.maximum(t - win // 2, 0)
        hi = jnp.minimum(t + win // 2, T)
        cs = csum[..., g * POOL_GROUP_DIM:(g + 1) * POOL_GROUP_DIM]
        pooled.append((cs[:, hi] - cs[:, lo]) / (hi - lo).astype(jnp.float32)[:, None])
    d = (jnp.concatenate(pooled, axis=-1) - af).astype(a.dtype)
    d = d.reshape(B, T, POOL_GROUPS, POOL_GROUP_DIM)
    y = jnp.einsum('btgc,gcd->btgd', d, w).reshape(B, T, GROUP_WIDTH)
    return y * scale


def _diff_mix(q, k, v, lam):
    s = jnp.einsum('bqhmd,bkhmd->bhmqk', q, k).astype(jnp.float32) * HEAD_DIM ** -0.5
    p = jax.nn.softmax(s, axis=-1)
    a = p[:, :, 0] - lam * p[:, :, 1]
    return jnp.einsum('bhqk,bkhd->bqhd', a.astype(v.dtype), v)


def _diff_out(o, g, lam_init):
    B, T = o.shape[:2]
    return (_rmsnorm(o, g) * (1.0 - lam_init)).reshape(B, T, GROUP_WIDTH)


def _sgu_mix(z, g, b, w_s, b_s):
    B, T, _ = z.shape
    u, v = jnp.split(jax.nn.gelu(z), 2, axis=-1)
    v = _layernorm(v, g, b).reshape(B, T // SGU_CHUNK, SGU_CHUNK, SGU_GROUPS, SGU_GROUP_DIM)
    v = jnp.einsum('gpq,bnqgc->bnpgc', w_s, v) + b_s.T[:, :, None]
    return u * v.reshape(B, T, GROUP_WIDTH)


def _window_attend(q, k, v, k_ctx, v_ctx, sink):
    B, T, G, R, dh = q.shape
    nb = T // WIN_BLOCK
    band = 3 * WIN_BLOCK

    def to_band(a):
        ap = jnp.pad(a, ((0, 0), (WIN_BLOCK, WIN_BLOCK), (0, 0), (0, 0)))
        ap = ap.reshape(B, nb + 2, WIN_BLOCK, G, dh)
        return jnp.concatenate([ap[:, :-2], ap[:, 1:-1], ap[:, 2:]], axis=2)

    k_band, v_band = to_band(k), to_band(v)
    qb = q.reshape(B, nb, WIN_BLOCK, G, R, dh)
    scale = dh ** -0.5
    s_band = jnp.einsum('bnqgrd,bnkgd->bngrqk', qb, k_band).astype(jnp.float32) * scale
    q_off = jnp.arange(WIN_BLOCK)[:, None]
    k_off = jnp.arange(band)[None, :] - WIN_BLOCK
    k_pos = jnp.arange(nb)[:, None, None] * WIN_BLOCK + k_off[None]
    mask = (jnp.abs(k_off - q_off) <= WINDOW)[None] & (k_pos >= 0) & (k_pos < T)
    s_band = jnp.where(mask[None, :, None, None], s_band, NEG_INF)
    s_ctx = jnp.einsum('bnqgrd,bcgd->bngrqc', qb, k_ctx).astype(jnp.float32) * scale
    s_sink = jnp.broadcast_to(sink.astype(jnp.float32).reshape(1, 1, G, R, 1, 1),
                              s_band.shape[:-1] + (1,))
    p = jax.nn.softmax(jnp.concatenate([s_band, s_ctx, s_sink], axis=-1), axis=-1).astype(v.dtype)
    o = (jnp.einsum('bngrqk,bnkgd->bnqgrd', p[..., :band], v_band)
         + jnp.einsum('bngrqc,bcgd->bnqgrd', p[..., band:-1], v_ctx))
    return o.reshape(B, T, G * R * dh)


def _sink_attend(q, k, v, sink):
    B, T, G, R, dh = q.shape
    s = jnp.einsum('bqgrd,bkgd->bgrqk', q, k).astype(jnp.float32) * dh ** -0.5
    s_sink = jnp.broadcast_to(sink.astype(jnp.float32).reshape(1, G, R, 1, 1), s.shape[:-1] + (1,))
    p = jax.nn.softmax(jnp.concatenate([s, s_sink], axis=-1), axis=-1)[..., :-1].astype(v.dtype)
    return jnp.einsum('bgrqk,bkgd->bqgrd', p, v).reshape(B, T, G * R * dh)


def _swiglu(h, w1, w3, w2):
    return (jax.nn.silu(h @ w1) * (h @ w3)) @ w2


def _moe_swiglu(h, router, w1, w3, w2):
    logits = (h @ router).astype(jnp.float32)
    top_v, top_i = lax.top_k(logits, TOP_K)
    top_w = jax.nn.softmax(top_v, axis=-1)
    gates = jnp.sum(jax.nn.one_hot(top_i, N_EXPERTS, dtype=jnp.float32) * top_w[..., None], axis=-2)
    y = jnp.zeros_like(h)
    for e in range(N_EXPERTS):
        y = y + gates[..., e:e + 1].astype(h.dtype) * _swiglu(h, w1[e], w3[e], w2[e])
    return y


def setup_inputs(seed: int = 0) -> dict:
    key = jax.random.key(seed)
    keys = iter(jax.random.split(key, 32))
    D = D_MODEL

    def nrm(shape, s):
        return jax.random.normal(next(keys), shape, jnp.float32) * s

    return {
        'x': nrm((BATCH, SEQ, D), 1.0),
        'c': nrm((BATCH, D), 1.0),
        'ctx': nrm((BATCH, CTX_LEN, D), 1.0),
        'c_ctx': nrm((D,), 1.0),
        'w_mod': nrm((DEPTH, D, 6 * D), 0.5 * D ** -0.5),
        'b_mod': nrm((DEPTH, 6 * D), 0.02),
        'norm_mix': 1.0 + nrm((DEPTH, D), 0.05),
        'norm_ffn': 1.0 + nrm((DEPTH, D), 0.05),
        'w_in': nrm((DEPTH, D, IN_COLS), D ** -0.5),
        'w_out': nrm((DEPTH, MIX_WIDTH, D), MIX_WIDTH ** -0.5),
        'pool_w': nrm((DEPTH, POOL_GROUPS, POOL_GROUP_DIM, POOL_GROUP_DIM), POOL_GROUP_DIM ** -0.5),
        'pool_scale': 1.0 + nrm((DEPTH, GROUP_WIDTH), 0.1),
        'diff_lam': nrm((DEPTH, 4, HEAD_DIM), 0.1),
        'diff_subln': 1.0 + nrm((DEPTH, 2 * HEAD_DIM), 0.05),
        'sgu_ln_g': 1.0 + nrm((DEPTH, GROUP_WIDTH), 0.05),
        'sgu_ln_b': nrm((DEPTH, GROUP_WIDTH), 0.02),
        'sgu_w': nrm((DEPTH, SGU_GROUPS, SGU_CHUNK, SGU_CHUNK), SGU_CHUNK ** -0.5),
        'sgu_b': 1.0 + nrm((DEPTH, SGU_GROUPS, SGU_CHUNK), 0.1),
        'win_sink': nrm((DEPTH, WIN_HEADS), 0.5),
        'ffn_w1': nrm((N_DENSE, D, D_FF), D ** -0.5),
        'ffn_w3': nrm((N_DENSE, D, D_FF), D ** -0.5),
        'ffn_w2': nrm((N_DENSE, D_FF, D), D_FF ** -0.5),
        'moe_router': nrm((N_MOE, D, N_EXPERTS), D ** -0.5),
        'moe_w1': nrm((N_MOE, N_EXPERTS, D, D_FF), D ** -0.5),
        'moe_w3': nrm((N_MOE, N_EXPERTS, D, D_FF), D ** -0.5),
        'moe_w2': nrm((N_MOE, N_EXPERTS, D_FF, D), D_FF ** -0.5),
        'norm_final': 1.0 + nrm((D,), 0.05),
    }


def reference(x, c, ctx, c_ctx, w_mod, b_mod, norm_mix, norm_ffn, w_in, w_out,
              pool_w, pool_scale, diff_lam, diff_subln, sgu_ln_g, sgu_ln_b, sgu_w, sgu_b,
              win_sink, ffn_w1, ffn_w3, ffn_w2, moe_router, moe_w1, moe_w3, moe_w2,
              norm_final):
    B, L, _ = x.shape
    C = ctx.shape[1]
    dh = HEAD_DIM
    cos, sin = _axial_rope(L, dh)
    s_lat = jax.nn.silu(c)
    s_ctx = jax.nn.silu(c_ctx)[None]
    h_lat, h_ctx = x, ctx
    for l in range(DEPTH):
        last = l == DEPTH - 1
        m_lat = jnp.split((s_lat @ w_mod[l] + b_mod[l])[:, None, :], 6, axis=-1)
        m_ctx = jnp.split((s_ctx @ w_mod[l] + b_mod[l])[:, None, :], 6, axis=-1)

        n_lat = _modulate(h_lat, norm_mix[l], m_lat[0], m_lat[1])
        n_ctx = _modulate(h_ctx, norm_mix[l], m_ctx[0], m_ctx[1])
        p_all = jnp.concatenate([n_ctx, n_lat], axis=1) @ w_in[l]
        pa_c, dq_c, dk_c, dv_c, z_c, wq_c, wk_c, wv_c = _split_in(p_all[:, :C])
        pa_l, dq_l, dk_l, dv_l, z_l, wq_l, wk_l, wv_l = _split_in(p_all[:, C:])

        lam_init = 0.8 - 0.6 * math.exp(-0.3 * l)
        lq1, lk1, lq2, lk2 = diff_lam[l].astype(jnp.float32)
        lam = jnp.exp(jnp.sum(lq1 * lk1)) - jnp.exp(jnp.sum(lq2 * lk2)) + lam_init
        dk_c = dk_c.reshape(B, C, DIFF_HEADS, 2, dh)
        dv_c = dv_c.reshape(B, C, DIFF_HEADS, 2 * dh)
        dq_l = _apply_rope(dq_l.reshape(B, L, DIFF_HEADS, 2, dh), cos, sin)
        dk_l = _apply_rope(dk_l.reshape(B, L, DIFF_HEADS, 2, dh), cos, sin)
        k_all = jnp.concatenate([dk_l, dk_c], axis=1)
        v_all = jnp.concatenate([dv_l.reshape(B, L, DIFF_HEADS, 2 * dh), dv_c], axis=1)
        q_blocks = dq_l.reshape(B, L // Q_BLOCK, Q_BLOCK, DIFF_HEADS, 2, dh).swapaxes(0, 1)
        o_blocks = lax.map(lambda qb: _diff_mix(qb, k_all, v_all, lam), q_blocks)
        diff_l = _diff_out(o_blocks.swapaxes(0, 1).reshape(B, L, DIFF_HEADS, 2 * dh),
                           diff_subln[l], lam_init)

        wk_c = wk_c.reshape(B, C, WIN_KV_HEADS, dh)
        wv_c = wv_c.reshape(B, C, WIN_KV_HEADS, dh)
        wq_l = _apply_rope(wq_l.reshape(B, L, WIN_KV_HEADS, WIN_REP, dh), cos, sin)
        wk_l = _apply_rope(wk_l.reshape(B, L, WIN_KV_HEADS, dh), cos, sin)
        win_l = _window_attend(wq_l, wk_l, wv_l.reshape(B, L, WIN_KV_HEADS, dh),
                               wk_c, wv_c, win_sink[l])

        mix_l = jnp.concatenate([
            _pool_mix(pa_l, pool_w[l], pool_scale[l]),
            diff_l,
            _sgu_mix(z_l, sgu_ln_g[l], sgu_ln_b[l], sgu_w[l], sgu_b[l]),
            win_l], axis=-1)
        h_lat = h_lat + m_lat[2] * (mix_l @ w_out[l])
        if not last:
            diff_c = _diff_out(_diff_mix(dq_c.reshape(B, C, DIFF_HEADS, 2, dh), dk_c, dv_c, lam),
                               diff_subln[l], lam_init)
            win_c = _sink_attend(wq_c.reshape(B, C, WIN_KV_HEADS, WIN_REP, dh), wk_c, wv_c, win_sink[l])
            mix_c = jnp.concatenate([
                _pool_mix(pa_c, pool_w[l], pool_scale[l]),
                diff_c,
                _sgu_mix(z_c, sgu_ln_g[l], sgu_ln_b[l], sgu_w[l], sgu_b[l]),
                win_c], axis=-1)
            h_ctx = h_ctx + m_ctx[2] * (mix_c @ w_out[l])

        f_lat = _modulate(h_lat, norm_ffn[l], m_lat[3], m_lat[4])
        if last:
            f_in = f_lat
        else:
            f_in = jnp.concatenate([_modulate(h_ctx, norm_ffn[l], m_ctx[3], m_ctx[4]), f_lat], axis=1)
        i = l // 2
        if l % 2 == 0:
            y = _swiglu(f_in, ffn_w1[i], ffn_w3[i], ffn_w2[i])
        else:
            y = _moe_swiglu(f_in, moe_router[i], moe_w1[i], moe_w3[i], moe_w2[i])
        if not last:
            h_ctx = h_ctx + m_ctx[5] * y[:, :C]
        h_lat = h_lat + m_lat[5] * y[:, -L:]
    return _rmsnorm(h_lat, norm_final)
```

```cpp
#define DENSE_UP_F8_ON 0
#include <hip/hip_runtime.h>
#include <cstdio>
#include <cstdint>
#include <cmath>

#define GAS __attribute__((address_space(1)))
#define LAS __attribute__((address_space(3)))
namespace pg8 {
#define PG8_LAS __attribute__((address_space(3)))
typedef unsigned short bf16_t;
typedef short bf16x8 __attribute__((ext_vector_type(8)));
typedef float f32x4 __attribute__((ext_vector_type(4)));
typedef unsigned u32x4 __attribute__((ext_vector_type(4)));
typedef int i32x4 __attribute__((ext_vector_type(4)));
typedef int i32x8 __attribute__((ext_vector_type(8)));
constexpr int BM = 256, BK = 64, HALF = 128, HTB = HALF * BK * 2  , STAGE_BYTES = 8 * HTB, NXCD = 8, WGM = 8;

__host__ __device__ __forceinline__ int lds_byte(int r, int c) { const int st = (r >> 4) * 2 + (c >> 5), rr = r & 15, cc = c & 31, ob = rr * 64 + cc * 2; return st * 1024 + (ob ^ (((ob >> 9) & 1) << 5)); }
__host__ __device__ __forceinline__ void stage_rc(int b, int& R, int& C) { const int st = b / 1024, sb = b % 1024, swz = sb ^ (((sb >> 9) & 1) << 5); R = (st >> 1) * 16 + swz / 64; C = (st & 1) * 32 + (swz % 64) / 2; }
__host__ __device__ __forceinline__ int perm32(int rho) { const int n = rho >> 4, i = rho & 15; return 8 * (i >> 2) + 4 * n + (i & 3); }

struct Unit { int pm, pn, k0, nkt, sid; };
struct Gemm { const bf16_t* A; const bf16_t* Bt; int M, N, K; };

struct StaticOrder {
    int nM, nN, nwg, G, c;
    __host__ __device__ void init(int M, int N, int G_, int c_, int K_) { nM = M / BM; nN = N / BM; nwg = nM * nN; G = G_; c = c_; K = K_; }
    int K;
    __host__ __device__ bool next(int i, Unit& u) const { const long L = (long)i * G + c; if (L >= nwg) return false; map(L, u); return true; }
    __host__ __device__ void map(long L, Unit& u) const {
        int wgid = (int)L; { const int q = nwg / NXCD, r = nwg % NXCD, xcd = wgid % NXCD, off = wgid / NXCD; wgid = (xcd < r ? xcd * (q + 1) : r * (q + 1) + (xcd - r) * q) + off; }
        const int nig = WGM * nN, gid = wgid / nig, fm = gid * WGM, gsz = (nM - fm) < WGM ? (nM - fm) : WGM;
        u.pm = fm + ((wgid % nig) % gsz); u.pn = (wgid % nig) / gsz; u.k0 = 0; u.nkt = K / BK; u.sid = -1;
    }
    __device__ __forceinline__ void a_ready(const Unit&) const {}
    __device__ __forceinline__ void done(const Unit&) const {}
};

__device__ __forceinline__ unsigned cvt_pk_bf16(float lo, float hi) { unsigned r; asm volatile("v_cvt_pk_bf16_f32 %0, %1, %2" : "=v"(r) : "v"(lo), "v"(hi)); return r; }
typedef unsigned u32x4 __attribute__((ext_vector_type(4)));
constexpr float QSCALE = 0.125f * 1.4426950408889634f;
__device__ __forceinline__ float gelu_tanh(float x) {
    const float y = 0.7978845608028654f * (x + 0.044715f * x * x * x);
    return x * __builtin_amdgcn_rcpf(1.0f + __builtin_amdgcn_exp2f(-2.0f * 1.4426950408889634f * y));
}
__device__ __forceinline__ float silu_f(float x) { return x * __builtin_amdgcn_rcpf(1.0f + __builtin_amdgcn_exp2f(-1.4426950408889634f * x)); }

struct EpiIn {
    static constexpr bool PERM = true, AFTER_DRAIN = false;
    bf16_t* O; const float* rope;
    __device__ __forceinline__ void operator()(const f32x4 (&acc)[2][2][4][2], const Unit& u, int wr, int wc, int fr, int fq) const {
        const int row0 = u.pm * BM + wr * 64 + fr; const bool lat = u.pm >= 4;
#pragma unroll
        for (int bj = 0; bj < 2; ++bj) {
            const int cb = u.pn * BM + bj * HALF; int role;
            if (cb < 512) role = 0; else if (cb < 1024) role = 1; else if (cb < 1536) role = 2; else if (cb < 2048) role = 0; else if (cb < 3072) role = 3; else if (cb < 3584) role = 1; else if (cb < 3712) role = 2; else role = 0;
            const int col0 = cb + wc * 32 + 8 * fq;
#pragma unroll
            for (int ai = 0; ai < 2; ++ai)
#pragma unroll
                for (int m = 0; m < 4; ++m) {
                    const int row = row0 + ai * HALF + m * 16;
                    f32x4 v0 = acc[ai][bj][m][0], v1 = acc[ai][bj][m][1];
                    if (role == 1 || role == 2) {
                        if (lat) {
                            const int t = (row - 1024) & 2047, pos = (wc & 1) ? (t & 63) : (t >> 6);
                            const f32x4 cs = *(const f32x4*)(rope + pos * 16 + 4 * fq), sn = *(const f32x4*)(rope + 1024 + pos * 16 + 4 * fq);
                            f32x4 a0, a1;
                            a0[0] = v0[0] * cs[0] - v0[1] * sn[0]; a0[1] = v0[0] * sn[0] + v0[1] * cs[0];
                            a0[2] = v0[2] * cs[1] - v0[3] * sn[1]; a0[3] = v0[2] * sn[1] + v0[3] * cs[1];
                            a1[0] = v1[0] * cs[2] - v1[1] * sn[2]; a1[1] = v1[0] * sn[2] + v1[1] * cs[2];
                            a1[2] = v1[2] * cs[3] - v1[3] * sn[3]; a1[3] = v1[2] * sn[3] + v1[3] * cs[3];
                            v0 = a0; v1 = a1;
                        }
                        if (role == 1) { v0 = v0 * QSCALE; v1 = v1 * QSCALE; }
                    } else if (role == 3) {
#pragma unroll
                        for (int e = 0; e < 4; ++e) { v0[e] = gelu_tanh(v0[e]); v1[e] = gelu_tanh(v1[e]); }
                    }
                    u32x4 w; w.x = cvt_pk_bf16(v0[0], v0[1]); w.y = cvt_pk_bf16(v0[2], v0[3]); w.z = cvt_pk_bf16(v1[0], v1[1]); w.w = cvt_pk_bf16(v1[2], v1[3]);
                    *(u32x4*)(O + (size_t)row * 3840 + col0) = w;
                }
        }
    }
};
__device__ __forceinline__ float clamp_fp8(float x) { return __builtin_amdgcn_fmed3f(x, -448.0f, 448.0f); }
__device__ __forceinline__ unsigned cvt4_fp8(float a, float b, float c, float d) { a = clamp_fp8(a); b = clamp_fp8(b); c = clamp_fp8(c); d = clamp_fp8(d); int w = 0; w = __builtin_amdgcn_cvt_pk_fp8_f32(a, b, w, false); w = __builtin_amdgcn_cvt_pk_fp8_f32(c, d, w, true); return (unsigned)w; }
template <bool F8OUT> struct EpiSwiglu {
    static constexpr bool PERM = true, AFTER_DRAIN = false;
    void* O; int ldo; int ntn; float sc;
    __device__ __forceinline__ void operator()(const f32x4 (&acc)[2][2][4][2], const Unit& u, int wr, int wc, int fr, int fq) const {
        const int row0 = u.pm * BM + wr * 64 + fr, col0 = (u.pn % ntn) * HALF + wc * 32 + 8 * fq;
#pragma unroll
        for (int ai = 0; ai < 2; ++ai)
#pragma unroll
            for (int m = 0; m < 4; ++m) {
                const f32x4 g0 = acc[ai][0][m][0] * sc, g1 = acc[ai][0][m][1] * sc, u0 = acc[ai][1][m][0] * sc, u1 = acc[ai][1][m][1] * sc;
                f32x4 r0, r1;
#pragma unroll
                for (int e = 0; e < 4; ++e) { r0[e] = silu_f(g0[e]) * u0[e]; r1[e] = silu_f(g1[e]) * u1[e]; }
                const size_t row = (size_t)(row0 + ai * HALF + m * 16);
                if constexpr (F8OUT) { typedef unsigned u32x2 __attribute__((ext_vector_type(2))); u32x2 w; w.x = cvt4_fp8(r0[0], r0[1], r0[2], r0[3]); w.y = cvt4_fp8(r1[0], r1[1], r1[2], r1[3]);
                    *(u32x2*)((unsigned char*)O + row * ldo + col0) = w; }
                else { u32x4 w; w.x = cvt_pk_bf16(r0[0], r0[1]); w.y = cvt_pk_bf16(r0[2], r0[3]); w.z = cvt_pk_bf16(r1[0], r1[1]); w.w = cvt_pk_bf16(r1[2], r1[3]);
                    *(u32x4*)((bf16_t*)O + row * ldo + col0) = w; }
            }
    }
};
struct EpiResid {
    static constexpr bool PERM = false, AFTER_DRAIN = false;
    const float* resC; const float* resL; float* out; const float* gate; float sc;
    __device__ __forceinline__ void operator()(const f32x4 (&acc)[2][2][4][2], const Unit& u, int wr, int wc, int fr, int fq) const {
        const int bidx = u.pm < 4 ? 4 : ((u.pm - 4) >> 3); const float* res = u.pm < 4 ? resC : resL; const float* gp = gate + bidx * 12288;
        const int row0 = u.pm * BM + wr * 64 + fr;
#pragma unroll
        for (int bj = 0; bj < 2; ++bj)
#pragma unroll
            for (int n = 0; n < 2; ++n) {
                const int col = u.pn * BM + bj * HALF + wc * 32 + 16 * n + 4 * fq; const f32x4 g4 = *(const f32x4*)(gp + col);
#pragma unroll
                for (int ai = 0; ai < 2; ++ai)
#pragma unroll
                    for (int m = 0; m < 4; ++m) { const size_t off = (size_t)(row0 + ai * HALF + m * 16) * 2048 + col; const f32x4 r = *(const f32x4*)(res + off); *(f32x4*)(out + off) = r + g4 * (acc[ai][bj][m][n] * sc); }
                asm volatile("" ::: "memory");
            }
    }
};
struct EpiF32 {
    static constexpr bool PERM = true, AFTER_DRAIN = false;
    bf16_t* O; int ntn; float sc;
    __device__ __forceinline__ void operator()(const f32x4 (&acc)[2][2][4][2], const Unit& u, int wr, int wc, int fr, int fq) const {
        const int row0 = u.pm * BM + wr * 64 + fr;
#pragma unroll
        for (int bj = 0; bj < 2; ++bj) {
            const int col0 = (u.pn % ntn) * BM + bj * HALF + wc * 32 + 8 * fq;
#pragma unroll
            for (int ai = 0; ai < 2; ++ai)
#pragma unroll
                for (int m = 0; m < 4; ++m) { const f32x4 v0 = acc[ai][bj][m][0] * sc, v1 = acc[ai][bj][m][1] * sc;
                    u32x4 w; w.x = cvt_pk_bf16(v0[0], v0[1]); w.y = cvt_pk_bf16(v0[2], v0[3]); w.z = cvt_pk_bf16(v1[0], v1[1]); w.w = cvt_pk_bf16(v1[2], v1[3]);
                    *(u32x4*)(O + (size_t)(row0 + ai * HALF + m * 16) * 2048 + col0) = w; }
        }
    }
};
template <class Epi> struct EpiSplit {
    static constexpr bool PERM = Epi::PERM, AFTER_DRAIN = false;
    Epi E; float* slab;
    __device__ __forceinline__ void operator()(const f32x4 (&acc)[2][2][4][2], const Unit& u, int wr, int wc, int fr, int fq) const {
        if (u.sid < 0) { E(acc, u, wr, wc, fr, fq); return; }
        f32x4* sp = (f32x4*)slab + (size_t)u.sid * (32 * 512) + (wr * 4 + wc) * 64 + fq * 16 + fr;
#pragma unroll
        for (int ai = 0; ai < 2; ++ai)
#pragma unroll
            for (int bj = 0; bj < 2; ++bj)
#pragma unroll
                for (int m = 0; m < 4; ++m)
#pragma unroll
                    for (int n = 0; n < 2; ++n) sp[(size_t)((((ai * 2 + bj) * 4 + m) * 2) + n) * 512] = acc[ai][bj][m][n];
    }
};
struct TailPlan { int nfull, ntail, S;
    __device__ __forceinline__ void make(int nwg, int G, bool allow, int K) { nfull = (nwg / G) * G; ntail = nwg - nfull;
        S = (!allow || ntail == 0) ? 1 : ((4 * ntail <= G && K % 512 == 0) ? 4 : ((2 * ntail <= G && K % 256 == 0) ? 2 : 1)); } };
template <class Base> struct OrderSplit : Base {
    TailPlan tp;
    __device__ __forceinline__ void plan(bool allow) { tp.make(this->nwg, this->G, allow, this->K); }
    __device__ __forceinline__ bool next(int i, Unit& u) const {
        const long L = (long)i * this->G + this->c;
        if (tp.S == 1) { if (L >= this->nwg) return false; this->map(L, u); return true; }
        if (L < tp.nfull) { this->map(L, u); return true; }
        const int j = (int)(L - tp.nfull); if (j >= tp.ntail * tp.S) return false;
        this->map(tp.nfull + j / tp.S, u); const int ks = j % tp.S, klen = this->K / tp.S; u.k0 = ks * klen; u.nkt = klen / BK; u.sid = j; return true;
    }
    __device__ __forceinline__ bool tail_unit(int& tt, Unit& u) const { if (tp.S == 1 || this->c >= tp.ntail * tp.S) return false; tt = this->c / tp.S; this->map(tp.nfull + tt, u); return true; }
};
struct CachedOrder {
    const PG8_LAS int* tab;
    template <class Ord> __device__ __forceinline__ void fill(const Ord& S, PG8_LAS int* t, int tid) {
        if (tid < 32) { Unit u; u.pm = 0; u.pn = 0; u.k0 = 0; u.nkt = 2; u.sid = -1; const bool ok = S.next(tid, u);
            t[tid * 8 + 0] = ok ? 1 : 0; t[tid * 8 + 1] = u.pm; t[tid * 8 + 2] = u.pn; t[tid * 8 + 3] = u.k0; t[tid * 8 + 4] = u.nkt; t[tid * 8 + 5] = u.sid; }
        tab = t;
    }
    __device__ __forceinline__ bool next(int i, Unit& u) const {
        if (i >= 32) return false;
        const i32x4 a = *(const PG8_LAS i32x4*)(tab + i * 8); const int b0 = tab[i * 8 + 4], b1 = tab[i * 8 + 5];
        if (!__builtin_amdgcn_readfirstlane(a[0])) return false;
        u.pm = __builtin_amdgcn_readfirstlane(a[1]); u.pn = __builtin_amdgcn_readfirstlane(a[2]); u.k0 = __builtin_amdgcn_readfirstlane(a[3]); u.nkt = __builtin_amdgcn_readfirstlane(b0); u.sid = __builtin_amdgcn_readfirstlane(b1); return true;
    }
    __device__ __forceinline__ void a_ready(const Unit&) const {}
    __device__ __forceinline__ void done(const Unit&) const {}
};
struct MapOff : StaticOrder {
    int pm_off;
    __device__ __forceinline__ void map(long L, Unit& u) const { StaticOrder::map(L, u); u.pm += pm_off; }
};
struct MapIn {
    StaticOrder lat; int nwg, G, c, K, nextra;
    __device__ __forceinline__ void init(int G_, int c_, int K_, int nextra_) { lat.init(8192, 3840, G_, c_, K_); G = G_; c = c_; K = K_; nextra = nextra_; nwg = lat.nwg + nextra_; }
    __device__ __forceinline__ void map(long L, Unit& u) const {
        if (L < lat.nwg) { lat.map(L, u); u.pm += 4; return; }
        const int e = (int)(L - lat.nwg);
        if (nextra == 60) { u.pm = e / 15; u.pn = e % 15; } else { u.pm = e / 5; const int idx = e % 5; u.pn = idx < 4 ? 4 + idx : 14; }
        u.k0 = 0; u.nkt = K / BK; u.sid = -1;
    }
    __device__ __forceinline__ void a_ready(const Unit&) const {}
    __device__ __forceinline__ void done(const Unit&) const {}
};
struct MapMoe {
    const PG8_LAS int* tb; int ntn, G, c, K, nwg;
    __device__ __forceinline__ void init(const PG8_LAS int* tb_, int ntn_, int G_, int c_, int K_) { tb = tb_; ntn = ntn_; G = G_; c = c_; K = K_; nwg = tb_[8] * ntn_; }
    __device__ __forceinline__ void map(long L, Unit& u) const {
        int wgid = (int)L; { const int q = nwg / NXCD, r = nwg % NXCD, xcd = wgid % NXCD, off = wgid / NXCD; wgid = (xcd < r ? xcd * (q + 1) : r * (q + 1) + (xcd - r) * q) + off; }
        int e = 0;
#pragma unroll
        for (int k = 1; k < 8; ++k) if (wgid >= tb[k] * ntn) e = k;
        const int t0 = tb[e], Te = tb[e + 1] - t0, local = wgid - t0 * ntn;
        const int nig = WGM * ntn, gid = local / nig, fm = gid * WGM, gsz = (Te - fm) < WGM ? (Te - fm) : WGM;
        u.pm = t0 + fm + ((local % nig) % gsz); u.pn = e * ntn + (local % nig) / gsz; u.k0 = 0; u.nkt = K / BK; u.sid = -1;
    }
    __device__ __forceinline__ void a_ready(const Unit&) const {}
    __device__ __forceinline__ void done(const Unit&) const {}
};

template <class Epi, class Sched, bool ALIGN_EPI = false, bool SP2 = false, bool F8 = false>
__device__ __forceinline__ void gemm_phase(PG8_LAS unsigned char* lds, const Gemm g, const Sched& S, const Epi& E) {
    int tid_o = threadIdx.x; asm volatile("" : "+v"(tid_o));
    const int tid = tid_o, wid = __builtin_amdgcn_readfirstlane(tid >> 6), lane = tid & 63, wr = wid >> 2, wc = wid & 3, fr = lane & 15, fq = lane >> 4;
    const int K = g.K;
    unsigned voffA[2], voffB[2];
#pragma unroll
    for (int i = 0; i < 2; ++i) { int R, C; stage_rc(tid * 16 + i * 8192, R, C); const int Rb = Epi::PERM ? ((R & ~31) + perm32(R & 31)) : R;
        voffA[i] = (unsigned)(R * K + C) * 2u; voffB[i] = (unsigned)(Rb * K + C) * 2u; }
    const size_t kstep = (size_t)(BK * 2);
    const size_t hstep = (size_t)HALF * K * 2;
    const size_t tstep = 2 * hstep;
    const unsigned ldsw = (unsigned)wid * 1024u;
    const int aoff = lds_byte(wr * 64 + fr, fq * 8), boff = lds_byte(wc * 32 + fr, fq * 8);
#define PG8_SA(b, h) (((b) * 2 + (h)) * HTB)
#define PG8_SB(b, h) ((4 + (b) * 2 + (h)) * HTB)
#define PG8_STAGE(bufoff, gbase, voff) do { _Pragma("unroll") for (int _i = 0; _i < 2; ++_i) \
        __builtin_amdgcn_global_load_lds((const unsigned*)((const char*)(gbase) + (voff)[_i]), (PG8_LAS unsigned*)(lds + (bufoff) + ldsw + _i * 8192), 16, 0, 0); } while (0)
#define PG8_LD32(p0_, p1_) __builtin_shufflevector(*(const PG8_LAS i32x4*)(p0_), *(const PG8_LAS i32x4*)(p1_), 0, 1, 2, 3, 4, 5, 6, 7)
#define PG8_LDA(dst, b, h) do { if constexpr (F8) { _Pragma("unroll") for (int m = 0; m < 4; ++m) dst##8[m] = PG8_LD32(lds + PG8_SA(b, h) + aoff + m * 2048, lds + PG8_SA(b, h) + aoff + m * 2048 + 1024); } else { \
        _Pragma("unroll") for (int m = 0; m < 4; ++m) _Pragma("unroll") for (int k = 0; k < 2; ++k) dst[m][k] = *(const PG8_LAS bf16x8*)(lds + PG8_SA(b, h) + aoff + m * 2048 + k * 1024); } } while (0)
#define PG8_LDB(dst, b, h) do { if constexpr (F8) { _Pragma("unroll") for (int n = 0; n < 2; ++n) dst##8[n] = PG8_LD32(lds + PG8_SB(b, h) + boff + n * 2048, lds + PG8_SB(b, h) + boff + n * 2048 + 1024); } else { \
        _Pragma("unroll") for (int n = 0; n < 2; ++n) _Pragma("unroll") for (int k = 0; k < 2; ++k) dst[n][k] = *(const PG8_LAS bf16x8*)(lds + PG8_SB(b, h) + boff + n * 2048 + k * 1024); } } while (0)
#define PG8_MMA(ai, bj, At, Bt) do { __builtin_amdgcn_s_setprio(1); if constexpr (F8) { _Pragma("unroll") for (int m = 0; m < 4; ++m) _Pragma("unroll") for (int n = 0; n < 2; ++n) \
        asm volatile("v_mfma_f32_16x16x128_f8f6f4 %0, %1, %2, %0" : "+v"(acc[ai][bj][m][n]) : "v"(Bt##8[n]), "v"(At##8[m])); } else { \
        _Pragma("unroll") for (int m = 0; m < 4; ++m) _Pragma("unroll") for (int n = 0; n < 2; ++n) _Pragma("unroll") for (int k = 0; k < 2; ++k) \
        acc[ai][bj][m][n] = __builtin_amdgcn_mfma_f32_16x16x32_bf16(Bt[n][k], At[m][k], acc[ai][bj][m][n], 0, 0, 0); } __builtin_amdgcn_s_setprio(0); } while (0)
#define PG8_WAIT_V(n) asm volatile("s_waitcnt vmcnt(" #n ")" ::: "memory")
#define PG8_WAIT_L(n) asm volatile("s_waitcnt lgkmcnt(" #n ")" ::: "memory")
#define PG8_BAR __builtin_amdgcn_s_barrier()
#define PG8_SCHED __builtin_amdgcn_sched_barrier(0)
    Unit cur, nxt; int ui = 0;
    if (!S.next(0, cur)) return;
    f32x4 acc[2][2][4][2];
#pragma unroll
    for (int a = 0; a < 2; ++a)
#pragma unroll
        for (int b = 0; b < 2; ++b)
#pragma unroll
            for (int m = 0; m < 4; ++m)
#pragma unroll
                for (int n = 0; n < 2; ++n) acc[a][b][m][n] = (f32x4){0.f, 0.f, 0.f, 0.f};
    bf16x8 At[4][2], B0[2][2], B1[2][2]; i32x8 At8[4], B08[2], B18[2];
    const char* cA = (const char*)g.A + (size_t)cur.pm * tstep + (size_t)cur.k0 * 2; const char* cB = (const char*)g.Bt + (size_t)cur.pn * tstep + (size_t)cur.k0 * 2;
    S.a_ready(cur);
    if constexpr (SP2) {
        PG8_STAGE(PG8_SB(0, 0), cB, voffB); PG8_STAGE(PG8_SB(0, 1), cB + hstep, voffB); PG8_STAGE(PG8_SA(0, 0), cA, voffA); PG8_STAGE(PG8_SA(0, 1), cA + hstep, voffA);
        if (wr == 1) PG8_BAR;
        PG8_WAIT_V(2); PG8_BAR;
        PG8_STAGE(PG8_SB(1, 0), cB + kstep, voffB); PG8_STAGE(PG8_SA(1, 0), cA + kstep, voffA); PG8_STAGE(PG8_SB(1, 1), cB + hstep + kstep, voffB);
        PG8_WAIT_V(6); PG8_BAR;
    } else {
        PG8_STAGE(PG8_SB(0, 0), cB, voffB); PG8_STAGE(PG8_SA(0, 0), cA, voffA); PG8_STAGE(PG8_SB(0, 1), cB + hstep, voffB); PG8_STAGE(PG8_SA(0, 1), cA + hstep, voffA);
        if (wr == 1) PG8_BAR;
        PG8_WAIT_V(4); PG8_BAR;
        PG8_STAGE(PG8_SB(1, 0), cB + kstep, voffB); PG8_STAGE(PG8_SA(1, 0), cA + kstep, voffA); PG8_STAGE(PG8_SB(1, 1), cB + hstep + kstep, voffB);
        PG8_WAIT_V(6); PG8_BAR;
    }
    for (;;) {
        const bool has_next = S.next(ui + 1, nxt);
        const char* nA = has_next ? (const char*)g.A + (size_t)nxt.pm * tstep + (size_t)nxt.k0 * 2 : cA; const char* nB = has_next ? (const char*)g.Bt + (size_t)nxt.pn * tstep + (size_t)nxt.k0 * 2 : cB;
        const int nt = cur.nkt;
        for (int t = 0; t < nt; t += 2) {
            const bool last = (t == nt - 2);
            const char* a1 = cA + (size_t)(t + 1) * kstep;
            const char* a2 = last ? nA : cA + (size_t)(t + 2) * kstep; const char* b2 = last ? nB : cB + (size_t)(t + 2) * kstep;
            const char* a3 = a2 + kstep; const char* b3 = b2 + kstep;
            if (last && has_next) S.a_ready(nxt);
            if constexpr (SP2) {
            PG8_LDB(B0, 0, 0); PG8_LDB(B1, 0, 1); PG8_SCHED; PG8_LDA(At, 0, 0); PG8_STAGE(PG8_SA(1, 1), a1 + hstep, voffA);
            PG8_WAIT_V(8); PG8_WAIT_L(0); PG8_BAR; PG8_MMA(0, 0, At, B0); PG8_MMA(0, 1, At, B1); PG8_BAR; PG8_SCHED;
            PG8_LDA(At, 0, 1); PG8_STAGE(PG8_SB(0, 0), b2, voffB); PG8_STAGE(PG8_SB(0, 1), b2 + hstep, voffB); PG8_STAGE(PG8_SA(0, 0), a2, voffA);
            PG8_WAIT_V(8); PG8_WAIT_L(0); PG8_BAR; PG8_MMA(1, 0, At, B0); PG8_MMA(1, 1, At, B1); PG8_BAR; PG8_SCHED;
            PG8_LDB(B0, 1, 0); PG8_LDB(B1, 1, 1); PG8_SCHED; PG8_LDA(At, 1, 0); PG8_STAGE(PG8_SA(0, 1), a2 + hstep, voffA);
            PG8_WAIT_V(8); PG8_WAIT_L(0); PG8_BAR; PG8_MMA(0, 0, At, B0); PG8_MMA(0, 1, At, B1); PG8_BAR; PG8_SCHED;
            PG8_LDA(At, 1, 1); PG8_STAGE(PG8_SB(1, 0), b3, voffB); PG8_STAGE(PG8_SB(1, 1), b3 + hstep, voffB); PG8_STAGE(PG8_SA(1, 0), a3, voffA);
            PG8_WAIT_V(8); PG8_WAIT_L(0); PG8_BAR; PG8_MMA(1, 0, At, B0); PG8_MMA(1, 1, At, B1); PG8_BAR; PG8_SCHED;
            } else {
            PG8_LDB(B0, 0, 0); PG8_SCHED; PG8_LDA(At, 0, 0); PG8_STAGE(PG8_SA(1, 1), a1 + hstep, voffA);
            PG8_WAIT_L(8); PG8_BAR; PG8_WAIT_L(0); PG8_MMA(0, 0, At, B0); PG8_BAR; PG8_SCHED;
            PG8_LDB(B1, 0, 1); PG8_STAGE(PG8_SB(0, 0), b2, voffB);
            PG8_BAR; PG8_WAIT_L(0); PG8_MMA(0, 1, At, B1); PG8_BAR;
            PG8_LDA(At, 0, 1); PG8_STAGE(PG8_SA(0, 0), a2, voffA);
            PG8_BAR; PG8_WAIT_L(0); PG8_MMA(1, 0, At, B0); PG8_BAR; PG8_SCHED;
            PG8_STAGE(PG8_SB(0, 1), b2 + hstep, voffB);
            PG8_WAIT_V(6); PG8_BAR; PG8_MMA(1, 1, At, B1); PG8_BAR;
            PG8_LDB(B0, 1, 0); PG8_SCHED; PG8_LDA(At, 1, 0); PG8_STAGE(PG8_SA(0, 1), a2 + hstep, voffA);
            PG8_WAIT_L(8); PG8_BAR; PG8_WAIT_L(0); PG8_MMA(0, 0, At, B0); PG8_BAR; PG8_SCHED;
            PG8_LDB(B1, 1, 1); PG8_STAGE(PG8_SB(1, 0), b3, voffB);
            PG8_BAR; PG8_WAIT_L(0); PG8_MMA(0, 1, At, B1); PG8_BAR;
            PG8_LDA(At, 1, 1); PG8_STAGE(PG8_SA(1, 0), a3, voffA);
            PG8_BAR; PG8_WAIT_L(0); PG8_MMA(1, 0, At, B0); PG8_BAR; PG8_SCHED;
            PG8_STAGE(PG8_SB(1, 1), b3 + hstep, voffB);
            PG8_WAIT_V(6); PG8_BAR; PG8_MMA(1, 1, At, B1); PG8_BAR;
            }
        }
        if constexpr (ALIGN_EPI) { if (wr == 0) PG8_BAR; }
        if constexpr (F8) asm volatile("s_nop 15\n\ts_nop 7" ::: "memory");
        if constexpr (!Epi::AFTER_DRAIN) { E(acc, cur, wr, wc, fr, fq); S.done(cur); }
        if (!has_next) break;
#pragma unroll
        for (int a = 0; a < 2; ++a)
#pragma unroll
            for (int b = 0; b < 2; ++b)
#pragma unroll
                for (int m = 0; m < 4; ++m)
#pragma unroll
                    for (int n = 0; n < 2; ++n) acc[a][b][m][n] = (f32x4){0.f, 0.f, 0.f, 0.f};
        cur = nxt; cA = nA; cB = nB; ++ui;
        if constexpr (ALIGN_EPI) { if (wr == 1) PG8_BAR; }
    }
    PG8_WAIT_V(0);
    if constexpr (!ALIGN_EPI) { if (wr == 0) PG8_BAR; }
    PG8_BAR;
    if constexpr (Epi::AFTER_DRAIN) { E.fused(acc, cur, wr, wc, fr, fq, lds, wid, lane); S.done(cur); }
#undef PG8_SA
#undef PG8_SB
#undef PG8_STAGE
#undef PG8_LDA
#undef PG8_LDB
#undef PG8_MMA
#undef PG8_LD32
#undef PG8_WAIT_V
#undef PG8_WAIT_L
#undef PG8_BAR
#undef PG8_SCHED
}
}

constexpr int D = 2048, NB = 4, SEQ = 2048, CTX = 256, DFF = 5632, NE = 8, INC = 3840, MODN = 12288;
constexpr int RC = NB * CTX, RL = NB * SEQ, RT = RC + RL;
constexpr int NTN_UP = DFF / 128;
constexpr int MAXSLOT = 2 * RL + NE * 256;
constexpr float EPS = 1e-6f, LOG2E = 1.4426950408889634f;
constexpr int NWAVES = 8;
#ifndef MK_PER_PHASE
#define MK_PER_PHASE 0
#endif
constexpr int NPHASE = 17;
#ifndef MOE_F8_ON
#define MOE_F8_ON 1
#endif
#ifndef DENSE_UP_F8_ON
#define DENSE_UP_F8_ON 1
#endif
#ifndef DENSE_DN_F8_ON
#define DENSE_DN_F8_ON 0
#endif
constexpr bool DENSE_UP_F8 = DENSE_UP_F8_ON != 0, DENSE_DN_F8 = DENSE_DN_F8_ON != 0;
constexpr bool MOE_F8 = MOE_F8_ON != 0;

constexpr size_t MiB = 1u << 20;
constexpr size_t WS_CTL = 0, CTL_ZERO_BYTES = 1 * MiB;
constexpr size_t WS_MOD = 1 * MiB;
constexpr size_t WS_ROPE = 1 * MiB + 512 * 1024;
constexpr size_t WS_ROUTE = 1 * MiB + 768 * 1024;
constexpr size_t WS_WIN = 2 * MiB, WS_WOUT = 32 * MiB, WS_W13 = 48 * MiB, WS_W2 = 92 * MiB, WS_MW13 = 114 * MiB, WS_MW2 = 466 * MiB;
constexpr size_t WS_H = 642 * MiB;
constexpr size_t WS_XN = 714 * MiB;
constexpr size_t WS_PALL = 750 * MiB;
constexpr size_t WS_MIX = 818 * MiB;
constexpr size_t WS_ACT = 854 * MiB;
constexpr size_t WS_XG = 1052 * MiB;
constexpr size_t WS_Y = 1124 * MiB;
constexpr size_t WS_SLAB = 1268 * MiB;
constexpr size_t WS_END = 1332 * MiB;
constexpr int CW_TMO = 0, CW_CODE = 1, CW_BAR = 4096, CW_CNT = 8192;
constexpr int CW_TK = 16384;
constexpr int CW_Q0 = 9216, CW_Q1 = 9280, CW_DONE = 9344;

constexpr int RING_BYTES = 131072, LDSCTL_OFF = 139264, MISC_OFF = LDSCTL_OFF + 320, TB_OFF = LDSCTL_OFF + 512, FLAG_OFF = LDSCTL_OFF + 256, UT_OFF = LDSCTL_OFF + 1024, LDS_BYTES = 147456;

typedef unsigned short bf16;
typedef unsigned v4u __attribute__((ext_vector_type(4)));
typedef unsigned v2u __attribute__((ext_vector_type(2)));
typedef float f32x4 __attribute__((ext_vector_type(4)));
typedef float f32x16 __attribute__((ext_vector_type(16)));
typedef short bf16x8 __attribute__((ext_vector_type(8)));
typedef short v4i16_t __attribute__((ext_vector_type(4)));
typedef GAS unsigned gu32;
#define RLX_AGENT __ATOMIC_RELAXED, __HIP_MEMORY_SCOPE_AGENT
#define LDS_WAIT() asm volatile("s_waitcnt lgkmcnt(0)" ::: "memory")
__device__ __forceinline__ unsigned f2bf(float f) { unsigned u = __builtin_bit_cast(unsigned, f); return (u + 0x7fffu + ((u >> 16) & 1u)) >> 16; }
__device__ __forceinline__ unsigned pk2(float lo, float hi) { return f2bf(lo) | (f2bf(hi) << 16); }
__device__ __forceinline__ float bf2f(unsigned short b) { return __builtin_bit_cast(float, (unsigned)b << 16); }
__device__ __forceinline__ float wave_sum(float v) {
#pragma unroll
    for (int o = 1; o < 64; o <<= 1) v += __shfl_xor(v, o);
    return v;
}

#define XB_TMO      128
#define XB_XCNT(j)  (256  + 64 * (j))
#define XB_XSUB(j)  (1280 + 64 * (j))
#define XB_XGEN(j)  (2304 + 64 * (j))
#define XB_TOP      3328
#define XB_TOPGEN   3392
#define XCD_BAR_WORDS 3456
#define XB_SPIN_CAP (1u << 18)

__device__ __forceinline__ unsigned xb_ld(unsigned* p)              { return __hip_atomic_load(p, __ATOMIC_RELAXED, __HIP_MEMORY_SCOPE_AGENT); }
__device__ __forceinline__ unsigned xb_add(unsigned* p, unsigned v) { return __hip_atomic_fetch_add(p, v, __ATOMIC_RELAXED, __HIP_MEMORY_SCOPE_AGENT); }
__device__ __forceinline__ unsigned xb_xcc_id() { return (unsigned)__builtin_amdgcn_s_getreg((3 << 11) | 20) & 0xFu; }
#define XB_SPIN(cond, bar) do { unsigned _sp = 0; while (cond) { __builtin_amdgcn_s_sleep(1); \
    if ((++_sp & 255u) == 0u) { if (xb_ld(&(bar)[XB_TMO])) break; if (_sp > XB_SPIN_CAP) { atomicAdd(&(bar)[XB_TMO], 1u); break; } } } } while (0)

struct XcdBarrier {
    unsigned* bar; unsigned x;
    volatile LAS unsigned* st;
};

__device__ __forceinline__ XcdBarrier xcd_barrier_post(unsigned* bar, volatile LAS unsigned* st) {
    XcdBarrier b; b.bar = bar; b.x = xb_xcc_id(); b.st = st;
    if (threadIdx.x == 0) (void)xb_add(&bar[XB_XCNT(b.x)], 1u);
    return b;
}
__device__ __forceinline__ void xcd_barrier_complete(unsigned* bar, unsigned x, unsigned& nloc, unsigned& nx) {
    const unsigned G = gridDim.x * gridDim.y * gridDim.z;
    unsigned sum, cnt, mine, sp = 0u;
    for (;;) {
        sum = 0u; cnt = 0u; mine = 0u;
#pragma unroll
        for (unsigned j = 0; j < 16; ++j) { const unsigned c = xb_ld(&bar[XB_XCNT(j)]); sum += c; cnt += (c > 0u) ? 1u : 0u; mine = (j == x) ? c : mine; }
        if (sum == G) break;
        __builtin_amdgcn_s_sleep(1);
        if ((++sp & 255u) == 0u) { if (xb_ld(&bar[XB_TMO])) break; if (sp > XB_SPIN_CAP) { atomicAdd(&bar[XB_TMO], 1u); break; } }
    }
    nloc = mine > 0u ? mine : 1u; nx = cnt > 0u ? cnt : 1u;
}

__device__ __attribute__((noinline)) void xcd_barrier(const XcdBarrier b) {
    asm volatile("s_waitcnt vmcnt(0)" ::: "memory");
    __syncthreads();
    if (threadIdx.x == 0) {
        unsigned* bar = b.bar;
        __builtin_amdgcn_s_waitcnt(0);
        unsigned nloc = b.st[0], nx = b.st[1];
        if (nloc == 0u) { xcd_barrier_complete(bar, b.x, nloc, nx); b.st[0] = nloc; b.st[1] = nx; }
        const unsigned old = xb_add(&bar[XB_XSUB(b.x)], 1u);
        const unsigned gen = old / nloc;
        if (old + 1u == (gen + 1u) * nloc) {
            __builtin_amdgcn_fence(__ATOMIC_RELEASE, "agent");
            asm volatile("s_waitcnt vmcnt(0)" ::: "memory");
            const unsigned og = xb_add(&bar[XB_TOP], 1u);
            const unsigned tg = og / nx;
            if (og + 1u == (tg + 1u) * nx) xb_add(&bar[XB_TOPGEN], 1u);
            else XB_SPIN(xb_ld(&bar[XB_TOPGEN]) == tg, bar);
            __builtin_amdgcn_fence(__ATOMIC_ACQUIRE, "agent");
            xb_add(&bar[XB_XGEN(b.x)], 1u);
            asm volatile("s_waitcnt vmcnt(0)" ::: "memory");
        } else {
            XB_SPIN(xb_ld(&bar[XB_XGEN(b.x)]) == gen, bar);
            __builtin_amdgcn_fence(__ATOMIC_ACQUIRE, "agent");
            asm volatile("s_waitcnt vmcnt(0)" ::: "memory");
        }
    }
    __syncthreads();
}

struct Args { const float* in[27]; float* out; unsigned char* ws; int ph_lo, ph_hi; };
#define CAS __attribute__((address_space(4)))
typedef const CAS unsigned char* kaptr;
__device__ __forceinline__ kaptr ka_get() { kaptr p = (kaptr)__builtin_amdgcn_kernarg_segment_ptr(); asm volatile("" : "+s"(p)); return p; }
#define KIN(kp, i) (*(const float* const CAS*)((kp) + 8 * (i)))
#define KOUT(kp) (*(float* const CAS*)((kp) + 216))
#define KWS(kp) (*(unsigned char* const CAS*)((kp) + 224))
#define KLO(kp) (*(const int CAS*)((kp) + 232))
#define KHI(kp) (*(const int CAS*)((kp) + 236))
static_assert(sizeof(Args) == 240, "Args layout");

__device__ __forceinline__ int dst_row(int mode, int n) {
    if (mode == 1) {
        const bool qk = (n >= 512 && n < 1536) || (n >= 3072 && n < 3712);
        if (qk) { const int d = n & 63; return (n & ~63) + (d < 32 ? 2 * d : 2 * (d - 32) + 1); }
        return n;
    }
    if (mode == 2) return (n >> 7) * 256 + (n & 127);
    if (mode == 3) return (n >> 7) * 256 + 128 + (n & 127);
    return n;
}
constexpr int TSCR = 64 * 65 * 4;
template <bool NTL>
__device__ __forceinline__ void ti_load(const float* W, int N, int item, int lane, f32x4 (&v)[16]) {
    const int nblk = N / 64, kb = item / nblk, nb = item % nblk, k0 = 64 * kb, n0 = 64 * nb;
    const GAS f32x4* src = (const GAS f32x4*)(W + (size_t)(k0 + (lane >> 4)) * N + n0 + 4 * (lane & 15));
#pragma unroll
    for (int i = 0; i < 16; ++i) v[i] = NTL ? __builtin_nontemporal_load(src + (size_t)i * N) : src[(size_t)i * N];
}
template <bool NTS, bool F8>
__device__ __forceinline__ void ti_store(const f32x4 (&v)[16], int K, int N, bf16* WT, int mode, LAS float* scr, int item, int lane) {
    const int nblk = N / 64, kb = item / nblk, nb = item % nblk, k0 = 64 * kb, n0 = 64 * nb;
    LAS float* wp = scr + (lane >> 4) * 65 + 4 * (lane & 15);
#pragma unroll
    for (int i = 0; i < 16; ++i) { wp[i * 4 * 65 + 0] = v[i].x; wp[i * 4 * 65 + 1] = v[i].y; wp[i * 4 * 65 + 2] = v[i].z; wp[i * 4 * 65 + 3] = v[i].w; }
    LDS_WAIT(); asm volatile("" ::: "memory");
    if constexpr (F8) {
        const int c = lane & 3;
#pragma unroll
        for (int j = 0; j < 4; ++j) { const int n = (lane >> 2) + 16 * j; const LAS float* s = scr + (16 * c) * 65 + n;
            v4u o;
#pragma unroll
            for (int q = 0; q < 4; ++q) o[q] = pg8::cvt4_fp8(256.0f * s[(4 * q) * 65], 256.0f * s[(4 * q + 1) * 65], 256.0f * s[(4 * q + 2) * 65], 256.0f * s[(4 * q + 3) * 65]);
            GAS v4u* dp = (GAS v4u*)((unsigned char*)WT + (size_t)dst_row(mode, n0 + n) * K + k0 + 16 * c); if (NTS) __builtin_nontemporal_store(o, dp); else *dp = o; }
    } else {
        const int c = lane & 7;
#pragma unroll
        for (int j = 0; j < 8; ++j) { const int n = (lane >> 3) + 8 * j; const LAS float* s = scr + (8 * c) * 65 + n;
            v4u o; o.x = pk2(s[0 * 65], s[1 * 65]); o.y = pk2(s[2 * 65], s[3 * 65]); o.z = pk2(s[4 * 65], s[5 * 65]); o.w = pk2(s[6 * 65], s[7 * 65]);
            GAS v4u* dp = (GAS v4u*)(WT + (size_t)dst_row(mode, n0 + n) * K + k0 + 8 * c); if (NTS) __builtin_nontemporal_store(o, dp); else *dp = o; }
    }
    LDS_WAIT(); asm volatile("" ::: "memory");
}
template <bool NT, bool F8 = false, bool NTL = false>
__device__ __forceinline__ void transpose_item(const float* W, int K, int N, bf16* WT, int mode, LAS float* scr, int item, int lane, const float*) {
    f32x4 v[16]; ti_load<NT || NTL>(W, N, item, lane, v); ti_store<NT, F8>(v, K, N, WT, mode, scr, item, lane);
}
__device__ __forceinline__ void p0_prologue(kaptr kp, LAS unsigned char* lds, int vcu, int G, int tid, int lane, int wave) {
    unsigned char* ws = KWS(kp);
    for (int j = vcu; j < 256; j += G) {
        const int l = j >> 7, g = (j >> 5) & 3, k0 = (j & 31) * 64;
        LAS float* As = (LAS float*)lds;
        LAS float* Ps = As + 64 * 132;
        const float* Wsrc = KIN(kp, 8) + (size_t)l * D * INC + (size_t)k0 * INC + g * 128;
        const float* Psrc = KIN(kp, 10) + ((size_t)l * 4 + g) * 128 * 128;
#pragma unroll
        for (int i = 0; i < 4; ++i) { const int idx = tid + 512 * i, r = idx >> 5, c4 = idx & 31; *(LAS f32x4*)(As + r * 132 + 4 * c4) = *(const GAS f32x4*)(Wsrc + (size_t)r * INC + 4 * c4); }
#pragma unroll
        for (int i = 0; i < 8; ++i) { const int idx = tid + 512 * i, r = idx >> 5, c4 = idx & 31; *(LAS f32x4*)(Ps + r * 132 + 4 * c4) = *(const GAS f32x4*)(Psrc + (size_t)r * 128 + 4 * c4); }
        __syncthreads();
        const int n4 = tid & 31, kq = tid >> 5;
        f32x4 acc[4];
#pragma unroll
        for (int i = 0; i < 4; ++i) acc[i] = (f32x4){0.f, 0.f, 0.f, 0.f};
#pragma unroll 4
        for (int c = 0; c < 128; ++c) { const f32x4 pv = *(const LAS f32x4*)(Ps + c * 132 + 4 * n4);
#pragma unroll
            for (int i = 0; i < 4; ++i) acc[i] += As[(4 * kq + i) * 132 + c] * pv; }
        bf16* WT = (bf16*)(ws + WS_WIN) + (size_t)l * INC * D;
#pragma unroll
        for (int e = 0; e < 4; ++e) { v2u o; o.x = pk2(acc[0][e], acc[1][e]); o.y = pk2(acc[2][e], acc[3][e]);
            *(GAS v2u*)(WT + (size_t)(g * 128 + 4 * n4 + e) * D + k0 + 4 * kq) = o; }
        __syncthreads();
    }
    for (int j = vcu; j < 192; j += G) {
        const int l = j / 96, n0 = (j % 96) * 128;
        LAS float* S = (LAS float*)lds; LAS float* red = S + 5 * 2048;
        for (int idx = tid; idx < 5 * 2048; idx += NWAVES * 64) { const int i = idx >> 11, k = idx & 2047; const float v = i < 4 ? KIN(kp, 1)[i * 2048 + k] : KIN(kp, 3)[k]; S[idx] = v / (1.0f + expf(-v)); }
        __syncthreads();
        f32x4 acc[5];
#pragma unroll
        for (int i = 0; i < 5; ++i) acc[i] = (f32x4){0.f, 0.f, 0.f, 0.f};
        const int kh = lane >> 5;
        const GAS f32x4* wp = (const GAS f32x4*)(KIN(kp, 4) + ((size_t)l * 2048 + wave * 256 + kh) * MODN + n0 + 4 * (lane & 31));
#pragma unroll 8
        for (int k = 0; k < 128; ++k) { const f32x4 w = __builtin_nontemporal_load(wp + (size_t)k * (2 * MODN / 4));
#pragma unroll
            for (int i = 0; i < 5; ++i) acc[i] += S[i * 2048 + wave * 256 + 2 * k + kh] * w; }
#pragma unroll
        for (int i = 0; i < 5; ++i) { f32x4 t = acc[i]; t.x += __shfl_xor(t.x, 32); t.y += __shfl_xor(t.y, 32); t.z += __shfl_xor(t.z, 32); t.w += __shfl_xor(t.w, 32);
            if (kh == 0) *(LAS f32x4*)(red + (wave * 5 + i) * 128 + 4 * (lane & 31)) = t; }
        __syncthreads();
        for (int idx = tid; idx < 640; idx += NWAVES * 64) { const int i = idx >> 7, n = idx & 127; float s = 0.f;
#pragma unroll
            for (int w = 0; w < 8; ++w) s += red[(w * 5 + i) * 128 + n];
            ((float*)(ws + WS_MOD))[(l * 5 + i) * MODN + n0 + n] = s + KIN(kp, 5)[l * MODN + n0 + n]; }
        __syncthreads();
    }
    if (vcu == (200 % G)) {
        for (int idx = tid; idx < 1024; idx += NWAVES * 64) { const int pos = idx >> 4, f = idx & 15; const float inv = powf(10000.0f, -(float)f / 16.0f); const float ang = (float)pos * inv;
            ((float*)(ws + WS_ROPE))[idx] = cosf(ang); ((float*)(ws + WS_ROPE))[1024 + idx] = sinf(ang); }
    }
    __syncthreads();
    LAS float* scr = (LAS float*)(lds + wave * TSCR);
    constexpr int I_IN = 32 * 52, I_OUT = 32 * 32, I_UP = 32 * 88, I_DN = 88 * 32;
    constexpr int NITEMS = 2 * I_IN + 2 * I_OUT + 2 * I_UP + I_DN;
    unsigned* q0 = (unsigned*)(ws + WS_CTL) + CW_Q0;
#define P0_DESC(it_, W_, K_, N_, WT_, M_, I_, F_) do { int r = (it_); F_ = false; \
        if (r < 2 * I_IN) { const int l = r / I_IN; W_ = KIN(kp, 8) + (size_t)l * D * INC; K_ = D; N_ = INC; WT_ = (bf16*)(ws + WS_WIN) + (size_t)l * INC * D; M_ = 1; const int q = r % I_IN; I_ = (q / 52) * 60 + 8 + (q % 52); } \
        else if ((r -= 2 * I_IN) < 2 * I_OUT) { const int l = r / I_OUT; W_ = KIN(kp, 9) + (size_t)l * D * D; K_ = D; N_ = D; WT_ = (bf16*)(ws + WS_WOUT) + (size_t)l * D * D; M_ = 0; I_ = r % I_OUT; } \
        else if ((r -= 2 * I_OUT) < I_UP) { W_ = KIN(kp, 19); K_ = D; N_ = DFF; WT_ = (bf16*)(ws + WS_W13); M_ = 2; I_ = r; F_ = DENSE_UP_F8; } \
        else if ((r -= I_UP) < I_UP) { W_ = KIN(kp, 20); K_ = D; N_ = DFF; WT_ = (bf16*)(ws + WS_W13); M_ = 3; I_ = r; F_ = DENSE_UP_F8; } \
        else { r -= I_UP; W_ = KIN(kp, 21); K_ = DFF; N_ = D; WT_ = (bf16*)(ws + WS_W2); M_ = 0; I_ = r; F_ = DENSE_DN_F8; } } while (0)
    for (;;) {
        unsigned k0 = 0; if (lane == 0) k0 = __hip_atomic_fetch_add(q0, 2u, RLX_AGENT);
        const int kb = (int)__builtin_amdgcn_readfirstlane(k0); if (kb >= NITEMS) break;
        const float* Wa; int Ka, Na, ma, ia; bf16* WTa; bool fa; f32x4 va[16];
        P0_DESC(kb, Wa, Ka, Na, WTa, ma, ia, fa); ti_load<true>(Wa, Na, ia, lane, va);
        const bool two = kb + 1 < NITEMS;
        const float* Wb = Wa; int Kb = Ka, Nb = Na, mb = ma, ib = ia; bf16* WTb = WTa; bool fb = fa; f32x4 vb[16];
        if (two) { P0_DESC(kb + 1, Wb, Kb, Nb, WTb, mb, ib, fb); ti_load<true>(Wb, Nb, ib, lane, vb); }
        if (fa) ti_store<false, true>(va, Ka, Na, WTa, ma, scr, ia, lane); else ti_store<false, false>(va, Ka, Na, WTa, ma, scr, ia, lane);
        if (two) { if (fb) ti_store<false, true>(vb, Kb, Nb, WTb, mb, scr, ib, lane); else ti_store<false, false>(vb, Kb, Nb, WTb, mb, scr, ib, lane); }
    }
#undef P0_DESC
}

__device__ __attribute__((noinline)) void fill_tail(unsigned char* ws, const float* w1, const float* w3, const float* w2, unsigned* done, int G, int nw) {
    extern __shared__ __attribute__((aligned(16))) unsigned char lds_fill[];
    LAS unsigned char* lds = (LAS unsigned char*)lds_fill;
    const int tid = threadIdx.x, lane = tid & 63, wave = __builtin_amdgcn_readfirstlane(tid >> 6);
    volatile LAS unsigned* flag = (volatile LAS unsigned*)(lds + FLAG_OFF);
    __syncthreads();
    if (tid == 0) { unsigned f = 0u; if (done) { const unsigned old = __hip_atomic_fetch_add(done, 1u, RLX_AGENT); f = (old + 1u >= (unsigned)G) ? 1u : 0u; } *flag = f; }
    __syncthreads();
    LAS float* scr = (LAS float*)(lds + wave * TSCR);
    unsigned* q1 = (unsigned*)(ws + WS_CTL) + CW_Q1;
    constexpr int I_UP = 32 * 88, NIT = 24 * I_UP;
#ifndef FILLW
#define FILLW 2
#endif
#ifndef FILLB
#define FILLB 4
#endif
#ifdef PROBE_BURN
    if (done && wave >= FILLW) {
        f32x16 acc; for (int r = 0; r < 16; ++r) acc[r] = 0.f; const bf16x8 a = (bf16x8){1, 2, 3, 4, 5, 6, 7, 8};
        while (!*flag) { for (int it = 0; it < 64; ++it) acc = __builtin_amdgcn_mfma_f32_32x32x16_bf16(a, a, acc, 0, 0, 0); if (__hip_atomic_load(done, RLX_AGENT) >= (unsigned)G) break; }
        if (acc[0] == 12345.f) *flag = 2u;
        return; }
#endif
    if (done && wave >= nw) return;
#define FILL_ITEM(it_) do { const int it__ = (it_); const int seg = it__ / I_UP, item = it__ % I_UP, mat = seg >> 3, e = seg & 7; \
        if (mat == 0) transpose_item<true, MOE_F8>(w1 + (size_t)e * D * DFF, D, DFF, (bf16*)(ws + WS_MW13 + (size_t)e * 2 * DFF * D * (MOE_F8 ? 1 : 2)), 2, scr, item, lane, nullptr); \
        else if (mat == 1) transpose_item<true, MOE_F8>(w3 + (size_t)e * D * DFF, D, DFF, (bf16*)(ws + WS_MW13 + (size_t)e * 2 * DFF * D * (MOE_F8 ? 1 : 2)), 3, scr, item, lane, nullptr); \
        else transpose_item<true, MOE_F8>(w2 + (size_t)e * DFF * D, DFF, D, (bf16*)(ws + WS_MW2 + (size_t)e * D * DFF * (MOE_F8 ? 1 : 2)), 0, scr, item, lane, nullptr); } while (0)
    if (!done) return;
    for (;;) {
        if (*flag) break;
        if (tid == 0) { if (__hip_atomic_load(done, RLX_AGENT) >= (unsigned)G) *flag = 1u; }
        if (*flag) break;
        unsigned k0 = 0; if (lane == 0) k0 = __hip_atomic_fetch_add(q1, (unsigned)FILLB, RLX_AGENT);
        const int kb = (int)__builtin_amdgcn_readfirstlane(k0); if (kb >= NIT) break;
        for (int it = kb; it < kb + FILLB && it < NIT; ++it) FILL_ITEM(it);
    }
#undef FILL_ITEM
}

__device__ __forceinline__ void drain_tail(unsigned char* ws, const float* w1, const float* w3, const float* w2, int G, LAS unsigned char* lds) {
    int tid = threadIdx.x; asm volatile("" : "+v"(tid));
    const int lane = tid & 63, wave = __builtin_amdgcn_readfirstlane(tid >> 6);
    __syncthreads();
    LAS float* scr = (LAS float*)(lds + wave * TSCR);
    unsigned* q1 = (unsigned*)(ws + WS_CTL) + CW_Q1;
    constexpr int I_UP = 32 * 88, NIT = 24 * I_UP;
        const int h = (int)__builtin_amdgcn_readfirstlane(__hip_atomic_load(q1, RLX_AGENT));
        const int gwv = blockIdx.x * NWAVES + wave, ngw = G * NWAVES;
#define MOE_DESC(it_, W_, K_, N_, WT_, M_, I_) do { const int seg_ = (it_) / I_UP, mat_ = seg_ >> 3, e_ = seg_ & 7; I_ = (it_) % I_UP; \
        if (mat_ == 0) { W_ = w1 + (size_t)e_ * D * DFF; K_ = D; N_ = DFF; WT_ = (bf16*)(ws + WS_MW13 + (size_t)e_ * 2 * DFF * D * (MOE_F8 ? 1 : 2)); M_ = 2; } \
        else if (mat_ == 1) { W_ = w3 + (size_t)e_ * D * DFF; K_ = D; N_ = DFF; WT_ = (bf16*)(ws + WS_MW13 + (size_t)e_ * 2 * DFF * D * (MOE_F8 ? 1 : 2)); M_ = 3; } \
        else { W_ = w2 + (size_t)e_ * DFF * D; K_ = DFF; N_ = D; WT_ = (bf16*)(ws + WS_MW2 + (size_t)e_ * D * DFF * (MOE_F8 ? 1 : 2)); M_ = 0; } } while (0)
        int it = h + gwv;
        if (it < NIT) {
            const float* W; int K, N, md, item; bf16* WT; f32x4 v[16];
            MOE_DESC(it, W, K, N, WT, md, item); ti_load<true>(W, N, item, lane, v);
            for (;;) {
                const int nx = it + ngw; const float* Wn = W; int Kn = K, Nn = N, mdn = md, itemn = item; bf16* WTn = WT; f32x4 vn[16];
                const bool more = nx < NIT;
                if (more) { MOE_DESC(nx, Wn, Kn, Nn, WTn, mdn, itemn); ti_load<true>(Wn, Nn, itemn, lane, vn); }
                ti_store<true, MOE_F8>(v, K, N, WT, md, scr, item, lane);
                if (!more) break;
#pragma unroll
                for (int i = 0; i < 16; ++i) v[i] = vn[i];
                it = nx; W = Wn; K = Kn; N = Nn; WT = WTn; md = mdn; item = itemn;
            }
        }
#undef MOE_DESC
}

template <class Epi, class Ord>
__device__ __forceinline__ void combine_tail(const Epi& E, const Ord& S, const float* slab, unsigned* tickets, LAS unsigned char* lds) {
    int tt; pg8::Unit tu;
    if (!S.tail_unit(tt, tu)) return;
    int tid = threadIdx.x; asm volatile("" : "+v"(tid));
    const int lane = tid & 63, wid = __builtin_amdgcn_readfirstlane(tid >> 6), wr = wid >> 2, wc = wid & 3, fr = lane & 15, fq = lane >> 4;
    volatile LAS unsigned* flag = (volatile LAS unsigned*)(lds + FLAG_OFF);
    asm volatile("s_waitcnt vmcnt(0)" ::: "memory");
    __syncthreads();
    if (tid == 0) {
        __builtin_amdgcn_fence(__ATOMIC_RELEASE, "agent");
        asm volatile("s_waitcnt vmcnt(0)" ::: "memory");
        const unsigned t = __hip_atomic_fetch_add(tickets + 64 * tt, 1u, RLX_AGENT);
        const bool last = (t == (unsigned)S.tp.S - 1u);
        if (last) { __builtin_amdgcn_fence(__ATOMIC_ACQUIRE, "agent"); asm volatile("s_waitcnt vmcnt(0)" ::: "memory"); }
        *flag = last ? 1u : 0u;
    }
    __syncthreads();
    if (*flag) {
        const int ns = S.tp.S;
        const GAS pg8::f32x4* sp = (const GAS pg8::f32x4*)slab + (size_t)(tt * ns) * (32 * 512) + tid;
        pg8::f32x4 acc[2][2][4][2];
#pragma unroll
        for (int ai = 0; ai < 2; ++ai)
#pragma unroll
            for (int bj = 0; bj < 2; ++bj)
#pragma unroll
                for (int m = 0; m < 4; ++m)
#pragma unroll
                    for (int n = 0; n < 2; ++n) { const int r = (((ai * 2 + bj) * 4 + m) * 2) + n; pg8::f32x4 a = sp[(size_t)r * 512];
                        for (int ks = 1; ks < ns; ++ks) a += sp[(size_t)ks * (32 * 512) + (size_t)r * 512];
                        acc[ai][bj][m][n] = a; }
        E(acc, tu, wr, wc, fr, fq);
    }
    __syncthreads();
}

template <bool ROUTE, bool F8 = false>
__device__ __forceinline__ void norm_rows(const float* srcC, const float* srcL, const float* gain, const float* shift, const float* scale, bf16* XN, int row_lo, int row_hi, int gw, int NGW, int lane,
                                          const LAS float* rt, unsigned* cnt, int* route) {
    f32x4 vn[8];
    { const int row = row_lo + gw; if (row < row_hi) { const GAS f32x4* xr = (const GAS f32x4*)((row < RC ? srcC : srcL) + (size_t)row * D) + lane;
#pragma unroll
        for (int j = 0; j < 8; ++j) vn[j] = xr[64 * j]; } }
    for (int row = row_lo + gw; row < row_hi; row += NGW) {
        const int bidx = row < RC ? 4 : ((row - RC) >> 11);
        f32x4 v[8]; float ss = 0.f;
#pragma unroll
        for (int j = 0; j < 8; ++j) { v[j] = vn[j]; ss += (v[j].x * v[j].x + v[j].y * v[j].y) + (v[j].z * v[j].z + v[j].w * v[j].w); }
        { const int nrow = row + NGW; if (nrow < row_hi) { const GAS f32x4* xr = (const GAS f32x4*)((nrow < RC ? srcC : srcL) + (size_t)nrow * D) + lane;
#pragma unroll
            for (int j = 0; j < 8; ++j) vn[j] = xr[64 * j]; } }
        const float rstd = 1.0f / sqrtf(wave_sum(ss) * (1.0f / D) + EPS);
        const GAS f32x4* g4 = (const GAS f32x4*)gain + lane; const GAS f32x4* sh4 = (const GAS f32x4*)(shift + bidx * MODN) + lane; const GAS f32x4* sc4 = (const GAS f32x4*)(scale + bidx * MODN) + lane;
        GAS unsigned long long* o8 = (GAS unsigned long long*)(XN + (size_t)row * D) + lane; GAS unsigned* o4 = (GAS unsigned*)((unsigned char*)XN + (size_t)row * D) + lane;
#pragma unroll
        for (int j = 0; j < 8; ++j) { const f32x4 g = g4[64 * j], sh = sh4[64 * j], sc = sc4[64 * j]; v[j] = (v[j] * rstd * g) * (1.0f + sc) + sh;
            if constexpr (F8) o4[64 * j] = pg8::cvt4_fp8(v[j].x, v[j].y, v[j].z, v[j].w);
            else o8[64 * j] = (unsigned long long)pk2(v[j].x, v[j].y) | ((unsigned long long)pk2(v[j].z, v[j].w) << 32); }
        if (ROUTE) {
            float lg[8];
#pragma unroll
            for (int e = 0; e < 8; ++e) lg[e] = 0.f;
#pragma unroll
            for (int j = 0; j < 8; ++j)
#pragma unroll
                for (int q = 0; q < 4; ++q) { const int k = 256 * j + 4 * lane + q; const LAS f32x4* rp = (const LAS f32x4*)(rt + k * 8); const f32x4 r0 = rp[0], r1 = rp[1]; const float f = v[j][q];
                    lg[0] += f * r0.x; lg[1] += f * r0.y; lg[2] += f * r0.z; lg[3] += f * r0.w; lg[4] += f * r1.x; lg[5] += f * r1.y; lg[6] += f * r1.z; lg[7] += f * r1.w;
                    if (q == 3) asm volatile("" ::: "memory"); }
#pragma unroll
            for (int e = 0; e < 8; ++e) lg[e] = wave_sum(lg[e]);
            int i1 = 0; float v1 = lg[0];
#pragma unroll
            for (int e = 1; e < 8; ++e) if (lg[e] > v1) { v1 = lg[e]; i1 = e; }
            int i2 = -1; float v2 = -INFINITY;
#pragma unroll
            for (int e = 0; e < 8; ++e) if (e != i1 && lg[e] > v2) { v2 = lg[e]; i2 = e; }
            const float w1 = 1.0f / (1.0f + expf(v2 - v1)), w2 = 1.0f - w1;
            if (lane == 0) { const int s1 = (int)__hip_atomic_fetch_add(cnt + 64 * i1, 1u, RLX_AGENT), s2 = (int)__hip_atomic_fetch_add(cnt + 64 * i2, 1u, RLX_AGENT);
                int* rec = route + (size_t)(row - RC) * 8; rec[0] = i1; rec[1] = s1; rec[2] = __builtin_bit_cast(int, w1); rec[3] = i2; rec[4] = s2; rec[5] = __builtin_bit_cast(int, w2); }
        }
    }
}

struct TileSpec { int nband, band_row0, ctx_row0, nt; };
__device__ __forceinline__ int crow(int r, int hi) { return (r & 3) + 8 * (r >> 2) + 4 * hi; }
template <int NKC, int DVB, bool WIN>
__device__ __forceinline__ void attn_core(LAS unsigned char* lds, const bf16* P, const bf16x8 (&qr)[4], int kcol, int vcol, int kofs, const TileSpec ts, int qpos, int bandpos0,
                                          f32x16 (&o)[DVB], f32x16& ol, float& mref_out, int tid, int lane) {
    constexpr int SB = NKC * 1024 + DVB * 4096, NK = NKC / 8, NV = DVB / 2;
    constexpr float THR = 8.0f;
    const int r32 = lane & 31, hi = lane >> 5, wv = __builtin_amdgcn_readfirstlane(tid >> 6);
    int koff[NK], voff[NV];
#pragma unroll
    for (int i = 0; i < NK; ++i) { const int q = tid + 512 * i, key = q / NKC, s = q % NKC; koff[i] = key * INC + kcol + (s ^ (NKC == 16 ? (key & 15) : ((key >> 1) & 7))) * 8; }
#pragma unroll
    for (int i = 0; i < NV; ++i) { const int q = tid + 512 * i; voff[i] = (((q >> 6) & 3) * 16 + ((q >> 2) & 15)) * INC + vcol + (q >> 8) * 32 + (q & 3) * 8; }
#define ATT_DMA(t_, s_) do { const int t__ = (t_); const int rb_ = t__ < ts.nband ? ts.band_row0 + 64 * t__ : ts.ctx_row0 + 64 * (t__ - ts.nband); const bf16* tb_ = P + (size_t)rb_ * INC; \
        _Pragma("unroll") for (int i_ = 0; i_ < NK; ++i_) __builtin_amdgcn_global_load_lds((const unsigned*)(tb_ + koff[i_]), (LAS unsigned*)(lds + (s_) * SB + (wv * 64 + 512 * i_) * 16), 16, 0, 0); \
        _Pragma("unroll") for (int i_ = 0; i_ < NV; ++i_) __builtin_amdgcn_global_load_lds((const unsigned*)(tb_ + voff[i_]), (LAS unsigned*)(lds + (s_) * SB + NKC * 1024 + (wv * 64 + 512 * i_) * 16), 16, 0, 0); } while (0)
    float mref = 0.f;
    f32x16 negm;
#pragma unroll
    for (int r = 0; r < 16; ++r) { negm[r] = 0.f; ol[r] = 0.f; }
#pragma unroll
    for (int d0 = 0; d0 < DVB; ++d0)
#pragma unroll
        for (int r = 0; r < 16; ++r) o[d0][r] = 0.f;
    const short one = (r32 == 0) ? (short)0x3F80 : (short)0;
    const bf16x8 onesf = (bf16x8){one, one, one, one, one, one, one, one};
    ATT_DMA(0, 0); asm volatile("s_waitcnt vmcnt(0)" ::: "memory"); __syncthreads();
#pragma unroll 1
    for (int t = 0; t < ts.nt; ++t) {
        if (t + 1 < ts.nt) ATT_DMA(t + 1, (t + 1) & 1);
        LAS unsigned char* sb = lds + (t & 1) * SB;
        f32x16 p0, p1;
        { const LAS unsigned char* kb = sb + r32 * (NKC * 16);
#pragma unroll
          for (int d0 = 0; d0 < 4; ++d0) { const int so = ((kofs + 2 * d0 + hi) ^ (NKC == 16 ? (r32 & 15) : ((r32 >> 1) & 7))) * 16; const bf16x8 b0 = *(const LAS bf16x8*)(kb + so), b1 = *(const LAS bf16x8*)(kb + 32 * (NKC * 16) + so);
              if (d0 == 0) { p0 = __builtin_amdgcn_mfma_f32_32x32x16_bf16(b0, qr[0], negm, 0, 0, 0); p1 = __builtin_amdgcn_mfma_f32_32x32x16_bf16(b1, qr[0], negm, 0, 0, 0); }
              else { p0 = __builtin_amdgcn_mfma_f32_32x32x16_bf16(b0, qr[d0], p0, 0, 0, 0); p1 = __builtin_amdgcn_mfma_f32_32x32x16_bf16(b1, qr[d0], p1, 0, 0, 0); } } }
        if (WIN) { if (t < ts.nband) { const int kp0 = bandpos0 + 64 * t + 4 * hi;
#pragma unroll
            for (int r = 0; r < 16; ++r) { const int dlt = qpos - (kp0 + (r & 3) + 8 * (r >> 2)); if (dlt > 128 || dlt < -128) p0[r] = -1e30f; if (dlt - 32 > 128 || dlt - 32 < -128) p1[r] = -1e30f; } } }
        float rm = fmaxf(fmaxf(p0[0], p0[1]), p1[0]);
#pragma unroll
        for (int r = 1; r < 16; ++r) rm = fmaxf(fmaxf(rm, p0[r]), p1[r]);
        rm = fmaxf(rm, p0[1]);
        rm = fmaxf(rm, __shfl_xor(rm, 32));
        if (t == 0 || __any(rm > THR)) {
            const float dl = t == 0 ? rm : fmaxf(rm, 0.f);
            mref += dl;
#pragma unroll
            for (int r = 0; r < 16; ++r) { p0[r] -= dl; p1[r] -= dl; negm[r] = -mref; }
            if (t != 0) { const float f = __builtin_amdgcn_exp2f(-dl);
#pragma unroll
                for (int r = 0; r < 16; ++r) { const float fr = __shfl(f, crow(r, hi)); ol[r] *= fr;
#pragma unroll
                    for (int d0 = 0; d0 < DVB; ++d0) o[d0][r] *= fr; } }
        }
#pragma unroll
        for (int r = 0; r < 16; ++r) { p0[r] = __builtin_amdgcn_exp2f(p0[r]); p1[r] = __builtin_amdgcn_exp2f(p1[r]); }
        v4u pw[4];
#pragma unroll
        for (int i = 0; i < 4; ++i) { pw[0][i] = pg8::cvt_pk_bf16(p0[2 * i], p0[2 * i + 1]); pw[1][i] = pg8::cvt_pk_bf16(p0[8 + 2 * i], p0[8 + 2 * i + 1]); pw[2][i] = pg8::cvt_pk_bf16(p1[2 * i], p1[2 * i + 1]); pw[3][i] = pg8::cvt_pk_bf16(p1[8 + 2 * i], p1[8 + 2 * i + 1]); }
        { const LAS unsigned char* vb = sb + NKC * 1024 + ((lane >> 4) & 1) * 32 + (lane & 3) * 8 + (4 * hi + ((lane & 15) >> 2)) * 64;
#pragma unroll
          for (int d0 = 0; d0 < DVB; ++d0)
#pragma unroll
              for (int ks = 0; ks < 4; ++ks) {
                  const v4i16_t lo = __builtin_amdgcn_ds_read_tr16_b64_v4i16((LAS v4i16_t*)(vb + d0 * 4096 + ks * 1024)), hh = __builtin_amdgcn_ds_read_tr16_b64_v4i16((LAS v4i16_t*)(vb + d0 * 4096 + ks * 1024 + 512));
                  const bf16x8 vf = (bf16x8){lo[0], lo[1], lo[2], lo[3], hh[0], hh[1], hh[2], hh[3]};
                  o[d0] = __builtin_amdgcn_mfma_f32_32x32x16_bf16(__builtin_bit_cast(bf16x8, pw[ks]), vf, o[d0], 0, 0, 0);
                  if (ks == 3) asm volatile("" ::: "memory"); }
#pragma unroll
          for (int ks = 0; ks < 4; ++ks) ol = __builtin_amdgcn_mfma_f32_32x32x16_bf16(__builtin_bit_cast(bf16x8, pw[ks]), onesf, ol, 0, 0, 0); }
        asm volatile("s_waitcnt vmcnt(0)" ::: "memory");
        __syncthreads();
    }
#undef ATT_DMA
    mref_out = mref;
}
template <int DVB>
__device__ __forceinline__ void attn_normalize(f32x16 (&o)[DVB], const f32x16& ol, float extra, int hi) {
#pragma unroll
    for (int r = 0; r < 16; ++r) { const float l = __shfl(ol[r], hi << 5) + __shfl(extra, crow(r, hi)); const float ir = 1.0f / l;
#pragma unroll
        for (int d0 = 0; d0 < DVB; ++d0) o[d0][r] *= ir; }
}

__device__ __forceinline__ void win_unit(LAS unsigned char* lds, const bf16* P, bf16* MIX, const float* sink, int b, int g, int qb, bool ctxq, int tid, int lane, int wave) {
    const int r32 = lane & 31, hi = lane >> 5, hr = wave >> 1, sub = (wave & 1) * 32;
    TileSpec ts; int qrow0, qpos = 0, bandpos0 = 0;
    if (!ctxq) { const int tl = qb - 2 < 0 ? 0 : qb - 2, th = qb + 2 > 31 ? 31 : qb + 2; ts.nband = th - tl + 1; ts.band_row0 = RC + b * SEQ + tl * 64; bandpos0 = tl * 64; ts.ctx_row0 = b * CTX; ts.nt = ts.nband + 4;
        qrow0 = RC + b * SEQ + qb * 64 + sub; qpos = qb * 64 + sub + r32; }
    else { ts.nband = 0; ts.band_row0 = 0; ts.ctx_row0 = b * CTX; ts.nt = 4; qrow0 = b * CTX + qb * 64 + sub; }
    const int qcol = 3072 + g * 256 + hr * 64;
    bf16x8 qr[4];
#pragma unroll
    for (int d0 = 0; d0 < 4; ++d0) qr[d0] = *(const GAS bf16x8*)(P + (size_t)(qrow0 + r32) * INC + qcol + d0 * 16 + hi * 8);
    f32x16 o[2], ol; float mref;
    attn_core<8, 2, true>(lds, P, qr, 3584 + g * 64, 3712 + g * 64, 0, ts, qpos, bandpos0, o, ol, mref, tid, lane);
    attn_normalize<2>(o, ol, __builtin_amdgcn_exp2f(sink[g * 4 + hr] * LOG2E - mref), hi);
#pragma unroll
    for (int r = 0; r < 16; ++r) { bf16* op = MIX + (size_t)(qrow0 + crow(r, hi)) * D + 1536 + (g * 4 + hr) * 64 + r32;
#pragma unroll
        for (int d0 = 0; d0 < 2; ++d0) op[d0 * 32] = (bf16)f2bf(o[d0][r]); }
}

__device__ __forceinline__ void diff_unit(LAS unsigned char* lds, const bf16* P, bf16* MIX, const float* dlam, const float* subln, float lam_init, int b, int h, int qb, bool ctxq, int tid, int lane, int wave) {
    const int r32 = lane & 31, hi = lane >> 5, m = wave >> 2, sub = (wave & 3) * 32;
    TileSpec ts; int qrow0;
    if (!ctxq) { ts.nband = 32; ts.band_row0 = RC + b * SEQ; ts.ctx_row0 = b * CTX; ts.nt = 36; qrow0 = RC + b * SEQ + qb * 128 + sub; }
    else { ts.nband = 0; ts.band_row0 = 0; ts.ctx_row0 = b * CTX; ts.nt = 4; qrow0 = b * CTX + qb * 128 + sub; }
    const int qcol = 512 + h * 128 + m * 64;
    bf16x8 qr[4];
#pragma unroll
    for (int d0 = 0; d0 < 4; ++d0) qr[d0] = *(const GAS bf16x8*)(P + (size_t)(qrow0 + r32) * INC + qcol + d0 * 16 + hi * 8);
    const float lam = expf(wave_sum(dlam[lane] * dlam[64 + lane])) - expf(wave_sum(dlam[128 + lane] * dlam[192 + lane])) + lam_init;
    f32x16 o[4], ol; float mref;
    attn_core<16, 4, false>(lds, P, qr, 1024 + h * 128, 1536 + h * 128, m * 8, ts, 0, 0, o, ol, mref, tid, lane);
    attn_normalize<4>(o, ol, 0.f, hi);
    LAS float* ex = (LAS float*)lds + (wave & 3) * 4096;
    if (m == 1) {
#pragma unroll
        for (int d0 = 0; d0 < 4; ++d0)
#pragma unroll
            for (int r = 0; r < 16; ++r) ex[(d0 * 16 + r) * 64 + lane] = o[d0][r];
    }
    __syncthreads();
    if (m == 0) {
        float sl[4];
#pragma unroll
        for (int d0 = 0; d0 < 4; ++d0) sl[d0] = subln[d0 * 32 + r32] * (1.0f - lam_init);
#pragma unroll
        for (int r = 0; r < 16; ++r) {
            float ss = 0.f;
#pragma unroll
            for (int d0 = 0; d0 < 4; ++d0) { const float v = o[d0][r] - lam * ex[(d0 * 16 + r) * 64 + lane]; o[d0][r] = v; ss += v * v; }
            asm volatile("" ::: "memory");
#pragma unroll
            for (int off = 1; off < 32; off <<= 1) ss += __shfl_xor(ss, off);
            const float rstd = 1.0f / sqrtf(ss * (1.0f / 128.0f) + EPS);
            bf16* op = MIX + (size_t)(qrow0 + crow(r, hi)) * D + 512 + h * 128 + r32;
#pragma unroll
            for (int d0 = 0; d0 < 4; ++d0) op[d0 * 32] = (bf16)f2bf(o[d0][r] * rstd * sl[d0]);
        }
    }
    __syncthreads();
}

__device__ __forceinline__ void sgu_unit(LAS unsigned char* lds, const bf16* P, bf16* MIX, const float* ln_g, const float* ln_b, const float* Ws, const float* bs, int row0, int g, int tid, int lane, int wave) {
    constexpr int VS = 136;
    LAS bf16* VT = (LAS bf16*)lds;
    const int r32 = lane & 31, hi = lane >> 5;
    { const int tq = lane >> 4, j = lane & 15;
      v4u raws[4][4];
#pragma unroll
      for (int ps = 0; ps < 4; ++ps)
#pragma unroll
          for (int q = 0; q < 4; ++q) raws[ps][q] = *(const GAS v4u*)(P + (size_t)(row0 + wave * 16 + ps * 4 + tq) * INC + 2560 + (j + 16 * q) * 8);
      float lg8[8], lb8[8];
#pragma unroll
      for (int e = 0; e < 8; ++e) { lg8[e] = ln_g[g * 128 + 8 * j + e]; lb8[e] = ln_b[g * 128 + 8 * j + e]; }
#pragma unroll
      for (int ps = 0; ps < 4; ++ps) {
          float x[4][8]; float s = 0.f;
#pragma unroll
          for (int q = 0; q < 4; ++q)
#pragma unroll
              for (int e = 0; e < 4; ++e) { x[q][2 * e] = bf2f((unsigned short)(raws[ps][q][e] & 0xffffu)); x[q][2 * e + 1] = bf2f((unsigned short)(raws[ps][q][e] >> 16)); s += x[q][2 * e] + x[q][2 * e + 1]; }
#pragma unroll
          for (int off = 1; off < 16; off <<= 1) s += __shfl_xor(s, off);
          const float mean = s * (1.0f / 512.0f); float s2 = 0.f;
#pragma unroll
          for (int q = 0; q < 4; ++q)
#pragma unroll
              for (int e = 0; e < 8; ++e) { x[q][e] -= mean; s2 += x[q][e] * x[q][e]; }
#pragma unroll
          for (int off = 1; off < 16; off <<= 1) s2 += __shfl_xor(s2, off);
          const float rstd = 1.0f / sqrtf(s2 * (1.0f / 512.0f) + EPS);
          const int qtok = wave * 16 + ps * 4 + tq;
#pragma unroll
          for (int e = 0; e < 8; ++e) { const float xv = g == 0 ? x[0][e] : (g == 1 ? x[1][e] : (g == 2 ? x[2][e] : x[3][e])); VT[(8 * j + e) * VS + qtok] = (bf16)f2bf(xv * rstd * lg8[e] + lb8[e]); }
      }
    }
    __syncthreads();
    const int pb = wave & 3, ch = wave >> 2;
    f32x16 acc[2];
#pragma unroll
    for (int cb = 0; cb < 2; ++cb)
#pragma unroll
        for (int r = 0; r < 16; ++r) acc[cb][r] = 0.f;
    const float* wrow = Ws + (size_t)(g * 128 + pb * 32 + r32) * 128 + hi * 8;
#pragma unroll
    for (int ks = 0; ks < 8; ++ks) {
        const f32x4 w0 = *(const GAS f32x4*)(wrow + ks * 16), w1 = *(const GAS f32x4*)(wrow + ks * 16 + 4);
        v4u aw; aw.x = pk2(w0.x, w0.y); aw.y = pk2(w0.z, w0.w); aw.z = pk2(w1.x, w1.y); aw.w = pk2(w1.z, w1.w);
#pragma unroll
        for (int cb = 0; cb < 2; ++cb) { const bf16x8 bv = *(const LAS bf16x8*)(VT + (ch * 64 + cb * 32 + r32) * VS + ks * 16 + hi * 8);
            acc[cb] = __builtin_amdgcn_mfma_f32_32x32x16_bf16(__builtin_bit_cast(bf16x8, aw), bv, acc[cb], 0, 0, 0); }
    }
#pragma unroll
    for (int r = 0; r < 16; ++r) { const int p = pb * 32 + crow(r, hi); const float bias = bs[g * 128 + p];
#pragma unroll
        for (int cb = 0; cb < 2; ++cb) { const int c = g * 128 + ch * 64 + cb * 32 + r32; const float u = bf2f(P[(size_t)(row0 + p) * INC + 2048 + c]);
            MIX[(size_t)(row0 + p) * D + 1024 + c] = (bf16)f2bf(u * (acc[cb][r] + bias)); } }
    __syncthreads();
}

template <int HALF>
__device__ __forceinline__ void pool_body(const bf16* P, bf16* MIX, const float* pscale, int seq0, int T, int tk0, int cc) {
    constexpr int NR = 4 + 2 * HALF;
    v4u raw[NR];
#pragma unroll
    for (int r = 0; r < NR; ++r) { const int t = tk0 - HALF + r; raw[r] = (t >= 0 && t < T) ? *(const GAS v4u*)(P + (size_t)(seq0 + t) * INC + cc * 8) : (v4u){0u, 0u, 0u, 0u}; }
    const f32x4 s0 = *(const GAS f32x4*)(pscale + cc * 8), s1 = *(const GAS f32x4*)(pscale + cc * 8 + 4);
    const float sc[8] = {s0.x, s0.y, s0.z, s0.w, s1.x, s1.y, s1.z, s1.w};
    float w[8];
#pragma unroll
    for (int e = 0; e < 8; ++e) w[e] = 0.f;
#pragma unroll
    for (int r = 0; r < 2 * HALF - 1; ++r)
#pragma unroll
        for (int e = 0; e < 4; ++e) { w[2 * e] += bf2f((unsigned short)(raw[r][e] & 0xffffu)); w[2 * e + 1] += bf2f((unsigned short)(raw[r][e] >> 16)); }
#pragma unroll
    for (int i = 0; i < 4; ++i) {
        const int t = tk0 + i, lo = t - HALF < 0 ? 0 : t - HALF, hh = t + HALF > T ? T : t + HALF; const float rc = 1.0f / (float)(hh - lo);
        v4u o;
#pragma unroll
        for (int e = 0; e < 4; ++e) {
            w[2 * e] += bf2f((unsigned short)(raw[i + 2 * HALF - 1][e] & 0xffffu)); w[2 * e + 1] += bf2f((unsigned short)(raw[i + 2 * HALF - 1][e] >> 16));
            const float x0 = bf2f((unsigned short)(raw[HALF + i][e] & 0xffffu)), x1 = bf2f((unsigned short)(raw[HALF + i][e] >> 16));
            o[e] = pk2((w[2 * e] * rc - x0) * sc[2 * e], (w[2 * e + 1] * rc - x1) * sc[2 * e + 1]);
            w[2 * e] -= bf2f((unsigned short)(raw[i][e] & 0xffffu)); w[2 * e + 1] -= bf2f((unsigned short)(raw[i][e] >> 16));
        }
        *(GAS v4u*)(MIX + (size_t)(seq0 + t) * D + cc * 8) = o;
    }
}
__device__ __forceinline__ void pool_unit(const bf16* P, bf16* MIX, const float* pscale, int row0, int tid, int wave) {
    const int seq0 = row0 < RC ? (row0 & ~255) : RC + ((row0 - RC) & ~2047), T = row0 < RC ? CTX : SEQ, tk0 = row0 - seq0 + 4 * (tid & 7), cc = tid >> 3, g = wave >> 1;
    if (g == 0) pool_body<1>(P, MIX, pscale, seq0, T, tk0, cc); else if (g == 1) pool_body<2>(P, MIX, pscale, seq0, T, tk0, cc); else if (g == 2) pool_body<4>(P, MIX, pscale, seq0, T, tk0, cc); else pool_body<8>(P, MIX, pscale, seq0, T, tk0, cc);
}

__global__ void __launch_bounds__(NWAVES * 64, 2) fwd_kernel(Args args_unused) {
    extern __shared__ __attribute__((aligned(16))) unsigned char lds_raw[];
    LAS unsigned char* lds = (LAS unsigned char*)lds_raw;
    volatile LAS unsigned* MISC = (volatile LAS unsigned*)(lds + MISC_OFF);
    const int tid0 = threadIdx.x;
#define TID_HERE() int tid = threadIdx.x; asm volatile("" : "+v"(tid)); int G = G0, bx = bx0; asm volatile("" : "+s"(G), "+s"(bx)); const int vcu = (G % 8 == 0) ? (bx % 8) * (G / 8) + bx / 8 : bx; const int NGW = G * NWAVES; \
    const int lane = tid & 63, wave = __builtin_amdgcn_readfirstlane(tid >> 6); const int gw = vcu * NWAVES + wave; (void)lane; (void)gw; (void)NGW
    const int G0 = gridDim.x, bx0 = blockIdx.x;
    for (int u = tid0; u < (LDS_BYTES - LDSCTL_OFF) / 4; u += NWAVES * 64) ((LAS unsigned*)(lds + LDSCTL_OFF))[u] = 0u;
    __syncthreads();
    int lo, hi;
    XcdBarrier bar;
    { kaptr kp = ka_get(); lo = KLO(kp); hi = KHI(kp); unsigned* bw = (unsigned*)(KWS(kp) + WS_CTL) + CW_BAR; bar.bar = bw; bar.x = 0; bar.st = nullptr;
      if (!MK_PER_PHASE) bar = xcd_barrier_post(bw, MISC + 8); }
#ifndef SITEMASK
#define SITEMASK 0xfff
#endif
#ifndef UNITMASK
#define UNITMASK 0xf
#endif
#define UEN(s) (((UNITMASK) >> (s)) & 1)
#ifndef REPMASK
#define REPMASK 0
#endif
#ifndef REPU
#define REPU 0
#endif
#define NREPU(s) (1 + (((REPU) >> (s)) & 1))
#define NREP(s) (1 + (((REPMASK) >> (s)) & 1))
#define EN(s) (((SITEMASK) >> (s)) & 1)
#define IN(k) (lo <= (k) && (k) < hi)
#ifndef NCONV
#define NCONV 16
#endif
#ifndef FILLW
#define FILLW 2
#endif
#define CONVPH(k) ((k) == 2 || (k) == 4 || (k) == 6 || (k) == 7)
#ifndef SPLITK
#define SPLITK false
#endif
#ifndef SPLITK_FFN_DOWN
#define SPLITK_FFN_DOWN false
#endif
#ifndef SPLITK_MOE_DOWN
#define SPLITK_MOE_DOWN true
#endif
#ifndef FILLMODE
#define FILLMODE 1
#endif
#define FILL(k) do { if (FILLMODE == 1 && l == 0 && IN(k)) {     kaptr kq = ka_get(); int Gq = G0; asm volatile("" : "+s"(Gq)); fill_tail(KWS(kq), KIN(kq, 23), KIN(kq, 24), KIN(kq, 25), (unsigned*)(KWS(kq) + WS_CTL) + CW_DONE + 64 * (k), Gq, (FILLMODE == 1 && l == 0 && (int)blockIdx.x < NCONV && CONVPH(k)) ? 8 : FILLW); } } while (0)
#define DRAIN(k) do { if (((FILLMODE == 1) || (k) == 0) && IN(k)) { kaptr kq = ka_get(); int Gq = G0; asm volatile("" : "+s"(Gq)); drain_tail(KWS(kq), KIN(kq, 23), KIN(kq, 24), KIN(kq, 25), Gq, lds); } } while (0)
#define SEAM(k) do { if (IN(k) && IN((k) + 1)) { XcdBarrier b_ = bar; asm volatile("" : "+s"(b_.bar)); xcd_barrier(b_); } } while (0)
    LAS int* TB = (LAS int*)(lds + TB_OFF);

    for (int rep = 0; rep < NREP(0); ++rep) if (EN(0) && IN(0)) { kaptr kp = ka_get(); TID_HERE(); p0_prologue(kp, lds, vcu, G, tid, lane, wave); }
    if (FILLMODE == 0) DRAIN(0);
    SEAM(0);

    for (int l = 0; l < 2; ++l) {
        const int pb = l == 0 ? 1 : 8;
        const bool last = (l == 1);
        for (int rep = 0; rep < NREP(1); ++rep) if (EN(1) && IN(pb + 0)) {
            kaptr kp = ka_get(); TID_HERE(); unsigned char* ws = KWS(kp); const float* H = (const float*)(ws + WS_H); const float* mod = (const float*)(ws + WS_MOD) + l * 5 * MODN;
            const float* srcC = l == 0 ? KIN(kp, 2) : H; const float* srcL = l == 0 ? KIN(kp, 0) - (size_t)RC * D : H;
            norm_rows<false>(srcC, srcL, KIN(kp, 6) + l * D, mod + 0 * D, mod + 1 * D, (bf16*)(ws + WS_XN), 0, RT, gw, NGW, lane, nullptr, nullptr, nullptr);
        }
        SEAM(pb + 0);
        for (int rep = 0; rep < NREP(2); ++rep) if (EN(2) && IN(pb + 1)) {
            kaptr kp = ka_get(); TID_HERE(); unsigned char* ws = KWS(kp);
            pg8::Gemm g{(const bf16*)(ws + WS_XN), (const bf16*)(ws + WS_WIN) + (size_t)l * INC * D, RT, INC, D}; pg8::EpiIn E{(bf16*)(ws + WS_PALL), (const float*)(ws + WS_ROPE)};
            const int nc = (FILLMODE == 1 && l == 0) ? NCONV : 0;
            if (bx >= nc) {
            pg8::OrderSplit<pg8::MapIn> S; S.init(G - nc, bx - nc, D, last ? 20 : 60); S.plan(SPLITK);
            pg8::EpiSplit<pg8::EpiIn> ES{E, (float*)(ws + WS_SLAB)};
            { pg8::CachedOrder CS; CS.fill(S, (PG8_LAS int*)(lds + UT_OFF), tid); __syncthreads();
                  pg8::gemm_phase<pg8::EpiSplit<pg8::EpiIn>, pg8::CachedOrder, true, true>(lds, g, CS, ES); }
            combine_tail(E, S, (float*)(ws + WS_SLAB), (unsigned*)(ws + WS_CTL) + CW_TK + 4096 * (pb + 1), lds); }
        }
        FILL(pb + 1); SEAM(pb + 1);
        for (int rep = 0; rep < NREP(3); ++rep) if (EN(3) && IN(pb + 2)) {
            kaptr kp = ka_get(); TID_HERE(); unsigned char* ws = KWS(kp); const bf16* PALL = (const bf16*)(ws + WS_PALL); bf16* MIX = (bf16*)(ws + WS_MIX);
            const float lam_init = 0.8f - 0.6f * expf(-0.3f * (float)l);
            for (int ru = 0; ru < NREPU(0); ++ru) if (UEN(0)) for (int u = vcu; u < 256; u += G) diff_unit(lds, PALL, MIX, KIN(kp, 12) + l * 256, KIN(kp, 13) + l * 128, lam_init, u >> 6, (u >> 4) & 3, u & 15, false, tid, lane, wave);
            for (int ru = 0; ru < NREPU(1); ++ru) if (UEN(1)) for (int u = vcu; u < 256; u += G) win_unit(lds, PALL, MIX, KIN(kp, 18) + l * 8, u >> 6, (u >> 5) & 1, u & 31, false, tid, lane, wave);
            if (!last) {
                if (UEN(0)) for (int u = vcu; u < 32; u += G) diff_unit(lds, PALL, MIX, KIN(kp, 12) + l * 256, KIN(kp, 13) + l * 128, lam_init, u >> 3, (u >> 1) & 3, u & 1, true, tid, lane, wave);
                if (UEN(1)) for (int u = (vcu + G - (32 % G)) % G; u < 32; u += G) win_unit(lds, PALL, MIX, KIN(kp, 18) + l * 8, u >> 3, (u >> 2) & 1, u & 3, true, tid, lane, wave);
            }
            { const int ch0 = last ? 8 : 0, nu = (72 - ch0) * 4;
              for (int ru = 0; ru < NREPU(2); ++ru) if (UEN(2)) for (int u = (vcu + G - (64 % G)) % G; u < nu; u += G) sgu_unit(lds, PALL, MIX, KIN(kp, 14) + l * 512, KIN(kp, 15) + l * 512, KIN(kp, 16) + (size_t)l * 4 * 128 * 128, KIN(kp, 17) + l * 512, (ch0 + (u >> 2)) * 128, u & 3, tid, lane, wave); }
            { const int r0 = last ? RC : 0, nu = (RT - r0) / 32;
              for (int ru = 0; ru < NREPU(3); ++ru) if (UEN(3)) for (int u = (vcu + G - (96 % G)) % G; u < nu; u += G) pool_unit(PALL, MIX, KIN(kp, 11) + l * 512, r0 + 32 * u, tid, wave); }
        }
        FILL(pb + 2); SEAM(pb + 2);
        for (int rep = 0; rep < NREP(4); ++rep) if (EN(4) && IN(pb + 3)) {
            kaptr kp = ka_get(); TID_HERE(); unsigned char* ws = KWS(kp); float* H = (float*)(ws + WS_H);
            const float* srcC = l == 0 ? KIN(kp, 2) : H; const float* srcL = l == 0 ? KIN(kp, 0) - (size_t)RC * D : H;
            pg8::Gemm g{(const bf16*)(ws + WS_MIX), (const bf16*)(ws + WS_WOUT) + (size_t)l * D * D, RT, D, D}; pg8::EpiResid E{srcC, srcL, rep ? (float*)(ws + WS_Y) : H, (const float*)(ws + WS_MOD) + l * 5 * MODN + 2 * D, 1.0f};
            const int nc = (FILLMODE == 1 && l == 0) ? NCONV : 0;
            if (bx >= nc) {
            pg8::OrderSplit<pg8::MapOff> S; S.init(last ? RL : RT, D, G - nc, bx - nc, D); S.pm_off = last ? 4 : 0; S.plan(SPLITK);
            pg8::EpiSplit<pg8::EpiResid> ES{E, (float*)(ws + WS_SLAB)};
            { pg8::CachedOrder CS; CS.fill(S, (PG8_LAS int*)(lds + UT_OFF), tid); __syncthreads();
                  pg8::gemm_phase<pg8::EpiSplit<pg8::EpiResid>, pg8::CachedOrder, true, true>(lds, g, CS, ES); }
            combine_tail(E, S, (float*)(ws + WS_SLAB), (unsigned*)(ws + WS_CTL) + CW_TK + 4096 * (pb + 3), lds); }
        }
        FILL(pb + 3); SEAM(pb + 3);
        for (int rep = 0; rep < NREP(5); ++rep) if (EN(5) && IN(pb + 4)) {
            kaptr kp = ka_get(); TID_HERE(); unsigned char* ws = KWS(kp); const float* H = (const float*)(ws + WS_H); const float* mod = (const float*)(ws + WS_MOD) + l * 5 * MODN;
            if (!last || rep) norm_rows<false, DENSE_UP_F8>(H, H, KIN(kp, 7) + l * D, mod + 3 * D, mod + 4 * D, (bf16*)(ws + WS_XN), last ? RC : 0, RT, gw, NGW, lane, nullptr, nullptr, nullptr);
            else {
                LAS float* rt = (LAS float*)lds;
                for (int i = tid; i < D * NE / 4; i += NWAVES * 64) ((LAS f32x4*)rt)[i] = ((const GAS f32x4*)KIN(kp, 22))[i];
                __syncthreads();
                norm_rows<true, MOE_F8>(H, H, KIN(kp, 7) + l * D, mod + 3 * D, mod + 4 * D, (bf16*)(ws + WS_XN), RC, RT, gw, NGW, lane, rt, (unsigned*)(ws + WS_CTL) + CW_CNT, (int*)(ws + WS_ROUTE));
            }
        }
        SEAM(pb + 4);
        if (!last) {
            for (int rep = 0; rep < NREP(6); ++rep) if (EN(6) && IN(pb + 5)) {
                kaptr kp = ka_get(); TID_HERE(); unsigned char* ws = KWS(kp);
                constexpr int KP = DENSE_UP_F8 ? D / 2 : D;
                pg8::Gemm g{(const bf16*)(ws + WS_XN), (const bf16*)(ws + WS_W13), RT, 2 * DFF, KP}; pg8::EpiSwiglu<DENSE_DN_F8> E{(void*)(ws + WS_ACT), DFF, NTN_UP, DENSE_UP_F8 ? 1.0f / 256.0f : 1.0f};
                const int nc = (FILLMODE == 1) ? NCONV : 0;
                if (bx >= nc) {
                pg8::OrderSplit<pg8::StaticOrder> S; S.init(RT, 2 * DFF, G - nc, bx - nc, KP); S.plan(SPLITK);
                pg8::EpiSplit<pg8::EpiSwiglu<DENSE_DN_F8>> ES{E, (float*)(ws + WS_SLAB)};
                { pg8::CachedOrder CS; CS.fill(S, (PG8_LAS int*)(lds + UT_OFF), tid); __syncthreads();
                  pg8::gemm_phase<pg8::EpiSplit<pg8::EpiSwiglu<DENSE_DN_F8>>, pg8::CachedOrder, true, true, DENSE_UP_F8>(lds, g, CS, ES); }
                combine_tail(E, S, (float*)(ws + WS_SLAB), (unsigned*)(ws + WS_CTL) + CW_TK + 4096 * (pb + 5), lds); }
            }
            FILL(pb + 5); SEAM(pb + 5);
            for (int rep = 0; rep < NREP(7); ++rep) if (EN(7) && IN(pb + 6)) {
                kaptr kp = ka_get(); TID_HERE(); unsigned char* ws = KWS(kp); float* H = (float*)(ws + WS_H);
                constexpr int KP = DENSE_DN_F8 ? DFF / 2 : DFF;
                pg8::Gemm g{(const bf16*)(ws + WS_ACT), (const bf16*)(ws + WS_W2), RT, D, KP}; pg8::EpiResid E{H, H, rep ? (float*)(ws + WS_Y) : H, (const float*)(ws + WS_MOD) + l * 5 * MODN + 5 * D, DENSE_DN_F8 ? 1.0f / 256.0f : 1.0f};
                const int nc = (FILLMODE == 1) ? NCONV : 0;
                if (bx >= nc) {
                pg8::OrderSplit<pg8::MapOff> S; S.init(RT, D, G - nc, bx - nc, KP); S.pm_off = 0; S.plan(SPLITK_FFN_DOWN);
                pg8::EpiSplit<pg8::EpiResid> ES{E, (float*)(ws + WS_SLAB)};
                { pg8::CachedOrder CS; CS.fill(S, (PG8_LAS int*)(lds + UT_OFF), tid); __syncthreads();
                  pg8::gemm_phase<pg8::EpiSplit<pg8::EpiResid>, pg8::CachedOrder, true, true, DENSE_DN_F8>(lds, g, CS, ES); }
                combine_tail(E, S, (float*)(ws + WS_SLAB), (unsigned*)(ws + WS_CTL) + CW_TK + 4096 * (pb + 6), lds); }
            }
            FILL(pb + 6); SEAM(pb + 6);
        } else {
            if (IN(pb + 5) || IN(pb + 6) || IN(pb + 7) || IN(pb + 8)) {
                kaptr kp = ka_get(); TID_HERE(); const unsigned* CNT = (const unsigned*)(KWS(kp) + WS_CTL) + CW_CNT;
                if (tid == 0) { int acc = 0; TB[0] = 0;
                    for (int e = 0; e < 8; ++e) { const unsigned c = __hip_atomic_load(CNT + 64 * e, RLX_AGENT); acc += (int)((c + 255u) >> 8); TB[e + 1] = acc; } }
                __syncthreads();
            }
            for (int rep = 0; rep < NREP(8); ++rep) if (EN(8) && IN(pb + 5)) {
                kaptr kp = ka_get(); TID_HERE(); unsigned char* ws = KWS(kp); const int* ROUTE = (const int*)(ws + WS_ROUTE); const bf16* XN = (const bf16*)(ws + WS_XN); bf16* XG = (bf16*)(ws + WS_XG);
                for (int t = gw; t < RL; t += NGW) {
                    const int* rec = ROUTE + (size_t)t * 8; const int e1 = rec[0], s1 = rec[1], e2 = rec[3], s2 = rec[4];
                    const int b1 = TB[e1], b2 = TB[e2];
                    constexpr int RB = MOE_F8 ? D : 2 * D;
                    const GAS v4u* src = (const GAS v4u*)((const unsigned char*)XN + (size_t)(RC + t) * RB) + lane; GAS v4u* d1 = (GAS v4u*)((unsigned char*)XG + (size_t)(b1 * 256 + s1) * RB) + lane; GAS v4u* d2 = (GAS v4u*)((unsigned char*)XG + (size_t)(b2 * 256 + s2) * RB) + lane;
#pragma unroll
                    for (int j = 0; j < RB / 1024; ++j) { const v4u v = src[64 * j]; d1[64 * j] = v; d2[64 * j] = v; }
                }
            }
            DRAIN(pb + 5); SEAM(pb + 5);
            for (int rep = 0; rep < NREP(9); ++rep) if (EN(9) && IN(pb + 6)) {
                kaptr kp = ka_get(); TID_HERE(); unsigned char* ws = KWS(kp);
                constexpr int KP = MOE_F8 ? D / 2 : D;
                pg8::Gemm g{(const bf16*)(ws + WS_XG), (const bf16*)(ws + WS_MW13), MAXSLOT, NE * 2 * DFF, KP}; pg8::EpiSwiglu<MOE_F8> E{(void*)(ws + WS_ACT), DFF, NTN_UP, MOE_F8 ? 1.0f / 256.0f : 1.0f};
                pg8::OrderSplit<pg8::MapMoe> S; S.init((const PG8_LAS int*)TB, NTN_UP, G, bx, KP); S.plan(SPLITK);
                pg8::EpiSplit<pg8::EpiSwiglu<MOE_F8>> ES{E, (float*)(ws + WS_SLAB)};
                { pg8::CachedOrder CS; CS.fill(S, (PG8_LAS int*)(lds + UT_OFF), tid); __syncthreads();
                  pg8::gemm_phase<pg8::EpiSplit<pg8::EpiSwiglu<MOE_F8>>, pg8::CachedOrder, true, true, MOE_F8>(lds, g, CS, ES); }
                combine_tail(E, S, (float*)(ws + WS_SLAB), (unsigned*)(ws + WS_CTL) + CW_TK + 4096 * (pb + 6), lds);
            }
            SEAM(pb + 6);
            for (int rep = 0; rep < NREP(10); ++rep) if (EN(10) && IN(pb + 7)) {
                kaptr kp = ka_get(); TID_HERE(); unsigned char* ws = KWS(kp);
                constexpr int KP = MOE_F8 ? DFF / 2 : DFF;
                pg8::Gemm g{(const bf16*)(ws + WS_ACT), (const bf16*)(ws + WS_MW2), MAXSLOT, NE * D, KP}; pg8::EpiF32 E{(bf16*)(ws + WS_Y), D / 256, MOE_F8 ? 1.0f / 256.0f : 1.0f};
                pg8::OrderSplit<pg8::MapMoe> S; S.init((const PG8_LAS int*)TB, D / 256, G, bx, KP); S.plan(SPLITK_MOE_DOWN);
                pg8::EpiSplit<pg8::EpiF32> ES{E, (float*)(ws + WS_SLAB)};
                { pg8::CachedOrder CS; CS.fill(S, (PG8_LAS int*)(lds + UT_OFF), tid); __syncthreads();
                  pg8::gemm_phase<pg8::EpiSplit<pg8::EpiF32>, pg8::CachedOrder, true, true, MOE_F8>(lds, g, CS, ES); }
                combine_tail(E, S, (float*)(ws + WS_SLAB), (unsigned*)(ws + WS_CTL) + CW_TK + 4096 * (pb + 7), lds);
            }
            SEAM(pb + 7);
            for (int rep = 0; rep < NREP(11); ++rep) if (EN(11) && IN(pb + 8)) {
                kaptr kp = ka_get(); TID_HERE(); unsigned char* ws = KWS(kp); const int* ROUTE = (const int*)(ws + WS_ROUTE); const float* H = (const float*)(ws + WS_H); const bf16* Y = (const bf16*)(ws + WS_Y);
                const float* gate = (const float*)(ws + WS_MOD) + l * 5 * MODN + 5 * D; const float* nf = KIN(kp, 26); float* out = KOUT(kp);
                for (int t = gw; t < RL; t += NGW) {
                    const int* rec = ROUTE + (size_t)t * 8; const int e1 = rec[0], s1 = rec[1], e2 = rec[3], s2 = rec[4]; const float w1 = __builtin_bit_cast(float, rec[2]), w2 = __builtin_bit_cast(float, rec[5]);
                    const int b1 = TB[e1], b2 = TB[e2];
                    const int bidx = t >> 11;
                    const GAS f32x4* hr = (const GAS f32x4*)(H + (size_t)(RC + t) * D) + lane; const GAS v2u* y1 = (const GAS v2u*)(Y + (size_t)(b1 * 256 + s1) * D) + lane; const GAS v2u* y2 = (const GAS v2u*)(Y + (size_t)(b2 * 256 + s2) * D) + lane;
                    const GAS f32x4* g4 = (const GAS f32x4*)(gate + bidx * MODN) + lane;
                    f32x4 v[8]; float ss = 0.f;
#pragma unroll
                    for (int j = 0; j < 8; ++j) { const v2u ra = y1[64 * j], rb = y2[64 * j];
                        const f32x4 a = (f32x4){bf2f((unsigned short)(ra.x & 0xffffu)), bf2f((unsigned short)(ra.x >> 16)), bf2f((unsigned short)(ra.y & 0xffffu)), bf2f((unsigned short)(ra.y >> 16))};
                        const f32x4 b = (f32x4){bf2f((unsigned short)(rb.x & 0xffffu)), bf2f((unsigned short)(rb.x >> 16)), bf2f((unsigned short)(rb.y & 0xffffu)), bf2f((unsigned short)(rb.y >> 16))};
                        v[j] = hr[64 * j] + g4[64 * j] * (a * w1 + b * w2); ss += (v[j].x * v[j].x + v[j].y * v[j].y) + (v[j].z * v[j].z + v[j].w * v[j].w); }
                    const float rstd = 1.0f / sqrtf(wave_sum(ss) * (1.0f / D) + EPS);
                    GAS f32x4* op = (GAS f32x4*)(out + (size_t)t * D) + lane; const GAS f32x4* n4 = (const GAS f32x4*)nf + lane;
#pragma unroll
                    for (int j = 0; j < 8; ++j) op[64 * j] = v[j] * rstd * n4[64 * j];
                }
            }
        }
    }
#undef IN
#undef SEAM
}

extern "C" void kernel_launch(void* const* d_in, const int* in_sizes, int n_in, void* d_out, int out_size, void* d_ws, size_t ws_size, hipStream_t stream) {
    static int grid = 0;
    if (grid == 0) {
        if (n_in != 27 || out_size != RL * D || ws_size < WS_END) { fprintf(stderr, "kernel_launch: unexpected problem (n_in %d, out %d, ws %zu); nothing launched\n", n_in, out_size, ws_size); grid = -1; return; }
        int dev = 0, cus = 0, per_cu = 0;
        if (hipGetDevice(&dev) != hipSuccess || hipDeviceGetAttribute(&cus, hipDeviceAttributeMultiprocessorCount, dev) != hipSuccess) { grid = -1; return; }
        if (hipFuncSetAttribute((const void*)fwd_kernel, hipFuncAttributeMaxDynamicSharedMemorySize, LDS_BYTES) != hipSuccess) { fprintf(stderr, "kernel_launch: hipFuncSetAttribute failed\n"); grid = -1; return; }
        if (hipOccupancyMaxActiveBlocksPerMultiprocessor(&per_cu, (const void*)fwd_kernel, NWAVES * 64, LDS_BYTES) != hipSuccess || per_cu < 1) fprintf(stderr, "kernel_launch: occupancy query reports %d\n", per_cu);
        (void)hipGetLastError();
        grid = cus;
    }
    if (grid < 0) return;
    if (hipMemsetAsync((char*)d_ws + WS_CTL, 0, CTL_ZERO_BYTES, stream) != hipSuccess) { fprintf(stderr, "kernel_launch: memset failed\n"); return; }
    Args a{};
    for (int i = 0; i < 27; ++i) a.in[i] = (const float*)d_in[i];
    a.out = (float*)d_out; a.ws = (unsigned char*)d_ws;
#if MK_PER_PHASE
    for (int p = 0; p < NPHASE; ++p) { a.ph_lo = p; a.ph_hi = p + 1; hipLaunchKernelGGL(fwd_kernel, dim3(grid), dim3(NWAVES * 64), LDS_BYTES, stream, a); }
#else
    a.ph_lo = 0; a.ph_hi = NPHASE;
    hipLaunchKernelGGL(fwd_kernel, dim3(grid), dim3(NWAVES * 64), LDS_BYTES, stream, a);
#endif
    const hipError_t le = hipPeekAtLastError();
    if (le != hipSuccess) fprintf(stderr, "kernel_launch: launch failed: %s\n", hipGetErrorName(le));
}
```

```cpp
#include <hip/hip_runtime.h>
#include <cstdio>
#include <cstdint>
#include <cmath>

#define GAS __attribute__((address_space(1)))
#define LAS __attribute__((address_space(3)))
namespace pg8 {
#define PG8_LAS __attribute__((address_space(3)))
typedef unsigned short bf16_t;
typedef short bf16x8 __attribute__((ext_vector_type(8)));
typedef float f32x4 __attribute__((ext_vector_type(4)));
typedef unsigned u32x4 __attribute__((ext_vector_type(4)));
typedef int i32x4 __attribute__((ext_vector_type(4)));
typedef int i32x8 __attribute__((ext_vector_type(8)));
constexpr int BM = 256, BK = 64, HALF = 128, HTB = HALF * BK * 2  , STAGE_BYTES = 8 * HTB, NXCD = 8, WGM = 8;

__host__ __device__ __forceinline__ int lds_byte(int r, int c) { const int st = (r >> 4) * 2 + (c >> 5), rr = r & 15, cc = c & 31, ob = rr * 64 + cc * 2; return st * 1024 + (ob ^ (((ob >> 9) & 1) << 5)); }
__host__ __device__ __forceinline__ void stage_rc(int b, int& R, int& C) { const int st = b / 1024, sb = b % 1024, swz = sb ^ (((sb >> 9) & 1) << 5); R = (st >> 1) * 16 + swz / 64; C = (st & 1) * 32 + (swz % 64) / 2; }
__host__ __device__ __forceinline__ int perm32(int rho) { const int n = rho >> 4, i = rho & 15; return 8 * (i >> 2) + 4 * n + (i & 3); }

struct Unit { int pm, pn, k0, nkt, sid; };
struct Gemm { const bf16_t* A; const bf16_t* Bt; int M, N, K; };

struct StaticOrder {
    int nM, nN, nwg, G, c;
    __host__ __device__ void init(int M, int N, int G_, int c_, int K_) { nM = M / BM; nN = N / BM; nwg = nM * nN; G = G_; c = c_; K = K_; }
    int K;
    __host__ __device__ bool next(int i, Unit& u) const { const long L = (long)i * G + c; if (L >= nwg) return false; map(L, u); return true; }
    __host__ __device__ void map(long L, Unit& u) const {
        int wgid = (int)L; { const int q = nwg / NXCD, r = nwg % NXCD, xcd = wgid % NXCD, off = wgid / NXCD; wgid = (xcd < r ? xcd * (q + 1) : r * (q + 1) + (xcd - r) * q) + off; }
        const int nig = WGM * nN, gid = wgid / nig, fm = gid * WGM, gsz = (nM - fm) < WGM ? (nM - fm) : WGM;
        u.pm = fm + ((wgid % nig) % gsz); u.pn = (wgid % nig) / gsz; u.k0 = 0; u.nkt = K / BK; u.sid = -1;
    }
    __device__ __forceinline__ void a_ready(const Unit&) const {}
    __device__ __forceinline__ void done(const Unit&) const {}
};

__device__ __forceinline__ unsigned cvt_pk_bf16(float lo, float hi) { unsigned r; asm volatile("v_cvt_pk_bf16_f32 %0, %1, %2" : "=v"(r) : "v"(lo), "v"(hi)); return r; }
typedef unsigned u32x4 __attribute__((ext_vector_type(4)));
constexpr float QSCALE = 0.125f * 1.4426950408889634f;
__device__ __forceinline__ float gelu_tanh(float x) {
    const float y = 0.7978845608028654f * (x + 0.044715f * x * x * x);
    return x * __builtin_amdgcn_rcpf(1.0f + __builtin_amdgcn_exp2f(-2.0f * 1.4426950408889634f * y));
}
__device__ __forceinline__ float silu_f(float x) { return x * __builtin_amdgcn_rcpf(1.0f + __builtin_amdgcn_exp2f(-1.4426950408889634f * x)); }

struct EpiIn {
    static constexpr bool PERM = true, AFTER_DRAIN = false;
    bf16_t* O; const float* rope;
    __device__ __forceinline__ void operator()(const f32x4 (&acc)[2][2][4][2], const Unit& u, int wr, int wc, int fr, int fq) const {
        const int row0 = u.pm * BM + wr * 64 + fr; const bool lat = u.pm >= 4;
#pragma unroll
        for (int bj = 0; bj < 2; ++bj) {
            const int cb = u.pn * BM + bj * HALF; int role;
            if (cb < 512) role = 0; else if (cb < 1024) role = 1; else if (cb < 1536) role = 2; else if (cb < 2048) role = 0; else if (cb < 3072) role = 3; else if (cb < 3584) role = 1; else if (cb < 3712) role = 2; else role = 0;
            const int col0 = cb + wc * 32 + 8 * fq;
#pragma unroll
            for (int ai = 0; ai < 2; ++ai)
#pragma unroll
                for (int m = 0; m < 4; ++m) {
                    const int row = row0 + ai * HALF + m * 16;
                    f32x4 v0 = acc[ai][bj][m][0], v1 = acc[ai][bj][m][1];
                    if (role == 1 || role == 2) {
                        if (lat) {
                            const int t = (row - 1024) & 2047, pos = (wc & 1) ? (t & 63) : (t >> 6);
                            const f32x4 cs = *(const f32x4*)(rope + pos * 16 + 4 * fq), sn = *(const f32x4*)(rope + 1024 + pos * 16 + 4 * fq);
                            f32x4 a0, a1;
                            a0[0] = v0[0] * cs[0] - v0[1] * sn[0]; a0[1] = v0[0] * sn[0] + v0[1] * cs[0];
                            a0[2] = v0[2] * cs[1] - v0[3] * sn[1]; a0[3] = v0[2] * sn[1] + v0[3] * cs[1];
                            a1[0] = v1[0] * cs[2] - v1[1] * sn[2]; a1[1] = v1[0] * sn[2] + v1[1] * cs[2];
                            a1[2] = v1[2] * cs[3] - v1[3] * sn[3]; a1[3] = v1[2] * sn[3] + v1[3] * cs[3];
                            v0 = a0; v1 = a1;
                        }
                        if (role == 1) { v0 = v0 * QSCALE; v1 = v1 * QSCALE; }
                    } else if (role == 3) {
#pragma unroll
                        for (int e = 0; e < 4; ++e) { v0[e] = gelu_tanh(v0[e]); v1[e] = gelu_tanh(v1[e]); }
                    }
                    u32x4 w; w.x = cvt_pk_bf16(v0[0], v0[1]); w.y = cvt_pk_bf16(v0[2], v0[3]); w.z = cvt_pk_bf16(v1[0], v1[1]); w.w = cvt_pk_bf16(v1[2], v1[3]);
                    *(u32x4*)(O + (size_t)row * 3840 + col0) = w;
                }
        }
    }
};
__device__ __forceinline__ float clamp_fp8(float x) { return __builtin_amdgcn_fmed3f(x, -448.0f, 448.0f); }
__device__ __forceinline__ unsigned cvt4_fp8(float a, float b, float c, float d) { a = clamp_fp8(a); b = clamp_fp8(b); c = clamp_fp8(c); d = clamp_fp8(d); int w = 0; w = __builtin_amdgcn_cvt_pk_fp8_f32(a, b, w, false); w = __builtin_amdgcn_cvt_pk_fp8_f32(c, d, w, true); return (unsigned)w; }
template <bool F8OUT> struct EpiSwiglu {
    static constexpr bool PERM = true, AFTER_DRAIN = false;
    void* O; int ldo; int ntn; float sc;
    __device__ __forceinline__ void operator()(const f32x4 (&acc)[2][2][4][2], const Unit& u, int wr, int wc, int fr, int fq) const {
        const int row0 = u.pm * BM + wr * 64 + fr, col0 = (u.pn % ntn) * HALF + wc * 32 + 8 * fq;
#pragma unroll
        for (int ai = 0; ai < 2; ++ai)
#pragma unroll
            for (int m = 0; m < 4; ++m) {
                const f32x4 g0 = acc[ai][0][m][0] * sc, g1 = acc[ai][0][m][1] * sc, u0 = acc[ai][1][m][0] * sc, u1 = acc[ai][1][m][1] * sc;
                f32x4 r0, r1;
#pragma unroll
                for (int e = 0; e < 4; ++e) { r0[e] = silu_f(g0[e]) * u0[e]; r1[e] = silu_f(g1[e]) * u1[e]; }
                const size_t row = (size_t)(row0 + ai * HALF + m * 16);
                if constexpr (F8OUT) { typedef unsigned u32x2 __attribute__((ext_vector_type(2))); u32x2 w; w.x = cvt4_fp8(r0[0], r0[1], r0[2], r0[3]); w.y = cvt4_fp8(r1[0], r1[1], r1[2], r1[3]);
                    *(u32x2*)((unsigned char*)O + row * ldo + col0) = w; }
                else { u32x4 w; w.x = cvt_pk_bf16(r0[0], r0[1]); w.y = cvt_pk_bf16(r0[2], r0[3]); w.z = cvt_pk_bf16(r1[0], r1[1]); w.w = cvt_pk_bf16(r1[2], r1[3]);
                    *(u32x4*)((bf16_t*)O + row * ldo + col0) = w; }
            }
    }
};
struct EpiResid {
    static constexpr bool PERM = false, AFTER_DRAIN = false;
    const float* resC; const float* resL; float* out; const float* gate; float sc;
    __device__ __forceinline__ void operator()(const f32x4 (&acc)[2][2][4][2], const Unit& u, int wr, int wc, int fr, int fq) const {
        const int bidx = u.pm < 4 ? 4 : ((u.pm - 4) >> 3); const float* res = u.pm < 4 ? resC : resL; const float* gp = gate + bidx * 12288;
        const int row0 = u.pm * BM + wr * 64 + fr;
#pragma unroll
        for (int bj = 0; bj < 2; ++bj)
#pragma unroll
            for (int n = 0; n < 2; ++n) {
                const int col = u.pn * BM + bj * HALF + wc * 32 + 16 * n + 4 * fq; const f32x4 g4 = *(const f32x4*)(gp + col);
#pragma unroll
                for (int ai = 0; ai < 2; ++ai)
#pragma unroll
                    for (int m = 0; m < 4; ++m) { const size_t off = (size_t)(row0 + ai * HALF + m * 16) * 2048 + col; const f32x4 r = *(const f32x4*)(res + off); *(f32x4*)(out + off) = r + g4 * (acc[ai][bj][m][n] * sc); }
                asm volatile("" ::: "memory");
            }
    }
};
struct EpiF32 {
    static constexpr bool PERM = true, AFTER_DRAIN = false;
    bf16_t* O; int ntn; float sc;
    __device__ __forceinline__ void operator()(const f32x4 (&acc)[2][2][4][2], const Unit& u, int wr, int wc, int fr, int fq) const {
        const int row0 = u.pm * BM + wr * 64 + fr;
#pragma unroll
        for (int bj = 0; bj < 2; ++bj) {
            const int col0 = (u.pn % ntn) * BM + bj * HALF + wc * 32 + 8 * fq;
#pragma unroll
            for (int ai = 0; ai < 2; ++ai)
#pragma unroll
                for (int m = 0; m < 4; ++m) { const f32x4 v0 = acc[ai][bj][m][0] * sc, v1 = acc[ai][bj][m][1] * sc;
                    u32x4 w; w.x = cvt_pk_bf16(v0[0], v0[1]); w.y = cvt_pk_bf16(v0[2], v0[3]); w.z = cvt_pk_bf16(v1[0], v1[1]); w.w = cvt_pk_bf16(v1[2], v1[3]);
                    *(u32x4*)(O + (size_t)(row0 + ai * HALF + m * 16) * 2048 + col0) = w; }
        }
    }
};
template <class Epi> struct EpiSplit {
    static constexpr bool PERM = Epi::PERM, AFTER_DRAIN = false;
    Epi E; float* slab;
    __device__ __forceinline__ void operator()(const f32x4 (&acc)[2][2][4][2], const Unit& u, int wr, int wc, int fr, int fq) const {
        if (u.sid < 0) { E(acc, u, wr, wc, fr, fq); return; }
        f32x4* sp = (f32x4*)slab + (size_t)u.sid * (32 * 512) + (wr * 4 + wc) * 64 + fq * 16 + fr;
#pragma unroll
        for (int ai = 0; ai < 2; ++ai)
#pragma unroll
            for (int bj = 0; bj < 2; ++bj)
#pragma unroll
                for (int m = 0; m < 4; ++m)
#pragma unroll
                    for (int n = 0; n < 2; ++n) sp[(size_t)((((ai * 2 + bj) * 4 + m) * 2) + n) * 512] = acc[ai][bj][m][n];
    }
};
struct TailPlan { int nfull, ntail, S;
    __device__ __forceinline__ void make(int nwg, int G, bool allow, int K) { nfull = (nwg / G) * G; ntail = nwg - nfull;
        S = (!allow || ntail == 0) ? 1 : ((4 * ntail <= G && K % 512 == 0) ? 4 : ((2 * ntail <= G && K % 256 == 0) ? 2 : 1)); } };
template <class Base> struct OrderSplit : Base {
    TailPlan tp;
    __device__ __forceinline__ void plan(bool allow) { tp.make(this->nwg, this->G, allow, this->K); }
    __device__ __forceinline__ bool next(int i, Unit& u) const {
        const long L = (long)i * this->G + this->c;
        if (tp.S == 1) { if (L >= this->nwg) return false; this->map(L, u); return true; }
        if (L < tp.nfull) { this->map(L, u); return true; }
        const int j = (int)(L - tp.nfull); if (j >= tp.ntail * tp.S) return false;
        this->map(tp.nfull + j / tp.S, u); const int ks = j % tp.S, klen = this->K / tp.S; u.k0 = ks * klen; u.nkt = klen / BK; u.sid = j; return true;
    }
    __device__ __forceinline__ bool tail_unit(int& tt, Unit& u) const { if (tp.S == 1 || this->c >= tp.ntail * tp.S) return false; tt = this->c / tp.S; this->map(tp.nfull + tt, u); return true; }
};
struct CachedOrder {
    const PG8_LAS int* tab;
    template <class Ord> __device__ __forceinline__ void fill(const Ord& S, PG8_LAS int* t, int tid) {
        if (tid < 32) { Unit u; u.pm = 0; u.pn = 0; u.k0 = 0; u.nkt = 2; u.sid = -1; const bool ok = S.next(tid, u);
            t[tid * 8 + 0] = ok ? 1 : 0; t[tid * 8 + 1] = u.pm; t[tid * 8 + 2] = u.pn; t[tid * 8 + 3] = u.k0; t[tid * 8 + 4] = u.nkt; t[tid * 8 + 5] = u.sid; }
        tab = t;
    }
    __device__ __forceinline__ bool next(int i, Unit& u) const {
        if (i >= 32) return false;
        const i32x4 a = *(const PG8_LAS i32x4*)(tab + i * 8); const int b0 = tab[i * 8 + 4], b1 = tab[i * 8 + 5];
        if (!__builtin_amdgcn_readfirstlane(a[0])) return false;
        u.pm = __builtin_amdgcn_readfirstlane(a[1]); u.pn = __builtin_amdgcn_readfirstlane(a[2]); u.k0 = __builtin_amdgcn_readfirstlane(a[3]); u.nkt = __builtin_amdgcn_readfirstlane(b0); u.sid = __builtin_amdgcn_readfirstlane(b1); return true;
    }
    __device__ __forceinline__ void a_ready(const Unit&) const {}
    __device__ __forceinline__ void done(const Unit&) const {}
};
struct MapOff : StaticOrder {
    int pm_off;
    __device__ __forceinline__ void map(long L, Unit& u) const { StaticOrder::map(L, u); u.pm += pm_off; }
};
struct MapIn {
    StaticOrder lat; int nwg, G, c, K, nextra;
    __device__ __forceinline__ void init(int G_, int c_, int K_, int nextra_) { lat.init(8192, 3840, G_, c_, K_); G = G_; c = c_; K = K_; nextra = nextra_; nwg = lat.nwg + nextra_; }
    __device__ __forceinline__ void map(long L, Unit& u) const {
        if (L < lat.nwg) { lat.map(L, u); u.pm += 4; return; }
        const int e = (int)(L - lat.nwg);
        if (nextra == 60) { u.pm = e / 15; u.pn = e % 15; } else { u.pm = e / 5; const int idx = e % 5; u.pn = idx < 4 ? 4 + idx : 14; }
        u.k0 = 0; u.nkt = K / BK; u.sid = -1;
    }
    __device__ __forceinline__ void a_ready(const Unit&) const {}
    __device__ __forceinline__ void done(const Unit&) const {}
};
struct MapMoe {
    const PG8_LAS int* tb; int ntn, G, c, K, nwg;
    __device__ __forceinline__ void init(const PG8_LAS int* tb_, int ntn_, int G_, int c_, int K_) { tb = tb_; ntn = ntn_; G = G_; c = c_; K = K_; nwg = tb_[8] * ntn_; }
    __device__ __forceinline__ void map(long L, Unit& u) const {
        int wgid = (int)L; { const int q = nwg / NXCD, r = nwg % NXCD, xcd = wgid % NXCD, off = wgid / NXCD; wgid = (xcd < r ? xcd * (q + 1) : r * (q + 1) + (xcd - r) * q) + off; }
        int e = 0;
#pragma unroll
        for (int k = 1; k < 8; ++k) if (wgid >= tb[k] * ntn) e = k;
        const int t0 = tb[e], Te = tb[e + 1] - t0, local = wgid - t0 * ntn;
        const int nig = WGM * ntn, gid = local / nig, fm = gid * WGM, gsz = (Te - fm) < WGM ? (Te - fm) : WGM;
        u.pm = t0 + fm + ((local % nig) % gsz); u.pn = e * ntn + (local % nig) / gsz; u.k0 = 0; u.nkt = K / BK; u.sid = -1;
    }
    __device__ __forceinline__ void a_ready(const Unit&) const {}
    __device__ __forceinline__ void done(const Unit&) const {}
};

template <class Epi, class Sched, bool ALIGN_EPI = false, bool SP2 = false, bool F8 = false>
__device__ __forceinline__ void gemm_phase(PG8_LAS unsigned char* lds, const Gemm g, const Sched& S, const Epi& E) {
    int tid_o = threadIdx.x; asm volatile("" : "+v"(tid_o));
    const int tid = tid_o, wid = __builtin_amdgcn_readfirstlane(tid >> 6), lane = tid & 63, wr = wid >> 2, wc = wid & 3, fr = lane & 15, fq = lane >> 4;
    const int K = g.K;
    unsigned voffA[2], voffB[2];
#pragma unroll
    for (int i = 0; i < 2; ++i) { int R, C; stage_rc(tid * 16 + i * 8192, R, C); const int Rb = Epi::PERM ? ((R & ~31) + perm32(R & 31)) : R;
        voffA[i] = (unsigned)(R * K + C) * 2u; voffB[i] = (unsigned)(Rb * K + C) * 2u; }
    const size_t kstep = (size_t)(BK * 2);
    const size_t hstep = (size_t)HALF * K * 2;
    const size_t tstep = 2 * hstep;
    const unsigned ldsw = (unsigned)wid * 1024u;
    const int aoff = lds_byte(wr * 64 + fr, fq * 8), boff = lds_byte(wc * 32 + fr, fq * 8);
#define PG8_SA(b, h) (((b) * 2 + (h)) * HTB)
#define PG8_SB(b, h) ((4 + (b) * 2 + (h)) * HTB)
#define PG8_STAGE(bufoff, gbase, voff) do { _Pragma("unroll") for (int _i = 0; _i < 2; ++_i) \
        __builtin_amdgcn_global_load_lds((const unsigned*)((const char*)(gbase) + (voff)[_i]), (PG8_LAS unsigned*)(lds + (bufoff) + ldsw + _i * 8192), 16, 0, 0); } while (0)
#define PG8_LD32(p0_, p1_) __builtin_shufflevector(*(const PG8_LAS i32x4*)(p0_), *(const PG8_LAS i32x4*)(p1_), 0, 1, 2, 3, 4, 5, 6, 7)
#define PG8_LDA(dst, b, h) do { if constexpr (F8) { _Pragma("unroll") for (int m = 0; m < 4; ++m) dst##8[m] = PG8_LD32(lds + PG8_SA(b, h) + aoff + m * 2048, lds + PG8_SA(b, h) + aoff + m * 2048 + 1024); } else { \
        _Pragma("unroll") for (int m = 0; m < 4; ++m) _Pragma("unroll") for (int k = 0; k < 2; ++k) dst[m][k] = *(const PG8_LAS bf16x8*)(lds + PG8_SA(b, h) + aoff + m * 2048 + k * 1024); } } while (0)
#define PG8_LDB(dst, b, h) do { if constexpr (F8) { _Pragma("unroll") for (int n = 0; n < 2; ++n) dst##8[n] = PG8_LD32(lds + PG8_SB(b, h) + boff + n * 2048, lds + PG8_SB(b, h) + boff + n * 2048 + 1024); } else { \
        _Pragma("unroll") for (int n = 0; n < 2; ++n) _Pragma("unroll") for (int k = 0; k < 2; ++k) dst[n][k] = *(const PG8_LAS bf16x8*)(lds + PG8_SB(b, h) + boff + n * 2048 + k * 1024); } } while (0)
#define PG8_MMA(ai, bj, At, Bt) do { __builtin_amdgcn_s_setprio(1); if constexpr (F8) { _Pragma("unroll") for (int m = 0; m < 4; ++m) _Pragma("unroll") for (int n = 0; n < 2; ++n) \
        asm volatile("v_mfma_f32_16x16x128_f8f6f4 %0, %1, %2, %0" : "+v"(acc[ai][bj][m][n]) : "v"(Bt##8[n]), "v"(At##8[m])); } else { \
        _Pragma("unroll") for (int m = 0; m < 4; ++m) _Pragma("unroll") for (int n = 0; n < 2; ++n) _Pragma("unroll") for (int k = 0; k < 2; ++k) \
        acc[ai][bj][m][n] = __builtin_amdgcn_mfma_f32_16x16x32_bf16(Bt[n][k], At[m][k], acc[ai][bj][m][n], 0, 0, 0); } __builtin_amdgcn_s_setprio(0); } while (0)
#define PG8_WAIT_V(n) asm volatile("s_waitcnt vmcnt(" #n ")" ::: "memory")
#define PG8_WAIT_L(n) asm volatile("s_waitcnt lgkmcnt(" #n ")" ::: "memory")
#define PG8_BAR __builtin_amdgcn_s_barrier()
#define PG8_SCHED __builtin_amdgcn_sched_barrier(0)
    Unit cur, nxt; int ui = 0;
    if (!S.next(0, cur)) return;
    f32x4 acc[2][2][4][2];
#pragma unroll
    for (int a = 0; a < 2; ++a)
#pragma unroll
        for (int b = 0; b < 2; ++b)
#pragma unroll
            for (int m = 0; m < 4; ++m)
#pragma unroll
                for (int n = 0; n < 2; ++n) acc[a][b][m][n] = (f32x4){0.f, 0.f, 0.f, 0.f};
    bf16x8 At[4][2], B0[2][2], B1[2][2]; i32x8 At8[4], B08[2], B18[2];
    const char* cA = (const char*)g.A + (size_t)cur.pm * tstep + (size_t)cur.k0 * 2; const char* cB = (const char*)g.Bt + (size_t)cur.pn * tstep + (size_t)cur.k0 * 2;
    S.a_ready(cur);
    if constexpr (SP2) {
        PG8_STAGE(PG8_SB(0, 0), cB, voffB); PG8_STAGE(PG8_SB(0, 1), cB + hstep, voffB); PG8_STAGE(PG8_SA(0, 0), cA, voffA); PG8_STAGE(PG8_SA(0, 1), cA + hstep, voffA);
        if (wr == 1) PG8_BAR;
        PG8_WAIT_V(2); PG8_BAR;
        PG8_STAGE(PG8_SB(1, 0), cB + kstep, voffB); PG8_STAGE(PG8_SA(1, 0), cA + kstep, voffA); PG8_STAGE(PG8_SB(1, 1), cB + hstep + kstep, voffB);
        PG8_WAIT_V(6); PG8_BAR;
    } else {
        PG8_STAGE(PG8_SB(0, 0), cB, voffB); PG8_STAGE(PG8_SA(0, 0), cA, voffA); PG8_STAGE(PG8_SB(0, 1), cB + hstep, voffB); PG8_STAGE(PG8_SA(0, 1), cA + hstep, voffA);
        if (wr == 1) PG8_BAR;
        PG8_WAIT_V(4); PG8_BAR;
        PG8_STAGE(PG8_SB(1, 0), cB + kstep, voffB); PG8_STAGE(PG8_SA(1, 0), cA + kstep, voffA); PG8_STAGE(PG8_SB(1, 1), cB + hstep + kstep, voffB);
        PG8_WAIT_V(6); PG8_BAR;
    }
    for (;;) {
        const bool has_next = S.next(ui + 1, nxt);
        const char* nA = has_next ? (const char*)g.A + (size_t)nxt.pm * tstep + (size_t)nxt.k0 * 2 : cA; const char* nB = has_next ? (const char*)g.Bt + (size_t)nxt.pn * tstep + (size_t)nxt.k0 * 2 : cB;
        const int nt = cur.nkt;
        for (int t = 0; t < nt; t += 2) {
            const bool last = (t == nt - 2);
            const char* a1 = cA + (size_t)(t + 1) * kstep;
            const char* a2 = last ? nA : cA + (size_t)(t + 2) * kstep; const char* b2 = last ? nB : cB + (size_t)(t + 2) * kstep;
            const char* a3 = a2 + kstep; const char* b3 = b2 + kstep;
            if (last && has_next) S.a_ready(nxt);
            if constexpr (SP2) {
            PG8_LDB(B0, 0, 0); PG8_LDB(B1, 0, 1); PG8_SCHED; PG8_LDA(At, 0, 0); PG8_STAGE(PG8_SA(1, 1), a1 + hstep, voffA);
            PG8_WAIT_V(8); PG8_WAIT_L(0); PG8_BAR; PG8_MMA(0, 0, At, B0); PG8_MMA(0, 1, At, B1); PG8_BAR; PG8_SCHED;
            PG8_LDA(At, 0, 1); PG8_STAGE(PG8_SB(0, 0), b2, voffB); PG8_STAGE(PG8_SB(0, 1), b2 + hstep, voffB); PG8_STAGE(PG8_SA(0, 0), a2, voffA);
            PG8_WAIT_V(8); PG8_WAIT_L(0); PG8_BAR; PG8_MMA(1, 0, At, B0); PG8_MMA(1, 1, At, B1); PG8_BAR; PG8_SCHED;
            PG8_LDB(B0, 1, 0); PG8_LDB(B1, 1, 1); PG8_SCHED; PG8_LDA(At, 1, 0); PG8_STAGE(PG8_SA(0, 1), a2 + hstep, voffA);
            PG8_WAIT_V(8); PG8_WAIT_L(0); PG8_BAR; PG8_MMA(0, 0, At, B0); PG8_MMA(0, 1, At, B1); PG8_BAR; PG8_SCHED;
            PG8_LDA(At, 1, 1); PG8_STAGE(PG8_SB(1, 0), b3, voffB); PG8_STAGE(PG8_SB(1, 1), b3 + hstep, voffB); PG8_STAGE(PG8_SA(1, 0), a3, voffA);
            PG8_WAIT_V(8); PG8_WAIT_L(0); PG8_BAR; PG8_MMA(1, 0, At, B0); PG8_MMA(1, 1, At, B1); PG8_BAR; PG8_SCHED;
            } else {
            PG8_LDB(B0, 0, 0); PG8_SCHED; PG8_LDA(At, 0, 0); PG8_STAGE(PG8_SA(1, 1), a1 + hstep, voffA);
            PG8_WAIT_L(8); PG8_BAR; PG8_WAIT_L(0); PG8_MMA(0, 0, At, B0); PG8_BAR; PG8_SCHED;
            PG8_LDB(B1, 0, 1); PG8_STAGE(PG8_SB(0, 0), b2, voffB);
            PG8_BAR; PG8_WAIT_L(0); PG8_MMA(0, 1, At, B1); PG8_BAR;
            PG8_LDA(At, 0, 1); PG8_STAGE(PG8_SA(0, 0), a2, voffA);
            PG8_BAR; PG8_WAIT_L(0); PG8_MMA(1, 0, At, B0); PG8_BAR; PG8_SCHED;
            PG8_STAGE(PG8_SB(0, 1), b2 + hstep, voffB);
            PG8_WAIT_V(6); PG8_BAR; PG8_MMA(1, 1, At, B1); PG8_BAR;
            PG8_LDB(B0, 1, 0); PG8_SCHED; PG8_LDA(At, 1, 0); PG8_STAGE(PG8_SA(0, 1), a2 + hstep, voffA);
            PG8_WAIT_L(8); PG8_BAR; PG8_WAIT_L(0); PG8_MMA(0, 0, At, B0); PG8_BAR; PG8_SCHED;
            PG8_LDB(B1, 1, 1); PG8_STAGE(PG8_SB(1, 0), b3, voffB);
            PG8_BAR; PG8_WAIT_L(0); PG8_MMA(0, 1, At, B1); PG8_BAR;
            PG8_LDA(At, 1, 1); PG8_STAGE(PG8_SA(1, 0), a3, voffA);
            PG8_BAR; PG8_WAIT_L(0); PG8_MMA(1, 0, At, B0); PG8_BAR; PG8_SCHED;
            PG8_STAGE(PG8_SB(1, 1), b3 + hstep, voffB);
            PG8_WAIT_V(6); PG8_BAR; PG8_MMA(1, 1, At, B1); PG8_BAR;
            }
        }
        if constexpr (ALIGN_EPI) { if (wr == 0) PG8_BAR; }
        if constexpr (F8) asm volatile("s_nop 15\n\ts_nop 7" ::: "memory");
        if constexpr (!Epi::AFTER_DRAIN) { E(acc, cur, wr, wc, fr, fq); S.done(cur); }
        if (!has_next) break;
#pragma unroll
        for (int a = 0; a < 2; ++a)
#pragma unroll
            for (int b = 0; b < 2; ++b)
#pragma unroll
                for (int m = 0; m < 4; ++m)
#pragma unroll
                    for (int n = 0; n < 2; ++n) acc[a][b][m][n] = (f32x4){0.f, 0.f, 0.f, 0.f};
        cur = nxt; cA = nA; cB = nB; ++ui;
        if constexpr (ALIGN_EPI) { if (wr == 1) PG8_BAR; }
    }
    PG8_WAIT_V(0);
    if constexpr (!ALIGN_EPI) { if (wr == 0) PG8_BAR; }
    PG8_BAR;
    if constexpr (Epi::AFTER_DRAIN) { E.fused(acc, cur, wr, wc, fr, fq, lds, wid, lane); S.done(cur); }
#undef PG8_SA
#undef PG8_SB
#undef PG8_STAGE
#undef PG8_LDA
#undef PG8_LDB
#undef PG8_MMA
#undef PG8_LD32
#undef PG8_WAIT_V
#undef PG8_WAIT_L
#undef PG8_BAR
#undef PG8_SCHED
}
}

constexpr int D = 2048, NB = 4, SEQ = 2048, CTX = 256, DFF = 5632, NE = 8, INC = 3840, MODN = 12288;
constexpr int RC = NB * CTX, RL = NB * SEQ, RT = RC + RL;
constexpr int NTN_UP = DFF / 128;
constexpr int MAXSLOT = 2 * RL + NE * 256;
constexpr float EPS = 1e-6f, LOG2E = 1.4426950408889634f;
constexpr int NWAVES = 8;
#ifndef MK_PER_PHASE
#define MK_PER_PHASE 0
#endif
constexpr int NPHASE = 17;
#ifndef MOE_F8_ON
#define MOE_F8_ON 1
#endif
#ifndef DENSE_UP_F8_ON
#define DENSE_UP_F8_ON 1
#endif
#ifndef DENSE_DN_F8_ON
#define DENSE_DN_F8_ON 0
#endif
constexpr bool DENSE_UP_F8 = DENSE_UP_F8_ON != 0, DENSE_DN_F8 = DENSE_DN_F8_ON != 0;
constexpr bool MOE_F8 = MOE_F8_ON != 0;

constexpr size_t MiB = 1u << 20;
constexpr size_t WS_CTL = 0, CTL_ZERO_BYTES = 1 * MiB;
constexpr size_t WS_MOD = 1 * MiB;
constexpr size_t WS_ROPE = 1 * MiB + 512 * 1024;
constexpr size_t WS_ROUTE = 1 * MiB + 768 * 1024;
constexpr size_t WS_WIN = 2 * MiB, WS_WOUT = 32 * MiB, WS_W13 = 48 * MiB, WS_W2 = 92 * MiB, WS_MW13 = 114 * MiB, WS_MW2 = 466 * MiB;
constexpr size_t WS_H = 642 * MiB;
constexpr size_t WS_XN = 714 * MiB;
constexpr size_t WS_PALL = 750 * MiB;
constexpr size_t WS_MIX = 818 * MiB;
constexpr size_t WS_ACT = 854 * MiB;
constexpr size_t WS_XG = 1052 * MiB;
constexpr size_t WS_Y = 1124 * MiB;
constexpr size_t WS_SLAB = 1268 * MiB;
constexpr size_t WS_END = 1332 * MiB;
constexpr int CW_TMO = 0, CW_CODE = 1, CW_BAR = 4096, CW_CNT = 8192;
constexpr int CW_TK = 16384;
constexpr int CW_Q0 = 9216, CW_Q1 = 9280, CW_DONE = 9344;

constexpr int RING_BYTES = 131072, LDSCTL_OFF = 139264, MISC_OFF = LDSCTL_OFF + 320, TB_OFF = LDSCTL_OFF + 512, FLAG_OFF = LDSCTL_OFF + 256, UT_OFF = LDSCTL_OFF + 1024, LDS_BYTES = 147456;

typedef unsigned short bf16;
typedef unsigned v4u __attribute__((ext_vector_type(4)));
typedef unsigned v2u __attribute__((ext_vector_type(2)));
typedef float f32x4 __attribute__((ext_vector_type(4)));
typedef float f32x16 __attribute__((ext_vector_type(16)));
typedef short bf16x8 __attribute__((ext_vector_type(8)));
typedef short v4i16_t __attribute__((ext_vector_type(4)));
typedef GAS unsigned gu32;
#define RLX_AGENT __ATOMIC_RELAXED, __HIP_MEMORY_SCOPE_AGENT
#define LDS_WAIT() asm volatile("s_waitcnt lgkmcnt(0)" ::: "memory")
__device__ __forceinline__ unsigned f2bf(float f) { unsigned u = __builtin_bit_cast(unsigned, f); return (u + 0x7fffu + ((u >> 16) & 1u)) >> 16; }
__device__ __forceinline__ unsigned pk2(float lo, float hi) { return f2bf(lo) | (f2bf(hi) << 16); }
__device__ __forceinline__ float bf2f(unsigned short b) { return __builtin_bit_cast(float, (unsigned)b << 16); }
__device__ __forceinline__ float wave_sum(float v) {
#pragma unroll
    for (int o = 1; o < 64; o <<= 1) v += __shfl_xor(v, o);
    return v;
}

#define XB_TMO      128
#define XB_XCNT(j)  (256  + 64 * (j))
#define XB_XSUB(j)  (1280 + 64 * (j))
#define XB_XGEN(j)  (2304 + 64 * (j))
#define XB_TOP      3328
#define XB_TOPGEN   3392
#define XCD_BAR_WORDS 3456
#define XB_SPIN_CAP (1u << 18)

__device__ __forceinline__ unsigned xb_ld(unsigned* p)              { return __hip_atomic_load(p, __ATOMIC_RELAXED, __HIP_MEMORY_SCOPE_AGENT); }
__device__ __forceinline__ unsigned xb_add(unsigned* p, unsigned v) { return __hip_atomic_fetch_add(p, v, __ATOMIC_RELAXED, __HIP_MEMORY_SCOPE_AGENT); }
__device__ __forceinline__ unsigned xb_xcc_id() { return (unsigned)__builtin_amdgcn_s_getreg((3 << 11) | 20) & 0xFu; }
#define XB_SPIN(cond, bar) do { unsigned _sp = 0; while (cond) { __builtin_amdgcn_s_sleep(1); \
    if ((++_sp & 255u) == 0u) { if (xb_ld(&(bar)[XB_TMO])) break; if (_sp > XB_SPIN_CAP) { atomicAdd(&(bar)[XB_TMO], 1u); break; } } } } while (0)

struct XcdBarrier {
    unsigned* bar; unsigned x;
    volatile LAS unsigned* st;
};

__device__ __forceinline__ XcdBarrier xcd_barrier_post(unsigned* bar, volatile LAS unsigned* st) {
    XcdBarrier b; b.bar = bar; b.x = xb_xcc_id(); b.st = st;
    if (threadIdx.x == 0) (void)xb_add(&bar[XB_XCNT(b.x)], 1u);
    return b;
}
__device__ __forceinline__ void xcd_barrier_complete(unsigned* bar, unsigned x, unsigned& nloc, unsigned& nx) {
    const unsigned G = gridDim.x * gridDim.y * gridDim.z;
    unsigned sum, cnt, mine, sp = 0u;
    for (;;) {
        sum = 0u; cnt = 0u; mine = 0u;
#pragma unroll
        for (unsigned j = 0; j < 16; ++j) { const unsigned c = xb_ld(&bar[XB_XCNT(j)]); sum += c; cnt += (c > 0u) ? 1u : 0u; mine = (j == x) ? c : mine; }
        if (sum == G) break;
        __builtin_amdgcn_s_sleep(1);
        if ((++sp & 255u) == 0u) { if (xb_ld(&bar[XB_TMO])) break; if (sp > XB_SPIN_CAP) { atomicAdd(&bar[XB_TMO], 1u); break; } }
    }
    nloc = mine > 0u ? mine : 1u; nx = cnt > 0u ? cnt : 1u;
}

__device__ __attribute__((noinline)) void xcd_barrier(const XcdBarrier b) {
    asm volatile("s_waitcnt vmcnt(0)" ::: "memory");
    __syncthreads();
    if (threadIdx.x == 0) {
        unsigned* bar = b.bar;
        __builtin_amdgcn_s_waitcnt(0);
        unsigned nloc = b.st[0], nx = b.st[1];
        if (nloc == 0u) { xcd_barrier_complete(bar, b.x, nloc, nx); b.st[0] = nloc; b.st[1] = nx; }
        const unsigned old = xb_add(&bar[XB_XSUB(b.x)], 1u);
        const unsigned gen = old / nloc;
        if (old + 1u == (gen + 1u) * nloc) {
            __builtin_amdgcn_fence(__ATOMIC_RELEASE, "agent");
            asm volatile("s_waitcnt vmcnt(0)" ::: "memory");
            const unsigned og = xb_add(&bar[XB_TOP], 1u);
            const unsigned tg = og / nx;
            if (og + 1u == (tg + 1u) * nx) xb_add(&bar[XB_TOPGEN], 1u);
            else XB_SPIN(xb_ld(&bar[XB_TOPGEN]) == tg, bar);
            __builtin_amdgcn_fence(__ATOMIC_ACQUIRE, "agent");
            xb_add(&bar[XB_XGEN(b.x)], 1u);
            asm volatile("s_waitcnt vmcnt(0)" ::: "memory");
        } else {
            XB_SPIN(xb_ld(&bar[XB_XGEN(b.x)]) == gen, bar);
            __builtin_amdgcn_fence(__ATOMIC_ACQUIRE, "agent");
            asm volatile("s_waitcnt vmcnt(0)" ::: "memory");
        }
    }
    __syncthreads();
}

struct Args { const float* in[27]; float* out; unsigned char* ws; int ph_lo, ph_hi; };
#define CAS __attribute__((address_space(4)))
typedef const CAS unsigned char* kaptr;
__device__ __forceinline__ kaptr ka_get() { kaptr p = (kaptr)__builtin_amdgcn_kernarg_segment_ptr(); asm volatile("" : "+s"(p)); return p; }
#define KIN(kp, i) (*(const float* const CAS*)((kp) + 8 * (i)))
#define KOUT(kp) (*(float* const CAS*)((kp) + 216))
#define KWS(kp) (*(unsigned char* const CAS*)((kp) + 224))
#define KLO(kp) (*(const int CAS*)((kp) + 232))
#define KHI(kp) (*(const int CAS*)((kp) + 236))
static_assert(sizeof(Args) == 240, "Args layout");

__device__ __forceinline__ int dst_row(int mode, int n) {
    if (mode == 1) {
        const bool qk = (n >= 512 && n < 1536) || (n >= 3072 && n < 3712);
        if (qk) { const int d = n & 63; return (n & ~63) + (d < 32 ? 2 * d : 2 * (d - 32) + 1); }
        return n;
    }
    if (mode == 2) return (n >> 7) * 256 + (n & 127);
    if (mode == 3) return (n >> 7) * 256 + 128 + (n & 127);
    return n;
}
constexpr int TSCR = 64 * 65 * 4;
template <bool NTL>
__device__ __forceinline__ void ti_load(const float* W, int N, int item, int lane, f32x4 (&v)[16]) {
    const int nblk = N / 64, kb = item / nblk, nb = item % nblk, k0 = 64 * kb, n0 = 64 * nb;
    const GAS f32x4* src = (const GAS f32x4*)(W + (size_t)(k0 + (lane >> 4)) * N + n0 + 4 * (lane & 15));
#pragma unroll
    for (int i = 0; i < 16; ++i) v[i] = NTL ? __builtin_nontemporal_load(src + (size_t)i * N) : src[(size_t)i * N];
}
template <bool NTS, bool F8>
__device__ __forceinline__ void ti_store(const f32x4 (&v)[16], int K, int N, bf16* WT, int mode, LAS float* scr, int item, int lane) {
    const int nblk = N / 64, kb = item / nblk, nb = item % nblk, k0 = 64 * kb, n0 = 64 * nb;
    LAS float* wp = scr + (lane >> 4) * 65 + 4 * (lane & 15);
#pragma unroll
    for (int i = 0; i < 16; ++i) { wp[i * 4 * 65 + 0] = v[i].x; wp[i * 4 * 65 + 1] = v[i].y; wp[i * 4 * 65 + 2] = v[i].z; wp[i * 4 * 65 + 3] = v[i].w; }
    LDS_WAIT(); asm volatile("" ::: "memory");
    if constexpr (F8) {
        const int c = lane & 3;
#pragma unroll
        for (int j = 0; j < 4; ++j) { const int n = (lane >> 2) + 16 * j; const LAS float* s = scr + (16 * c) * 65 + n;
            v4u o;
#pragma unroll
            for (int q = 0; q < 4; ++q) o[q] = pg8::cvt4_fp8(256.0f * s[(4 * q) * 65], 256.0f * s[(4 * q + 1) * 65], 256.0f * s[(4 * q + 2) * 65], 256.0f * s[(4 * q + 3) * 65]);
            GAS v4u* dp = (GAS v4u*)((unsigned char*)WT + (size_t)dst_row(mode, n0 + n) * K + k0 + 16 * c); if (NTS) __builtin_nontemporal_store(o, dp); else *dp = o; }
    } else {
        const int c = lane & 7;
#pragma unroll
        for (int j = 0; j < 8; ++j) { const int n = (lane >> 3) + 8 * j; const LAS float* s = scr + (8 * c) * 65 + n;
            v4u o; o.x = pk2(s[0 * 65], s[1 * 65]); o.y = pk2(s[2 * 65], s[3 * 65]); o.z = pk2(s[4 * 65], s[5 * 65]); o.w = pk2(s[6 * 65], s[7 * 65]);
            GAS v4u* dp = (GAS v4u*)(WT + (size_t)dst_row(mode, n0 + n) * K + k0 + 8 * c); if (NTS) __builtin_nontemporal_store(o, dp); else *dp = o; }
    }
    LDS_WAIT(); asm volatile("" ::: "memory");
}
template <bool NT, bool F8 = false, bool NTL = false>
__device__ __forceinline__ void transpose_item(const float* W, int K, int N, bf16* WT, int mode, LAS float* scr, int item, int lane, const float*) {
    f32x4 v[16]; ti_load<NT || NTL>(W, N, item, lane, v); ti_store<NT, F8>(v, K, N, WT, mode, scr, item, lane);
}
__device__ __forceinline__ void p0_prologue(kaptr kp, LAS unsigned char* lds, int vcu, int G, int tid, int lane, int wave) {
    unsigned char* ws = KWS(kp);
    for (int j = vcu; j < 256; j += G) {
        const int l = j >> 7, g = (j >> 5) & 3, k0 = (j & 31) * 64;
        LAS float* As = (LAS float*)lds;
        LAS float* Ps = As + 64 * 132;
        const float* Wsrc = KIN(kp, 8) + (size_t)l * D * INC + (size_t)k0 * INC + g * 128;
        const float* Psrc = KIN(kp, 10) + ((size_t)l * 4 + g) * 128 * 128;
#pragma unroll
        for (int i = 0; i < 4; ++i) { const int idx = tid + 512 * i, r = idx >> 5, c4 = idx & 31; *(LAS f32x4*)(As + r * 132 + 4 * c4) = *(const GAS f32x4*)(Wsrc + (size_t)r * INC + 4 * c4); }
#pragma unroll
        for (int i = 0; i < 8; ++i) { const int idx = tid + 512 * i, r = idx >> 5, c4 = idx & 31; *(LAS f32x4*)(Ps + r * 132 + 4 * c4) = *(const GAS f32x4*)(Psrc + (size_t)r * 128 + 4 * c4); }
        __syncthreads();
        const int n4 = tid & 31, kq = tid >> 5;
        f32x4 acc[4];
#pragma unroll
        for (int i = 0; i < 4; ++i) acc[i] = (f32x4){0.f, 0.f, 0.f, 0.f};
#pragma unroll 4
        for (int c = 0; c < 128; ++c) { const f32x4 pv = *(const LAS f32x4*)(Ps + c * 132 + 4 * n4);
#pragma unroll
            for (int i = 0; i < 4; ++i) acc[i] += As[(4 * kq + i) * 132 + c] * pv; }
        bf16* WT = (bf16*)(ws + WS_WIN) + (size_t)l * INC * D;
#pragma unroll
        for (int e = 0; e < 4; ++e) { v2u o; o.x = pk2(acc[0][e], acc[1][e]); o.y = pk2(acc[2][e], acc[3][e]);
            *(GAS v2u*)(WT + (size_t)(g * 128 + 4 * n4 + e) * D + k0 + 4 * kq) = o; }
        __syncthreads();
    }
    for (int j = vcu; j < 192; j += G) {
        const int l = j / 96, n0 = (j % 96) * 128;
        LAS float* S = (LAS float*)lds; LAS float* red = S + 5 * 2048;
        for (int idx = tid; idx < 5 * 2048; idx += NWAVES * 64) { const int i = idx >> 11, k = idx & 2047; const float v = i < 4 ? KIN(kp, 1)[i * 2048 + k] : KIN(kp, 3)[k]; S[idx] = v / (1.0f + expf(-v)); }
        __syncthreads();
        f32x4 acc[5];
#pragma unroll
        for (int i = 0; i < 5; ++i) acc[i] = (f32x4){0.f, 0.f, 0.f, 0.f};
        const int kh = lane >> 5;
        const GAS f32x4* wp = (const GAS f32x4*)(KIN(kp, 4) + ((size_t)l * 2048 + wave * 256 + kh) * MODN + n0 + 4 * (lane & 31));
#pragma unroll 8
        for (int k = 0; k < 128; ++k) { const f32x4 w = __builtin_nontemporal_load(wp + (size_t)k * (2 * MODN / 4));
#pragma unroll
            for (int i = 0; i < 5; ++i) acc[i] += S[i * 2048 + wave * 256 + 2 * k + kh] * w; }
#pragma unroll
        for (int i = 0; i < 5; ++i) { f32x4 t = acc[i]; t.x += __shfl_xor(t.x, 32); t.y += __shfl_xor(t.y, 32); t.z += __shfl_xor(t.z, 32); t.w += __shfl_xor(t.w, 32);
            if (kh == 0) *(LAS f32x4*)(red + (wave * 5 + i) * 128 + 4 * (lane & 31)) = t; }
        __syncthreads();
        for (int idx = tid; idx < 640; idx += NWAVES * 64) { const int i = idx >> 7, n = idx & 127; float s = 0.f;
#pragma unroll
            for (int w = 0; w < 8; ++w) s += red[(w * 5 + i) * 128 + n];
            ((float*)(ws + WS_MOD))[(l * 5 + i) * MODN + n0 + n] = s + KIN(kp, 5)[l * MODN + n0 + n]; }
        __syncthreads();
    }
    if (vcu == (200 % G)) {
        for (int idx = tid; idx < 1024; idx += NWAVES * 64) { const int pos = idx >> 4, f = idx & 15; const float inv = powf(10000.0f, -(float)f / 16.0f); const float ang = (float)pos * inv;
            ((float*)(ws + WS_ROPE))[idx] = cosf(ang); ((float*)(ws + WS_ROPE))[1024 + idx] = sinf(ang); }
    }
    __syncthreads();
    LAS float* scr = (LAS float*)(lds + wave * TSCR);
    constexpr int I_IN = 32 * 52, I_OUT = 32 * 32, I_UP = 32 * 88, I_DN = 88 * 32;
    constexpr int NITEMS = 2 * I_IN + 2 * I_OUT;
    unsigned* q0 = (unsigned*)(ws + WS_CTL) + CW_Q0;
#define P0_DESC(it_, W_, K_, N_, WT_, M_, I_, F_) do { int r = (it_); F_ = false; \
        if (r < 2 * I_IN) { const int l = r / I_IN; W_ = KIN(kp, 8) + (size_t)l * D * INC; K_ = D; N_ = INC; WT_ = (bf16*)(ws + WS_WIN) + (size_t)l * INC * D; M_ = 1; const int q = r % I_IN; I_ = (q / 52) * 60 + 8 + (q % 52); } \
        else { r -= 2 * I_IN; const int l = r / I_OUT; W_ = KIN(kp, 9) + (size_t)l * D * D; K_ = D; N_ = D; WT_ = (bf16*)(ws + WS_WOUT) + (size_t)l * D * D; M_ = 0; I_ = r % I_OUT; } } while (0)
    for (;;) {
        unsigned k0 = 0; if (lane == 0) k0 = __hip_atomic_fetch_add(q0, 2u, RLX_AGENT);
        const int kb = (int)__builtin_amdgcn_readfirstlane(k0); if (kb >= NITEMS) break;
        const float* Wa; int Ka, Na, ma, ia; bf16* WTa; bool fa; f32x4 va[16];
        P0_DESC(kb, Wa, Ka, Na, WTa, ma, ia, fa); ti_load<true>(Wa, Na, ia, lane, va);
        const bool two = kb + 1 < NITEMS;
        const float* Wb = Wa; int Kb = Ka, Nb = Na, mb = ma, ib = ia; bf16* WTb = WTa; bool fb = fa; f32x4 vb[16];
        if (two) { P0_DESC(kb + 1, Wb, Kb, Nb, WTb, mb, ib, fb); ti_load<true>(Wb, Nb, ib, lane, vb); }
        if (fa) ti_store<false, true>(va, Ka, Na, WTa, ma, scr, ia, lane); else ti_store<false, false>(va, Ka, Na, WTa, ma, scr, ia, lane);
        if (two) { if (fb) ti_store<false, true>(vb, Kb, Nb, WTb, mb, scr, ib, lane); else ti_store<false, false>(vb, Kb, Nb, WTb, mb, scr, ib, lane); }
    }
#undef P0_DESC
}

__device__ __attribute__((noinline)) void fill_tail(unsigned char* ws, const float* w1, const float* w3, const float* w2, const float* d1, const float* d3, const float* d2, unsigned* done, int G, int nw, int limit) {
    extern __shared__ __attribute__((aligned(16))) unsigned char lds_fill[];
    LAS unsigned char* lds = (LAS unsigned char*)lds_fill;
    const int tid = threadIdx.x, lane = tid & 63, wave = __builtin_amdgcn_readfirstlane(tid >> 6);
    volatile LAS unsigned* flag = (volatile LAS unsigned*)(lds + FLAG_OFF);
    __syncthreads();
    if (tid == 0) { unsigned f = 0u; if (done) { const unsigned old = __hip_atomic_fetch_add(done, 1u, RLX_AGENT); f = (old + 1u >= (unsigned)G) ? 1u : 0u; }
                    else f = (__hip_atomic_load((unsigned*)(ws + WS_CTL) + CW_Q1, RLX_AGENT) < (unsigned)limit) ? 2u : 0u;
                    *flag = f; }
    __syncthreads();
    LAS float* scr = (LAS float*)(lds + wave * TSCR);
    unsigned* q1 = (unsigned*)(ws + WS_CTL) + CW_Q1;
    constexpr int I_UP = 32 * 88, ND = 3 * I_UP, NIT = ND + 24 * I_UP;
#ifndef FILLW
#define FILLW 2
#endif
#ifndef FILLB
#define FILLB 4
#endif
#ifdef PROBE_BURN
    if (done && wave >= FILLW) {
        f32x16 acc; for (int r = 0; r < 16; ++r) acc[r] = 0.f; const bf16x8 a = (bf16x8){1, 2, 3, 4, 5, 6, 7, 8};
        while (!*flag) { for (int it = 0; it < 64; ++it) acc = __builtin_amdgcn_mfma_f32_32x32x16_bf16(a, a, acc, 0, 0, 0); if (__hip_atomic_load(done, RLX_AGENT) >= (unsigned)G) break; }
        if (acc[0] == 12345.f) *flag = 2u;
        return; }
#endif
    if (done && wave >= nw) return;
#define FILL_ITEM(it_) do { const int it__ = (it_); const int seg = (it__ < ND ? it__ : it__ - ND) / I_UP, item = it__ % I_UP, mat = seg >> 3, e = seg & 7; \
        if (it__ < ND) { if (seg == 0) transpose_item<false, DENSE_UP_F8, true>(d1, D, DFF, (bf16*)(ws + WS_W13), 2, scr, item, lane, nullptr); \
            else if (seg == 1) transpose_item<false, DENSE_UP_F8, true>(d3, D, DFF, (bf16*)(ws + WS_W13), 3, scr, item, lane, nullptr); \
            else transpose_item<false, DENSE_DN_F8, true>(d2, DFF, D, (bf16*)(ws + WS_W2), 0, scr, item, lane, nullptr); } \
        else if (mat == 0) transpose_item<true, MOE_F8>(w1 + (size_t)e * D * DFF, D, DFF, (bf16*)(ws + WS_MW13 + (size_t)e * 2 * DFF * D * (MOE_F8 ? 1 : 2)), 2, scr, item, lane, nullptr); \
        else if (mat == 1) transpose_item<true, MOE_F8>(w3 + (size_t)e * D * DFF, D, DFF, (bf16*)(ws + WS_MW13 + (size_t)e * 2 * DFF * D * (MOE_F8 ? 1 : 2)), 3, scr, item, lane, nullptr); \
        else transpose_item<true, MOE_F8>(w2 + (size_t)e * DFF * D, DFF, D, (bf16*)(ws + WS_MW2 + (size_t)e * D * DFF * (MOE_F8 ? 1 : 2)), 0, scr, item, lane, nullptr); } while (0)
    if (!done) {
        if (*flag != 2u) return;
        for (;;) {
            unsigned k0 = 0xffffffffu;
            if (lane == 0) { const unsigned h = __hip_atomic_load(q1, RLX_AGENT); if (h < (unsigned)limit) k0 = __hip_atomic_fetch_add(q1, (unsigned)FILLB, RLX_AGENT); }
            const unsigned kb = __builtin_amdgcn_readfirstlane(k0); if (kb == 0xffffffffu) break;
            for (int it = (int)kb; it < (int)kb + FILLB && it < NIT; ++it) FILL_ITEM(it);
        }
        return;
    }
    for (;;) {
        if (*flag) break;
        if (tid == 0) { if (__hip_atomic_load(done, RLX_AGENT) >= (unsigned)G) *flag = 1u; }
        if (*flag) break;
        unsigned k0 = 0; if (lane == 0) k0 = __hip_atomic_fetch_add(q1, (unsigned)FILLB, RLX_AGENT);
        const int kb = (int)__builtin_amdgcn_readfirstlane(k0); if (kb >= NIT) break;
        for (int it = kb; it < kb + FILLB && it < NIT; ++it) FILL_ITEM(it);
    }
#undef FILL_ITEM
}

__device__ __forceinline__ void drain_tail(unsigned char* ws, const float* w1, const float* w3, const float* w2, int G, LAS unsigned char* lds) {
    int tid = threadIdx.x; asm volatile("" : "+v"(tid));
    const int lane = tid & 63, wave = __builtin_amdgcn_readfirstlane(tid >> 6);
    __syncthreads();
    LAS float* scr = (LAS float*)(lds + wave * TSCR);
    unsigned* q1 = (unsigned*)(ws + WS_CTL) + CW_Q1;
    constexpr int I_UP = 32 * 88, ND = 3 * I_UP, NIT = ND + 24 * I_UP;
        const int h = max(ND, (int)__builtin_amdgcn_readfirstlane(__hip_atomic_load(q1, RLX_AGENT)));
        const int gwv = blockIdx.x * NWAVES + wave, ngw = G * NWAVES;
#define MOE_DESC(it_, W_, K_, N_, WT_, M_, I_) do { const int seg_ = ((it_) - ND) / I_UP, mat_ = seg_ >> 3, e_ = seg_ & 7; I_ = (it_) % I_UP; \
        if (mat_ == 0) { W_ = w1 + (size_t)e_ * D * DFF; K_ = D; N_ = DFF; WT_ = (bf16*)(ws + WS_MW13 + (size_t)e_ * 2 * DFF * D * (MOE_F8 ? 1 : 2)); M_ = 2; } \
        else if (mat_ == 1) { W_ = w3 + (size_t)e_ * D * DFF; K_ = D; N_ = DFF; WT_ = (bf16*)(ws + WS_MW13 + (size_t)e_ * 2 * DFF * D * (MOE_F8 ? 1 : 2)); M_ = 3; } \
        else { W_ = w2 + (size_t)e_ * DFF * D; K_ = DFF; N_ = D; WT_ = (bf16*)(ws + WS_MW2 + (size_t)e_ * D * DFF * (MOE_F8 ? 1 : 2)); M_ = 0; } } while (0)
        int it = h + gwv;
        if (it < NIT) {
            const float* W; int K, N, md, item; bf16* WT; f32x4 v[16];
            MOE_DESC(it, W, K, N, WT, md, item); ti_load<true>(W, N, item, lane, v);
            for (;;) {
                const int nx = it + ngw; const float* Wn = W; int Kn = K, Nn = N, mdn = md, itemn = item; bf16* WTn = WT; f32x4 vn[16];
                const bool more = nx < NIT;
                if (more) { MOE_DESC(nx, Wn, Kn, Nn, WTn, mdn, itemn); ti_load<true>(Wn, Nn, itemn, lane, vn); }
                ti_store<true, MOE_F8>(v, K, N, WT, md, scr, item, lane);
                if (!more) break;
#pragma unroll
                for (int i = 0; i < 16; ++i) v[i] = vn[i];
                it = nx; W = Wn; K = Kn; N = Nn; WT = WTn; md = mdn; item = itemn;
            }
        }
#undef MOE_DESC
}

template <class Epi, class Ord>
__device__ __forceinline__ void combine_tail(const Epi& E, const Ord& S, const float* slab, unsigned* tickets, LAS unsigned char* lds) {
    int tt; pg8::Unit tu;
    if (!S.tail_unit(tt, tu)) return;
    int tid = threadIdx.x; asm volatile("" : "+v"(tid));
    const int lane = tid & 63, wid = __builtin_amdgcn_readfirstlane(tid >> 6), wr = wid >> 2, wc = wid & 3, fr = lane & 15, fq = lane >> 4;
    volatile LAS unsigned* flag = (volatile LAS unsigned*)(lds + FLAG_OFF);
    asm volatile("s_waitcnt vmcnt(0)" ::: "memory");
    __syncthreads();
    if (tid == 0) {
        __builtin_amdgcn_fence(__ATOMIC_RELEASE, "agent");
        asm volatile("s_waitcnt vmcnt(0)" ::: "memory");
        const unsigned t = __hip_atomic_fetch_add(tickets + 64 * tt, 1u, RLX_AGENT);
        const bool last = (t == (unsigned)S.tp.S - 1u);
        if (last) { __builtin_amdgcn_fence(__ATOMIC_ACQUIRE, "agent"); asm volatile("s_waitcnt vmcnt(0)" ::: "memory"); }
        *flag = last ? 1u : 0u;
    }
    __syncthreads();
    if (*flag) {
        const int ns = S.tp.S;
        const GAS pg8::f32x4* sp = (const GAS pg8::f32x4*)slab + (size_t)(tt * ns) * (32 * 512) + tid;
        pg8::f32x4 acc[2][2][4][2];
#pragma unroll
        for (int ai = 0; ai < 2; ++ai)
#pragma unroll
            for (int bj = 0; bj < 2; ++bj)
#pragma unroll
                for (int m = 0; m < 4; ++m)
#pragma unroll
                    for (int n = 0; n < 2; ++n) { const int r = (((ai * 2 + bj) * 4 + m) * 2) + n; pg8::f32x4 a = sp[(size_t)r * 512];
                        for (int ks = 1; ks < ns; ++ks) a += sp[(size_t)ks * (32 * 512) + (size_t)r * 512];
                        acc[ai][bj][m][n] = a; }
        E(acc, tu, wr, wc, fr, fq);
    }
    __syncthreads();
}

template <bool ROUTE, bool F8 = false>
__device__ __forceinline__ void norm_rows(const float* srcC, const float* srcL, const float* gain, const float* shift, const float* scale, bf16* XN, int row_lo, int row_hi, int gw, int NGW, int lane,
                                          const LAS float* rt, unsigned* cnt, int* route) {
    f32x4 vn[8];
    { const int row = row_lo + gw; if (row < row_hi) { const GAS f32x4* xr = (const GAS f32x4*)((row < RC ? srcC : srcL) + (size_t)row * D) + lane;
#pragma unroll
        for (int j = 0; j < 8; ++j) vn[j] = xr[64 * j]; } }
    for (int row = row_lo + gw; row < row_hi; row += NGW) {
        const int bidx = row < RC ? 4 : ((row - RC) >> 11);
        f32x4 v[8]; float ss = 0.f;
#pragma unroll
        for (int j = 0; j < 8; ++j) { v[j] = vn[j]; ss += (v[j].x * v[j].x + v[j].y * v[j].y) + (v[j].z * v[j].z + v[j].w * v[j].w); }
        { const int nrow = row + NGW; if (nrow < row_hi) { const GAS f32x4* xr = (const GAS f32x4*)((nrow < RC ? srcC : srcL) + (size_t)nrow * D) + lane;
#pragma unroll
            for (int j = 0; j < 8; ++j) vn[j] = xr[64 * j]; } }
        const float rstd = 1.0f / sqrtf(wave_sum(ss) * (1.0f / D) + EPS);
        const GAS f32x4* g4 = (const GAS f32x4*)gain + lane; const GAS f32x4* sh4 = (const GAS f32x4*)(shift + bidx * MODN) + lane; const GAS f32x4* sc4 = (const GAS f32x4*)(scale + bidx * MODN) + lane;
        GAS unsigned long long* o8 = (GAS unsigned long long*)(XN + (size_t)row * D) + lane; GAS unsigned* o4 = (GAS unsigned*)((unsigned char*)XN + (size_t)row * D) + lane;
#pragma unroll
        for (int j = 0; j < 8; ++j) { const f32x4 g = g4[64 * j], sh = sh4[64 * j], sc = sc4[64 * j]; v[j] = (v[j] * rstd * g) * (1.0f + sc) + sh;
            if constexpr (F8) o4[64 * j] = pg8::cvt4_fp8(v[j].x, v[j].y, v[j].z, v[j].w);
            else o8[64 * j] = (unsigned long long)pk2(v[j].x, v[j].y) | ((unsigned long long)pk2(v[j].z, v[j].w) << 32); }
        if (ROUTE) {
            float lg[8];
#pragma unroll
            for (int e = 0; e < 8; ++e) lg[e] = 0.f;
#pragma unroll
            for (int j = 0; j < 8; ++j)
#pragma unroll
                for (int q = 0; q < 4; ++q) { const int k = 256 * j + 4 * lane + q; const LAS f32x4* rp = (const LAS f32x4*)(rt + k * 8); const f32x4 r0 = rp[0], r1 = rp[1]; const float f = v[j][q];
                    lg[0] += f * r0.x; lg[1] += f * r0.y; lg[2] += f * r0.z; lg[3] += f * r0.w; lg[4] += f * r1.x; lg[5] += f * r1.y; lg[6] += f * r1.z; lg[7] += f * r1.w;
                    if (q == 3) asm volatile("" ::: "memory"); }
#pragma unroll
            for (int e = 0; e < 8; ++e) lg[e] = wave_sum(lg[e]);
            int i1 = 0; float v1 = lg[0];
#pragma unroll
            for (int e = 1; e < 8; ++e) if (lg[e] > v1) { v1 = lg[e]; i1 = e; }
            int i2 = -1; float v2 = -INFINITY;
#pragma unroll
            for (int e = 0; e < 8; ++e) if (e != i1 && lg[e] > v2) { v2 = lg[e]; i2 = e; }
            const float w1 = 1.0f / (1.0f + expf(v2 - v1)), w2 = 1.0f - w1;
            if (lane == 0) { const int s1 = (int)__hip_atomic_fetch_add(cnt + 64 * i1, 1u, RLX_AGENT), s2 = (int)__hip_atomic_fetch_add(cnt + 64 * i2, 1u, RLX_AGENT);
                int* rec = route + (size_t)(row - RC) * 8; rec[0] = i1; rec[1] = s1; rec[2] = __builtin_bit_cast(int, w1); rec[3] = i2; rec[4] = s2; rec[5] = __builtin_bit_cast(int, w2); }
        }
    }
}

struct TileSpec { int nband, band_row0, ctx_row0, nt; };
__device__ __forceinline__ int crow(int r, int hi) { return (r & 3) + 8 * (r >> 2) + 4 * hi; }
template <int NKC, int DVB, bool WIN>
__device__ __forceinline__ void attn_core(LAS unsigned char* lds, const bf16* P, const bf16x8 (&qr)[4], int kcol, int vcol, int kofs, const TileSpec ts, int qpos, int bandpos0,
                                          f32x16 (&o)[DVB], f32x16& ol, float& mref_out, int tid, int lane) {
    constexpr int SB = NKC * 1024 + DVB * 4096, NK = NKC / 8, NV = DVB / 2;
    constexpr float THR = 8.0f;
    const int r32 = lane & 31, hi = lane >> 5, wv = __builtin_amdgcn_readfirstlane(tid >> 6);
    int koff[NK], voff[NV];
#pragma unroll
    for (int i = 0; i < NK; ++i) { const int q = tid + 512 * i, key = q / NKC, s = q % NKC; koff[i] = key * INC + kcol + (s ^ (NKC == 16 ? (key & 15) : ((key >> 1) & 7))) * 8; }
#pragma unroll
    for (int i = 0; i < NV; ++i) { const int q = tid + 512 * i; voff[i] = (((q >> 6) & 3) * 16 + ((q >> 2) & 15)) * INC + vcol + (q >> 8) * 32 + (q & 3) * 8; }
#define ATT_DMA(t_, s_) do { const int t__ = (t_); const int rb_ = t__ < ts.nband ? ts.band_row0 + 64 * t__ : ts.ctx_row0 + 64 * (t__ - ts.nband); const bf16* tb_ = P + (size_t)rb_ * INC; \
        _Pragma("unroll") for (int i_ = 0; i_ < NK; ++i_) __builtin_amdgcn_global_load_lds((const unsigned*)(tb_ + koff[i_]), (LAS unsigned*)(lds + (s_) * SB + (wv * 64 + 512 * i_) * 16), 16, 0, 0); \
        _Pragma("unroll") for (int i_ = 0; i_ < NV; ++i_) __builtin_amdgcn_global_load_lds((const unsigned*)(tb_ + voff[i_]), (LAS unsigned*)(lds + (s_) * SB + NKC * 1024 + (wv * 64 + 512 * i_) * 16), 16, 0, 0); } while (0)
    float mref = 0.f;
    f32x16 negm;
#pragma unroll
    for (int r = 0; r < 16; ++r) { negm[r] = 0.f; ol[r] = 0.f; }
#pragma unroll
    for (int d0 = 0; d0 < DVB; ++d0)
#pragma unroll
        for (int r = 0; r < 16; ++r) o[d0][r] = 0.f;
    const short one = (r32 == 0) ? (short)0x3F80 : (short)0;
    const bf16x8 onesf = (bf16x8){one, one, one, one, one, one, one, one};
    ATT_DMA(0, 0); asm volatile("s_waitcnt vmcnt(0)" ::: "memory"); __syncthreads();
#pragma unroll 1
    for (int t = 0; t < ts.nt; ++t) {
        if (t + 1 < ts.nt) ATT_DMA(t + 1, (t + 1) & 1);
        LAS unsigned char* sb = lds + (t & 1) * SB;
        f32x16 p0, p1;
        { const LAS unsigned char* kb = sb + r32 * (NKC * 16);
#pragma unroll
          for (int d0 = 0; d0 < 4; ++d0) { const int so = ((kofs + 2 * d0 + hi) ^ (NKC == 16 ? (r32 & 15) : ((r32 >> 1) & 7))) * 16; const bf16x8 b0 = *(const LAS bf16x8*)(kb + so), b1 = *(const LAS bf16x8*)(kb + 32 * (NKC * 16) + so);
              if (d0 == 0) { p0 = __builtin_amdgcn_mfma_f32_32x32x16_bf16(b0, qr[0], negm, 0, 0, 0); p1 = __builtin_amdgcn_mfma_f32_32x32x16_bf16(b1, qr[0], negm, 0, 0, 0); }
              else { p0 = __builtin_amdgcn_mfma_f32_32x32x16_bf16(b0, qr[d0], p0, 0, 0, 0); p1 = __builtin_amdgcn_mfma_f32_32x32x16_bf16(b1, qr[d0], p1, 0, 0, 0); } } }
        if (WIN) { if (t < ts.nband) { const int kp0 = bandpos0 + 64 * t + 4 * hi;
#pragma unroll
            for (int r = 0; r < 16; ++r) { const int dlt = qpos - (kp0 + (r & 3) + 8 * (r >> 2)); if (dlt > 128 || dlt < -128) p0[r] = -1e30f; if (dlt - 32 > 128 || dlt - 32 < -128) p1[r] = -1e30f; } } }
        float rm = fmaxf(fmaxf(p0[0], p0[1]), p1[0]);
#pragma unroll
        for (int r = 1; r < 16; ++r) rm = fmaxf(fmaxf(rm, p0[r]), p1[r]);
        rm = fmaxf(rm, p0[1]);
        rm = fmaxf(rm, __shfl_xor(rm, 32));
        if (t == 0 || __any(rm > THR)) {
            const float dl = t == 0 ? rm : fmaxf(rm, 0.f);
            mref += dl;
#pragma unroll
            for (int r = 0; r < 16; ++r) { p0[r] -= dl; p1[r] -= dl; negm[r] = -mref; }
            if (t != 0) { const float f = __builtin_amdgcn_exp2f(-dl);
#pragma unroll
                for (int r = 0; r < 16; ++r) { const float fr = __shfl(f, crow(r, hi)); ol[r] *= fr;
#pragma unroll
                    for (int d0 = 0; d0 < DVB; ++d0) o[d0][r] *= fr; } }
        }
#pragma unroll
        for (int r = 0; r < 16; ++r) { p0[r] = __builtin_amdgcn_exp2f(p0[r]); p1[r] = __builtin_amdgcn_exp2f(p1[r]); }
        v4u pw[4];
#pragma unroll
        for (int i = 0; i < 4; ++i) { pw[0][i] = pg8::cvt_pk_bf16(p0[2 * i], p0[2 * i + 1]); pw[1][i] = pg8::cvt_pk_bf16(p0[8 + 2 * i], p0[8 + 2 * i + 1]); pw[2][i] = pg8::cvt_pk_bf16(p1[2 * i], p1[2 * i + 1]); pw[3][i] = pg8::cvt_pk_bf16(p1[8 + 2 * i], p1[8 + 2 * i + 1]); }
        { const LAS unsigned char* vb = sb + NKC * 1024 + ((lane >> 4) & 1) * 32 + (lane & 3) * 8 + (4 * hi + ((lane & 15) >> 2)) * 64;
#pragma unroll
          for (int d0 = 0; d0 < DVB; ++d0)
#pragma unroll
              for (int ks = 0; ks < 4; ++ks) {
                  const v4i16_t lo = __builtin_amdgcn_ds_read_tr16_b64_v4i16((LAS v4i16_t*)(vb + d0 * 4096 + ks * 1024)), hh = __builtin_amdgcn_ds_read_tr16_b64_v4i16((LAS v4i16_t*)(vb + d0 * 4096 + ks * 1024 + 512));
                  const bf16x8 vf = (bf16x8){lo[0], lo[1], lo[2], lo[3], hh[0], hh[1], hh[2], hh[3]};
                  o[d0] = __builtin_amdgcn_mfma_f32_32x32x16_bf16(__builtin_bit_cast(bf16x8, pw[ks]), vf, o[d0], 0, 0, 0);
                  if (ks == 3) asm volatile("" ::: "memory"); }
#pragma unroll
          for (int ks = 0; ks < 4; ++ks) ol = __builtin_amdgcn_mfma_f32_32x32x16_bf16(__builtin_bit_cast(bf16x8, pw[ks]), onesf, ol, 0, 0, 0); }
        asm volatile("s_waitcnt vmcnt(0)" ::: "memory");
        __syncthreads();
    }
#undef ATT_DMA
    mref_out = mref;
}
template <int DVB>
__device__ __forceinline__ void attn_normalize(f32x16 (&o)[DVB], const f32x16& ol, float extra, int hi) {
#pragma unroll
    for (int r = 0; r < 16; ++r) { const float l = __shfl(ol[r], hi << 5) + __shfl(extra, crow(r, hi)); const float ir = 1.0f / l;
#pragma unroll
        for (int d0 = 0; d0 < DVB; ++d0) o[d0][r] *= ir; }
}

__device__ __forceinline__ void win_unit(LAS unsigned char* lds, const bf16* P, bf16* MIX, const float* sink, int b, int g, int qb, bool ctxq, int tid, int lane, int wave) {
    const int r32 = lane & 31, hi = lane >> 5, hr = wave >> 1, sub = (wave & 1) * 32;
    TileSpec ts; int qrow0, qpos = 0, bandpos0 = 0;
    if (!ctxq) { const int tl = qb - 2 < 0 ? 0 : qb - 2, th = qb + 2 > 31 ? 31 : qb + 2; ts.nband = th - tl + 1; ts.band_row0 = RC + b * SEQ + tl * 64; bandpos0 = tl * 64; ts.ctx_row0 = b * CTX; ts.nt = ts.nband + 4;
        qrow0 = RC + b * SEQ + qb * 64 + sub; qpos = qb * 64 + sub + r32; }
    else { ts.nband = 0; ts.band_row0 = 0; ts.ctx_row0 = b * CTX; ts.nt = 4; qrow0 = b * CTX + qb * 64 + sub; }
    const int qcol = 3072 + g * 256 + hr * 64;
    bf16x8 qr[4];
#pragma unroll
    for (int d0 = 0; d0 < 4; ++d0) qr[d0] = *(const GAS bf16x8*)(P + (size_t)(qrow0 + r32) * INC + qcol + d0 * 16 + hi * 8);
    f32x16 o[2], ol; float mref;
    attn_core<8, 2, true>(lds, P, qr, 3584 + g * 64, 3712 + g * 64, 0, ts, qpos, bandpos0, o, ol, mref, tid, lane);
    attn_normalize<2>(o, ol, __builtin_amdgcn_exp2f(sink[g * 4 + hr] * LOG2E - mref), hi);
#pragma unroll
    for (int r = 0; r < 16; ++r) { bf16* op = MIX + (size_t)(qrow0 + crow(r, hi)) * D + 1536 + (g * 4 + hr) * 64 + r32;
#pragma unroll
        for (int d0 = 0; d0 < 2; ++d0) op[d0 * 32] = (bf16)f2bf(o[d0][r]); }
}

__device__ __forceinline__ void diff_unit(LAS unsigned char* lds, const bf16* P, bf16* MIX, const float* dlam, const float* subln, float lam_init, int b, int h, int qb, bool ctxq, int tid, int lane, int wave) {
    const int r32 = lane & 31, hi = lane >> 5, m = wave >> 2, sub = (wave & 3) * 32;
    TileSpec ts; int qrow0;
    if (!ctxq) { ts.nband = 32; ts.band_row0 = RC + b * SEQ; ts.ctx_row0 = b * CTX; ts.nt = 36; qrow0 = RC + b * SEQ + qb * 128 + sub; }
    else { ts.nband = 0; ts.band_row0 = 0; ts.ctx_row0 = b * CTX; ts.nt = 4; qrow0 = b * CTX + qb * 128 + sub; }
    const int qcol = 512 + h * 128 + m * 64;
    bf16x8 qr[4];
#pragma unroll
    for (int d0 = 0; d0 < 4; ++d0) qr[d0] = *(const GAS bf16x8*)(P + (size_t)(qrow0 + r32) * INC + qcol + d0 * 16 + hi * 8);
    const float lam = expf(wave_sum(dlam[lane] * dlam[64 + lane])) - expf(wave_sum(dlam[128 + lane] * dlam[192 + lane])) + lam_init;
    f32x16 o[4], ol; float mref;
    attn_core<16, 4, false>(lds, P, qr, 1024 + h * 128, 1536 + h * 128, m * 8, ts, 0, 0, o, ol, mref, tid, lane);
    attn_normalize<4>(o, ol, 0.f, hi);
    LAS float* ex = (LAS float*)lds + (wave & 3) * 4096;
    if (m == 1) {
#pragma unroll
        for (int d0 = 0; d0 < 4; ++d0)
#pragma unroll
            for (int r = 0; r < 16; ++r) ex[(d0 * 16 + r) * 64 + lane] = o[d0][r];
    }
    __syncthreads();
    if (m == 0) {
        float sl[4];
#pragma unroll
        for (int d0 = 0; d0 < 4; ++d0) sl[d0] = subln[d0 * 32 + r32] * (1.0f - lam_init);
#pragma unroll
        for (int r = 0; r < 16; ++r) {
            float ss = 0.f;
#pragma unroll
            for (int d0 = 0; d0 < 4; ++d0) { const float v = o[d0][r] - lam * ex[(d0 * 16 + r) * 64 + lane]; o[d0][r] = v; ss += v * v; }
            asm volatile("" ::: "memory");
#pragma unroll
            for (int off = 1; off < 32; off <<= 1) ss += __shfl_xor(ss, off);
            const float rstd = 1.0f / sqrtf(ss * (1.0f / 128.0f) + EPS);
            bf16* op = MIX + (size_t)(qrow0 + crow(r, hi)) * D + 512 + h * 128 + r32;
#pragma unroll
            for (int d0 = 0; d0 < 4; ++d0) op[d0 * 32] = (bf16)f2bf(o[d0][r] * rstd * sl[d0]);
        }
    }
    __syncthreads();
}

__device__ __forceinline__ void sgu_unit(LAS unsigned char* lds, const bf16* P, bf16* MIX, const float* ln_g, const float* ln_b, const float* Ws, const float* bs, int row0, int g, int tid, int lane, int wave) {
    constexpr int VS = 136;
    LAS bf16* VT = (LAS bf16*)lds;
    const int r32 = lane & 31, hi = lane >> 5;
    { const int tq = lane >> 4, j = lane & 15;
      v4u raws[4][4];
#pragma unroll
      for (int ps = 0; ps < 4; ++ps)
#pragma unroll
          for (int q = 0; q < 4; ++q) raws[ps][q] = *(const GAS v4u*)(P + (size_t)(row0 + wave * 16 + ps * 4 + tq) * INC + 2560 + (j + 16 * q) * 8);
      float lg8[8], lb8[8];
#pragma unroll
      for (int e = 0; e < 8; ++e) { lg8[e] = ln_g[g * 128 + 8 * j + e]; lb8[e] = ln_b[g * 128 + 8 * j + e]; }
#pragma unroll
      for (int ps = 0; ps < 4; ++ps) {
          float x[4][8]; float s = 0.f;
#pragma unroll
          for (int q = 0; q < 4; ++q)
#pragma unroll
              for (int e = 0; e < 4; ++e) { x[q][2 * e] = bf2f((unsigned short)(raws[ps][q][e] & 0xffffu)); x[q][2 * e + 1] = bf2f((unsigned short)(raws[ps][q][e] >> 16)); s += x[q][2 * e] + x[q][2 * e + 1]; }
#pragma unroll
          for (int off = 1; off < 16; off <<= 1) s += __shfl_xor(s, off);
          const float mean = s * (1.0f / 512.0f); float s2 = 0.f;
#pragma unroll
          for (int q = 0; q < 4; ++q)
#pragma unroll
              for (int e = 0; e < 8; ++e) { x[q][e] -= mean; s2 += x[q][e] * x[q][e]; }
#pragma unroll
          for (int off = 1; off < 16; off <<= 1) s2 += __shfl_xor(s2, off);
          const float rstd = 1.0f / sqrtf(s2 * (1.0f / 512.0f) + EPS);
          const int qtok = wave * 16 + ps * 4 + tq;
#pragma unroll
          for (int e = 0; e < 8; ++e) { const float xv = g == 0 ? x[0][e] : (g == 1 ? x[1][e] : (g == 2 ? x[2][e] : x[3][e])); VT[(8 * j + e) * VS + qtok] = (bf16)f2bf(xv * rstd * lg8[e] + lb8[e]); }
      }
    }
    __syncthreads();
    const int pb = wave & 3, ch = wave >> 2;
    f32x16 acc[2];
#pragma unroll
    for (int cb = 0; cb < 2; ++cb)
#pragma unroll
        for (int r = 0; r < 16; ++r) acc[cb][r] = 0.f;
    const float* wrow = Ws + (size_t)(g * 128 + pb * 32 + r32) * 128 + hi * 8;
#pragma unroll
    for (int ks = 0; ks < 8; ++ks) {
        const f32x4 w0 = *(const GAS f32x4*)(wrow + ks * 16), w1 = *(const GAS f32x4*)(wrow + ks * 16 + 4);
        v4u aw; aw.x = pk2(w0.x, w0.y); aw.y = pk2(w0.z, w0.w); aw.z = pk2(w1.x, w1.y); aw.w = pk2(w1.z, w1.w);
#pragma unroll
        for (int cb = 0; cb < 2; ++cb) { const bf16x8 bv = *(const LAS bf16x8*)(VT + (ch * 64 + cb * 32 + r32) * VS + ks * 16 + hi * 8);
            acc[cb] = __builtin_amdgcn_mfma_f32_32x32x16_bf16(__builtin_bit_cast(bf16x8, aw), bv, acc[cb], 0, 0, 0); }
    }
#pragma unroll
    for (int r = 0; r < 16; ++r) { const int p = pb * 32 + crow(r, hi); const float bias = bs[g * 128 + p];
#pragma unroll
        for (int cb = 0; cb < 2; ++cb) { const int c = g * 128 + ch * 64 + cb * 32 + r32; const float u = bf2f(P[(size_t)(row0 + p) * INC + 2048 + c]);
            MIX[(size_t)(row0 + p) * D + 1024 + c] = (bf16)f2bf(u * (acc[cb][r] + bias)); } }
    __syncthreads();
}

template <int HALF>
__device__ __forceinline__ void pool_body(const bf16* P, bf16* MIX, const float* pscale, int seq0, int T, int tk0, int cc) {
    constexpr int NR = 4 + 2 * HALF;
    v4u raw[NR];
#pragma unroll
    for (int r = 0; r < NR; ++r) { const int t = tk0 - HALF + r; raw[r] = (t >= 0 && t < T) ? *(const GAS v4u*)(P + (size_t)(seq0 + t) * INC + cc * 8) : (v4u){0u, 0u, 0u, 0u}; }
    const f32x4 s0 = *(const GAS f32x4*)(pscale + cc * 8), s1 = *(const GAS f32x4*)(pscale + cc * 8 + 4);
    const float sc[8] = {s0.x, s0.y, s0.z, s0.w, s1.x, s1.y, s1.z, s1.w};
    float w[8];
#pragma unroll
    for (int e = 0; e < 8; ++e) w[e] = 0.f;
#pragma unroll
    for (int r = 0; r < 2 * HALF - 1; ++r)
#pragma unroll
        for (int e = 0; e < 4; ++e) { w[2 * e] += bf2f((unsigned short)(raw[r][e] & 0xffffu)); w[2 * e + 1] += bf2f((unsigned short)(raw[r][e] >> 16)); }
#pragma unroll
    for (int i = 0; i < 4; ++i) {
        const int t = tk0 + i, lo = t - HALF < 0 ? 0 : t - HALF, hh = t + HALF > T ? T : t + HALF; const float rc = 1.0f / (float)(hh - lo);
        v4u o;
#pragma unroll
        for (int e = 0; e < 4; ++e) {
            w[2 * e] += bf2f((unsigned short)(raw[i + 2 * HALF - 1][e] & 0xffffu)); w[2 * e + 1] += bf2f((unsigned short)(raw[i + 2 * HALF - 1][e] >> 16));
            const float x0 = bf2f((unsigned short)(raw[HALF + i][e] & 0xffffu)), x1 = bf2f((unsigned short)(raw[HALF + i][e] >> 16));
            o[e] = pk2((w[2 * e] * rc - x0) * sc[2 * e], (w[2 * e + 1] * rc - x1) * sc[2 * e + 1]);
            w[2 * e] -= bf2f((unsigned short)(raw[i][e] & 0xffffu)); w[2 * e + 1] -= bf2f((unsigned short)(raw[i][e] >> 16));
        }
        *(GAS v4u*)(MIX + (size_t)(seq0 + t) * D + cc * 8) = o;
    }
}
__device__ __forceinline__ void pool_unit(const bf16* P, bf16* MIX, const float* pscale, int row0, int tid, int wave) {
    const int seq0 = row0 < RC ? (row0 & ~255) : RC + ((row0 - RC) & ~2047), T = row0 < RC ? CTX : SEQ, tk0 = row0 - seq0 + 4 * (tid & 7), cc = tid >> 3, g = wave >> 1;
    if (g == 0) pool_body<1>(P, MIX, pscale, seq0, T, tk0, cc); else if (g == 1) pool_body<2>(P, MIX, pscale, seq0, T, tk0, cc); else if (g == 2) pool_body<4>(P, MIX, pscale, seq0, T, tk0, cc); else pool_body<8>(P, MIX, pscale, seq0, T, tk0, cc);
}

__global__ void __launch_bounds__(NWAVES * 64, 2) fwd_kernel(Args args_unused) {
    extern __shared__ __attribute__((aligned(16))) unsigned char lds_raw[];
    LAS unsigned char* lds = (LAS unsigned char*)lds_raw;
    volatile LAS unsigned* MISC = (volatile LAS unsigned*)(lds + MISC_OFF);
    const int tid0 = threadIdx.x;
#define TID_HERE() int tid = threadIdx.x; asm volatile("" : "+v"(tid)); int G = G0, bx = bx0; asm volatile("" : "+s"(G), "+s"(bx)); const int vcu = (G % 8 == 0) ? (bx % 8) * (G / 8) + bx / 8 : bx; const int NGW = G * NWAVES; \
    const int lane = tid & 63, wave = __builtin_amdgcn_readfirstlane(tid >> 6); const int gw = vcu * NWAVES + wave; (void)lane; (void)gw; (void)NGW
    const int G0 = gridDim.x, bx0 = blockIdx.x;
    for (int u = tid0; u < (LDS_BYTES - LDSCTL_OFF) / 4; u += NWAVES * 64) ((LAS unsigned*)(lds + LDSCTL_OFF))[u] = 0u;
    __syncthreads();
    int lo, hi;
    XcdBarrier bar;
    { kaptr kp = ka_get(); lo = KLO(kp); hi = KHI(kp); unsigned* bw = (unsigned*)(KWS(kp) + WS_CTL) + CW_BAR; bar.bar = bw; bar.x = 0; bar.st = nullptr;
      if (!MK_PER_PHASE) bar = xcd_barrier_post(bw, MISC + 8); }
#ifndef SITEMASK
#define SITEMASK 0xfff
#endif
#ifndef UNITMASK
#define UNITMASK 0xf
#endif
#define UEN(s) (((UNITMASK) >> (s)) & 1)
#ifndef REPMASK
#define REPMASK 0
#endif
#ifndef REPU
#define REPU 0
#endif
#define NREPU(s) (1 + (((REPU) >> (s)) & 1))
#define NREP(s) (1 + (((REPMASK) >> (s)) & 1))
#define EN(s) (((SITEMASK) >> (s)) & 1)
#define IN(k) (lo <= (k) && (k) < hi)
#ifndef NCONV
#define NCONV 16
#endif
#ifndef FILLW
#define FILLW 2
#endif
#define CONVPH(k) ((k) == 2 || (k) == 4 || (k) == 6 || (k) == 7)
#ifndef SPLITK
#define SPLITK false
#endif
#ifndef SPLITK_FFN_DOWN
#define SPLITK_FFN_DOWN false
#endif
#ifndef SPLITK_MOE_DOWN
#define SPLITK_MOE_DOWN true
#endif
#ifndef FILLMODE
#define FILLMODE 1
#endif
#define FILL(k) do { if (FILLMODE == 1 && l == 0 && IN(k)) {     kaptr kq = ka_get(); int Gq = G0; asm volatile("" : "+s"(Gq)); fill_tail(KWS(kq), KIN(kq, 23), KIN(kq, 24), KIN(kq, 25), KIN(kq, 19), KIN(kq, 20), KIN(kq, 21), (unsigned*)(KWS(kq) + WS_CTL) + CW_DONE + 64 * (k), Gq, (FILLMODE == 1 && l == 0 && (int)blockIdx.x < NCONV && CONVPH(k)) ? 8 : FILLW, 0); } } while (0)
#define DRAIN_DENSE(k, lim) do { if (l == 0 && IN(k)) {     kaptr kq = ka_get(); int Gq = G0; asm volatile("" : "+s"(Gq)); fill_tail(KWS(kq), KIN(kq, 23), KIN(kq, 24), KIN(kq, 25), KIN(kq, 19), KIN(kq, 20), KIN(kq, 21), nullptr, Gq, 8, (lim)); } } while (0)
#define DRAIN(k) do { if (((FILLMODE == 1) || (k) == 0) && IN(k)) { kaptr kq = ka_get(); int Gq = G0; asm volatile("" : "+s"(Gq)); drain_tail(KWS(kq), KIN(kq, 23), KIN(kq, 24), KIN(kq, 25), Gq, lds); } } while (0)
#define SEAM(k) do { if (IN(k) && IN((k) + 1)) { XcdBarrier b_ = bar; asm volatile("" : "+s"(b_.bar)); xcd_barrier(b_); } } while (0)
    LAS int* TB = (LAS int*)(lds + TB_OFF);

    for (int rep = 0; rep < NREP(0); ++rep) if (EN(0) && IN(0)) { kaptr kp = ka_get(); TID_HERE(); p0_prologue(kp, lds, vcu, G, tid, lane, wave); }
    if (FILLMODE == 0) DRAIN(0);
    SEAM(0);

    for (int l = 0; l < 2; ++l) {
        const int pb = l == 0 ? 1 : 8;
        const bool last = (l == 1);
        for (int rep = 0; rep < NREP(1); ++rep) if (EN(1) && IN(pb + 0)) {
            kaptr kp = ka_get(); TID_HERE(); unsigned char* ws = KWS(kp); const float* H = (const float*)(ws + WS_H); const float* mod = (const float*)(ws + WS_MOD) + l * 5 * MODN;
            const float* srcC = l == 0 ? KIN(kp, 2) : H; const float* srcL = l == 0 ? KIN(kp, 0) - (size_t)RC * D : H;
            norm_rows<false>(srcC, srcL, KIN(kp, 6) + l * D, mod + 0 * D, mod + 1 * D, (bf16*)(ws + WS_XN), 0, RT, gw, NGW, lane, nullptr, nullptr, nullptr);
        }
        SEAM(pb + 0);
        for (int rep = 0; rep < NREP(2); ++rep) if (EN(2) && IN(pb + 1)) {
            kaptr kp = ka_get(); TID_HERE(); unsigned char* ws = KWS(kp);
            pg8::Gemm g{(const bf16*)(ws + WS_XN), (const bf16*)(ws + WS_WIN) + (size_t)l * INC * D, RT, INC, D}; pg8::EpiIn E{(bf16*)(ws + WS_PALL), (const float*)(ws + WS_ROPE)};
            const int nc = (FILLMODE == 1 && l == 0) ? NCONV : 0;
            if (bx >= nc) {
            pg8::OrderSplit<pg8::MapIn> S; S.init(G - nc, bx - nc, D, last ? 20 : 60); S.plan(SPLITK);
            pg8::EpiSplit<pg8::EpiIn> ES{E, (float*)(ws + WS_SLAB)};
            { pg8::CachedOrder CS; CS.fill(S, (PG8_LAS int*)(lds + UT_OFF), tid); __syncthreads();
                  pg8::gemm_phase<pg8::EpiSplit<pg8::EpiIn>, pg8::CachedOrder, true, true>(lds, g, CS, ES); }
            combine_tail(E, S, (float*)(ws + WS_SLAB), (unsigned*)(ws + WS_CTL) + CW_TK + 4096 * (pb + 1), lds); }
        }
        FILL(pb + 1); SEAM(pb + 1);
        for (int rep = 0; rep < NREP(3); ++rep) if (EN(3) && IN(pb + 2)) {
            kaptr kp = ka_get(); TID_HERE(); unsigned char* ws = KWS(kp); const bf16* PALL = (const bf16*)(ws + WS_PALL); bf16* MIX = (bf16*)(ws + WS_MIX);
            const float lam_init = 0.8f - 0.6f * expf(-0.3f * (float)l);
            for (int ru = 0; ru < NREPU(0); ++ru) if (UEN(0)) for (int u = vcu; u < 256; u += G) diff_unit(lds, PALL, MIX, KIN(kp, 12) + l * 256, KIN(kp, 13) + l * 128, lam_init, u >> 6, (u >> 4) & 3, u & 15, false, tid, lane, wave);
            for (int ru = 0; ru < NREPU(1); ++ru) if (UEN(1)) for (int u = vcu; u < 256; u += G) win_unit(lds, PALL, MIX, KIN(kp, 18) + l * 8, u >> 6, (u >> 5) & 1, u & 31, false, tid, lane, wave);
            if (!last) {
                if (UEN(0)) for (int u = vcu; u < 32; u += G) diff_unit(lds, PALL, MIX, KIN(kp, 12) + l * 256, KIN(kp, 13) + l * 128, lam_init, u >> 3, (u >> 1) & 3, u & 1, true, tid, lane, wave);
                if (UEN(1)) for (int u = (vcu + G - (32 % G)) % G; u < 32; u += G) win_unit(lds, PALL, MIX, KIN(kp, 18) + l * 8, u >> 3, (u >> 2) & 1, u & 3, true, tid, lane, wave);
            }
            { const int ch0 = last ? 8 : 0, nu = (72 - ch0) * 4;
              for (int ru = 0; ru < NREPU(2); ++ru) if (UEN(2)) for (int u = (vcu + G - (64 % G)) % G; u < nu; u += G) sgu_unit(lds, PALL, MIX, KIN(kp, 14) + l * 512, KIN(kp, 15) + l * 512, KIN(kp, 16) + (size_t)l * 4 * 128 * 128, KIN(kp, 17) + l * 512, (ch0 + (u >> 2)) * 128, u & 3, tid, lane, wave); }
            { const int r0 = last ? RC : 0, nu = (RT - r0) / 32;
              for (int ru = 0; ru < NREPU(3); ++ru) if (UEN(3)) for (int u = (vcu + G - (96 % G)) % G; u < nu; u += G) pool_unit(PALL, MIX, KIN(kp, 11) + l * 512, r0 + 32 * u, tid, wave); }
        }
        FILL(pb + 2); SEAM(pb + 2);
        for (int rep = 0; rep < NREP(4); ++rep) if (EN(4) && IN(pb + 3)) {
            kaptr kp = ka_get(); TID_HERE(); unsigned char* ws = KWS(kp); float* H = (float*)(ws + WS_H);
            const float* srcC = l == 0 ? KIN(kp, 2) : H; const float* srcL = l == 0 ? KIN(kp, 0) - (size_t)RC * D : H;
            pg8::Gemm g{(const bf16*)(ws + WS_MIX), (const bf16*)(ws + WS_WOUT) + (size_t)l * D * D, RT, D, D}; pg8::EpiResid E{srcC, srcL, rep ? (float*)(ws + WS_Y) : H, (const float*)(ws + WS_MOD) + l * 5 * MODN + 2 * D, 1.0f};
            const int nc = (FILLMODE == 1 && l == 0) ? NCONV : 0;
            if (bx >= nc) {
            pg8::OrderSplit<pg8::MapOff> S; S.init(last ? RL : RT, D, G - nc, bx - nc, D); S.pm_off = last ? 4 : 0; S.plan(SPLITK);
            pg8::EpiSplit<pg8::EpiResid> ES{E, (float*)(ws + WS_SLAB)};
            { pg8::CachedOrder CS; CS.fill(S, (PG8_LAS int*)(lds + UT_OFF), tid); __syncthreads();
                  pg8::gemm_phase<pg8::EpiSplit<pg8::EpiResid>, pg8::CachedOrder, true, true>(lds, g, CS, ES); }
            combine_tail(E, S, (float*)(ws + WS_SLAB), (unsigned*)(ws + WS_CTL) + CW_TK + 4096 * (pb + 3), lds); }
        }
        FILL(pb + 3); SEAM(pb + 3);
        for (int rep = 0; rep < NREP(5); ++rep) if (EN(5) && IN(pb + 4)) {
            kaptr kp = ka_get(); TID_HERE(); unsigned char* ws = KWS(kp); const float* H = (const float*)(ws + WS_H); const float* mod = (const float*)(ws + WS_MOD) + l * 5 * MODN;
            if (!last || rep) norm_rows<false, DENSE_UP_F8>(H, H, KIN(kp, 7) + l * D, mod + 3 * D, mod + 4 * D, (bf16*)(ws + WS_XN), last ? RC : 0, RT, gw, NGW, lane, nullptr, nullptr, nullptr);
            else {
                LAS float* rt = (LAS float*)lds;
                for (int i = tid; i < D * NE / 4; i += NWAVES * 64) ((LAS f32x4*)rt)[i] = ((const GAS f32x4*)KIN(kp, 22))[i];
                __syncthreads();
                norm_rows<true, MOE_F8>(H, H, KIN(kp, 7) + l * D, mod + 3 * D, mod + 4 * D, (bf16*)(ws + WS_XN), RC, RT, gw, NGW, lane, rt, (unsigned*)(ws + WS_CTL) + CW_CNT, (int*)(ws + WS_ROUTE));
            }
        }
        DRAIN_DENSE(pb + 4, 2 * 2816); SEAM(pb + 4);
        if (!last) {
            for (int rep = 0; rep < NREP(6); ++rep) if (EN(6) && IN(pb + 5)) {
                kaptr kp = ka_get(); TID_HERE(); unsigned char* ws = KWS(kp);
                constexpr int KP = DENSE_UP_F8 ? D / 2 : D;
                pg8::Gemm g{(const bf16*)(ws + WS_XN), (const bf16*)(ws + WS_W13), RT, 2 * DFF, KP}; pg8::EpiSwiglu<DENSE_DN_F8> E{(void*)(ws + WS_ACT), DFF, NTN_UP, DENSE_UP_F8 ? 1.0f / 256.0f : 1.0f};
                const int nc = (FILLMODE == 1) ? NCONV : 0;
                if (bx >= nc) {
                pg8::OrderSplit<pg8::StaticOrder> S; S.init(RT, 2 * DFF, G - nc, bx - nc, KP); S.plan(SPLITK);
                pg8::EpiSplit<pg8::EpiSwiglu<DENSE_DN_F8>> ES{E, (float*)(ws + WS_SLAB)};
                { pg8::CachedOrder CS; CS.fill(S, (PG8_LAS int*)(lds + UT_OFF), tid); __syncthreads();
                  pg8::gemm_phase<pg8::EpiSplit<pg8::EpiSwiglu<DENSE_DN_F8>>, pg8::CachedOrder, true, true, DENSE_UP_F8>(lds, g, CS, ES); }
                combine_tail(E, S, (float*)(ws + WS_SLAB), (unsigned*)(ws + WS_CTL) + CW_TK + 4096 * (pb + 5), lds); }
            }
            FILL(pb + 5); DRAIN_DENSE(pb + 5, 3 * 2816); SEAM(pb + 5);
            for (int rep = 0; rep < NREP(7); ++rep) if (EN(7) && IN(pb + 6)) {
                kaptr kp = ka_get(); TID_HERE(); unsigned char* ws = KWS(kp); float* H = (float*)(ws + WS_H);
                constexpr int KP = DENSE_DN_F8 ? DFF / 2 : DFF;
                pg8::Gemm g{(const bf16*)(ws + WS_ACT), (const bf16*)(ws + WS_W2), RT, D, KP}; pg8::EpiResid E{H, H, rep ? (float*)(ws + WS_Y) : H, (const float*)(ws + WS_MOD) + l * 5 * MODN + 5 * D, DENSE_DN_F8 ? 1.0f / 256.0f : 1.0f};
                const int nc = (FILLMODE == 1) ? NCONV : 0;
                if (bx >= nc) {
                pg8::OrderSplit<pg8::MapOff> S; S.init(RT, D, G - nc, bx - nc, KP); S.pm_off = 0; S.plan(SPLITK_FFN_DOWN);
                pg8::EpiSplit<pg8::EpiResid> ES{E, (float*)(ws + WS_SLAB)};
                { pg8::CachedOrder CS; CS.fill(S, (PG8_LAS int*)(lds + UT_OFF), tid); __syncthreads();
                  pg8::gemm_phase<pg8::EpiSplit<pg8::EpiResid>, pg8::CachedOrder, true, true, DENSE_DN_F8>(lds, g, CS, ES); }
                combine_tail(E, S, (float*)(ws + WS_SLAB), (unsigned*)(ws + WS_CTL) + CW_TK + 4096 * (pb + 6), lds); }
            }
            FILL(pb + 6); SEAM(pb + 6);
        } else {
            if (IN(pb + 5) || IN(pb + 6) || IN(pb + 7) || IN(pb + 8)) {
                kaptr kp = ka_get(); TID_HERE(); const unsigned* CNT = (const unsigned*)(KWS(kp) + WS_CTL) + CW_CNT;
                if (tid == 0) { int acc = 0; TB[0] = 0;
                    for (int e = 0; e < 8; ++e) { const unsigned c = __hip_atomic_load(CNT + 64 * e, RLX_AGENT); acc += (int)((c + 255u) >> 8); TB[e + 1] = acc; } }
                __syncthreads();
            }
            for (int rep = 0; rep < NREP(8); ++rep) if (EN(8) && IN(pb + 5)) {
                kaptr kp = ka_get(); TID_HERE(); unsigned char* ws = KWS(kp); const int* ROUTE = (const int*)(ws + WS_ROUTE); const bf16* XN = (const bf16*)(ws + WS_XN); bf16* XG = (bf16*)(ws + WS_XG);
                for (int t = gw; t < RL; t += NGW) {
                    const int* rec = ROUTE + (size_t)t * 8; const int e1 = rec[0], s1 = rec[1], e2 = rec[3], s2 = rec[4];
                    const int b1 = TB[e1], b2 = TB[e2];
                    constexpr int RB = MOE_F8 ? D : 2 * D;
                    const GAS v4u* src = (const GAS v4u*)((const unsigned char*)XN + (size_t)(RC + t) * RB) + lane; GAS v4u* d1 = (GAS v4u*)((unsigned char*)XG + (size_t)(b1 * 256 + s1) * RB) + lane; GAS v4u* d2 = (GAS v4u*)((unsigned char*)XG + (size_t)(b2 * 256 + s2) * RB) + lane;
#pragma unroll
                    for (int j = 0; j < RB / 1024; ++j) { const v4u v = src[64 * j]; d1[64 * j] = v; d2[64 * j] = v; }
                }
            }
            DRAIN(pb + 5); SEAM(pb + 5);
            for (int rep = 0; rep < NREP(9); ++rep) if (EN(9) && IN(pb + 6)) {
                kaptr kp = ka_get(); TID_HERE(); unsigned char* ws = KWS(kp);
                constexpr int KP = MOE_F8 ? D / 2 : D;
                pg8::Gemm g{(const bf16*)(ws + WS_XG), (const bf16*)(ws + WS_MW13), MAXSLOT, NE * 2 * DFF, KP}; pg8::EpiSwiglu<MOE_F8> E{(void*)(ws + WS_ACT), DFF, NTN_UP, MOE_F8 ? 1.0f / 256.0f : 1.0f};
                pg8::OrderSplit<pg8::MapMoe> S; S.init((const PG8_LAS int*)TB, NTN_UP, G, bx, KP); S.plan(SPLITK);
                pg8::EpiSplit<pg8::EpiSwiglu<MOE_F8>> ES{E, (float*)(ws + WS_SLAB)};
                { pg8::CachedOrder CS; CS.fill(S, (PG8_LAS int*)(lds + UT_OFF), tid); __syncthreads();
                  pg8::gemm_phase<pg8::EpiSplit<pg8::EpiSwiglu<MOE_F8>>, pg8::CachedOrder, true, true, MOE_F8>(lds, g, CS, ES); }
                combine_tail(E, S, (float*)(ws + WS_SLAB), (unsigned*)(ws + WS_CTL) + CW_TK + 4096 * (pb + 6), lds);
            }
            SEAM(pb + 6);
            for (int rep = 0; rep < NREP(10); ++rep) if (EN(10) && IN(pb + 7)) {
                kaptr kp = ka_get(); TID_HERE(); unsigned char* ws = KWS(kp);
                constexpr int KP = MOE_F8 ? DFF / 2 : DFF;
                pg8::Gemm g{(const bf16*)(ws + WS_ACT), (const bf16*)(ws + WS_MW2), MAXSLOT, NE * D, KP}; pg8::EpiF32 E{(bf16*)(ws + WS_Y), D / 256, MOE_F8 ? 1.0f / 256.0f : 1.0f};
                pg8::OrderSplit<pg8::MapMoe> S; S.init((const PG8_LAS int*)TB, D / 256, G, bx, KP); S.plan(SPLITK_MOE_DOWN);
                pg8::EpiSplit<pg8::EpiF32> ES{E, (float*)(ws + WS_SLAB)};
                { pg8::CachedOrder CS; CS.fill(S, (PG8_LAS int*)(lds + UT_OFF), tid); __syncthreads();
                  pg8::gemm_phase<pg8::EpiSplit<pg8::EpiF32>, pg8::CachedOrder, true, true, MOE_F8>(lds, g, CS, ES); }
                combine_tail(E, S, (float*)(ws + WS_SLAB), (unsigned*)(ws + WS_CTL) + CW_TK + 4096 * (pb + 7), lds);
            }
            SEAM(pb + 7);
            for (int rep = 0; rep < NREP(11); ++rep) if (EN(11) && IN(pb + 8)) {
                kaptr kp = ka_get(); TID_HERE(); unsigned char* ws = KWS(kp); const int* ROUTE = (const int*)(ws + WS_ROUTE); const float* H = (const float*)(ws + WS_H); const bf16* Y = (const bf16*)(ws + WS_Y);
                const float* gate = (const float*)(ws + WS_MOD) + l * 5 * MODN + 5 * D; const float* nf = KIN(kp, 26); float* out = KOUT(kp);
                for (int t = gw; t < RL; t += NGW) {
                    const int* rec = ROUTE + (size_t)t * 8; const int e1 = rec[0], s1 = rec[1], e2 = rec[3], s2 = rec[4]; const float w1 = __builtin_bit_cast(float, rec[2]), w2 = __builtin_bit_cast(float, rec[5]);
                    const int b1 = TB[e1], b2 = TB[e2];
                    const int bidx = t >> 11;
                    const GAS f32x4* hr = (const GAS f32x4*)(H + (size_t)(RC + t) * D) + lane; const GAS v2u* y1 = (const GAS v2u*)(Y + (size_t)(b1 * 256 + s1) * D) + lane; const GAS v2u* y2 = (const GAS v2u*)(Y + (size_t)(b2 * 256 + s2) * D) + lane;
                    const GAS f32x4* g4 = (const GAS f32x4*)(gate + bidx * MODN) + lane;
                    f32x4 v[8]; float ss = 0.f;
#pragma unroll
                    for (int j = 0; j < 8; ++j) { const v2u ra = y1[64 * j], rb = y2[64 * j];
                        const f32x4 a = (f32x4){bf2f((unsigned short)(ra.x & 0xffffu)), bf2f((unsigned short)(ra.x >> 16)), bf2f((unsigned short)(ra.y & 0xffffu)), bf2f((unsigned short)(ra.y >> 16))};
                        const f32x4 b = (f32x4){bf2f((unsigned short)(rb.x & 0xffffu)), bf2f((unsigned short)(rb.x >> 16)), bf2f((unsigned short)(rb.y & 0xffffu)), bf2f((unsigned short)(rb.y >> 16))};
                        v[j] = hr[64 * j] + g4[64 * j] * (a * w1 + b * w2); ss += (v[j].x * v[j].x + v[j].y * v[j].y) + (v[j].z * v[j].z + v[j].w * v[j].w); }
                    const float rstd = 1.0f / sqrtf(wave_sum(ss) * (1.0f / D) + EPS);
                    GAS f32x4* op = (GAS f32x4*)(out + (size_t)t * D) + lane; const GAS f32x4* n4 = (const GAS f32x4*)nf + lane;
#pragma unroll
                    for (int j = 0; j < 8; ++j) op[64 * j] = v[j] * rstd * n4[64 * j];
                }
            }
        }
    }
#undef IN
#undef SEAM
}

extern "C" void kernel_launch(void* const* d_in, const int* in_sizes, int n_in, void* d_out, int out_size, void* d_ws, size_t ws_size, hipStream_t stream) {
    static int grid = 0;
    if (grid == 0) {
        if (n_in != 27 || out_size != RL * D || ws_size < WS_END) { fprintf(stderr, "kernel_launch: unexpected problem (n_in %d, out %d, ws %zu); nothing launched\n", n_in, out_size, ws_size); grid = -1; return; }
        int dev = 0, cus = 0, per_cu = 0;
        if (hipGetDevice(&dev) != hipSuccess || hipDeviceGetAttribute(&cus, hipDeviceAttributeMultiprocessorCount, dev) != hipSuccess) { grid = -1; return; }
        if (hipFuncSetAttribute((const void*)fwd_kernel, hipFuncAttributeMaxDynamicSharedMemorySize, LDS_BYTES) != hipSuccess) { fprintf(stderr, "kernel_launch: hipFuncSetAttribute failed\n"); grid = -1; return; }
        if (hipOccupancyMaxActiveBlocksPerMultiprocessor(&per_cu, (const void*)fwd_kernel, NWAVES * 64, LDS_BYTES) != hipSuccess || per_cu < 1) fprintf(stderr, "kernel_launch: occupancy query reports %d\n", per_cu);
        (void)hipGetLastError();
        grid = cus;
    }
    if (grid < 0) return;
    if (hipMemsetAsync((char*)d_ws + WS_CTL, 0, CTL_ZERO_BYTES, stream) != hipSuccess) { fprintf(stderr, "kernel_launch: memset failed\n"); return; }
    Args a{};
    for (int i = 0; i < 27; ++i) a.in[i] = (const float*)d_in[i];
    a.out = (float*)d_out; a.ws = (unsigned char*)d_ws;
#if MK_PER_PHASE
    for (int p = 0; p < NPHASE; ++p) { a.ph_lo = p; a.ph_hi = p + 1; hipLaunchKernelGGL(fwd_kernel, dim3(grid), dim3(NWAVES * 64), LDS_BYTES, stream, a); }
#else
    a.ph_lo = 0; a.ph_hi = NPHASE;
    hipLaunchKernelGGL(fwd_kernel, dim3(grid), dim3(NWAVES * 64), LDS_BYTES, stream, a);
#endif
    const hipError_t le = hipPeekAtLastError();
    if (le != hipSuccess) fprintf(stderr, "kernel_launch: launch failed: %s\n", hipGetErrorName(le));
}
```

```cpp
#include <hip/hip_runtime.h>
#include <cstdio>
#include <cstdint>
#include <cmath>

#define GAS __attribute__((address_space(1)))
#define LAS __attribute__((address_space(3)))
namespace pg8 {
#define PG8_LAS __attribute__((address_space(3)))
typedef unsigned short bf16_t;
typedef short bf16x8 __attribute__((ext_vector_type(8)));
typedef float f32x4 __attribute__((ext_vector_type(4)));
typedef unsigned u32x4 __attribute__((ext_vector_type(4)));
typedef int i32x4 __attribute__((ext_vector_type(4)));
typedef int i32x8 __attribute__((ext_vector_type(8)));
constexpr int BM = 256, BK = 64, HALF = 128, HTB = HALF * BK * 2  , STAGE_BYTES = 8 * HTB, NXCD = 8, WGM = 8;

__host__ __device__ __forceinline__ int lds_byte(int r, int c) { const int st = (r >> 4) * 2 + (c >> 5), rr = r & 15, cc = c & 31, ob = rr * 64 + cc * 2; return st * 1024 + (ob ^ (((ob >> 9) & 1) << 5)); }
__host__ __device__ __forceinline__ void stage_rc(int b, int& R, int& C) { const int st = b / 1024, sb = b % 1024, swz = sb ^ (((sb >> 9) & 1) << 5); R = (st >> 1) * 16 + swz / 64; C = (st & 1) * 32 + (swz % 64) / 2; }
__host__ __device__ __forceinline__ int perm32(int rho) { const int n = rho >> 4, i = rho & 15; return 8 * (i >> 2) + 4 * n + (i & 3); }

struct Unit { int pm, pn, k0, nkt, sid; };
struct Gemm { const bf16_t* A; const bf16_t* Bt; int M, N, K; };

struct StaticOrder {
    int nM, nN, nwg, G, c;
    __host__ __device__ void init(int M, int N, int G_, int c_, int K_) { nM = M / BM; nN = N / BM; nwg = nM * nN; G = G_; c = c_; K = K_; }
    int K;
    __host__ __device__ bool next(int i, Unit& u) const { const long L = (long)i * G + c; if (L >= nwg) return false; map(L, u); return true; }
    __host__ __device__ void map(long L, Unit& u) const {
        int wgid = (int)L; { const int q = nwg / NXCD, r = nwg % NXCD, xcd = wgid % NXCD, off = wgid / NXCD; wgid = (xcd < r ? xcd * (q + 1) : r * (q + 1) + (xcd - r) * q) + off; }
        const int nig = WGM * nN, gid = wgid / nig, fm = gid * WGM, gsz = (nM - fm) < WGM ? (nM - fm) : WGM;
        u.pm = fm + ((wgid % nig) % gsz); u.pn = (wgid % nig) / gsz; u.k0 = 0; u.nkt = K / BK; u.sid = -1;
    }
    __device__ __forceinline__ void a_ready(const Unit&) const {}
    __device__ __forceinline__ void done(const Unit&) const {}
};

__device__ __forceinline__ unsigned cvt_pk_bf16(float lo, float hi) { unsigned r; asm volatile("v_cvt_pk_bf16_f32 %0, %1, %2" : "=v"(r) : "v"(lo), "v"(hi)); return r; }
typedef unsigned u32x4 __attribute__((ext_vector_type(4)));
constexpr float QSCALE = 0.125f * 1.4426950408889634f;
__device__ __forceinline__ float gelu_tanh(float x) {
    const float y = 0.7978845608028654f * (x + 0.044715f * x * x * x);
    return x * __builtin_amdgcn_rcpf(1.0f + __builtin_amdgcn_exp2f(-2.0f * 1.4426950408889634f * y));
}
__device__ __forceinline__ float silu_f(float x) { return x * __builtin_amdgcn_rcpf(1.0f + __builtin_amdgcn_exp2f(-1.4426950408889634f * x)); }

struct EpiIn {
    static constexpr bool PERM = true, AFTER_DRAIN = false;
    bf16_t* O; const float* rope;
    __device__ __forceinline__ void operator()(const f32x4 (&acc)[2][2][4][2], const Unit& u, int wr, int wc, int fr, int fq) const {
        const int row0 = u.pm * BM + wr * 64 + fr; const bool lat = u.pm >= 4;
#pragma unroll
        for (int bj = 0; bj < 2; ++bj) {
            const int cb = u.pn * BM + bj * HALF; int role;
            if (cb < 512) role = 0; else if (cb < 1024) role = 1; else if (cb < 1536) role = 2; else if (cb < 2048) role = 0; else if (cb < 3072) role = 3; else if (cb < 3584) role = 1; else if (cb < 3712) role = 2; else role = 0;
            const int col0 = cb + wc * 32 + 8 * fq;
#pragma unroll
            for (int ai = 0; ai < 2; ++ai)
#pragma unroll
                for (int m = 0; m < 4; ++m) {
                    const int row = row0 + ai * HALF + m * 16;
                    f32x4 v0 = acc[ai][bj][m][0], v1 = acc[ai][bj][m][1];
                    if (role == 1 || role == 2) {
                        if (lat) {
                            const int t = (row - 1024) & 2047, pos = (wc & 1) ? (t & 63) : (t >> 6);
                            const f32x4 cs = *(const f32x4*)(rope + pos * 16 + 4 * fq), sn = *(const f32x4*)(rope + 1024 + pos * 16 + 4 * fq);
                            f32x4 a0, a1;
                            a0[0] = v0[0] * cs[0] - v0[1] * sn[0]; a0[1] = v0[0] * sn[0] + v0[1] * cs[0];
                            a0[2] = v0[2] * cs[1] - v0[3] * sn[1]; a0[3] = v0[2] * sn[1] + v0[3] * cs[1];
                            a1[0] = v1[0] * cs[2] - v1[1] * sn[2]; a1[1] = v1[0] * sn[2] + v1[1] * cs[2];
                            a1[2] = v1[2] * cs[3] - v1[3] * sn[3]; a1[3] = v1[2] * sn[3] + v1[3] * cs[3];
                            v0 = a0; v1 = a1;
                        }
                        if (role == 1) { v0 = v0 * QSCALE; v1 = v1 * QSCALE; }
                    } else if (role == 3) {
#pragma unroll
                        for (int e = 0; e < 4; ++e) { v0[e] = gelu_tanh(v0[e]); v1[e] = gelu_tanh(v1[e]); }
                    }
                    u32x4 w; w.x = cvt_pk_bf16(v0[0], v0[1]); w.y = cvt_pk_bf16(v0[2], v0[3]); w.z = cvt_pk_bf16(v1[0], v1[1]); w.w = cvt_pk_bf16(v1[2], v1[3]);
                    *(u32x4*)(O + (size_t)row * 3840 + col0) = w;
                }
        }
    }
};
__device__ __forceinline__ float clamp_fp8(float x) { return __builtin_amdgcn_fmed3f(x, -448.0f, 448.0f); }
__device__ __forceinline__ unsigned cvt4_fp8(float a, float b, float c, float d) { a = clamp_fp8(a); b = clamp_fp8(b); c = clamp_fp8(c); d = clamp_fp8(d); int w = 0; w = __builtin_amdgcn_cvt_pk_fp8_f32(a, b, w, false); w = __builtin_amdgcn_cvt_pk_fp8_f32(c, d, w, true); return (unsigned)w; }
template <bool F8OUT> struct EpiSwiglu {
    static constexpr bool PERM = true, AFTER_DRAIN = false;
    void* O; int ldo; int ntn; float sc;
    const PG8_LAS int* tb;
    __device__ __forceinline__ void operator()(const f32x4 (&acc)[2][2][4][2], const Unit& u, int wr, int wc, int fr, int fq) const {
        const int pmo = tb ? tb[u.pm >> 5] + (u.pm & 31) : u.pm;
        const int row0 = pmo * BM + wr * 64 + fr, col0 = (u.pn % ntn) * HALF + wc * 32 + 8 * fq;
#pragma unroll
        for (int ai = 0; ai < 2; ++ai)
#pragma unroll
            for (int m = 0; m < 4; ++m) {
                const f32x4 g0 = acc[ai][0][m][0] * sc, g1 = acc[ai][0][m][1] * sc, u0 = acc[ai][1][m][0] * sc, u1 = acc[ai][1][m][1] * sc;
                f32x4 r0, r1;
#pragma unroll
                for (int e = 0; e < 4; ++e) { r0[e] = silu_f(g0[e]) * u0[e]; r1[e] = silu_f(g1[e]) * u1[e]; }
                const size_t row = (size_t)(row0 + ai * HALF + m * 16);
                if constexpr (F8OUT) { typedef unsigned u32x2 __attribute__((ext_vector_type(2))); u32x2 w; w.x = cvt4_fp8(r0[0], r0[1], r0[2], r0[3]); w.y = cvt4_fp8(r1[0], r1[1], r1[2], r1[3]);
                    *(u32x2*)((unsigned char*)O + row * ldo + col0) = w; }
                else { u32x4 w; w.x = cvt_pk_bf16(r0[0], r0[1]); w.y = cvt_pk_bf16(r0[2], r0[3]); w.z = cvt_pk_bf16(r1[0], r1[1]); w.w = cvt_pk_bf16(r1[2], r1[3]);
                    *(u32x4*)((bf16_t*)O + row * ldo + col0) = w; }
            }
    }
};
struct EpiResid {
    static constexpr bool PERM = false, AFTER_DRAIN = false;
    const float* resC; const float* resL; float* out; const float* gate; float sc;
    __device__ __forceinline__ void operator()(const f32x4 (&acc)[2][2][4][2], const Unit& u, int wr, int wc, int fr, int fq) const {
        const int bidx = u.pm < 4 ? 4 : ((u.pm - 4) >> 3); const float* res = u.pm < 4 ? resC : resL; const float* gp = gate + bidx * 12288;
        const int row0 = u.pm * BM + wr * 64 + fr;
#pragma unroll
        for (int bj = 0; bj < 2; ++bj)
#pragma unroll
            for (int n = 0; n < 2; ++n) {
                const int col = u.pn * BM + bj * HALF + wc * 32 + 16 * n + 4 * fq; const f32x4 g4 = *(const f32x4*)(gp + col);
#pragma unroll
                for (int ai = 0; ai < 2; ++ai)
#pragma unroll
                    for (int m = 0; m < 4; ++m) { const size_t off = (size_t)(row0 + ai * HALF + m * 16) * 2048 + col; const f32x4 r = *(const f32x4*)(res + off); *(f32x4*)(out + off) = r + g4 * (acc[ai][bj][m][n] * sc); }
                asm volatile("" ::: "memory");
            }
    }
};
struct EpiF32 {
    static constexpr bool PERM = true, AFTER_DRAIN = false;
    bf16_t* O; int ntn; float sc;
    __device__ __forceinline__ void operator()(const f32x4 (&acc)[2][2][4][2], const Unit& u, int wr, int wc, int fr, int fq) const {
        const int row0 = u.pm * BM + wr * 64 + fr;
#pragma unroll
        for (int bj = 0; bj < 2; ++bj) {
            const int col0 = (u.pn % ntn) * BM + bj * HALF + wc * 32 + 8 * fq;
#pragma unroll
            for (int ai = 0; ai < 2; ++ai)
#pragma unroll
                for (int m = 0; m < 4; ++m) { const f32x4 v0 = acc[ai][bj][m][0] * sc, v1 = acc[ai][bj][m][1] * sc;
                    u32x4 w; w.x = cvt_pk_bf16(v0[0], v0[1]); w.y = cvt_pk_bf16(v0[2], v0[3]); w.z = cvt_pk_bf16(v1[0], v1[1]); w.w = cvt_pk_bf16(v1[2], v1[3]);
                    *(u32x4*)(O + (size_t)(row0 + ai * HALF + m * 16) * 2048 + col0) = w; }
        }
    }
};
template <class Epi> struct EpiSplit {
    static constexpr bool PERM = Epi::PERM, AFTER_DRAIN = false;
    Epi E; float* slab;
    __device__ __forceinline__ void operator()(const f32x4 (&acc)[2][2][4][2], const Unit& u, int wr, int wc, int fr, int fq) const {
        if (u.sid < 0) { E(acc, u, wr, wc, fr, fq); return; }
        f32x4* sp = (f32x4*)slab + (size_t)u.sid * (32 * 512) + (wr * 4 + wc) * 64 + fq * 16 + fr;
#pragma unroll
        for (int ai = 0; ai < 2; ++ai)
#pragma unroll
            for (int bj = 0; bj < 2; ++bj)
#pragma unroll
                for (int m = 0; m < 4; ++m)
#pragma unroll
                    for (int n = 0; n < 2; ++n) sp[(size_t)((((ai * 2 + bj) * 4 + m) * 2) + n) * 512] = acc[ai][bj][m][n];
    }
};
struct TailPlan { int nfull, ntail, S;
    __device__ __forceinline__ void make(int nwg, int G, bool allow, int K) { nfull = (nwg / G) * G; ntail = nwg - nfull;
        S = (!allow || ntail == 0) ? 1 : ((4 * ntail <= G && K % 512 == 0) ? 4 : ((2 * ntail <= G && K % 256 == 0) ? 2 : 1)); } };
template <class Base> struct OrderSplit : Base {
    TailPlan tp;
    __device__ __forceinline__ void plan(bool allow) { tp.make(this->nwg, this->G, allow, this->K); }
    __device__ __forceinline__ bool next(int i, Unit& u) const {
        const long L = (long)i * this->G + this->c;
        if (tp.S == 1) { if (L >= this->nwg) return false; this->map(L, u); return true; }
        if (L < tp.nfull) { this->map(L, u); return true; }
        const int j = (int)(L - tp.nfull); if (j >= tp.ntail * tp.S) return false;
        this->map(tp.nfull + j / tp.S, u); const int ks = j % tp.S, klen = this->K / tp.S; u.k0 = ks * klen; u.nkt = klen / BK; u.sid = j; return true;
    }
    __device__ __forceinline__ bool tail_unit(int& tt, Unit& u) const { if (tp.S == 1 || this->c >= tp.ntail * tp.S) return false; tt = this->c / tp.S; this->map(tp.nfull + tt, u); return true; }
};
struct CachedOrder {
    const PG8_LAS int* tab;
    template <class Ord> __device__ __forceinline__ void fill(const Ord& S, PG8_LAS int* t, int tid) {
        if (tid < 32) { Unit u; u.pm = 0; u.pn = 0; u.k0 = 0; u.nkt = 2; u.sid = -1; const bool ok = S.next(tid, u);
            t[tid * 8 + 0] = ok ? 1 : 0; t[tid * 8 + 1] = u.pm; t[tid * 8 + 2] = u.pn; t[tid * 8 + 3] = u.k0; t[tid * 8 + 4] = u.nkt; t[tid * 8 + 5] = u.sid; }
        tab = t;
    }
    __device__ __forceinline__ bool next(int i, Unit& u) const {
        if (i >= 32) return false;
        const i32x4 a = *(const PG8_LAS i32x4*)(tab + i * 8); const int b0 = tab[i * 8 + 4], b1 = tab[i * 8 + 5];
        if (!__builtin_amdgcn_readfirstlane(a[0])) return false;
        u.pm = __builtin_amdgcn_readfirstlane(a[1]); u.pn = __builtin_amdgcn_readfirstlane(a[2]); u.k0 = __builtin_amdgcn_readfirstlane(a[3]); u.nkt = __builtin_amdgcn_readfirstlane(b0); u.sid = __builtin_amdgcn_readfirstlane(b1); return true;
    }
    __device__ __forceinline__ void a_ready(const Unit&) const {}
    __device__ __forceinline__ void done(const Unit&) const {}
};
struct MapOff : StaticOrder {
    int pm_off;
    __device__ __forceinline__ void map(long L, Unit& u) const { StaticOrder::map(L, u); u.pm += pm_off; }
};
struct MapIn {
    StaticOrder lat; int nwg, G, c, K, nextra;
    __device__ __forceinline__ void init(int G_, int c_, int K_, int nextra_) { lat.init(8192, 3840, G_, c_, K_); G = G_; c = c_; K = K_; nextra = nextra_; nwg = lat.nwg + nextra_; }
    __device__ __forceinline__ void map(long L, Unit& u) const {
        if (L < lat.nwg) { lat.map(L, u); u.pm += 4; return; }
        const int e = (int)(L - lat.nwg);
        if (nextra == 60) { u.pm = e / 15; u.pn = e % 15; } else { u.pm = e / 5; const int idx = e % 5; u.pn = idx < 4 ? 4 + idx : 14; }
        u.k0 = 0; u.nkt = K / BK; u.sid = -1;
    }
    __device__ __forceinline__ void a_ready(const Unit&) const {}
    __device__ __forceinline__ void done(const Unit&) const {}
};
struct MapMoe {
    const PG8_LAS int* tb; int ntn, G, c, K, nwg, sp;
    __device__ __forceinline__ void init(const PG8_LAS int* tb_, int ntn_, int G_, int c_, int K_, int sp_ = 0) { tb = tb_; ntn = ntn_; G = G_; c = c_; K = K_; nwg = tb_[8] * ntn_; sp = sp_; }
    __device__ __forceinline__ void map(long L, Unit& u) const {
        int wgid = (int)L; { const int q = nwg / NXCD, r = nwg % NXCD, xcd = wgid % NXCD, off = wgid / NXCD; wgid = (xcd < r ? xcd * (q + 1) : r * (q + 1) + (xcd - r) * q) + off; }
        int e = 0;
#pragma unroll
        for (int k = 1; k < 8; ++k) if (wgid >= tb[k] * ntn) e = k;
        const int t0 = tb[e], Te = tb[e + 1] - t0, local = wgid - t0 * ntn;
        const int nig = WGM * ntn, gid = local / nig, fm = gid * WGM, gsz = (Te - fm) < WGM ? (Te - fm) : WGM;
        u.pm = (sp ? e * 32 : t0) + fm + ((local % nig) % gsz); u.pn = e * ntn + (local % nig) / gsz; u.k0 = 0; u.nkt = K / BK; u.sid = -1;
    }
    __device__ __forceinline__ void a_ready(const Unit&) const {}
    __device__ __forceinline__ void done(const Unit&) const {}
};

template <class Epi, class Sched, bool ALIGN_EPI = false, bool SP2 = false, bool F8 = false>
__device__ __forceinline__ void gemm_phase(PG8_LAS unsigned char* lds, const Gemm g, const Sched& S, const Epi& E) {
    int tid_o = threadIdx.x; asm volatile("" : "+v"(tid_o));
    const int tid = tid_o, wid = __builtin_amdgcn_readfirstlane(tid >> 6), lane = tid & 63, wr = wid >> 2, wc = wid & 3, fr = lane & 15, fq = lane >> 4;
    const int K = g.K;
    unsigned voffA[2], voffB[2];
#pragma unroll
    for (int i = 0; i < 2; ++i) { int R, C; stage_rc(tid * 16 + i * 8192, R, C); const int Rb = Epi::PERM ? ((R & ~31) + perm32(R & 31)) : R;
        voffA[i] = (unsigned)(R * K + C) * 2u; voffB[i] = (unsigned)(Rb * K + C) * 2u; }
    const size_t kstep = (size_t)(BK * 2);
    const size_t hstep = (size_t)HALF * K * 2;
    const size_t tstep = 2 * hstep;
    const unsigned ldsw = (unsigned)wid * 1024u;
    const int aoff = lds_byte(wr * 64 + fr, fq * 8), boff = lds_byte(wc * 32 + fr, fq * 8);
#define PG8_SA(b, h) (((b) * 2 + (h)) * HTB)
#define PG8_SB(b, h) ((4 + (b) * 2 + (h)) * HTB)
#define PG8_STAGE(bufoff, gbase, voff) do { _Pragma("unroll") for (int _i = 0; _i < 2; ++_i) \
        __builtin_amdgcn_global_load_lds((const unsigned*)((const char*)(gbase) + (voff)[_i]), (PG8_LAS unsigned*)(lds + (bufoff) + ldsw + _i * 8192), 16, 0, 0); } while (0)
#define PG8_LD32(p0_, p1_) __builtin_shufflevector(*(const PG8_LAS i32x4*)(p0_), *(const PG8_LAS i32x4*)(p1_), 0, 1, 2, 3, 4, 5, 6, 7)
#define PG8_LDA(dst, b, h) do { if constexpr (F8) { _Pragma("unroll") for (int m = 0; m < 4; ++m) dst##8[m] = PG8_LD32(lds + PG8_SA(b, h) + aoff + m * 2048, lds + PG8_SA(b, h) + aoff + m * 2048 + 1024); } else { \
        _Pragma("unroll") for (int m = 0; m < 4; ++m) _Pragma("unroll") for (int k = 0; k < 2; ++k) dst[m][k] = *(const PG8_LAS bf16x8*)(lds + PG8_SA(b, h) + aoff + m * 2048 + k * 1024); } } while (0)
#define PG8_LDB(dst, b, h) do { if constexpr (F8) { _Pragma("unroll") for (int n = 0; n < 2; ++n) dst##8[n] = PG8_LD32(lds + PG8_SB(b, h) + boff + n * 2048, lds + PG8_SB(b, h) + boff + n * 2048 + 1024); } else { \
        _Pragma("unroll") for (int n = 0; n < 2; ++n) _Pragma("unroll") for (int k = 0; k < 2; ++k) dst[n][k] = *(const PG8_LAS bf16x8*)(lds + PG8_SB(b, h) + boff + n * 2048 + k * 1024); } } while (0)
#define PG8_MMA(ai, bj, At, Bt) do { __builtin_amdgcn_s_setprio(1); if constexpr (F8) { _Pragma("unroll") for (int m = 0; m < 4; ++m) _Pragma("unroll") for (int n = 0; n < 2; ++n) \
        asm volatile("v_mfma_f32_16x16x128_f8f6f4 %0, %1, %2, %0" : "+v"(acc[ai][bj][m][n]) : "v"(Bt##8[n]), "v"(At##8[m])); } else { \
        _Pragma("unroll") for (int m = 0; m < 4; ++m) _Pragma("unroll") for (int n = 0; n < 2; ++n) _Pragma("unroll") for (int k = 0; k < 2; ++k) \
        acc[ai][bj][m][n] = __builtin_amdgcn_mfma_f32_16x16x32_bf16(Bt[n][k], At[m][k], acc[ai][bj][m][n], 0, 0, 0); } __builtin_amdgcn_s_setprio(0); } while (0)
#define PG8_WAIT_V(n) asm volatile("s_waitcnt vmcnt(" #n ")" ::: "memory")
#define PG8_WAIT_L(n) asm volatile("s_waitcnt lgkmcnt(" #n ")" ::: "memory")
#define PG8_BAR __builtin_amdgcn_s_barrier()
#define PG8_SCHED __builtin_amdgcn_sched_barrier(0)
    Unit cur, nxt; int ui = 0;
    if (!S.next(0, cur)) return;
    f32x4 acc[2][2][4][2];
#pragma unroll
    for (int a = 0; a < 2; ++a)
#pragma unroll
        for (int b = 0; b < 2; ++b)
#pragma unroll
            for (int m = 0; m < 4; ++m)
#pragma unroll
                for (int n = 0; n < 2; ++n) acc[a][b][m][n] = (f32x4){0.f, 0.f, 0.f, 0.f};
    bf16x8 At[4][2], B0[2][2], B1[2][2]; i32x8 At8[4], B08[2], B18[2];
    const char* cA = (const char*)g.A + (size_t)cur.pm * tstep + (size_t)cur.k0 * 2; const char* cB = (const char*)g.Bt + (size_t)cur.pn * tstep + (size_t)cur.k0 * 2;
    S.a_ready(cur);
    if constexpr (SP2) {
        PG8_STAGE(PG8_SB(0, 0), cB, voffB); PG8_STAGE(PG8_SB(0, 1), cB + hstep, voffB); PG8_STAGE(PG8_SA(0, 0), cA, voffA); PG8_STAGE(PG8_SA(0, 1), cA + hstep, voffA);
        if (wr == 1) PG8_BAR;
        PG8_WAIT_V(2); PG8_BAR;
        PG8_STAGE(PG8_SB(1, 0), cB + kstep, voffB); PG8_STAGE(PG8_SA(1, 0), cA + kstep, voffA); PG8_STAGE(PG8_SB(1, 1), cB + hstep + kstep, voffB);
        PG8_WAIT_V(6); PG8_BAR;
    } else {
        PG8_STAGE(PG8_SB(0, 0), cB, voffB); PG8_STAGE(PG8_SA(0, 0), cA, voffA); PG8_STAGE(PG8_SB(0, 1), cB + hstep, voffB); PG8_STAGE(PG8_SA(0, 1), cA + hstep, voffA);
        if (wr == 1) PG8_BAR;
        PG8_WAIT_V(4); PG8_BAR;
        PG8_STAGE(PG8_SB(1, 0), cB + kstep, voffB); PG8_STAGE(PG8_SA(1, 0), cA + kstep, voffA); PG8_STAGE(PG8_SB(1, 1), cB + hstep + kstep, voffB);
        PG8_WAIT_V(6); PG8_BAR;
    }
    for (;;) {
        const bool has_next = S.next(ui + 1, nxt);
        const char* nA = has_next ? (const char*)g.A + (size_t)nxt.pm * tstep + (size_t)nxt.k0 * 2 : cA; const char* nB = has_next ? (const char*)g.Bt + (size_t)nxt.pn * tstep + (size_t)nxt.k0 * 2 : cB;
        const int nt = cur.nkt;
        for (int t = 0; t < nt; t += 2) {
            const bool last = (t == nt - 2);
            const char* a1 = cA + (size_t)(t + 1) * kstep;
            const char* a2 = last ? nA : cA + (size_t)(t + 2) * kstep; const char* b2 = last ? nB : cB + (size_t)(t + 2) * kstep;
            const char* a3 = a2 + kstep; const char* b3 = b2 + kstep;
            if (last && has_next) S.a_ready(nxt);
            if constexpr (SP2) {
            PG8_LDB(B0, 0, 0); PG8_LDB(B1, 0, 1); PG8_SCHED; PG8_LDA(At, 0, 0); PG8_STAGE(PG8_SA(1, 1), a1 + hstep, voffA);
            PG8_WAIT_V(8); PG8_WAIT_L(0); PG8_BAR; PG8_MMA(0, 0, At, B0); PG8_MMA(0, 1, At, B1); PG8_BAR; PG8_SCHED;
            PG8_LDA(At, 0, 1); PG8_STAGE(PG8_SB(0, 0), b2, voffB); PG8_STAGE(PG8_SB(0, 1), b2 + hstep, voffB); PG8_STAGE(PG8_SA(0, 0), a2, voffA);
            PG8_WAIT_V(8); PG8_WAIT_L(0); PG8_BAR; PG8_MMA(1, 0, At, B0); PG8_MMA(1, 1, At, B1); PG8_BAR; PG8_SCHED;
            PG8_LDB(B0, 1, 0); PG8_LDB(B1, 1, 1); PG8_SCHED; PG8_LDA(At, 1, 0); PG8_STAGE(PG8_SA(0, 1), a2 + hstep, voffA);
            PG8_WAIT_V(8); PG8_WAIT_L(0); PG8_BAR; PG8_MMA(0, 0, At, B0); PG8_MMA(0, 1, At, B1); PG8_BAR; PG8_SCHED;
            PG8_LDA(At, 1, 1); PG8_STAGE(PG8_SB(1, 0), b3, voffB); PG8_STAGE(PG8_SB(1, 1), b3 + hstep, voffB); PG8_STAGE(PG8_SA(1, 0), a3, voffA);
            PG8_WAIT_V(8); PG8_WAIT_L(0); PG8_BAR; PG8_MMA(1, 0, At, B0); PG8_MMA(1, 1, At, B1); PG8_BAR; PG8_SCHED;
            } else {
            PG8_LDB(B0, 0, 0); PG8_SCHED; PG8_LDA(At, 0, 0); PG8_STAGE(PG8_SA(1, 1), a1 + hstep, voffA);
            PG8_WAIT_L(8); PG8_BAR; PG8_WAIT_L(0); PG8_MMA(0, 0, At, B0); PG8_BAR; PG8_SCHED;
            PG8_LDB(B1, 0, 1); PG8_STAGE(PG8_SB(0, 0), b2, voffB);
            PG8_BAR; PG8_WAIT_L(0); PG8_MMA(0, 1, At, B1); PG8_BAR;
            PG8_LDA(At, 0, 1); PG8_STAGE(PG8_SA(0, 0), a2, voffA);
            PG8_BAR; PG8_WAIT_L(0); PG8_MMA(1, 0, At, B0); PG8_BAR; PG8_SCHED;
            PG8_STAGE(PG8_SB(0, 1), b2 + hstep, voffB);
            PG8_WAIT_V(6); PG8_BAR; PG8_MMA(1, 1, At, B1); PG8_BAR;
            PG8_LDB(B0, 1, 0); PG8_SCHED; PG8_LDA(At, 1, 0); PG8_STAGE(PG8_SA(0, 1), a2 + hstep, voffA);
            PG8_WAIT_L(8); PG8_BAR; PG8_WAIT_L(0); PG8_MMA(0, 0, At, B0); PG8_BAR; PG8_SCHED;
            PG8_LDB(B1, 1, 1); PG8_STAGE(PG8_SB(1, 0), b3, voffB);
            PG8_BAR; PG8_WAIT_L(0); PG8_MMA(0, 1, At, B1); PG8_BAR;
            PG8_LDA(At, 1, 1); PG8_STAGE(PG8_SA(1, 0), a3, voffA);
            PG8_BAR; PG8_WAIT_L(0); PG8_MMA(1, 0, At, B0); PG8_BAR; PG8_SCHED;
            PG8_STAGE(PG8_SB(1, 1), b3 + hstep, voffB);
            PG8_WAIT_V(6); PG8_BAR; PG8_MMA(1, 1, At, B1); PG8_BAR;
            }
        }
        if constexpr (ALIGN_EPI) { if (wr == 0) PG8_BAR; }
        if constexpr (F8) asm volatile("s_nop 15\n\ts_nop 7" ::: "memory");
        if constexpr (!Epi::AFTER_DRAIN) { E(acc, cur, wr, wc, fr, fq); S.done(cur); }
        if (!has_next) break;
#pragma unroll
        for (int a = 0; a < 2; ++a)
#pragma unroll
            for (int b = 0; b < 2; ++b)
#pragma unroll
                for (int m = 0; m < 4; ++m)
#pragma unroll
                    for (int n = 0; n < 2; ++n) acc[a][b][m][n] = (f32x4){0.f, 0.f, 0.f, 0.f};
        cur = nxt; cA = nA; cB = nB; ++ui;
        if constexpr (ALIGN_EPI) { if (wr == 1) PG8_BAR; }
    }
    PG8_WAIT_V(0);
    if constexpr (!ALIGN_EPI) { if (wr == 0) PG8_BAR; }
    PG8_BAR;
    if constexpr (Epi::AFTER_DRAIN) { E.fused(acc, cur, wr, wc, fr, fq, lds, wid, lane); S.done(cur); }
#undef PG8_SA
#undef PG8_SB
#undef PG8_STAGE
#undef PG8_LDA
#undef PG8_LDB
#undef PG8_MMA
#undef PG8_LD32
#undef PG8_WAIT_V
#undef PG8_WAIT_L
#undef PG8_BAR
#undef PG8_SCHED
}
}

constexpr int D = 2048, NB = 4, SEQ = 2048, CTX = 256, DFF = 5632, NE = 8, INC = 3840, MODN = 12288;
constexpr int RC = NB * CTX, RL = NB * SEQ, RT = RC + RL;
constexpr int NTN_UP = DFF / 128;
constexpr int MAXSLOT = 2 * RL + NE * 256;
constexpr float EPS = 1e-6f, LOG2E = 1.4426950408889634f;
constexpr int NWAVES = 8;
#ifndef MK_PER_PHASE
#define MK_PER_PHASE 0
#endif
constexpr int NPHASE = 17;
#ifndef MOE_F8_ON
#define MOE_F8_ON 1
#endif
#ifndef DENSE_UP_F8_ON
#define DENSE_UP_F8_ON 1
#endif
#ifndef DENSE_DN_F8_ON
#define DENSE_DN_F8_ON 0
#endif
constexpr bool DENSE_UP_F8 = DENSE_UP_F8_ON != 0, DENSE_DN_F8 = DENSE_DN_F8_ON != 0;
constexpr bool MOE_F8 = MOE_F8_ON != 0;

constexpr size_t MiB = 1u << 20;
constexpr size_t WS_CTL = 0, CTL_ZERO_BYTES = 1 * MiB;
constexpr size_t WS_MOD = 1 * MiB;
constexpr size_t WS_ROPE = 1 * MiB + 512 * 1024;
constexpr size_t WS_ROUTE = 1 * MiB + 768 * 1024;
constexpr size_t WS_WIN = 2 * MiB, WS_WOUT = 32 * MiB, WS_W13 = 48 * MiB, WS_W2 = 92 * MiB, WS_MW13 = 114 * MiB, WS_MW2 = 466 * MiB;
constexpr size_t WS_H = 642 * MiB;
constexpr size_t WS_XN = 714 * MiB;
constexpr size_t WS_PALL = 750 * MiB;
constexpr size_t WS_MIX = 818 * MiB;
constexpr size_t WS_ACT = 854 * MiB;
constexpr size_t WS_XG = 1052 * MiB;
constexpr size_t WS_Y = 1180 * MiB;
static_assert(MOE_F8, "the per-expert input regions are laid out for fp8 rows");
constexpr size_t WS_SLAB = 1268 * MiB;
constexpr size_t WS_END = 1332 * MiB;
constexpr int CW_TMO = 0, CW_CODE = 1, CW_BAR = 4096, CW_CNT = 8192;
constexpr int CW_TK = 16384;
constexpr int CW_Q0 = 9216, CW_Q1 = 9280, CW_DONE = 9344;

constexpr int RING_BYTES = 131072, LDSCTL_OFF = 139264, MISC_OFF = LDSCTL_OFF + 320, TB_OFF = LDSCTL_OFF + 512, FLAG_OFF = LDSCTL_OFF + 256, UT_OFF = LDSCTL_OFF + 1024, LDS_BYTES = 147456;

typedef unsigned short bf16;
typedef unsigned v4u __attribute__((ext_vector_type(4)));
typedef unsigned v2u __attribute__((ext_vector_type(2)));
typedef float f32x4 __attribute__((ext_vector_type(4)));
typedef float f32x16 __attribute__((ext_vector_type(16)));
typedef short bf16x8 __attribute__((ext_vector_type(8)));
typedef short v4i16_t __attribute__((ext_vector_type(4)));
typedef GAS unsigned gu32;
#define RLX_AGENT __ATOMIC_RELAXED, __HIP_MEMORY_SCOPE_AGENT
#define LDS_WAIT() asm volatile("s_waitcnt lgkmcnt(0)" ::: "memory")
__device__ __forceinline__ unsigned f2bf(float f) { unsigned u = __builtin_bit_cast(unsigned, f); return (u + 0x7fffu + ((u >> 16) & 1u)) >> 16; }
__device__ __forceinline__ unsigned pk2(float lo, float hi) { return f2bf(lo) | (f2bf(hi) << 16); }
__device__ __forceinline__ float bf2f(unsigned short b) { return __builtin_bit_cast(float, (unsigned)b << 16); }
__device__ __forceinline__ float wave_sum(float v) {
#pragma unroll
    for (int o = 1; o < 64; o <<= 1) v += __shfl_xor(v, o);
    return v;
}

#define XB_TMO      128
#define XB_XCNT(j)  (256  + 64 * (j))
#define XB_XSUB(j)  (1280 + 64 * (j))
#define XB_XGEN(j)  (2304 + 64 * (j))
#define XB_TOP      3328
#define XB_TOPGEN   3392
#define XCD_BAR_WORDS 3456
#define XB_SPIN_CAP (1u << 18)

__device__ __forceinline__ unsigned xb_ld(unsigned* p)              { return __hip_atomic_load(p, __ATOMIC_RELAXED, __HIP_MEMORY_SCOPE_AGENT); }
__device__ __forceinline__ unsigned xb_add(unsigned* p, unsigned v) { return __hip_atomic_fetch_add(p, v, __ATOMIC_RELAXED, __HIP_MEMORY_SCOPE_AGENT); }
__device__ __forceinline__ unsigned xb_xcc_id() { return (unsigned)__builtin_amdgcn_s_getreg((3 << 11) | 20) & 0xFu; }
#define XB_SPIN(cond, bar) do { unsigned _sp = 0; while (cond) { __builtin_amdgcn_s_sleep(1); \
    if ((++_sp & 255u) == 0u) { if (xb_ld(&(bar)[XB_TMO])) break; if (_sp > XB_SPIN_CAP) { atomicAdd(&(bar)[XB_TMO], 1u); break; } } } } while (0)

struct XcdBarrier {
    unsigned* bar; unsigned x;
    volatile LAS unsigned* st;
};

__device__ __forceinline__ XcdBarrier xcd_barrier_post(unsigned* bar, volatile LAS unsigned* st) {
    XcdBarrier b; b.bar = bar; b.x = xb_xcc_id(); b.st = st;
    if (threadIdx.x == 0) (void)xb_add(&bar[XB_XCNT(b.x)], 1u);
    return b;
}
__device__ __forceinline__ void xcd_barrier_complete(unsigned* bar, unsigned x, unsigned& nloc, unsigned& nx) {
    const unsigned G = gridDim.x * gridDim.y * gridDim.z;
    unsigned sum, cnt, mine, sp = 0u;
    for (;;) {
        sum = 0u; cnt = 0u; mine = 0u;
#pragma unroll
        for (unsigned j = 0; j < 16; ++j) { const unsigned c = xb_ld(&bar[XB_XCNT(j)]); sum += c; cnt += (c > 0u) ? 1u : 0u; mine = (j == x) ? c : mine; }
        if (sum == G) break;
        __builtin_amdgcn_s_sleep(1);
        if ((++sp & 255u) == 0u) { if (xb_ld(&bar[XB_TMO])) break; if (sp > XB_SPIN_CAP) { atomicAdd(&bar[XB_TMO], 1u); break; } }
    }
    nloc = mine > 0u ? mine : 1u; nx = cnt > 0u ? cnt : 1u;
}

__device__ __attribute__((noinline)) void xcd_barrier(const XcdBarrier b) {
    asm volatile("s_waitcnt vmcnt(0)" ::: "memory");
    __syncthreads();
    if (threadIdx.x == 0) {
        unsigned* bar = b.bar;
        __builtin_amdgcn_s_waitcnt(0);
        unsigned nloc = b.st[0], nx = b.st[1];
        if (nloc == 0u) { xcd_barrier_complete(bar, b.x, nloc, nx); b.st[0] = nloc; b.st[1] = nx; }
        const unsigned old = xb_add(&bar[XB_XSUB(b.x)], 1u);
        const unsigned gen = old / nloc;
        if (old + 1u == (gen + 1u) * nloc) {
            __builtin_amdgcn_fence(__ATOMIC_RELEASE, "agent");
            asm volatile("s_waitcnt vmcnt(0)" ::: "memory");
            const unsigned og = xb_add(&bar[XB_TOP], 1u);
            const unsigned tg = og / nx;
            if (og + 1u == (tg + 1u) * nx) xb_add(&bar[XB_TOPGEN], 1u);
            else XB_SPIN(xb_ld(&bar[XB_TOPGEN]) == tg, bar);
            __builtin_amdgcn_fence(__ATOMIC_ACQUIRE, "agent");
            xb_add(&bar[XB_XGEN(b.x)], 1u);
            asm volatile("s_waitcnt vmcnt(0)" ::: "memory");
        } else {
            XB_SPIN(xb_ld(&bar[XB_XGEN(b.x)]) == gen, bar);
            __builtin_amdgcn_fence(__ATOMIC_ACQUIRE, "agent");
            asm volatile("s_waitcnt vmcnt(0)" ::: "memory");
        }
    }
    __syncthreads();
}

struct Args { const float* in[27]; float* out; unsigned char* ws; int ph_lo, ph_hi; };
#define CAS __attribute__((address_space(4)))
typedef const CAS unsigned char* kaptr;
__device__ __forceinline__ kaptr ka_get() { kaptr p = (kaptr)__builtin_amdgcn_kernarg_segment_ptr(); asm volatile("" : "+s"(p)); return p; }
#define KIN(kp, i) (*(const float* const CAS*)((kp) + 8 * (i)))
#define KOUT(kp) (*(float* const CAS*)((kp) + 216))
#define KWS(kp) (*(unsigned char* const CAS*)((kp) + 224))
#define KLO(kp) (*(const int CAS*)((kp) + 232))
#define KHI(kp) (*(const int CAS*)((kp) + 236))
static_assert(sizeof(Args) == 240, "Args layout");

__device__ __forceinline__ int dst_row(int mode, int n) {
    if (mode == 1) {
        const bool qk = (n >= 512 && n < 1536) || (n >= 3072 && n < 3712);
        if (qk) { const int d = n & 63; return (n & ~63) + (d < 32 ? 2 * d : 2 * (d - 32) + 1); }
        return n;
    }
    if (mode == 2) return (n >> 7) * 256 + (n & 127);
    if (mode == 3) return (n >> 7) * 256 + 128 + (n & 127);
    return n;
}
constexpr int TSCR = 64 * 65 * 4;
template <bool NTL>
__device__ __forceinline__ void ti_load(const float* W, int N, int item, int lane, f32x4 (&v)[16]) {
    const int nblk = N / 64, kb = item / nblk, nb = item % nblk, k0 = 64 * kb, n0 = 64 * nb;
    const GAS f32x4* src = (const GAS f32x4*)(W + (size_t)(k0 + (lane >> 4)) * N + n0 + 4 * (lane & 15));
#pragma unroll
    for (int i = 0; i < 16; ++i) v[i] = NTL ? __builtin_nontemporal_load(src + (size_t)i * N) : src[(size_t)i * N];
}
template <bool NTS, bool F8>
__device__ __forceinline__ void ti_store(const f32x4 (&v)[16], int K, int N, bf16* WT, int mode, LAS float* scr, int item, int lane) {
    const int nblk = N / 64, kb = item / nblk, nb = item % nblk, k0 = 64 * kb, n0 = 64 * nb;
    LAS float* wp = scr + (lane >> 4) * 65 + 4 * (lane & 15);
#pragma unroll
    for (int i = 0; i < 16; ++i) { wp[i * 4 * 65 + 0] = v[i].x; wp[i * 4 * 65 + 1] = v[i].y; wp[i * 4 * 65 + 2] = v[i].z; wp[i * 4 * 65 + 3] = v[i].w; }
    LDS_WAIT(); asm volatile("" ::: "memory");
    if constexpr (F8) {
        const int c = lane & 3;
#pragma unroll
        for (int j = 0; j < 4; ++j) { const int n = (lane >> 2) + 16 * j; const LAS float* s = scr + (16 * c) * 65 + n;
            v4u o;
#pragma unroll
            for (int q = 0; q < 4; ++q) o[q] = pg8::cvt4_fp8(256.0f * s[(4 * q) * 65], 256.0f * s[(4 * q + 1) * 65], 256.0f * s[(4 * q + 2) * 65], 256.0f * s[(4 * q + 3) * 65]);
            GAS v4u* dp = (GAS v4u*)((unsigned char*)WT + (size_t)dst_row(mode, n0 + n) * K + k0 + 16 * c); if (NTS) __builtin_nontemporal_store(o, dp); else *dp = o; }
    } else {
        const int c = lane & 7;
#pragma unroll
        for (int j = 0; j < 8; ++j) { const int n = (lane >> 3) + 8 * j; const LAS float* s = scr + (8 * c) * 65 + n;
            v4u o; o.x = pk2(s[0 * 65], s[1 * 65]); o.y = pk2(s[2 * 65], s[3 * 65]); o.z = pk2(s[4 * 65], s[5 * 65]); o.w = pk2(s[6 * 65], s[7 * 65]);
            GAS v4u* dp = (GAS v4u*)(WT + (size_t)dst_row(mode, n0 + n) * K + k0 + 8 * c); if (NTS) __builtin_nontemporal_store(o, dp); else *dp = o; }
    }
    LDS_WAIT(); asm volatile("" ::: "memory");
}
template <bool NT, bool F8 = false, bool NTL = false>
__device__ __forceinline__ void transpose_item(const float* W, int K, int N, bf16* WT, int mode, LAS float* scr, int item, int lane, const float*) {
    f32x4 v[16]; ti_load<NT || NTL>(W, N, item, lane, v); ti_store<NT, F8>(v, K, N, WT, mode, scr, item, lane);
}
__device__ __forceinline__ void p0_prologue(kaptr kp, LAS unsigned char* lds, int vcu, int G, int tid, int lane, int wave) {
    unsigned char* ws = KWS(kp);
    for (int j = vcu; j < 256; j += G) {
        const int l = j >> 7, g = (j >> 5) & 3, k0 = (j & 31) * 64;
        LAS float* As = (LAS float*)lds;
        LAS float* Ps = As + 64 * 132;
        const float* Wsrc = KIN(kp, 8) + (size_t)l * D * INC + (size_t)k0 * INC + g * 128;
        const float* Psrc = KIN(kp, 10) + ((size_t)l * 4 + g) * 128 * 128;
#pragma unroll
        for (int i = 0; i < 4; ++i) { const int idx = tid + 512 * i, r = idx >> 5, c4 = idx & 31; *(LAS f32x4*)(As + r * 132 + 4 * c4) = *(const GAS f32x4*)(Wsrc + (size_t)r * INC + 4 * c4); }
#pragma unroll
        for (int i = 0; i < 8; ++i) { const int idx = tid + 512 * i, r = idx >> 5, c4 = idx & 31; *(LAS f32x4*)(Ps + r * 132 + 4 * c4) = *(const GAS f32x4*)(Psrc + (size_t)r * 128 + 4 * c4); }
        __syncthreads();
        const int n4 = tid & 31, kq = tid >> 5;
        f32x4 acc[4];
#pragma unroll
        for (int i = 0; i < 4; ++i) acc[i] = (f32x4){0.f, 0.f, 0.f, 0.f};
#pragma unroll 4
        for (int c = 0; c < 128; ++c) { const f32x4 pv = *(const LAS f32x4*)(Ps + c * 132 + 4 * n4);
#pragma unroll
            for (int i = 0; i < 4; ++i) acc[i] += As[(4 * kq + i) * 132 + c] * pv; }
        bf16* WT = (bf16*)(ws + WS_WIN) + (size_t)l * INC * D;
#pragma unroll
        for (int e = 0; e < 4; ++e) { v2u o; o.x = pk2(acc[0][e], acc[1][e]); o.y = pk2(acc[2][e], acc[3][e]);
            *(GAS v2u*)(WT + (size_t)(g * 128 + 4 * n4 + e) * D + k0 + 4 * kq) = o; }
        __syncthreads();
    }
    for (int j = vcu; j < 192; j += G) {
        const int l = j / 96, n0 = (j % 96) * 128;
        LAS float* S = (LAS float*)lds; LAS float* red = S + 5 * 2048;
        for (int idx = tid; idx < 5 * 2048; idx += NWAVES * 64) { const int i = idx >> 11, k = idx & 2047; const float v = i < 4 ? KIN(kp, 1)[i * 2048 + k] : KIN(kp, 3)[k]; S[idx] = v / (1.0f + expf(-v)); }
        __syncthreads();
        f32x4 acc[5];
#pragma unroll
        for (int i = 0; i < 5; ++i) acc[i] = (f32x4){0.f, 0.f, 0.f, 0.f};
        const int kh = lane >> 5;
        const GAS f32x4* wp = (const GAS f32x4*)(KIN(kp, 4) + ((size_t)l * 2048 + wave * 256 + kh) * MODN + n0 + 4 * (lane & 31));
#pragma unroll 8
        for (int k = 0; k < 128; ++k) { const f32x4 w = __builtin_nontemporal_load(wp + (size_t)k * (2 * MODN / 4));
#pragma unroll
            for (int i = 0; i < 5; ++i) acc[i] += S[i * 2048 + wave * 256 + 2 * k + kh] * w; }
#pragma unroll
        for (int i = 0; i < 5; ++i) { f32x4 t = acc[i]; t.x += __shfl_xor(t.x, 32); t.y += __shfl_xor(t.y, 32); t.z += __shfl_xor(t.z, 32); t.w += __shfl_xor(t.w, 32);
            if (kh == 0) *(LAS f32x4*)(red + (wave * 5 + i) * 128 + 4 * (lane & 31)) = t; }
        __syncthreads();
        for (int idx = tid; idx < 640; idx += NWAVES * 64) { const int i = idx >> 7, n = idx & 127; float s = 0.f;
#pragma unroll
            for (int w = 0; w < 8; ++w) s += red[(w * 5 + i) * 128 + n];
            ((float*)(ws + WS_MOD))[(l * 5 + i) * MODN + n0 + n] = s + KIN(kp, 5)[l * MODN + n0 + n]; }
        __syncthreads();
    }
    if (vcu == (200 % G)) {
        for (int idx = tid; idx < 1024; idx += NWAVES * 64) { const int pos = idx >> 4, f = idx & 15; const float inv = powf(10000.0f, -(float)f / 16.0f); const float ang = (float)pos * inv;
            ((float*)(ws + WS_ROPE))[idx] = cosf(ang); ((float*)(ws + WS_ROPE))[1024 + idx] = sinf(ang); }
    }
    __syncthreads();
    LAS float* scr = (LAS float*)(lds + wave * TSCR);
    constexpr int I_IN = 32 * 52, I_OUT = 32 * 32, I_UP = 32 * 88, I_DN = 88 * 32;
    constexpr int NITEMS = 2 * I_IN + 2 * I_OUT + 2 * I_UP + I_DN;
    unsigned* q0 = (unsigned*)(ws + WS_CTL) + CW_Q0;
#define P0_DESC(it_, W_, K_, N_, WT_, M_, I_, F_) do { int r = (it_); F_ = false; \
        if (r < 2 * I_IN) { const int l = r / I_IN; W_ = KIN(kp, 8) + (size_t)l * D * INC; K_ = D; N_ = INC; WT_ = (bf16*)(ws + WS_WIN) + (size_t)l * INC * D; M_ = 1; const int q = r % I_IN; I_ = (q / 52) * 60 + 8 + (q % 52); } \
        else if ((r -= 2 * I_IN) < 2 * I_OUT) { const int l = r / I_OUT; W_ = KIN(kp, 9) + (size_t)l * D * D; K_ = D; N_ = D; WT_ = (bf16*)(ws + WS_WOUT) + (size_t)l * D * D; M_ = 0; I_ = r % I_OUT; } \
        else if ((r -= 2 * I_OUT) < I_UP) { W_ = KIN(kp, 19); K_ = D; N_ = DFF; WT_ = (bf16*)(ws + WS_W13); M_ = 2; I_ = r; F_ = DENSE_UP_F8; } \
        else if ((r -= I_UP) < I_UP) { W_ = KIN(kp, 20); K_ = D; N_ = DFF; WT_ = (bf16*)(ws + WS_W13); M_ = 3; I_ = r; F_ = DENSE_UP_F8; } \
        else { r -= I_UP; W_ = KIN(kp, 21); K_ = DFF; N_ = D; WT_ = (bf16*)(ws + WS_W2); M_ = 0; I_ = r; F_ = DENSE_DN_F8; } } while (0)
    for (;;) {
        unsigned k0 = 0; if (lane == 0) k0 = __hip_atomic_fetch_add(q0, 2u, RLX_AGENT);
        const int kb = (int)__builtin_amdgcn_readfirstlane(k0); if (kb >= NITEMS) break;
        const float* Wa; int Ka, Na, ma, ia; bf16* WTa; bool fa; f32x4 va[16];
        P0_DESC(kb, Wa, Ka, Na, WTa, ma, ia, fa); ti_load<true>(Wa, Na, ia, lane, va);
        const bool two = kb + 1 < NITEMS;
        const float* Wb = Wa; int Kb = Ka, Nb = Na, mb = ma, ib = ia; bf16* WTb = WTa; bool fb = fa; f32x4 vb[16];
        if (two) { P0_DESC(kb + 1, Wb, Kb, Nb, WTb, mb, ib, fb); ti_load<true>(Wb, Nb, ib, lane, vb); }
        if (fa) ti_store<false, true>(va, Ka, Na, WTa, ma, scr, ia, lane); else ti_store<false, false>(va, Ka, Na, WTa, ma, scr, ia, lane);
        if (two) { if (fb) ti_store<false, true>(vb, Kb, Nb, WTb, mb, scr, ib, lane); else ti_store<false, false>(vb, Kb, Nb, WTb, mb, scr, ib, lane); }
    }
#undef P0_DESC
}

__device__ __attribute__((noinline)) void fill_tail(unsigned char* ws, const float* w1, const float* w3, const float* w2, unsigned* done, int G, int nw) {
    extern __shared__ __attribute__((aligned(16))) unsigned char lds_fill[];
    LAS unsigned char* lds = (LAS unsigned char*)lds_fill;
    const int tid = threadIdx.x, lane = tid & 63, wave = __builtin_amdgcn_readfirstlane(tid >> 6);
    volatile LAS unsigned* flag = (volatile LAS unsigned*)(lds + FLAG_OFF);
    __syncthreads();
    if (tid == 0) { unsigned f = 0u; if (done) { const unsigned old = __hip_atomic_fetch_add(done, 1u, RLX_AGENT); f = (old + 1u >= (unsigned)G) ? 1u : 0u; } *flag = f; }
    __syncthreads();
    LAS float* scr = (LAS float*)(lds + wave * TSCR);
    unsigned* q1 = (unsigned*)(ws + WS_CTL) + CW_Q1;
    constexpr int I_UP = 32 * 88, NIT = 24 * I_UP;
#ifndef FILLW
#define FILLW 2
#endif
#ifndef FILLB
#define FILLB 4
#endif
#ifdef PROBE_BURN
    if (done && wave >= FILLW) {
        f32x16 acc; for (int r = 0; r < 16; ++r) acc[r] = 0.f; const bf16x8 a = (bf16x8){1, 2, 3, 4, 5, 6, 7, 8};
        while (!*flag) { for (int it = 0; it < 64; ++it) acc = __builtin_amdgcn_mfma_f32_32x32x16_bf16(a, a, acc, 0, 0, 0); if (__hip_atomic_load(done, RLX_AGENT) >= (unsigned)G) break; }
        if (acc[0] == 12345.f) *flag = 2u;
        return; }
#endif
    if (done && wave >= nw) return;
#define FILL_ITEM(it_) do { const int it__ = (it_); const int seg = it__ / I_UP, item = it__ % I_UP, mat = seg >> 3, e = seg & 7; \
        if (mat == 0) transpose_item<true, MOE_F8>(w1 + (size_t)e * D * DFF, D, DFF, (bf16*)(ws + WS_MW13 + (size_t)e * 2 * DFF * D * (MOE_F8 ? 1 : 2)), 2, scr, item, lane, nullptr); \
        else if (mat == 1) transpose_item<true, MOE_F8>(w3 + (size_t)e * D * DFF, D, DFF, (bf16*)(ws + WS_MW13 + (size_t)e * 2 * DFF * D * (MOE_F8 ? 1 : 2)), 3, scr, item, lane, nullptr); \
        else transpose_item<true, MOE_F8>(w2 + (size_t)e * DFF * D, DFF, D, (bf16*)(ws + WS_MW2 + (size_t)e * D * DFF * (MOE_F8 ? 1 : 2)), 0, scr, item, lane, nullptr); } while (0)
    if (!done) return;
    for (;;) {
        if (*flag) break;
        if (tid == 0) { if (__hip_atomic_load(done, RLX_AGENT) >= (unsigned)G) *flag = 1u; }
        if (*flag) break;
        unsigned k0 = 0; if (lane == 0) k0 = __hip_atomic_fetch_add(q1, (unsigned)FILLB, RLX_AGENT);
        const int kb = (int)__builtin_amdgcn_readfirstlane(k0); if (kb >= NIT) break;
        for (int it = kb; it < kb + FILLB && it < NIT; ++it) FILL_ITEM(it);
    }
#undef FILL_ITEM
}

__device__ __forceinline__ void drain_tail(unsigned char* ws, const float* w1, const float* w3, const float* w2, int G, LAS unsigned char* lds) {
    int tid = threadIdx.x; asm volatile("" : "+v"(tid));
    const int lane = tid & 63, wave = __builtin_amdgcn_readfirstlane(tid >> 6);
    __syncthreads();
    LAS float* scr = (LAS float*)(lds + wave * TSCR);
    unsigned* q1 = (unsigned*)(ws + WS_CTL) + CW_Q1;
    constexpr int I_UP = 32 * 88, NIT = 24 * I_UP;
        const int h = (int)__builtin_amdgcn_readfirstlane(__hip_atomic_load(q1, RLX_AGENT));
        const int gwv = blockIdx.x * NWAVES + wave, ngw = G * NWAVES;
#define MOE_DESC(it_, W_, K_, N_, WT_, M_, I_) do { const int seg_ = (it_) / I_UP, mat_ = seg_ >> 3, e_ = seg_ & 7; I_ = (it_) % I_UP; \
        if (mat_ == 0) { W_ = w1 + (size_t)e_ * D * DFF; K_ = D; N_ = DFF; WT_ = (bf16*)(ws + WS_MW13 + (size_t)e_ * 2 * DFF * D * (MOE_F8 ? 1 : 2)); M_ = 2; } \
        else if (mat_ == 1) { W_ = w3 + (size_t)e_ * D * DFF; K_ = D; N_ = DFF; WT_ = (bf16*)(ws + WS_MW13 + (size_t)e_ * 2 * DFF * D * (MOE_F8 ? 1 : 2)); M_ = 3; } \
        else { W_ = w2 + (size_t)e_ * DFF * D; K_ = DFF; N_ = D; WT_ = (bf16*)(ws + WS_MW2 + (size_t)e_ * D * DFF * (MOE_F8 ? 1 : 2)); M_ = 0; } } while (0)
        int it = h + gwv;
        if (it < NIT) {
            const float* W; int K, N, md, item; bf16* WT; f32x4 v[16];
            MOE_DESC(it, W, K, N, WT, md, item); ti_load<true>(W, N, item, lane, v);
            for (;;) {
                const int nx = it + ngw; const float* Wn = W; int Kn = K, Nn = N, mdn = md, itemn = item; bf16* WTn = WT; f32x4 vn[16];
                const bool more = nx < NIT;
                if (more) { MOE_DESC(nx, Wn, Kn, Nn, WTn, mdn, itemn); ti_load<true>(Wn, Nn, itemn, lane, vn); }
                ti_store<true, MOE_F8>(v, K, N, WT, md, scr, item, lane);
                if (!more) break;
#pragma unroll
                for (int i = 0; i < 16; ++i) v[i] = vn[i];
                it = nx; W = Wn; K = Kn; N = Nn; WT = WTn; md = mdn; item = itemn;
            }
        }
#undef MOE_DESC
}

template <class Epi, class Ord>
__device__ __forceinline__ void combine_tail(const Epi& E, const Ord& S, const float* slab, unsigned* tickets, LAS unsigned char* lds) {
    int tt; pg8::Unit tu;
    if (!S.tail_unit(tt, tu)) return;
    int tid = threadIdx.x; asm volatile("" : "+v"(tid));
    const int lane = tid & 63, wid = __builtin_amdgcn_readfirstlane(tid >> 6), wr = wid >> 2, wc = wid & 3, fr = lane & 15, fq = lane >> 4;
    volatile LAS unsigned* flag = (volatile LAS unsigned*)(lds + FLAG_OFF);
    asm volatile("s_waitcnt vmcnt(0)" ::: "memory");
    __syncthreads();
    if (tid == 0) {
        __builtin_amdgcn_fence(__ATOMIC_RELEASE, "agent");
        asm volatile("s_waitcnt vmcnt(0)" ::: "memory");
        const unsigned t = __hip_atomic_fetch_add(tickets + 64 * tt, 1u, RLX_AGENT);
        const bool last = (t == (unsigned)S.tp.S - 1u);
        if (last) { __builtin_amdgcn_fence(__ATOMIC_ACQUIRE, "agent"); asm volatile("s_waitcnt vmcnt(0)" ::: "memory"); }
        *flag = last ? 1u : 0u;
    }
    __syncthreads();
    if (*flag) {
        const int ns = S.tp.S;
        const GAS pg8::f32x4* sp = (const GAS pg8::f32x4*)slab + (size_t)(tt * ns) * (32 * 512) + tid;
        pg8::f32x4 acc[2][2][4][2];
#pragma unroll
        for (int ai = 0; ai < 2; ++ai)
#pragma unroll
            for (int bj = 0; bj < 2; ++bj)
#pragma unroll
                for (int m = 0; m < 4; ++m)
#pragma unroll
                    for (int n = 0; n < 2; ++n) { const int r = (((ai * 2 + bj) * 4 + m) * 2) + n; pg8::f32x4 a = sp[(size_t)r * 512];
                        for (int ks = 1; ks < ns; ++ks) a += sp[(size_t)ks * (32 * 512) + (size_t)r * 512];
                        acc[ai][bj][m][n] = a; }
        E(acc, tu, wr, wc, fr, fq);
    }
    __syncthreads();
}

template <bool ROUTE, bool F8 = false>
__device__ __forceinline__ void norm_rows(const float* srcC, const float* srcL, const float* gain, const float* shift, const float* scale, bf16* XN, int row_lo, int row_hi, int gw, int NGW, int lane,
                                          const LAS float* rt, unsigned* cnt, int* route) {
    f32x4 vn[8];
    { const int row = row_lo + gw; if (row < row_hi) { const GAS f32x4* xr = (const GAS f32x4*)((row < RC ? srcC : srcL) + (size_t)row * D) + lane;
#pragma unroll
        for (int j = 0; j < 8; ++j) vn[j] = xr[64 * j]; } }
    unsigned pk[8]; int pe1 = 0, pe2 = 0, ps1 = 0, ps2 = 0, prow = 0; float pw1 = 0.f, pw2 = 0.f; bool have = false;
#define ROUTE_FLUSH() do { if constexpr (ROUTE && F8) { \
        if (lane == 0) { int* rec = route + (size_t)(prow - RC) * 8; rec[0] = pe1; rec[1] = ps1; rec[2] = __builtin_bit_cast(int, pw1); rec[3] = pe2; rec[4] = ps2; rec[5] = __builtin_bit_cast(int, pw2); } \
        const int e1_ = __builtin_amdgcn_readfirstlane(pe1), e2_ = __builtin_amdgcn_readfirstlane(pe2), s1_ = __builtin_amdgcn_readfirstlane(ps1), s2_ = __builtin_amdgcn_readfirstlane(ps2); \
        GAS unsigned* d1 = (GAS unsigned*)((unsigned char*)XN + ((size_t)e1_ * 8192 + s1_) * D) + lane; GAS unsigned* d2 = (GAS unsigned*)((unsigned char*)XN + ((size_t)e2_ * 8192 + s2_) * D) + lane; \
        _Pragma("unroll") for (int j = 0; j < 8; ++j) { d1[64 * j] = pk[j]; d2[64 * j] = pk[j]; } } } while (0)
    for (int row = row_lo + gw; row < row_hi; row += NGW) {
        const int bidx = row < RC ? 4 : ((row - RC) >> 11);
        f32x4 v[8]; float ss = 0.f;
#pragma unroll
        for (int j = 0; j < 8; ++j) { v[j] = vn[j]; ss += (v[j].x * v[j].x + v[j].y * v[j].y) + (v[j].z * v[j].z + v[j].w * v[j].w); }
        { const int nrow = row + NGW; if (nrow < row_hi) { const GAS f32x4* xr = (const GAS f32x4*)((nrow < RC ? srcC : srcL) + (size_t)nrow * D) + lane;
#pragma unroll
            for (int j = 0; j < 8; ++j) vn[j] = xr[64 * j]; } }
        const float rstd = 1.0f / sqrtf(wave_sum(ss) * (1.0f / D) + EPS);
        const GAS f32x4* g4 = (const GAS f32x4*)gain + lane; const GAS f32x4* sh4 = (const GAS f32x4*)(shift + bidx * MODN) + lane; const GAS f32x4* sc4 = (const GAS f32x4*)(scale + bidx * MODN) + lane;
        GAS unsigned long long* o8 = (GAS unsigned long long*)(XN + (size_t)row * D) + lane; GAS unsigned* o4 = (GAS unsigned*)((unsigned char*)XN + (size_t)row * D) + lane;
#pragma unroll
        for (int j = 0; j < 8; ++j) { const f32x4 g = g4[64 * j], sh = sh4[64 * j], sc = sc4[64 * j]; v[j] = (v[j] * rstd * g) * (1.0f + sc) + sh;
            if constexpr (ROUTE) {}
            else if constexpr (F8) o4[64 * j] = pg8::cvt4_fp8(v[j].x, v[j].y, v[j].z, v[j].w);
            else o8[64 * j] = (unsigned long long)pk2(v[j].x, v[j].y) | ((unsigned long long)pk2(v[j].z, v[j].w) << 32); }
        if (ROUTE) {
            float lg[8];
#pragma unroll
            for (int e = 0; e < 8; ++e) lg[e] = 0.f;
#pragma unroll
            for (int j = 0; j < 8; ++j)
#pragma unroll
                for (int q = 0; q < 4; ++q) { const int k = 256 * j + 4 * lane + q; const LAS f32x4* rp = (const LAS f32x4*)(rt + k * 8); const f32x4 r0 = rp[0], r1 = rp[1]; const float f = v[j][q];
                    lg[0] += f * r0.x; lg[1] += f * r0.y; lg[2] += f * r0.z; lg[3] += f * r0.w; lg[4] += f * r1.x; lg[5] += f * r1.y; lg[6] += f * r1.z; lg[7] += f * r1.w;
                    if (q == 3) asm volatile("" ::: "memory"); }
#pragma unroll
            for (int e = 0; e < 8; ++e) lg[e] = wave_sum(lg[e]);
            int i1 = 0; float v1 = lg[0];
#pragma unroll
            for (int e = 1; e < 8; ++e) if (lg[e] > v1) { v1 = lg[e]; i1 = e; }
            int i2 = -1; float v2 = -INFINITY;
#pragma unroll
            for (int e = 0; e < 8; ++e) if (e != i1 && lg[e] > v2) { v2 = lg[e]; i2 = e; }
            const float w1 = 1.0f / (1.0f + expf(v2 - v1)), w2 = 1.0f - w1;
            if (have) ROUTE_FLUSH();
            ps1 = 0; ps2 = 0;
            if (lane == 0) { ps1 = (int)__hip_atomic_fetch_add(cnt + 64 * i1, 1u, RLX_AGENT); ps2 = (int)__hip_atomic_fetch_add(cnt + 64 * i2, 1u, RLX_AGENT); }
            pe1 = i1; pe2 = i2; pw1 = w1; pw2 = w2; prow = row; have = true;
#pragma unroll
            for (int j = 0; j < 8; ++j) pk[j] = pg8::cvt4_fp8(v[j].x, v[j].y, v[j].z, v[j].w);
        }
    }
    if (ROUTE) { if (have) ROUTE_FLUSH(); }
#undef ROUTE_FLUSH
}

struct TileSpec { int nband, band_row0, ctx_row0, nt; };
__device__ __forceinline__ int crow(int r, int hi) { return (r & 3) + 8 * (r >> 2) + 4 * hi; }
template <int NKC, int DVB, bool WIN>
__device__ __forceinline__ void attn_core(LAS unsigned char* lds, const bf16* P, const bf16x8 (&qr)[4], int kcol, int vcol, int kofs, const TileSpec ts, int qpos, int bandpos0,
                                          f32x16 (&o)[DVB], f32x16& ol, float& mref_out, int tid, int lane) {
    constexpr int SB = NKC * 1024 + DVB * 4096, NK = NKC / 8, NV = DVB / 2;
    constexpr float THR = 8.0f;
    const int r32 = lane & 31, hi = lane >> 5, wv = __builtin_amdgcn_readfirstlane(tid >> 6);
    int koff[NK], voff[NV];
#pragma unroll
    for (int i = 0; i < NK; ++i) { const int q = tid + 512 * i, key = q / NKC, s = q % NKC; koff[i] = key * INC + kcol + (s ^ (NKC == 16 ? (key & 15) : ((key >> 1) & 7))) * 8; }
#pragma unroll
    for (int i = 0; i < NV; ++i) { const int q = tid + 512 * i; voff[i] = (((q >> 6) & 3) * 16 + ((q >> 2) & 15)) * INC + vcol + (q >> 8) * 32 + (q & 3) * 8; }
#define ATT_DMA(t_, s_) do { const int t__ = (t_); const int rb_ = t__ < ts.nband ? ts.band_row0 + 64 * t__ : ts.ctx_row0 + 64 * (t__ - ts.nband); const bf16* tb_ = P + (size_t)rb_ * INC; \
        _Pragma("unroll") for (int i_ = 0; i_ < NK; ++i_) __builtin_amdgcn_global_load_lds((const unsigned*)(tb_ + koff[i_]), (LAS unsigned*)(lds + (s_) * SB + (wv * 64 + 512 * i_) * 16), 16, 0, 0); \
        _Pragma("unroll") for (int i_ = 0; i_ < NV; ++i_) __builtin_amdgcn_global_load_lds((const unsigned*)(tb_ + voff[i_]), (LAS unsigned*)(lds + (s_) * SB + NKC * 1024 + (wv * 64 + 512 * i_) * 16), 16, 0, 0); } while (0)
    float mref = 0.f;
    f32x16 negm;
#pragma unroll
    for (int r = 0; r < 16; ++r) { negm[r] = 0.f; ol[r] = 0.f; }
#pragma unroll
    for (int d0 = 0; d0 < DVB; ++d0)
#pragma unroll
        for (int r = 0; r < 16; ++r) o[d0][r] = 0.f;
    const short one = (r32 == 0) ? (short)0x3F80 : (short)0;
    const bf16x8 onesf = (bf16x8){one, one, one, one, one, one, one, one};
    ATT_DMA(0, 0); asm volatile("s_waitcnt vmcnt(0)" ::: "memory"); __syncthreads();
#pragma unroll 1
    for (int t = 0; t < ts.nt; ++t) {
        if (t + 1 < ts.nt) ATT_DMA(t + 1, (t + 1) & 1);
        LAS unsigned char* sb = lds + (t & 1) * SB;
        f32x16 p0, p1;
        { const LAS unsigned char* kb = sb + r32 * (NKC * 16);
#pragma unroll
          for (int d0 = 0; d0 < 4; ++d0) { const int so = ((kofs + 2 * d0 + hi) ^ (NKC == 16 ? (r32 & 15) : ((r32 >> 1) & 7))) * 16; const bf16x8 b0 = *(const LAS bf16x8*)(kb + so), b1 = *(const LAS bf16x8*)(kb + 32 * (NKC * 16) + so);
              if (d0 == 0) { p0 = __builtin_amdgcn_mfma_f32_32x32x16_bf16(b0, qr[0], negm, 0, 0, 0); p1 = __builtin_amdgcn_mfma_f32_32x32x16_bf16(b1, qr[0], negm, 0, 0, 0); }
              else { p0 = __builtin_amdgcn_mfma_f32_32x32x16_bf16(b0, qr[d0], p0, 0, 0, 0); p1 = __builtin_amdgcn_mfma_f32_32x32x16_bf16(b1, qr[d0], p1, 0, 0, 0); } } }
        if (WIN) { if (t < ts.nband) { const int kp0 = bandpos0 + 64 * t + 4 * hi;
#pragma unroll
            for (int r = 0; r < 16; ++r) { const int dlt = qpos - (kp0 + (r & 3) + 8 * (r >> 2)); if (dlt > 128 || dlt < -128) p0[r] = -1e30f; if (dlt - 32 > 128 || dlt - 32 < -128) p1[r] = -1e30f; } } }
        float rm = fmaxf(fmaxf(p0[0], p0[1]), p1[0]);
#pragma unroll
        for (int r = 1; r < 16; ++r) rm = fmaxf(fmaxf(rm, p0[r]), p1[r]);
        rm = fmaxf(rm, p0[1]);
        rm = fmaxf(rm, __shfl_xor(rm, 32));
        if (t == 0 || __any(rm > THR)) {
            const float dl = t == 0 ? rm : fmaxf(rm, 0.f);
            mref += dl;
#pragma unroll
            for (int r = 0; r < 16; ++r) { p0[r] -= dl; p1[r] -= dl; negm[r] = -mref; }
            if (t != 0) { const float f = __builtin_amdgcn_exp2f(-dl);
#pragma unroll
                for (int r = 0; r < 16; ++r) { const float fr = __shfl(f, crow(r, hi)); ol[r] *= fr;
#pragma unroll
                    for (int d0 = 0; d0 < DVB; ++d0) o[d0][r] *= fr; } }
        }
#pragma unroll
        for (int r = 0; r < 16; ++r) { p0[r] = __builtin_amdgcn_exp2f(p0[r]); p1[r] = __builtin_amdgcn_exp2f(p1[r]); }
        v4u pw[4];
#pragma unroll
        for (int i = 0; i < 4; ++i) { pw[0][i] = pg8::cvt_pk_bf16(p0[2 * i], p0[2 * i + 1]); pw[1][i] = pg8::cvt_pk_bf16(p0[8 + 2 * i], p0[8 + 2 * i + 1]); pw[2][i] = pg8::cvt_pk_bf16(p1[2 * i], p1[2 * i + 1]); pw[3][i] = pg8::cvt_pk_bf16(p1[8 + 2 * i], p1[8 + 2 * i + 1]); }
        { const LAS unsigned char* vb = sb + NKC * 1024 + ((lane >> 4) & 1) * 32 + (lane & 3) * 8 + (4 * hi + ((lane & 15) >> 2)) * 64;
#pragma unroll
          for (int d0 = 0; d0 < DVB; ++d0)
#pragma unroll
              for (int ks = 0; ks < 4; ++ks) {
                  const v4i16_t lo = __builtin_amdgcn_ds_read_tr16_b64_v4i16((LAS v4i16_t*)(vb + d0 * 4096 + ks * 1024)), hh = __builtin_amdgcn_ds_read_tr16_b64_v4i16((LAS v4i16_t*)(vb + d0 * 4096 + ks * 1024 + 512));
                  const bf16x8 vf = (bf16x8){lo[0], lo[1], lo[2], lo[3], hh[0], hh[1], hh[2], hh[3]};
                  o[d0] = __builtin_amdgcn_mfma_f32_32x32x16_bf16(__builtin_bit_cast(bf16x8, pw[ks]), vf, o[d0], 0, 0, 0);
                  if (ks == 3) asm volatile("" ::: "memory"); }
#pragma unroll
          for (int ks = 0; ks < 4; ++ks) ol = __builtin_amdgcn_mfma_f32_32x32x16_bf16(__builtin_bit_cast(bf16x8, pw[ks]), onesf, ol, 0, 0, 0); }
        asm volatile("s_waitcnt vmcnt(0)" ::: "memory");
        __syncthreads();
    }
#undef ATT_DMA
    mref_out = mref;
}
template <int DVB>
__device__ __forceinline__ void attn_normalize(f32x16 (&o)[DVB], const f32x16& ol, float extra, int hi) {
#pragma unroll
    for (int r = 0; r < 16; ++r) { const float l = __shfl(ol[r], hi << 5) + __shfl(extra, crow(r, hi)); const float ir = 1.0f / l;
#pragma unroll
        for (int d0 = 0; d0 < DVB; ++d0) o[d0][r] *= ir; }
}

__device__ __forceinline__ void win_unit(LAS unsigned char* lds, const bf16* P, bf16* MIX, const float* sink, int b, int g, int qb, bool ctxq, int tid, int lane, int wave) {
    const int r32 = lane & 31, hi = lane >> 5, hr = wave >> 1, sub = (wave & 1) * 32;
    TileSpec ts; int qrow0, qpos = 0, bandpos0 = 0;
    if (!ctxq) { const int tl = qb - 2 < 0 ? 0 : qb - 2, th = qb + 2 > 31 ? 31 : qb + 2; ts.nband = th - tl + 1; ts.band_row0 = RC + b * SEQ + tl * 64; bandpos0 = tl * 64; ts.ctx_row0 = b * CTX; ts.nt = ts.nband + 4;
        qrow0 = RC + b * SEQ + qb * 64 + sub; qpos = qb * 64 + sub + r32; }
    else { ts.nband = 0; ts.band_row0 = 0; ts.ctx_row0 = b * CTX; ts.nt = 4; qrow0 = b * CTX + qb * 64 + sub; }
    const int qcol = 3072 + g * 256 + hr * 64;
    bf16x8 qr[4];
#pragma unroll
    for (int d0 = 0; d0 < 4; ++d0) qr[d0] = *(const GAS bf16x8*)(P + (size_t)(qrow0 + r32) * INC + qcol + d0 * 16 + hi * 8);
    f32x16 o[2], ol; float mref;
    attn_core<8, 2, true>(lds, P, qr, 3584 + g * 64, 3712 + g * 64, 0, ts, qpos, bandpos0, o, ol, mref, tid, lane);
    attn_normalize<2>(o, ol, __builtin_amdgcn_exp2f(sink[g * 4 + hr] * LOG2E - mref), hi);
#pragma unroll
    for (int r = 0; r < 16; ++r) { bf16* op = MIX + (size_t)(qrow0 + crow(r, hi)) * D + 1536 + (g * 4 + hr) * 64 + r32;
#pragma unroll
        for (int d0 = 0; d0 < 2; ++d0) op[d0 * 32] = (bf16)f2bf(o[d0][r]); }
}

__device__ __forceinline__ void diff_unit(LAS unsigned char* lds, const bf16* P, bf16* MIX, const float* dlam, const float* subln, float lam_init, int b, int h, int qb, bool ctxq, int tid, int lane, int wave) {
    const int r32 = lane & 31, hi = lane >> 5, m = wave >> 2, sub = (wave & 3) * 32;
    TileSpec ts; int qrow0;
    if (!ctxq) { ts.nband = 32; ts.band_row0 = RC + b * SEQ; ts.ctx_row0 = b * CTX; ts.nt = 36; qrow0 = RC + b * SEQ + qb * 128 + sub; }
    else { ts.nband = 0; ts.band_row0 = 0; ts.ctx_row0 = b * CTX; ts.nt = 4; qrow0 = b * CTX + qb * 128 + sub; }
    const int qcol = 512 + h * 128 + m * 64;
    bf16x8 qr[4];
#pragma unroll
    for (int d0 = 0; d0 < 4; ++d0) qr[d0] = *(const GAS bf16x8*)(P + (size_t)(qrow0 + r32) * INC + qcol + d0 * 16 + hi * 8);
    const float lam = expf(wave_sum(dlam[lane] * dlam[64 + lane])) - expf(wave_sum(dlam[128 + lane] * dlam[192 + lane])) + lam_init;
    f32x16 o[4], ol; float mref;
    attn_core<16, 4, false>(lds, P, qr, 1024 + h * 128, 1536 + h * 128, m * 8, ts, 0, 0, o, ol, mref, tid, lane);
    attn_normalize<4>(o, ol, 0.f, hi);
    LAS float* ex = (LAS float*)lds + (wave & 3) * 4096;
    if (m == 1) {
#pragma unroll
        for (int d0 = 0; d0 < 4; ++d0)
#pragma unroll
            for (int r = 0; r < 16; ++r) ex[(d0 * 16 + r) * 64 + lane] = o[d0][r];
    }
    __syncthreads();
    if (m == 0) {
        float sl[4];
#pragma unroll
        for (int d0 = 0; d0 < 4; ++d0) sl[d0] = subln[d0 * 32 + r32] * (1.0f - lam_init);
#pragma unroll
        for (int r = 0; r < 16; ++r) {
            float ss = 0.f;
#pragma unroll
            for (int d0 = 0; d0 < 4; ++d0) { const float v = o[d0][r] - lam * ex[(d0 * 16 + r) * 64 + lane]; o[d0][r] = v; ss += v * v; }
            asm volatile("" ::: "memory");
#pragma unroll
            for (int off = 1; off < 32; off <<= 1) ss += __shfl_xor(ss, off);
            const float rstd = 1.0f / sqrtf(ss * (1.0f / 128.0f) + EPS);
            bf16* op = MIX + (size_t)(qrow0 + crow(r, hi)) * D + 512 + h * 128 + r32;
#pragma unroll
            for (int d0 = 0; d0 < 4; ++d0) op[d0 * 32] = (bf16)f2bf(o[d0][r] * rstd * sl[d0]);
        }
    }
    __syncthreads();
}

__device__ __forceinline__ void sgu_unit(LAS unsigned char* lds, const bf16* P, bf16* MIX, const float* ln_g, const float* ln_b, const float* Ws, const float* bs, int row0, int g, int tid, int lane, int wave) {
    constexpr int VS = 136;
    LAS bf16* VT = (LAS bf16*)lds;
    const int r32 = lane & 31, hi = lane >> 5;
    { const int tq = lane >> 4, j = lane & 15;
      v4u raws[4][4];
#pragma unroll
      for (int ps = 0; ps < 4; ++ps)
#pragma unroll
          for (int q = 0; q < 4; ++q) raws[ps][q] = *(const GAS v4u*)(P + (size_t)(row0 + wave * 16 + ps * 4 + tq) * INC + 2560 + (j + 16 * q) * 8);
      float lg8[8], lb8[8];
#pragma unroll
      for (int e = 0; e < 8; ++e) { lg8[e] = ln_g[g * 128 + 8 * j + e]; lb8[e] = ln_b[g * 128 + 8 * j + e]; }
#pragma unroll
      for (int ps = 0; ps < 4; ++ps) {
          float x[4][8]; float s = 0.f;
#pragma unroll
          for (int q = 0; q < 4; ++q)
#pragma unroll
              for (int e = 0; e < 4; ++e) { x[q][2 * e] = bf2f((unsigned short)(raws[ps][q][e] & 0xffffu)); x[q][2 * e + 1] = bf2f((unsigned short)(raws[ps][q][e] >> 16)); s += x[q][2 * e] + x[q][2 * e + 1]; }
#pragma unroll
          for (int off = 1; off < 16; off <<= 1) s += __shfl_xor(s, off);
          const float mean = s * (1.0f / 512.0f); float s2 = 0.f;
#pragma unroll
          for (int q = 0; q < 4; ++q)
#pragma unroll
              for (int e = 0; e < 8; ++e) { x[q][e] -= mean; s2 += x[q][e] * x[q][e]; }
#pragma unroll
          for (int off = 1; off < 16; off <<= 1) s2 += __shfl_xor(s2, off);
          const float rstd = 1.0f / sqrtf(s2 * (1.0f / 512.0f) + EPS);
          const int qtok = wave * 16 + ps * 4 + tq;
#pragma unroll
          for (int e = 0; e < 8; ++e) { const float xv = g == 0 ? x[0][e] : (g == 1 ? x[1][e] : (g == 2 ? x[2][e] : x[3][e])); VT[(8 * j + e) * VS + qtok] = (bf16)f2bf(xv * rstd * lg8[e] + lb8[e]); }
      }
    }
    __syncthreads();
    const int pb = wave & 3, ch = wave >> 2;
    f32x16 acc[2];
#pragma unroll
    for (int cb = 0; cb < 2; ++cb)
#pragma unroll
        for (int r = 0; r < 16; ++r) acc[cb][r] = 0.f;
    const float* wrow = Ws + (size_t)(g * 128 + pb * 32 + r32) * 128 + hi * 8;
#pragma unroll
    for (int ks = 0; ks < 8; ++ks) {
        const f32x4 w0 = *(const GAS f32x4*)(wrow + ks * 16), w1 = *(const GAS f32x4*)(wrow + ks * 16 + 4);
        v4u aw; aw.x = pk2(w0.x, w0.y); aw.y = pk2(w0.z, w0.w); aw.z = pk2(w1.x, w1.y); aw.w = pk2(w1.z, w1.w);
#pragma unroll
        for (int cb = 0; cb < 2; ++cb) { const bf16x8 bv = *(const LAS bf16x8*)(VT + (ch * 64 + cb * 32 + r32) * VS + ks * 16 + hi * 8);
            acc[cb] = __builtin_amdgcn_mfma_f32_32x32x16_bf16(__builtin_bit_cast(bf16x8, aw), bv, acc[cb], 0, 0, 0); }
    }
#pragma unroll
    for (int r = 0; r < 16; ++r) { const int p = pb * 32 + crow(r, hi); const float bias = bs[g * 128 + p];
#pragma unroll
        for (int cb = 0; cb < 2; ++cb) { const int c = g * 128 + ch * 64 + cb * 32 + r32; const float u = bf2f(P[(size_t)(row0 + p) * INC + 2048 + c]);
            MIX[(size_t)(row0 + p) * D + 1024 + c] = (bf16)f2bf(u * (acc[cb][r] + bias)); } }
    __syncthreads();
}

template <int HALF>
__device__ __forceinline__ void pool_body(const bf16* P, bf16* MIX, const float* pscale, int seq0, int T, int tk0, int cc) {
    constexpr int NR = 4 + 2 * HALF;
    v4u raw[NR];
#pragma unroll
    for (int r = 0; r < NR; ++r) { const int t = tk0 - HALF + r; raw[r] = (t >= 0 && t < T) ? *(const GAS v4u*)(P + (size_t)(seq0 + t) * INC + cc * 8) : (v4u){0u, 0u, 0u, 0u}; }
    const f32x4 s0 = *(const GAS f32x4*)(pscale + cc * 8), s1 = *(const GAS f32x4*)(pscale + cc * 8 + 4);
    const float sc[8] = {s0.x, s0.y, s0.z, s0.w, s1.x, s1.y, s1.z, s1.w};
    float w[8];
#pragma unroll
    for (int e = 0; e < 8; ++e) w[e] = 0.f;
#pragma unroll
    for (int r = 0; r < 2 * HALF - 1; ++r)
#pragma unroll
        for (int e = 0; e < 4; ++e) { w[2 * e] += bf2f((unsigned short)(raw[r][e] & 0xffffu)); w[2 * e + 1] += bf2f((unsigned short)(raw[r][e] >> 16)); }
#pragma unroll
    for (int i = 0; i < 4; ++i) {
        const int t = tk0 + i, lo = t - HALF < 0 ? 0 : t - HALF, hh = t + HALF > T ? T : t + HALF; const float rc = 1.0f / (float)(hh - lo);
        v4u o;
#pragma unroll
        for (int e = 0; e < 4; ++e) {
            w[2 * e] += bf2f((unsigned short)(raw[i + 2 * HALF - 1][e] & 0xffffu)); w[2 * e + 1] += bf2f((unsigned short)(raw[i + 2 * HALF - 1][e] >> 16));
            const float x0 = bf2f((unsigned short)(raw[HALF + i][e] & 0xffffu)), x1 = bf2f((unsigned short)(raw[HALF + i][e] >> 16));
            o[e] = pk2((w[2 * e] * rc - x0) * sc[2 * e], (w[2 * e + 1] * rc - x1) * sc[2 * e + 1]);
            w[2 * e] -= bf2f((unsigned short)(raw[i][e] & 0xffffu)); w[2 * e + 1] -= bf2f((unsigned short)(raw[i][e] >> 16));
        }
        *(GAS v4u*)(MIX + (size_t)(seq0 + t) * D + cc * 8) = o;
    }
}
__device__ __forceinline__ void pool_unit(const bf16* P, bf16* MIX, const float* pscale, int row0, int tid, int wave) {
    const int seq0 = row0 < RC ? (row0 & ~255) : RC + ((row0 - RC) & ~2047), T = row0 < RC ? CTX : SEQ, tk0 = row0 - seq0 + 4 * (tid & 7), cc = tid >> 3, g = wave >> 1;
    if (g == 0) pool_body<1>(P, MIX, pscale, seq0, T, tk0, cc); else if (g == 1) pool_body<2>(P, MIX, pscale, seq0, T, tk0, cc); else if (g == 2) pool_body<4>(P, MIX, pscale, seq0, T, tk0, cc); else pool_body<8>(P, MIX, pscale, seq0, T, tk0, cc);
}

__global__ void __launch_bounds__(NWAVES * 64, 2) fwd_kernel(Args args_unused) {
    extern __shared__ __attribute__((aligned(16))) unsigned char lds_raw[];
    LAS unsigned char* lds = (LAS unsigned char*)lds_raw;
    volatile LAS unsigned* MISC = (volatile LAS unsigned*)(lds + MISC_OFF);
    const int tid0 = threadIdx.x;
#define TID_HERE() int tid = threadIdx.x; asm volatile("" : "+v"(tid)); int G = G0, bx = bx0; asm volatile("" : "+s"(G), "+s"(bx)); const int vcu = (G % 8 == 0) ? (bx % 8) * (G / 8) + bx / 8 : bx; const int NGW = G * NWAVES; \
    const int lane = tid & 63, wave = __builtin_amdgcn_readfirstlane(tid >> 6); const int gw = vcu * NWAVES + wave; (void)lane; (void)gw; (void)NGW
    const int G0 = gridDim.x, bx0 = blockIdx.x;
    for (int u = tid0; u < (LDS_BYTES - LDSCTL_OFF) / 4; u += NWAVES * 64) ((LAS unsigned*)(lds + LDSCTL_OFF))[u] = 0u;
    __syncthreads();
    int lo, hi;
    XcdBarrier bar;
    { kaptr kp = ka_get(); lo = KLO(kp); hi = KHI(kp); unsigned* bw = (unsigned*)(KWS(kp) + WS_CTL) + CW_BAR; bar.bar = bw; bar.x = 0; bar.st = nullptr;
      if (!MK_PER_PHASE) bar = xcd_barrier_post(bw, MISC + 8); }
#ifndef SITEMASK
#define SITEMASK 0xfff
#endif
#ifndef UNITMASK
#define UNITMASK 0xf
#endif
#define UEN(s) (((UNITMASK) >> (s)) & 1)
#ifndef REPMASK
#define REPMASK 0
#endif
#ifndef REPU
#define REPU 0
#endif
#define NREPU(s) (1 + (((REPU) >> (s)) & 1))
#define NREP(s) (1 + (((REPMASK) >> (s)) & 1))
#define EN(s) (((SITEMASK) >> (s)) & 1)
#define IN(k) (lo <= (k) && (k) < hi)
#ifndef NCONV
#define NCONV 16
#endif
#ifndef FILLW
#define FILLW 2
#endif
#define CONVPH(k) ((k) == 2 || (k) == 4 || (k) == 6 || (k) == 7)
#ifndef SPLITK
#define SPLITK false
#endif
#ifndef SPLITK_FFN_DOWN
#define SPLITK_FFN_DOWN false
#endif
#ifndef SPLITK_MOE_DOWN
#define SPLITK_MOE_DOWN true
#endif
#ifndef FILLMODE
#define FILLMODE 1
#endif
#define FILL(k) do { if (FILLMODE == 1 && l == 0 && IN(k)) {     kaptr kq = ka_get(); int Gq = G0; asm volatile("" : "+s"(Gq)); fill_tail(KWS(kq), KIN(kq, 23), KIN(kq, 24), KIN(kq, 25), (unsigned*)(KWS(kq) + WS_CTL) + CW_DONE + 64 * (k), Gq, (FILLMODE == 1 && l == 0 && (int)blockIdx.x < NCONV && CONVPH(k)) ? 8 : FILLW); } } while (0)
#define DRAIN(k) do { if (((FILLMODE == 1) || (k) == 0) && IN(k)) { kaptr kq = ka_get(); int Gq = G0; asm volatile("" : "+s"(Gq)); drain_tail(KWS(kq), KIN(kq, 23), KIN(kq, 24), KIN(kq, 25), Gq, lds); } } while (0)
#define SEAM(k) do { if (IN(k) && IN((k) + 1)) { XcdBarrier b_ = bar; asm volatile("" : "+s"(b_.bar)); xcd_barrier(b_); } } while (0)
    LAS int* TB = (LAS int*)(lds + TB_OFF);

    for (int rep = 0; rep < NREP(0); ++rep) if (EN(0) && IN(0)) { kaptr kp = ka_get(); TID_HERE(); p0_prologue(kp, lds, vcu, G, tid, lane, wave); }
    if (FILLMODE == 0) DRAIN(0);
    SEAM(0);

    for (int l = 0; l < 2; ++l) {
        const int pb = l == 0 ? 1 : 8;
        const bool last = (l == 1);
        for (int rep = 0; rep < NREP(1); ++rep) if (EN(1) && IN(pb + 0)) {
            kaptr kp = ka_get(); TID_HERE(); unsigned char* ws = KWS(kp); const float* H = (const float*)(ws + WS_H); const float* mod = (const float*)(ws + WS_MOD) + l * 5 * MODN;
            const float* srcC = l == 0 ? KIN(kp, 2) : H; const float* srcL = l == 0 ? KIN(kp, 0) - (size_t)RC * D : H;
            norm_rows<false>(srcC, srcL, KIN(kp, 6) + l * D, mod + 0 * D, mod + 1 * D, (bf16*)(ws + WS_XN), 0, RT, gw, NGW, lane, nullptr, nullptr, nullptr);
        }
        SEAM(pb + 0);
        for (int rep = 0; rep < NREP(2); ++rep) if (EN(2) && IN(pb + 1)) {
            kaptr kp = ka_get(); TID_HERE(); unsigned char* ws = KWS(kp);
            pg8::Gemm g{(const bf16*)(ws + WS_XN), (const bf16*)(ws + WS_WIN) + (size_t)l * INC * D, RT, INC, D}; pg8::EpiIn E{(bf16*)(ws + WS_PALL), (const float*)(ws + WS_ROPE)};
            const int nc = (FILLMODE == 1 && l == 0) ? NCONV : 0;
            if (bx >= nc) {
            pg8::OrderSplit<pg8::MapIn> S; S.init(G - nc, bx - nc, D, last ? 20 : 60); S.plan(SPLITK);
            pg8::EpiSplit<pg8::EpiIn> ES{E, (float*)(ws + WS_SLAB)};
            { pg8::CachedOrder CS; CS.fill(S, (PG8_LAS int*)(lds + UT_OFF), tid); __syncthreads();
                  pg8::gemm_phase<pg8::EpiSplit<pg8::EpiIn>, pg8::CachedOrder, true, true>(lds, g, CS, ES); }
            combine_tail(E, S, (float*)(ws + WS_SLAB), (unsigned*)(ws + WS_CTL) + CW_TK + 4096 * (pb + 1), lds); }
        }
        FILL(pb + 1); SEAM(pb + 1);
        for (int rep = 0; rep < NREP(3); ++rep) if (EN(3) && IN(pb + 2)) {
            kaptr kp = ka_get(); TID_HERE(); unsigned char* ws = KWS(kp); const bf16* PALL = (const bf16*)(ws + WS_PALL); bf16* MIX = (bf16*)(ws + WS_MIX);
            const float lam_init = 0.8f - 0.6f * expf(-0.3f * (float)l);
            for (int ru = 0; ru < NREPU(0); ++ru) if (UEN(0)) for (int u = vcu; u < 256; u += G) diff_unit(lds, PALL, MIX, KIN(kp, 12) + l * 256, KIN(kp, 13) + l * 128, lam_init, u >> 6, (u >> 4) & 3, u & 15, false, tid, lane, wave);
            for (int ru = 0; ru < NREPU(1); ++ru) if (UEN(1)) for (int u = vcu; u < 256; u += G) win_unit(lds, PALL, MIX, KIN(kp, 18) + l * 8, u >> 6, (u >> 5) & 1, u & 31, false, tid, lane, wave);
            if (!last) {
                if (UEN(0)) for (int u = vcu; u < 32; u += G) diff_unit(lds, PALL, MIX, KIN(kp, 12) + l * 256, KIN(kp, 13) + l * 128, lam_init, u >> 3, (u >> 1) & 3, u & 1, true, tid, lane, wave);
                if (UEN(1)) for (int u = (vcu + G - (32 % G)) % G; u < 32; u += G) win_unit(lds, PALL, MIX, KIN(kp, 18) + l * 8, u >> 3, (u >> 2) & 1, u & 3, true, tid, lane, wave);
            }
            { const int ch0 = last ? 8 : 0, nu = (72 - ch0) * 4;
              for (int ru = 0; ru < NREPU(2); ++ru) if (UEN(2)) for (int u = (vcu + G - (64 % G)) % G; u < nu; u += G) sgu_unit(lds, PALL, MIX, KIN(kp, 14) + l * 512, KIN(kp, 15) + l * 512, KIN(kp, 16) + (size_t)l * 4 * 128 * 128, KIN(kp, 17) + l * 512, (ch0 + (u >> 2)) * 128, u & 3, tid, lane, wave); }
            { const int r0 = last ? RC : 0, nu = (RT - r0) / 32;
              for (int ru = 0; ru < NREPU(3); ++ru) if (UEN(3)) for (int u = (vcu + G - (96 % G)) % G; u < nu; u += G) pool_unit(PALL, MIX, KIN(kp, 11) + l * 512, r0 + 32 * u, tid, wave); }
        }
        FILL(pb + 2); SEAM(pb + 2);
        for (int rep = 0; rep < NREP(4); ++rep) if (EN(4) && IN(pb + 3)) {
            kaptr kp = ka_get(); TID_HERE(); unsigned char* ws = KWS(kp); float* H = (float*)(ws + WS_H);
            const float* srcC = l == 0 ? KIN(kp, 2) : H; const float* srcL = l == 0 ? KIN(kp, 0) - (size_t)RC * D : H;
            pg8::Gemm g{(const bf16*)(ws + WS_MIX), (const bf16*)(ws + WS_WOUT) + (size_t)l * D * D, RT, D, D}; pg8::EpiResid E{srcC, srcL, rep ? (float*)(ws + WS_Y) : H, (const float*)(ws + WS_MOD) + l * 5 * MODN + 2 * D, 1.0f};
            const int nc = (FILLMODE == 1 && l == 0) ? NCONV : 0;
            if (bx >= nc) {
            pg8::OrderSplit<pg8::MapOff> S; S.init(last ? RL : RT, D, G - nc, bx - nc, D); S.pm_off = last ? 4 : 0; S.plan(SPLITK);
            pg8::EpiSplit<pg8::EpiResid> ES{E, (float*)(ws + WS_SLAB)};
            { pg8::CachedOrder CS; CS.fill(S, (PG8_LAS int*)(lds + UT_OFF), tid); __syncthreads();
                  pg8::gemm_phase<pg8::EpiSplit<pg8::EpiResid>, pg8::CachedOrder, true, true>(lds, g, CS, ES); }
            combine_tail(E, S, (float*)(ws + WS_SLAB), (unsigned*)(ws + WS_CTL) + CW_TK + 4096 * (pb + 3), lds); }
        }
        FILL(pb + 3); SEAM(pb + 3);
        for (int rep = 0; rep < NREP(5); ++rep) if (EN(5) && IN(pb + 4)) {
            kaptr kp = ka_get(); TID_HERE(); unsigned char* ws = KWS(kp); const float* H = (const float*)(ws + WS_H); const float* mod = (const float*)(ws + WS_MOD) + l * 5 * MODN;
            if (!last || rep) norm_rows<false, DENSE_UP_F8>(H, H, KIN(kp, 7) + l * D, mod + 3 * D, mod + 4 * D, (bf16*)(ws + WS_XN), last ? RC : 0, RT, gw, NGW, lane, nullptr, nullptr, nullptr);
            else {
                LAS float* rt = (LAS float*)lds;
                for (int i = tid; i < D * NE / 4; i += NWAVES * 64) ((LAS f32x4*)rt)[i] = ((const GAS f32x4*)KIN(kp, 22))[i];
                __syncthreads();
                norm_rows<true, MOE_F8>(H, H, KIN(kp, 7) + l * D, mod + 3 * D, mod + 4 * D, (bf16*)(ws + WS_XG), RC, RT, gw, NGW, lane, rt, (unsigned*)(ws + WS_CTL) + CW_CNT, (int*)(ws + WS_ROUTE));
            }
        }
        if (last) DRAIN(pb + 4);
        SEAM(pb + 4);
        if (!last) {
            for (int rep = 0; rep < NREP(6); ++rep) if (EN(6) && IN(pb + 5)) {
                kaptr kp = ka_get(); TID_HERE(); unsigned char* ws = KWS(kp);
                constexpr int KP = DENSE_UP_F8 ? D / 2 : D;
                pg8::Gemm g{(const bf16*)(ws + WS_XN), (const bf16*)(ws + WS_W13), RT, 2 * DFF, KP}; pg8::EpiSwiglu<DENSE_DN_F8> E{(void*)(ws + WS_ACT), DFF, NTN_UP, DENSE_UP_F8 ? 1.0f / 256.0f : 1.0f};
                const int nc = (FILLMODE == 1) ? NCONV : 0;
                if (bx >= nc) {
                pg8::OrderSplit<pg8::StaticOrder> S; S.init(RT, 2 * DFF, G - nc, bx - nc, KP); S.plan(SPLITK);
                pg8::EpiSplit<pg8::EpiSwiglu<DENSE_DN_F8>> ES{E, (float*)(ws + WS_SLAB)};
                { pg8::CachedOrder CS; CS.fill(S, (PG8_LAS int*)(lds + UT_OFF), tid); __syncthreads();
                  pg8::gemm_phase<pg8::EpiSplit<pg8::EpiSwiglu<DENSE_DN_F8>>, pg8::CachedOrder, true, true, DENSE_UP_F8>(lds, g, CS, ES); }
                combine_tail(E, S, (float*)(ws + WS_SLAB), (unsigned*)(ws + WS_CTL) + CW_TK + 4096 * (pb + 5), lds); }
            }
            FILL(pb + 5); SEAM(pb + 5);
            for (int rep = 0; rep < NREP(7); ++rep) if (EN(7) && IN(pb + 6)) {
                kaptr kp = ka_get(); TID_HERE(); unsigned char* ws = KWS(kp); float* H = (float*)(ws + WS_H);
                constexpr int KP = DENSE_DN_F8 ? DFF / 2 : DFF;
                pg8::Gemm g{(const bf16*)(ws + WS_ACT), (const bf16*)(ws + WS_W2), RT, D, KP}; pg8::EpiResid E{H, H, rep ? (float*)(ws + WS_Y) : H, (const float*)(ws + WS_MOD) + l * 5 * MODN + 5 * D, DENSE_DN_F8 ? 1.0f / 256.0f : 1.0f};
                const int nc = (FILLMODE == 1) ? NCONV : 0;
                if (bx >= nc) {
                pg8::OrderSplit<pg8::MapOff> S; S.init(RT, D, G - nc, bx - nc, KP); S.pm_off = 0; S.plan(SPLITK_FFN_DOWN);
                pg8::EpiSplit<pg8::EpiResid> ES{E, (float*)(ws + WS_SLAB)};
                { pg8::CachedOrder CS; CS.fill(S, (PG8_LAS int*)(lds + UT_OFF), tid); __syncthreads();
                  pg8::gemm_phase<pg8::EpiSplit<pg8::EpiResid>, pg8::CachedOrder, true, true, DENSE_DN_F8>(lds, g, CS, ES); }
                combine_tail(E, S, (float*)(ws + WS_SLAB), (unsigned*)(ws + WS_CTL) + CW_TK + 4096 * (pb + 6), lds); }
            }
            FILL(pb + 6); SEAM(pb + 6);
        } else {
            if (IN(pb + 5) || IN(pb + 6) || IN(pb + 7) || IN(pb + 8)) {
                kaptr kp = ka_get(); TID_HERE(); const unsigned* CNT = (const unsigned*)(KWS(kp) + WS_CTL) + CW_CNT;
                if (tid == 0) { int acc = 0; TB[0] = 0;
                    for (int e = 0; e < 8; ++e) { const unsigned c = __hip_atomic_load(CNT + 64 * e, RLX_AGENT); acc += (int)((c + 255u) >> 8); TB[e + 1] = acc; } }
                __syncthreads();
            }
            for (int rep = 0; rep < NREP(9); ++rep) if (EN(9) && IN(pb + 6)) {
                kaptr kp = ka_get(); TID_HERE(); unsigned char* ws = KWS(kp);
                constexpr int KP = MOE_F8 ? D / 2 : D;
                pg8::Gemm g{(const bf16*)(ws + WS_XG), (const bf16*)(ws + WS_MW13), NE * 8192, NE * 2 * DFF, KP}; pg8::EpiSwiglu<MOE_F8> E{(void*)(ws + WS_ACT), DFF, NTN_UP, MOE_F8 ? 1.0f / 256.0f : 1.0f, (const PG8_LAS int*)TB};
                pg8::OrderSplit<pg8::MapMoe> S; S.init((const PG8_LAS int*)TB, NTN_UP, G, bx, KP, 1); S.plan(SPLITK);
                pg8::EpiSplit<pg8::EpiSwiglu<MOE_F8>> ES{E, (float*)(ws + WS_SLAB)};
                { pg8::CachedOrder CS; CS.fill(S, (PG8_LAS int*)(lds + UT_OFF), tid); __syncthreads();
                  pg8::gemm_phase<pg8::EpiSplit<pg8::EpiSwiglu<MOE_F8>>, pg8::CachedOrder, true, true, MOE_F8>(lds, g, CS, ES); }
                combine_tail(E, S, (float*)(ws + WS_SLAB), (unsigned*)(ws + WS_CTL) + CW_TK + 4096 * (pb + 6), lds);
            }
            SEAM(pb + 6);
            for (int rep = 0; rep < NREP(10); ++rep) if (EN(10) && IN(pb + 7)) {
                kaptr kp = ka_get(); TID_HERE(); unsigned char* ws = KWS(kp);
                constexpr int KP = MOE_F8 ? DFF / 2 : DFF;
                pg8::Gemm g{(const bf16*)(ws + WS_ACT), (const bf16*)(ws + WS_MW2), MAXSLOT, NE * D, KP}; pg8::EpiF32 E{(bf16*)(ws + WS_Y), D / 256, MOE_F8 ? 1.0f / 256.0f : 1.0f};
                pg8::OrderSplit<pg8::MapMoe> S; S.init((const PG8_LAS int*)TB, D / 256, G, bx, KP); S.plan(SPLITK_MOE_DOWN);
                pg8::EpiSplit<pg8::EpiF32> ES{E, (float*)(ws + WS_SLAB)};
                { pg8::CachedOrder CS; CS.fill(S, (PG8_LAS int*)(lds + UT_OFF), tid); __syncthreads();
                  pg8::gemm_phase<pg8::EpiSplit<pg8::EpiF32>, pg8::CachedOrder, true, true, MOE_F8>(lds, g, CS, ES); }
                combine_tail(E, S, (float*)(ws + WS_SLAB), (unsigned*)(ws + WS_CTL) + CW_TK + 4096 * (pb + 7), lds);
            }
            SEAM(pb + 7);
            for (int rep = 0; rep < NREP(11); ++rep) if (EN(11) && IN(pb + 8)) {
                kaptr kp = ka_get(); TID_HERE(); unsigned char* ws = KWS(kp); const int* ROUTE = (const int*)(ws + WS_ROUTE); const float* H = (const float*)(ws + WS_H); const bf16* Y = (const bf16*)(ws + WS_Y);
                const float* gate = (const float*)(ws + WS_MOD) + l * 5 * MODN + 5 * D; const float* nf = KIN(kp, 26); float* out = KOUT(kp);
                for (int t = gw; t < RL; t += NGW) {
                    const int* rec = ROUTE + (size_t)t * 8; const int e1 = rec[0], s1 = rec[1], e2 = rec[3], s2 = rec[4]; const float w1 = __builtin_bit_cast(float, rec[2]), w2 = __builtin_bit_cast(float, rec[5]);
                    const int b1 = TB[e1], b2 = TB[e2];
                    const int bidx = t >> 11;
                    const GAS f32x4* hr = (const GAS f32x4*)(H + (size_t)(RC + t) * D) + lane; const GAS v2u* y1 = (const GAS v2u*)(Y + (size_t)(b1 * 256 + s1) * D) + lane; const GAS v2u* y2 = (const GAS v2u*)(Y + (size_t)(b2 * 256 + s2) * D) + lane;
                    const GAS f32x4* g4 = (const GAS f32x4*)(gate + bidx * MODN) + lane;
                    f32x4 v[8]; float ss = 0.f;
#pragma unroll
                    for (int j = 0; j < 8; ++j) { const v2u ra = y1[64 * j], rb = y2[64 * j];
                        const f32x4 a = (f32x4){bf2f((unsigned short)(ra.x & 0xffffu)), bf2f((unsigned short)(ra.x >> 16)), bf2f((unsigned short)(ra.y & 0xffffu)), bf2f((unsigned short)(ra.y >> 16))};
                        const f32x4 b = (f32x4){bf2f((unsigned short)(rb.x & 0xffffu)), bf2f((unsigned short)(rb.x >> 16)), bf2f((unsigned short)(rb.y & 0xffffu)), bf2f((unsigned short)(rb.y >> 16))};
                        v[j] = hr[64 * j] + g4[64 * j] * (a * w1 + b * w2); ss += (v[j].x * v[j].x + v[j].y * v[j].y) + (v[j].z * v[j].z + v[j].w * v[j].w); }
                    const float rstd = 1.0f / sqrtf(wave_sum(ss) * (1.0f / D) + EPS);
                    GAS f32x4* op = (GAS f32x4*)(out + (size_t)t * D) + lane; const GAS f32x4* n4 = (const GAS f32x4*)nf + lane;
#pragma unroll
                    for (int j = 0; j < 8; ++j) op[64 * j] = v[j] * rstd * n4[64 * j];
                }
            }
        }
    }
#undef IN
#undef SEAM
}

extern "C" void kernel_launch(void* const* d_in, const int* in_sizes, int n_in, void* d_out, int out_size, void* d_ws, size_t ws_size, hipStream_t stream) {
    static int grid = 0;
    if (grid == 0) {
        if (n_in != 27 || out_size != RL * D || ws_size < WS_END) { fprintf(stderr, "kernel_launch: unexpected problem (n_in %d, out %d, ws %zu); nothing launched\n", n_in, out_size, ws_size); grid = -1; return; }
        int dev = 0, cus = 0, per_cu = 0;
        if (hipGetDevice(&dev) != hipSuccess || hipDeviceGetAttribute(&cus, hipDeviceAttributeMultiprocessorCount, dev) != hipSuccess) { grid = -1; return; }
        if (hipFuncSetAttribute((const void*)fwd_kernel, hipFuncAttributeMaxDynamicSharedMemorySize, LDS_BYTES) != hipSuccess) { fprintf(stderr, "kernel_launch: hipFuncSetAttribute failed\n"); grid = -1; return; }
        if (hipOccupancyMaxActiveBlocksPerMultiprocessor(&per_cu, (const void*)fwd_kernel, NWAVES * 64, LDS_BYTES) != hipSuccess || per_cu < 1) fprintf(stderr, "kernel_launch: occupancy query reports %d\n", per_cu);
        (void)hipGetLastError();
        grid = cus;
    }
    if (grid < 0) return;
    if (hipMemsetAsync((char*)d_ws + WS_CTL, 0, CTL_ZERO_BYTES, stream) != hipSuccess) { fprintf(stderr, "kernel_launch: memset failed\n"); return; }
    Args a{};
    for (int i = 0; i < 27; ++i) a.in[i] = (const float*)d_in[i];
    a.out = (float*)d_out; a.ws = (unsigned char*)d_ws;
#if MK_PER_PHASE
    for (int p = 0; p < NPHASE; ++p) { a.ph_lo = p; a.ph_hi = p + 1; hipLaunchKernelGGL(fwd_kernel, dim3(grid), dim3(NWAVES * 64), LDS_BYTES, stream, a); }
#else
    a.ph_lo = 0; a.ph_hi = NPHASE;
    hipLaunchKernelGGL(fwd_kernel, dim3(grid), dim3(NWAVES * 64), LDS_BYTES, stream, a);
#endif
    const hipError_t le = hipPeekAtLastError();
    if (le != hipSuccess) fprintf(stderr, "kernel_launch: launch failed: %s\n", hipGetErrorName(le));
}
```

```cpp
#include <hip/hip_runtime.h>
#include <cstdio>
#include <cstdint>
#include <cmath>

#define GAS __attribute__((address_space(1)))
#define LAS __attribute__((address_space(3)))
namespace pg8 {
#define PG8_LAS __attribute__((address_space(3)))
typedef unsigned short bf16_t;
typedef short bf16x8 __attribute__((ext_vector_type(8)));
typedef float f32x4 __attribute__((ext_vector_type(4)));
typedef unsigned u32x4 __attribute__((ext_vector_type(4)));
typedef int i32x4 __attribute__((ext_vector_type(4)));
typedef int i32x8 __attribute__((ext_vector_type(8)));
constexpr int BM = 256, BK = 64, HALF = 128, HTB = HALF * BK * 2  , STAGE_BYTES = 8 * HTB, NXCD = 8, WGM = 8;

__host__ __device__ __forceinline__ int lds_byte(int r, int c) { const int st = (r >> 4) * 2 + (c >> 5), rr = r & 15, cc = c & 31, ob = rr * 64 + cc * 2; return st * 1024 + (ob ^ (((ob >> 9) & 1) << 5)); }
__host__ __device__ __forceinline__ void stage_rc(int b, int& R, int& C) { const int st = b / 1024, sb = b % 1024, swz = sb ^ (((sb >> 9) & 1) << 5); R = (st >> 1) * 16 + swz / 64; C = (st & 1) * 32 + (swz % 64) / 2; }
__host__ __device__ __forceinline__ int perm32(int rho) { const int n = rho >> 4, i = rho & 15; return 8 * (i >> 2) + 4 * n + (i & 3); }

struct Unit { int pm, pn, k0, nkt, sid; };
struct Gemm { const bf16_t* A; const bf16_t* Bt; int M, N, K; };

struct StaticOrder {
    int nM, nN, nwg, G, c;
    __host__ __device__ void init(int M, int N, int G_, int c_, int K_) { nM = M / BM; nN = N / BM; nwg = nM * nN; G = G_; c = c_; K = K_; }
    int K;
    __host__ __device__ bool next(int i, Unit& u) const { const long L = (long)i * G + c; if (L >= nwg) return false; map(L, u); return true; }
    __host__ __device__ void map(long L, Unit& u) const {
        int wgid = (int)L; { const int q = nwg / NXCD, r = nwg % NXCD, xcd = wgid % NXCD, off = wgid / NXCD; wgid = (xcd < r ? xcd * (q + 1) : r * (q + 1) + (xcd - r) * q) + off; }
        const int nig = WGM * nN, gid = wgid / nig, fm = gid * WGM, gsz = (nM - fm) < WGM ? (nM - fm) : WGM;
        u.pm = fm + ((wgid % nig) % gsz); u.pn = (wgid % nig) / gsz; u.k0 = 0; u.nkt = K / BK; u.sid = -1;
    }
    __device__ __forceinline__ void a_ready(const Unit&) const {}
    __device__ __forceinline__ void done(const Unit&) const {}
};

__device__ __forceinline__ unsigned cvt_pk_bf16(float lo, float hi) { unsigned r; asm volatile("v_cvt_pk_bf16_f32 %0, %1, %2" : "=v"(r) : "v"(lo), "v"(hi)); return r; }
typedef unsigned u32x4 __attribute__((ext_vector_type(4)));
constexpr float QSCALE = 0.125f * 1.4426950408889634f;
__device__ __forceinline__ float gelu_tanh(float x) {
    const float y = 0.7978845608028654f * (x + 0.044715f * x * x * x);
    return x * __builtin_amdgcn_rcpf(1.0f + __builtin_amdgcn_exp2f(-2.0f * 1.4426950408889634f * y));
}
__device__ __forceinline__ float silu_f(float x) { return x * __builtin_amdgcn_rcpf(1.0f + __builtin_amdgcn_exp2f(-1.4426950408889634f * x)); }

struct EpiIn {
    static constexpr bool PERM = true, AFTER_DRAIN = false;
    bf16_t* O; const float* rope;
    __device__ __forceinline__ void operator()(const f32x4 (&acc)[2][2][4][2], const Unit& u, int wr, int wc, int fr, int fq) const {
        const int row0 = u.pm * BM + wr * 64 + fr; const bool lat = u.pm >= 4;
#pragma unroll
        for (int bj = 0; bj < 2; ++bj) {
            const int cb = u.pn * BM + bj * HALF; int role;
            if (cb < 512) role = 0; else if (cb < 1024) role = 1; else if (cb < 1536) role = 2; else if (cb < 2048) role = 0; else if (cb < 3072) role = 3; else if (cb < 3584) role = 1; else if (cb < 3712) role = 2; else role = 0;
            const int col0 = cb + wc * 32 + 8 * fq;
#pragma unroll
            for (int ai = 0; ai < 2; ++ai)
#pragma unroll
                for (int m = 0; m < 4; ++m) {
                    const int row = row0 + ai * HALF + m * 16;
                    f32x4 v0 = acc[ai][bj][m][0], v1 = acc[ai][bj][m][1];
                    if (role == 1 || role == 2) {
                        if (lat) {
                            const int t = (row - 1024) & 2047, pos = (wc & 1) ? (t & 63) : (t >> 6);
                            const f32x4 cs = *(const f32x4*)(rope + pos * 16 + 4 * fq), sn = *(const f32x4*)(rope + 1024 + pos * 16 + 4 * fq);
                            f32x4 a0, a1;
                            a0[0] = v0[0] * cs[0] - v0[1] * sn[0]; a0[1] = v0[0] * sn[0] + v0[1] * cs[0];
                            a0[2] = v0[2] * cs[1] - v0[3] * sn[1]; a0[3] = v0[2] * sn[1] + v0[3] * cs[1];
                            a1[0] = v1[0] * cs[2] - v1[1] * sn[2]; a1[1] = v1[0] * sn[2] + v1[1] * cs[2];
                            a1[2] = v1[2] * cs[3] - v1[3] * sn[3]; a1[3] = v1[2] * sn[3] + v1[3] * cs[3];
                            v0 = a0; v1 = a1;
                        }
                        if (role == 1) { v0 = v0 * QSCALE; v1 = v1 * QSCALE; }
                    } else if (role == 3) {
#pragma unroll
                        for (int e = 0; e < 4; ++e) { v0[e] = gelu_tanh(v0[e]); v1[e] = gelu_tanh(v1[e]); }
                    }
                    u32x4 w; w.x = cvt_pk_bf16(v0[0], v0[1]); w.y = cvt_pk_bf16(v0[2], v0[3]); w.z = cvt_pk_bf16(v1[0], v1[1]); w.w = cvt_pk_bf16(v1[2], v1[3]);
                    *(u32x4*)(O + (size_t)row * 3840 + col0) = w;
                }
        }
    }
};
__device__ __forceinline__ float clamp_fp8(float x) { return __builtin_amdgcn_fmed3f(x, -448.0f, 448.0f); }
__device__ __forceinline__ unsigned cvt4_fp8(float a, float b, float c, float d) { a = clamp_fp8(a); b = clamp_fp8(b); c = clamp_fp8(c); d = clamp_fp8(d); int w = 0; w = __builtin_amdgcn_cvt_pk_fp8_f32(a, b, w, false); w = __builtin_amdgcn_cvt_pk_fp8_f32(c, d, w, true); return (unsigned)w; }
template <bool F8OUT> struct EpiSwiglu {
    static constexpr bool PERM = true, AFTER_DRAIN = false;
    void* O; int ldo; int ntn; float sc;
    const PG8_LAS int* tb;
    __device__ __forceinline__ void operator()(const f32x4 (&acc)[2][2][4][2], const Unit& u, int wr, int wc, int fr, int fq) const {
        const int pmo = tb ? tb[u.pm >> 5] + (u.pm & 31) : u.pm;
        const int row0 = pmo * BM + wr * 64 + fr, col0 = (u.pn % ntn) * HALF + wc * 32 + 8 * fq;
#pragma unroll
        for (int ai = 0; ai < 2; ++ai)
#pragma unroll
            for (int m = 0; m < 4; ++m) {
                const f32x4 g0 = acc[ai][0][m][0] * sc, g1 = acc[ai][0][m][1] * sc, u0 = acc[ai][1][m][0] * sc, u1 = acc[ai][1][m][1] * sc;
                f32x4 r0, r1;
#pragma unroll
                for (int e = 0; e < 4; ++e) { r0[e] = silu_f(g0[e]) * u0[e]; r1[e] = silu_f(g1[e]) * u1[e]; }
                const size_t row = (size_t)(row0 + ai * HALF + m * 16);
                if constexpr (F8OUT) { typedef unsigned u32x2 __attribute__((ext_vector_type(2))); u32x2 w; w.x = cvt4_fp8(r0[0], r0[1], r0[2], r0[3]); w.y = cvt4_fp8(r1[0], r1[1], r1[2], r1[3]);
                    *(u32x2*)((unsigned char*)O + row * ldo + col0) = w; }
                else { u32x4 w; w.x = cvt_pk_bf16(r0[0], r0[1]); w.y = cvt_pk_bf16(r0[2], r0[3]); w.z = cvt_pk_bf16(r1[0], r1[1]); w.w = cvt_pk_bf16(r1[2], r1[3]);
                    *(u32x4*)((bf16_t*)O + row * ldo + col0) = w; }
            }
    }
};
struct EpiResid {
    static constexpr bool PERM = false, AFTER_DRAIN = false;
    const float* resC; const float* resL; float* out; const float* gate; float sc;
    __device__ __forceinline__ void operator()(const f32x4 (&acc)[2][2][4][2], const Unit& u, int wr, int wc, int fr, int fq) const {
        const int bidx = u.pm < 4 ? 4 : ((u.pm - 4) >> 3); const float* res = u.pm < 4 ? resC : resL; const float* gp = gate + bidx * 12288;
        const int row0 = u.pm * BM + wr * 64 + fr;
#pragma unroll
        for (int bj = 0; bj < 2; ++bj)
#pragma unroll
            for (int n = 0; n < 2; ++n) {
                const int col = u.pn * BM + bj * HALF + wc * 32 + 16 * n + 4 * fq; const f32x4 g4 = *(const f32x4*)(gp + col);
#pragma unroll
                for (int ai = 0; ai < 2; ++ai)
#pragma unroll
                    for (int m = 0; m < 4; ++m) { const size_t off = (size_t)(row0 + ai * HALF + m * 16) * 2048 + col; const f32x4 r = *(const f32x4*)(res + off); *(f32x4*)(out + off) = r + g4 * (acc[ai][bj][m][n] * sc); }
                asm volatile("" ::: "memory");
            }
    }
};
struct EpiF32 {
    static constexpr bool PERM = true, AFTER_DRAIN = false;
    bf16_t* O; int ntn; float sc;
    __device__ __forceinline__ void operator()(const f32x4 (&acc)[2][2][4][2], const Unit& u, int wr, int wc, int fr, int fq) const {
        const int row0 = u.pm * BM + wr * 64 + fr;
#pragma unroll
        for (int bj = 0; bj < 2; ++bj) {
            const int col0 = (u.pn % ntn) * BM + bj * HALF + wc * 32 + 8 * fq;
#pragma unroll
            for (int ai = 0; ai < 2; ++ai)
#pragma unroll
                for (int m = 0; m < 4; ++m) { const f32x4 v0 = acc[ai][bj][m][0] * sc, v1 = acc[ai][bj][m][1] * sc;
                    u32x4 w; w.x = cvt_pk_bf16(v0[0], v0[1]); w.y = cvt_pk_bf16(v0[2], v0[3]); w.z = cvt_pk_bf16(v1[0], v1[1]); w.w = cvt_pk_bf16(v1[2], v1[3]);
                    *(u32x4*)(O + (size_t)(row0 + ai * HALF + m * 16) * 2048 + col0) = w; }
        }
    }
};
template <class Epi> struct EpiSplit {
    static constexpr bool PERM = Epi::PERM, AFTER_DRAIN = false;
    Epi E; float* slab;
    __device__ __forceinline__ void operator()(const f32x4 (&acc)[2][2][4][2], const Unit& u, int wr, int wc, int fr, int fq) const {
        if (u.sid < 0) { E(acc, u, wr, wc, fr, fq); return; }
        f32x4* sp = (f32x4*)slab + (size_t)u.sid * (32 * 512) + (wr * 4 + wc) * 64 + fq * 16 + fr;
#pragma unroll
        for (int ai = 0; ai < 2; ++ai)
#pragma unroll
            for (int bj = 0; bj < 2; ++bj)
#pragma unroll
                for (int m = 0; m < 4; ++m)
#pragma unroll
                    for (int n = 0; n < 2; ++n) sp[(size_t)((((ai * 2 + bj) * 4 + m) * 2) + n) * 512] = acc[ai][bj][m][n];
    }
};
struct TailPlan { int nfull, ntail, S;
    __device__ __forceinline__ void make(int nwg, int G, bool allow, int K) { nfull = (nwg / G) * G; ntail = nwg - nfull;
        S = (!allow || ntail == 0) ? 1 : ((4 * ntail <= G && K % 512 == 0) ? 4 : ((2 * ntail <= G && K % 256 == 0) ? 2 : 1)); } };
template <class Base> struct OrderSplit : Base {
    TailPlan tp;
    __device__ __forceinline__ void plan(bool allow) { tp.make(this->nwg, this->G, allow, this->K); }
    __device__ __forceinline__ bool next(int i, Unit& u) const {
        const long L = (long)i * this->G + this->c;
        if (tp.S == 1) { if (L >= this->nwg) return false; this->map(L, u); return true; }
        if (L < tp.nfull) { this->map(L, u); return true; }
        const int j = (int)(L - tp.nfull); if (j >= tp.ntail * tp.S) return false;
        this->map(tp.nfull + j / tp.S, u); const int ks = j % tp.S, klen = this->K / tp.S; u.k0 = ks * klen; u.nkt = klen / BK; u.sid = j; return true;
    }
    __device__ __forceinline__ bool tail_unit(int& tt, Unit& u) const { if (tp.S == 1 || this->c >= tp.ntail * tp.S) return false; tt = this->c / tp.S; this->map(tp.nfull + tt, u); return true; }
};
struct CachedOrder {
    const PG8_LAS int* tab;
    template <class Ord> __device__ __forceinline__ void fill(const Ord& S, PG8_LAS int* t, int tid) {
        if (tid < 32) { Unit u; u.pm = 0; u.pn = 0; u.k0 = 0; u.nkt = 2; u.sid = -1; const bool ok = S.next(tid, u);
            t[tid * 8 + 0] = ok ? 1 : 0; t[tid * 8 + 1] = u.pm; t[tid * 8 + 2] = u.pn; t[tid * 8 + 3] = u.k0; t[tid * 8 + 4] = u.nkt; t[tid * 8 + 5] = u.sid; }
        tab = t;
    }
    __device__ __forceinline__ bool next(int i, Unit& u) const {
        if (i >= 32) return false;
        const i32x4 a = *(const PG8_LAS i32x4*)(tab + i * 8); const int b0 = tab[i * 8 + 4], b1 = tab[i * 8 + 5];
        if (!__builtin_amdgcn_readfirstlane(a[0])) return false;
        u.pm = __builtin_amdgcn_readfirstlane(a[1]); u.pn = __builtin_amdgcn_readfirstlane(a[2]); u.k0 = __builtin_amdgcn_readfirstlane(a[3]); u.nkt = __builtin_amdgcn_readfirstlane(b0); u.sid = __builtin_amdgcn_readfirstlane(b1); return true;
    }
    __device__ __forceinline__ void a_ready(const Unit&) const {}
    __device__ __forceinline__ void done(const Unit&) const {}
};
struct MapOff : StaticOrder {
    int pm_off;
    __device__ __forceinline__ void map(long L, Unit& u) const { StaticOrder::map(L, u); u.pm += pm_off; }
};
struct MapIn {
    StaticOrder lat; int nwg, G, c, K, nextra;
    __device__ __forceinline__ void init(int G_, int c_, int K_, int nextra_) { lat.init(8192, 3840, G_, c_, K_); G = G_; c = c_; K = K_; nextra = nextra_; nwg = lat.nwg + nextra_; }
    __device__ __forceinline__ void map(long L, Unit& u) const {
        if (L < lat.nwg) { lat.map(L, u); u.pm += 4; return; }
        const int e = (int)(L - lat.nwg);
        if (nextra == 60) { u.pm = e / 15; u.pn = e % 15; } else { u.pm = e / 5; const int idx = e % 5; u.pn = idx < 4 ? 4 + idx : 14; }
        u.k0 = 0; u.nkt = K / BK; u.sid = -1;
    }
    __device__ __forceinline__ void a_ready(const Unit&) const {}
    __device__ __forceinline__ void done(const Unit&) const {}
};
struct MapMoe {
    const PG8_LAS int* tb; int ntn, G, c, K, nwg, sp;
    __device__ __forceinline__ void init(const PG8_LAS int* tb_, int ntn_, int G_, int c_, int K_, int sp_ = 0) { tb = tb_; ntn = ntn_; G = G_; c = c_; K = K_; nwg = tb_[8] * ntn_; sp = sp_; }
    __device__ __forceinline__ void map(long L, Unit& u) const {
        int wgid = (int)L; { const int q = nwg / NXCD, r = nwg % NXCD, xcd = wgid % NXCD, off = wgid / NXCD; wgid = (xcd < r ? xcd * (q + 1) : r * (q + 1) + (xcd - r) * q) + off; }
        int e = 0;
#pragma unroll
        for (int k = 1; k < 8; ++k) if (wgid >= tb[k] * ntn) e = k;
        const int t0 = tb[e], Te = tb[e + 1] - t0, local = wgid - t0 * ntn;
        const int nig = WGM * ntn, gid = local / nig, fm = gid * WGM, gsz = (Te - fm) < WGM ? (Te - fm) : WGM;
        u.pm = (sp ? e * 32 : t0) + fm + ((local % nig) % gsz); u.pn = e * ntn + (local % nig) / gsz; u.k0 = 0; u.nkt = K / BK; u.sid = -1;
    }
    __device__ __forceinline__ void a_ready(const Unit&) const {}
    __device__ __forceinline__ void done(const Unit&) const {}
};

template <class Epi, class Sched, bool ALIGN_EPI = false, bool SP2 = false, bool F8 = false>
__device__ __forceinline__ void gemm_phase(PG8_LAS unsigned char* lds, const Gemm g, const Sched& S, const Epi& E) {
    int tid_o = threadIdx.x; asm volatile("" : "+v"(tid_o));
    const int tid = tid_o, wid = __builtin_amdgcn_readfirstlane(tid >> 6), lane = tid & 63, wr = wid >> 2, wc = wid & 3, fr = lane & 15, fq = lane >> 4;
    const int K = g.K;
    unsigned voffA[2], voffB[2];
#pragma unroll
    for (int i = 0; i < 2; ++i) { int R, C; stage_rc(tid * 16 + i * 8192, R, C); const int Rb = Epi::PERM ? ((R & ~31) + perm32(R & 31)) : R;
        voffA[i] = (unsigned)(R * K + C) * 2u; voffB[i] = (unsigned)(Rb * K + C) * 2u; }
    const size_t kstep = (size_t)(BK * 2);
    const size_t hstep = (size_t)HALF * K * 2;
    const size_t tstep = 2 * hstep;
    const unsigned ldsw = (unsigned)wid * 1024u;
    const int aoff = lds_byte(wr * 64 + fr, fq * 8), boff = lds_byte(wc * 32 + fr, fq * 8);
#define PG8_SA(b, h) (((b) * 2 + (h)) * HTB)
#define PG8_SB(b, h) ((4 + (b) * 2 + (h)) * HTB)
#define PG8_STAGE(bufoff, gbase, voff) do { _Pragma("unroll") for (int _i = 0; _i < 2; ++_i) \
        __builtin_amdgcn_global_load_lds((const unsigned*)((const char*)(gbase) + (voff)[_i]), (PG8_LAS unsigned*)(lds + (bufoff) + ldsw + _i * 8192), 16, 0, 0); } while (0)
#define PG8_LD32(p0_, p1_) __builtin_shufflevector(*(const PG8_LAS i32x4*)(p0_), *(const PG8_LAS i32x4*)(p1_), 0, 1, 2, 3, 4, 5, 6, 7)
#define PG8_LDA(dst, b, h) do { if constexpr (F8) { _Pragma("unroll") for (int m = 0; m < 4; ++m) dst##8[m] = PG8_LD32(lds + PG8_SA(b, h) + aoff + m * 2048, lds + PG8_SA(b, h) + aoff + m * 2048 + 1024); } else { \
        _Pragma("unroll") for (int m = 0; m < 4; ++m) _Pragma("unroll") for (int k = 0; k < 2; ++k) dst[m][k] = *(const PG8_LAS bf16x8*)(lds + PG8_SA(b, h) + aoff + m * 2048 + k * 1024); } } while (0)
#define PG8_LDB(dst, b, h) do { if constexpr (F8) { _Pragma("unroll") for (int n = 0; n < 2; ++n) dst##8[n] = PG8_LD32(lds + PG8_SB(b, h) + boff + n * 2048, lds + PG8_SB(b, h) + boff + n * 2048 + 1024); } else { \
        _Pragma("unroll") for (int n = 0; n < 2; ++n) _Pragma("unroll") for (int k = 0; k < 2; ++k) dst[n][k] = *(const PG8_LAS bf16x8*)(lds + PG8_SB(b, h) + boff + n * 2048 + k * 1024); } } while (0)
#define PG8_MMA(ai, bj, At, Bt) do { __builtin_amdgcn_s_setprio(1); if constexpr (F8) { _Pragma("unroll") for (int m = 0; m < 4; ++m) _Pragma("unroll") for (int n = 0; n < 2; ++n) \
        asm volatile("v_mfma_f32_16x16x128_f8f6f4 %0, %1, %2, %0" : "+v"(acc[ai][bj][m][n]) : "v"(Bt##8[n]), "v"(At##8[m])); } else { \
        _Pragma("unroll") for (int m = 0; m < 4; ++m) _Pragma("unroll") for (int n = 0; n < 2; ++n) _Pragma("unroll") for (int k = 0; k < 2; ++k) \
        acc[ai][bj][m][n] = __builtin_amdgcn_mfma_f32_16x16x32_bf16(Bt[n][k], At[m][k], acc[ai][bj][m][n], 0, 0, 0); } __builtin_amdgcn_s_setprio(0); } while (0)
#define PG8_WAIT_V(n) asm volatile("s_waitcnt vmcnt(" #n ")" ::: "memory")
#define PG8_WAIT_L(n) asm volatile("s_waitcnt lgkmcnt(" #n ")" ::: "memory")
#define PG8_BAR __builtin_amdgcn_s_barrier()
#define PG8_SCHED __builtin_amdgcn_sched_barrier(0)
    Unit cur, nxt; int ui = 0;
    if (!S.next(0, cur)) return;
    f32x4 acc[2][2][4][2];
#pragma unroll
    for (int a = 0; a < 2; ++a)
#pragma unroll
        for (int b = 0; b < 2; ++b)
#pragma unroll
            for (int m = 0; m < 4; ++m)
#pragma unroll
                for (int n = 0; n < 2; ++n) acc[a][b][m][n] = (f32x4){0.f, 0.f, 0.f, 0.f};
    bf16x8 At[4][2], B0[2][2], B1[2][2]; i32x8 At8[4], B08[2], B18[2];
    const char* cA = (const char*)g.A + (size_t)cur.pm * tstep + (size_t)cur.k0 * 2; const char* cB = (const char*)g.Bt + (size_t)cur.pn * tstep + (size_t)cur.k0 * 2;
    S.a_ready(cur);
    if constexpr (SP2) {
        PG8_STAGE(PG8_SB(0, 0), cB, voffB); PG8_STAGE(PG8_SB(0, 1), cB + hstep, voffB); PG8_STAGE(PG8_SA(0, 0), cA, voffA); PG8_STAGE(PG8_SA(0, 1), cA + hstep, voffA);
        if (wr == 1) PG8_BAR;
        PG8_WAIT_V(2); PG8_BAR;
        PG8_STAGE(PG8_SB(1, 0), cB + kstep, voffB); PG8_STAGE(PG8_SA(1, 0), cA + kstep, voffA); PG8_STAGE(PG8_SB(1, 1), cB + hstep + kstep, voffB);
        PG8_WAIT_V(6); PG8_BAR;
    } else {
        PG8_STAGE(PG8_SB(0, 0), cB, voffB); PG8_STAGE(PG8_SA(0, 0), cA, voffA); PG8_STAGE(PG8_SB(0, 1), cB + hstep, voffB); PG8_STAGE(PG8_SA(0, 1), cA + hstep, voffA);
        if (wr == 1) PG8_BAR;
        PG8_WAIT_V(4); PG8_BAR;
        PG8_STAGE(PG8_SB(1, 0), cB + kstep, voffB); PG8_STAGE(PG8_SA(1, 0), cA + kstep, voffA); PG8_STAGE(PG8_SB(1, 1), cB + hstep + kstep, voffB);
        PG8_WAIT_V(6); PG8_BAR;
    }
    for (;;) {
        const bool has_next = S.next(ui + 1, nxt);
        const char* nA = has_next ? (const char*)g.A + (size_t)nxt.pm * tstep + (size_t)nxt.k0 * 2 : cA; const char* nB = has_next ? (const char*)g.Bt + (size_t)nxt.pn * tstep + (size_t)nxt.k0 * 2 : cB;
        const int nt = cur.nkt;
        for (int t = 0; t < nt; t += 2) {
            const bool last = (t == nt - 2);
            const char* a1 = cA + (size_t)(t + 1) * kstep;
            const char* a2 = last ? nA : cA + (size_t)(t + 2) * kstep; const char* b2 = last ? nB : cB + (size_t)(t + 2) * kstep;
            const char* a3 = a2 + kstep; const char* b3 = b2 + kstep;
            if (last && has_next) S.a_ready(nxt);
            if constexpr (SP2) {
            PG8_LDB(B0, 0, 0); PG8_LDB(B1, 0, 1); PG8_SCHED; PG8_LDA(At, 0, 0); PG8_STAGE(PG8_SA(1, 1), a1 + hstep, voffA);
            PG8_WAIT_V(8); PG8_WAIT_L(0); PG8_BAR; PG8_MMA(0, 0, At, B0); PG8_MMA(0, 1, At, B1); PG8_BAR; PG8_SCHED;
            PG8_LDA(At, 0, 1); PG8_STAGE(PG8_SB(0, 0), b2, voffB); PG8_STAGE(PG8_SB(0, 1), b2 + hstep, voffB); PG8_STAGE(PG8_SA(0, 0), a2, voffA);
            PG8_WAIT_V(8); PG8_WAIT_L(0); PG8_BAR; PG8_MMA(1, 0, At, B0); PG8_MMA(1, 1, At, B1); PG8_BAR; PG8_SCHED;
            PG8_LDB(B0, 1, 0); PG8_LDB(B1, 1, 1); PG8_SCHED; PG8_LDA(At, 1, 0); PG8_STAGE(PG8_SA(0, 1), a2 + hstep, voffA);
            PG8_WAIT_V(8); PG8_WAIT_L(0); PG8_BAR; PG8_MMA(0, 0, At, B0); PG8_MMA(0, 1, At, B1); PG8_BAR; PG8_SCHED;
            PG8_LDA(At, 1, 1); PG8_STAGE(PG8_SB(1, 0), b3, voffB); PG8_STAGE(PG8_SB(1, 1), b3 + hstep, voffB); PG8_STAGE(PG8_SA(1, 0), a3, voffA);
            PG8_WAIT_V(8); PG8_WAIT_L(0); PG8_BAR; PG8_MMA(1, 0, At, B0); PG8_MMA(1, 1, At, B1); PG8_BAR; PG8_SCHED;
            } else {
            PG8_LDB(B0, 0, 0); PG8_SCHED; PG8_LDA(At, 0, 0); PG8_STAGE(PG8_SA(1, 1), a1 + hstep, voffA);
            PG8_WAIT_L(8); PG8_BAR; PG8_WAIT_L(0); PG8_MMA(0, 0, At, B0); PG8_BAR; PG8_SCHED;
            PG8_LDB(B1, 0, 1); PG8_STAGE(PG8_SB(0, 0), b2, voffB);
            PG8_BAR; PG8_WAIT_L(0); PG8_MMA(0, 1, At, B1); PG8_BAR;
            PG8_LDA(At, 0, 1); PG8_STAGE(PG8_SA(0, 0), a2, voffA);
            PG8_BAR; PG8_WAIT_L(0); PG8_MMA(1, 0, At, B0); PG8_BAR; PG8_SCHED;
            PG8_STAGE(PG8_SB(0, 1), b2 + hstep, voffB);
            PG8_WAIT_V(6); PG8_BAR; PG8_MMA(1, 1, At, B1); PG8_BAR;
            PG8_LDB(B0, 1, 0); PG8_SCHED; PG8_LDA(At, 1, 0); PG8_STAGE(PG8_SA(0, 1), a2 + hstep, voffA);
            PG8_WAIT_L(8); PG8_BAR; PG8_WAIT_L(0); PG8_MMA(0, 0, At, B0); PG8_BAR; PG8_SCHED;
            PG8_LDB(B1, 1, 1); PG8_STAGE(PG8_SB(1, 0), b3, voffB);
            PG8_BAR; PG8_WAIT_L(0); PG8_MMA(0, 1, At, B1); PG8_BAR;
            PG8_LDA(At, 1, 1); PG8_STAGE(PG8_SA(1, 0), a3, voffA);
            PG8_BAR; PG8_WAIT_L(0); PG8_MMA(1, 0, At, B0); PG8_BAR; PG8_SCHED;
            PG8_STAGE(PG8_SB(1, 1), b3 + hstep, voffB);
            PG8_WAIT_V(6); PG8_BAR; PG8_MMA(1, 1, At, B1); PG8_BAR;
            }
        }
        if constexpr (ALIGN_EPI) { if (wr == 0) PG8_BAR; }
        if constexpr (F8) asm volatile("s_nop 15\n\ts_nop 7" ::: "memory");
        if constexpr (!Epi::AFTER_DRAIN) { E(acc, cur, wr, wc, fr, fq); S.done(cur); }
        if (!has_next) break;
#pragma unroll
        for (int a = 0; a < 2; ++a)
#pragma unroll
            for (int b = 0; b < 2; ++b)
#pragma unroll
                for (int m = 0; m < 4; ++m)
#pragma unroll
                    for (int n = 0; n < 2; ++n) acc[a][b][m][n] = (f32x4){0.f, 0.f, 0.f, 0.f};
        cur = nxt; cA = nA; cB = nB; ++ui;
        if constexpr (ALIGN_EPI) { if (wr == 1) PG8_BAR; }
    }
    PG8_WAIT_V(0);
    if constexpr (!ALIGN_EPI) { if (wr == 0) PG8_BAR; }
    PG8_BAR;
    if constexpr (Epi::AFTER_DRAIN) { E.fused(acc, cur, wr, wc, fr, fq, lds, wid, lane); S.done(cur); }
#undef PG8_SA
#undef PG8_SB
#undef PG8_STAGE
#undef PG8_LDA
#undef PG8_LDB
#undef PG8_MMA
#undef PG8_LD32
#undef PG8_WAIT_V
#undef PG8_WAIT_L
#undef PG8_BAR
#undef PG8_SCHED
}
}

constexpr int D = 2048, NB = 4, SEQ = 2048, CTX = 256, DFF = 5632, NE = 8, INC = 3840, MODN = 12288;
constexpr int RC = NB * CTX, RL = NB * SEQ, RT = RC + RL;
constexpr int NTN_UP = DFF / 128;
constexpr int MAXSLOT = 2 * RL + NE * 256;
constexpr float EPS = 1e-6f, LOG2E = 1.4426950408889634f;
constexpr int NWAVES = 8;
#ifndef MK_PER_PHASE
#define MK_PER_PHASE 0
#endif
constexpr int NPHASE = 17;
#ifndef MOE_F8_ON
#define MOE_F8_ON 1
#endif
#ifndef DENSE_UP_F8_ON
#define DENSE_UP_F8_ON 1
#endif
#ifndef DENSE_DN_F8_ON
#define DENSE_DN_F8_ON 0
#endif
constexpr bool DENSE_UP_F8 = DENSE_UP_F8_ON != 0, DENSE_DN_F8 = DENSE_DN_F8_ON != 0;
constexpr bool MOE_F8 = MOE_F8_ON != 0;

constexpr size_t MiB = 1u << 20;
constexpr size_t WS_CTL = 0, CTL_ZERO_BYTES = 1 * MiB;
constexpr size_t WS_MOD = 1 * MiB;
constexpr size_t WS_ROPE = 1 * MiB + 512 * 1024;
constexpr size_t WS_ROUTE = 1 * MiB + 768 * 1024;
constexpr size_t WS_WIN = 2 * MiB, WS_WOUT = 32 * MiB, WS_W13 = 48 * MiB, WS_W2 = 92 * MiB, WS_MW13 = 114 * MiB, WS_MW2 = 466 * MiB;
constexpr size_t WS_H = 642 * MiB;
constexpr size_t WS_XN = 714 * MiB;
constexpr size_t WS_PALL = 750 * MiB;
constexpr size_t WS_MIX = 818 * MiB;
constexpr size_t WS_ACT = 854 * MiB;
constexpr size_t WS_XG = 1052 * MiB;
constexpr size_t WS_Y = 1180 * MiB;
static_assert(MOE_F8, "the per-expert input regions are laid out for fp8 rows");
constexpr size_t WS_SLAB = 1268 * MiB;
constexpr size_t WS_END = 1332 * MiB;
constexpr int CW_TMO = 0, CW_CODE = 1, CW_BAR = 4096, CW_CNT = 8192;
constexpr int CW_TK = 16384;
constexpr int CW_Q0 = 9216, CW_Q1 = 9280, CW_DONE = 9344;

constexpr int RING_BYTES = 131072, LDSCTL_OFF = 139264, MISC_OFF = LDSCTL_OFF + 320, TB_OFF = LDSCTL_OFF + 512, FLAG_OFF = LDSCTL_OFF + 256, UT_OFF = LDSCTL_OFF + 1024, LDS_BYTES = 147456;

typedef unsigned short bf16;
typedef unsigned v4u __attribute__((ext_vector_type(4)));
typedef unsigned v2u __attribute__((ext_vector_type(2)));
typedef float f32x4 __attribute__((ext_vector_type(4)));
typedef float f32x16 __attribute__((ext_vector_type(16)));
typedef short bf16x8 __attribute__((ext_vector_type(8)));
typedef short v4i16_t __attribute__((ext_vector_type(4)));
typedef GAS unsigned gu32;
#define RLX_AGENT __ATOMIC_RELAXED, __HIP_MEMORY_SCOPE_AGENT
#define LDS_WAIT() asm volatile("s_waitcnt lgkmcnt(0)" ::: "memory")
__device__ __forceinline__ unsigned f2bf(float f) { unsigned u = __builtin_bit_cast(unsigned, f); return (u + 0x7fffu + ((u >> 16) & 1u)) >> 16; }
__device__ __forceinline__ unsigned pk2(float lo, float hi) { return f2bf(lo) | (f2bf(hi) << 16); }
__device__ __forceinline__ float bf2f(unsigned short b) { return __builtin_bit_cast(float, (unsigned)b << 16); }
__device__ __forceinline__ float wave_sum(float v) {
#pragma unroll
    for (int o = 1; o < 64; o <<= 1) v += __shfl_xor(v, o);
    return v;
}

#define XB_TMO      128
#define XB_XCNT(j)  (256  + 64 * (j))
#define XB_XSUB(j)  (1280 + 64 * (j))
#define XB_XGEN(j)  (2304 + 64 * (j))
#define XB_TOP      3328
#define XB_TOPGEN   3392
#define XCD_BAR_WORDS 3456
#define XB_SPIN_CAP (1u << 18)

__device__ __forceinline__ unsigned xb_ld(unsigned* p)              { return __hip_atomic_load(p, __ATOMIC_RELAXED, __HIP_MEMORY_SCOPE_AGENT); }
__device__ __forceinline__ unsigned xb_add(unsigned* p, unsigned v) { return __hip_atomic_fetch_add(p, v, __ATOMIC_RELAXED, __HIP_MEMORY_SCOPE_AGENT); }
__device__ __forceinline__ unsigned xb_xcc_id() { return (unsigned)__builtin_amdgcn_s_getreg((3 << 11) | 20) & 0xFu; }
#define XB_SPIN(cond, bar) do { unsigned _sp = 0; while (cond) { __builtin_amdgcn_s_sleep(1); \
    if ((++_sp & 255u) == 0u) { if (xb_ld(&(bar)[XB_TMO])) break; if (_sp > XB_SPIN_CAP) { atomicAdd(&(bar)[XB_TMO], 1u); break; } } } } while (0)

struct XcdBarrier {
    unsigned* bar; unsigned x;
    volatile LAS unsigned* st;
};

__device__ __forceinline__ XcdBarrier xcd_barrier_post(unsigned* bar, volatile LAS unsigned* st) {
    XcdBarrier b; b.bar = bar; b.x = xb_xcc_id(); b.st = st;
    if (threadIdx.x == 0) (void)xb_add(&bar[XB_XCNT(b.x)], 1u);
    return b;
}
__device__ __forceinline__ void xcd_barrier_complete(unsigned* bar, unsigned x, unsigned& nloc, unsigned& nx) {
    const unsigned G = gridDim.x * gridDim.y * gridDim.z;
    unsigned sum, cnt, mine, sp = 0u;
    for (;;) {
        sum = 0u; cnt = 0u; mine = 0u;
#pragma unroll
        for (unsigned j = 0; j < 16; ++j) { const unsigned c = xb_ld(&bar[XB_XCNT(j)]); sum += c; cnt += (c > 0u) ? 1u : 0u; mine = (j == x) ? c : mine; }
        if (sum == G) break;
        __builtin_amdgcn_s_sleep(1);
        if ((++sp & 255u) == 0u) { if (xb_ld(&bar[XB_TMO])) break; if (sp > XB_SPIN_CAP) { atomicAdd(&bar[XB_TMO], 1u); break; } }
    }
    nloc = mine > 0u ? mine : 1u; nx = cnt > 0u ? cnt : 1u;
}

__device__ __attribute__((noinline)) void xcd_barrier(const XcdBarrier b) {
    asm volatile("s_waitcnt vmcnt(0)" ::: "memory");
    __syncthreads();
    if (threadIdx.x == 0) {
        unsigned* bar = b.bar;
        __builtin_amdgcn_s_waitcnt(0);
        unsigned nloc = b.st[0], nx = b.st[1];
        if (nloc == 0u) { xcd_barrier_complete(bar, b.x, nloc, nx); b.st[0] = nloc; b.st[1] = nx; }
        const unsigned old = xb_add(&bar[XB_XSUB(b.x)], 1u);
        const unsigned gen = old / nloc;
        if (old + 1u == (gen + 1u) * nloc) {
            __builtin_amdgcn_fence(__ATOMIC_RELEASE, "agent");
            asm volatile("s_waitcnt vmcnt(0)" ::: "memory");
            const unsigned og = xb_add(&bar[XB_TOP], 1u);
            const unsigned tg = og / nx;
            if (og + 1u == (tg + 1u) * nx) xb_add(&bar[XB_TOPGEN], 1u);
            else XB_SPIN(xb_ld(&bar[XB_TOPGEN]) == tg, bar);
            __builtin_amdgcn_fence(__ATOMIC_ACQUIRE, "agent");
            xb_add(&bar[XB_XGEN(b.x)], 1u);
            asm volatile("s_waitcnt vmcnt(0)" ::: "memory");
        } else {
            XB_SPIN(xb_ld(&bar[XB_XGEN(b.x)]) == gen, bar);
            __builtin_amdgcn_fence(__ATOMIC_ACQUIRE, "agent");
            asm volatile("s_waitcnt vmcnt(0)" ::: "memory");
        }
    }
    __syncthreads();
}

struct Args { const float* in[27]; float* out; unsigned char* ws; int ph_lo, ph_hi; };
#define CAS __attribute__((address_space(4)))
typedef const CAS unsigned char* kaptr;
__device__ __forceinline__ kaptr ka_get() { kaptr p = (kaptr)__builtin_amdgcn_kernarg_segment_ptr(); asm volatile("" : "+s"(p)); return p; }
#define KIN(kp, i) (*(const float* const CAS*)((kp) + 8 * (i)))
#define KOUT(kp) (*(float* const CAS*)((kp) + 216))
#define KWS(kp) (*(unsigned char* const CAS*)((kp) + 224))
#define KLO(kp) (*(const int CAS*)((kp) + 232))
#define KHI(kp) (*(const int CAS*)((kp) + 236))
static_assert(sizeof(Args) == 240, "Args layout");

__device__ __forceinline__ int dst_row(int mode, int n) {
    if (mode == 1) {
        const bool qk = (n >= 512 && n < 1536) || (n >= 3072 && n < 3712);
        if (qk) { const int d = n & 63; return (n & ~63) + (d < 32 ? 2 * d : 2 * (d - 32) + 1); }
        return n;
    }
    if (mode == 2) return (n >> 7) * 256 + (n & 127);
    if (mode == 3) return (n >> 7) * 256 + 128 + (n & 127);
    return n;
}
constexpr int TSCR = 64 * 65 * 4;
template <bool NTL>
__device__ __forceinline__ void ti_load(const float* W, int N, int item, int lane, f32x4 (&v)[16]) {
    const int nblk = N / 64, kb = item / nblk, nb = item % nblk, k0 = 64 * kb, n0 = 64 * nb;
    const GAS f32x4* src = (const GAS f32x4*)(W + (size_t)(k0 + (lane >> 4)) * N + n0 + 4 * (lane & 15));
#pragma unroll
    for (int i = 0; i < 16; ++i) v[i] = NTL ? __builtin_nontemporal_load(src + (size_t)i * N) : src[(size_t)i * N];
}
template <bool NTS, bool F8>
__device__ __forceinline__ void ti_store(const f32x4 (&v)[16], int K, int N, bf16* WT, int mode, LAS float* scr, int item, int lane) {
    const int nblk = N / 64, kb = item / nblk, nb = item % nblk, k0 = 64 * kb, n0 = 64 * nb;
    LAS float* wp = scr + (lane >> 4) * 65 + 4 * (lane & 15);
#pragma unroll
    for (int i = 0; i < 16; ++i) { wp[i * 4 * 65 + 0] = v[i].x; wp[i * 4 * 65 + 1] = v[i].y; wp[i * 4 * 65 + 2] = v[i].z; wp[i * 4 * 65 + 3] = v[i].w; }
    LDS_WAIT(); asm volatile("" ::: "memory");
    if constexpr (F8) {
        const int c = lane & 3;
#pragma unroll
        for (int j = 0; j < 4; ++j) { const int n = (lane >> 2) + 16 * j; const LAS float* s = scr + (16 * c) * 65 + n;
            v4u o;
#pragma unroll
            for (int q = 0; q < 4; ++q) o[q] = pg8::cvt4_fp8(256.0f * s[(4 * q) * 65], 256.0f * s[(4 * q + 1) * 65], 256.0f * s[(4 * q + 2) * 65], 256.0f * s[(4 * q + 3) * 65]);
            GAS v4u* dp = (GAS v4u*)((unsigned char*)WT + (size_t)dst_row(mode, n0 + n) * K + k0 + 16 * c); if (NTS) __builtin_nontemporal_store(o, dp); else *dp = o; }
    } else {
        const int c = lane & 7;
#pragma unroll
        for (int j = 0; j < 8; ++j) { const int n = (lane >> 3) + 8 * j; const LAS float* s = scr + (8 * c) * 65 + n;
            v4u o; o.x = pk2(s[0 * 65], s[1 * 65]); o.y = pk2(s[2 * 65], s[3 * 65]); o.z = pk2(s[4 * 65], s[5 * 65]); o.w = pk2(s[6 * 65], s[7 * 65]);
            GAS v4u* dp = (GAS v4u*)(WT + (size_t)dst_row(mode, n0 + n) * K + k0 + 8 * c); if (NTS) __builtin_nontemporal_store(o, dp); else *dp = o; }
    }
    LDS_WAIT(); asm volatile("" ::: "memory");
}
template <bool NT, bool F8 = false, bool NTL = false>
__device__ __forceinline__ void transpose_item(const float* W, int K, int N, bf16* WT, int mode, LAS float* scr, int item, int lane, const float*) {
    f32x4 v[16]; ti_load<NT || NTL>(W, N, item, lane, v); ti_store<NT, F8>(v, K, N, WT, mode, scr, item, lane);
}
__device__ __forceinline__ void p0_prologue(kaptr kp, LAS unsigned char* lds, int vcu, int G, int tid, int lane, int wave) {
    unsigned char* ws = KWS(kp);
    for (int j = vcu; j < 256; j += G) {
        const int l = j >> 7, g = (j >> 5) & 3, k0 = (j & 31) * 64;
        LAS float* As = (LAS float*)lds;
        LAS float* Ps = As + 64 * 132;
        const float* Wsrc = KIN(kp, 8) + (size_t)l * D * INC + (size_t)k0 * INC + g * 128;
        const float* Psrc = KIN(kp, 10) + ((size_t)l * 4 + g) * 128 * 128;
#pragma unroll
        for (int i = 0; i < 4; ++i) { const int idx = tid + 512 * i, r = idx >> 5, c4 = idx & 31; *(LAS f32x4*)(As + r * 132 + 4 * c4) = *(const GAS f32x4*)(Wsrc + (size_t)r * INC + 4 * c4); }
#pragma unroll
        for (int i = 0; i < 8; ++i) { const int idx = tid + 512 * i, r = idx >> 5, c4 = idx & 31; *(LAS f32x4*)(Ps + r * 132 + 4 * c4) = *(const GAS f32x4*)(Psrc + (size_t)r * 128 + 4 * c4); }
        __syncthreads();
        const int n4 = tid & 31, kq = tid >> 5;
        f32x4 acc[4];
#pragma unroll
        for (int i = 0; i < 4; ++i) acc[i] = (f32x4){0.f, 0.f, 0.f, 0.f};
#pragma unroll 4
        for (int c = 0; c < 128; ++c) { const f32x4 pv = *(const LAS f32x4*)(Ps + c * 132 + 4 * n4);
#pragma unroll
            for (int i = 0; i < 4; ++i) acc[i] += As[(4 * kq + i) * 132 + c] * pv; }
        bf16* WT = (bf16*)(ws + WS_WIN) + (size_t)l * INC * D;
#pragma unroll
        for (int e = 0; e < 4; ++e) { v2u o; o.x = pk2(acc[0][e], acc[1][e]); o.y = pk2(acc[2][e], acc[3][e]);
            *(GAS v2u*)(WT + (size_t)(g * 128 + 4 * n4 + e) * D + k0 + 4 * kq) = o; }
        __syncthreads();
    }
    for (int j = vcu; j < 192; j += G) {
        const int l = j / 96, n0 = (j % 96) * 128;
        LAS float* S = (LAS float*)lds; LAS float* red = S + 5 * 2048;
        for (int idx = tid; idx < 5 * 2048; idx += NWAVES * 64) { const int i = idx >> 11, k = idx & 2047; const float v = i < 4 ? KIN(kp, 1)[i * 2048 + k] : KIN(kp, 3)[k]; S[idx] = v / (1.0f + expf(-v)); }
        __syncthreads();
        f32x4 acc[5];
#pragma unroll
        for (int i = 0; i < 5; ++i) acc[i] = (f32x4){0.f, 0.f, 0.f, 0.f};
        const int kh = lane >> 5;
        const GAS f32x4* wp = (const GAS f32x4*)(KIN(kp, 4) + ((size_t)l * 2048 + wave * 256 + kh) * MODN + n0 + 4 * (lane & 31));
#pragma unroll 8
        for (int k = 0; k < 128; ++k) { const f32x4 w = __builtin_nontemporal_load(wp + (size_t)k * (2 * MODN / 4));
#pragma unroll
            for (int i = 0; i < 5; ++i) acc[i] += S[i * 2048 + wave * 256 + 2 * k + kh] * w; }
#pragma unroll
        for (int i = 0; i < 5; ++i) { f32x4 t = acc[i]; t.x += __shfl_xor(t.x, 32); t.y += __shfl_xor(t.y, 32); t.z += __shfl_xor(t.z, 32); t.w += __shfl_xor(t.w, 32);
            if (kh == 0) *(LAS f32x4*)(red + (wave * 5 + i) * 128 + 4 * (lane & 31)) = t; }
        __syncthreads();
        for (int idx = tid; idx < 640; idx += NWAVES * 64) { const int i = idx >> 7, n = idx & 127; float s = 0.f;
#pragma unroll
            for (int w = 0; w < 8; ++w) s += red[(w * 5 + i) * 128 + n];
            ((float*)(ws + WS_MOD))[(l * 5 + i) * MODN + n0 + n] = s + KIN(kp, 5)[l * MODN + n0 + n]; }
        __syncthreads();
    }
    if (vcu == (200 % G)) {
        for (int idx = tid; idx < 1024; idx += NWAVES * 64) { const int pos = idx >> 4, f = idx & 15; const float inv = powf(10000.0f, -(float)f / 16.0f); const float ang = (float)pos * inv;
            ((float*)(ws + WS_ROPE))[idx] = cosf(ang); ((float*)(ws + WS_ROPE))[1024 + idx] = sinf(ang); }
    }
    __syncthreads();
    LAS float* scr = (LAS float*)(lds + wave * TSCR);
    constexpr int I_IN = 32 * 52, I_OUT = 32 * 32, I_UP = 32 * 88, I_DN = 88 * 32;
    constexpr int NITEMS = 2 * I_IN + 2 * I_OUT + 2 * I_UP + I_DN;
    unsigned* q0 = (unsigned*)(ws + WS_CTL) + CW_Q0;
#define P0_DESC(it_, W_, K_, N_, WT_, M_, I_, F_) do { int r = (it_); F_ = false; \
        if (r < 2 * I_IN) { const int l = r / I_IN; W_ = KIN(kp, 8) + (size_t)l * D * INC; K_ = D; N_ = INC; WT_ = (bf16*)(ws + WS_WIN) + (size_t)l * INC * D; M_ = 1; const int q = r % I_IN; I_ = (q / 52) * 60 + 8 + (q % 52); } \
        else if ((r -= 2 * I_IN) < 2 * I_OUT) { const int l = r / I_OUT; W_ = KIN(kp, 9) + (size_t)l * D * D; K_ = D; N_ = D; WT_ = (bf16*)(ws + WS_WOUT) + (size_t)l * D * D; M_ = 0; I_ = r % I_OUT; } \
        else if ((r -= 2 * I_OUT) < I_UP) { W_ = KIN(kp, 19); K_ = D; N_ = DFF; WT_ = (bf16*)(ws + WS_W13); M_ = 2; I_ = r; F_ = DENSE_UP_F8; } \
        else if ((r -= I_UP) < I_UP) { W_ = KIN(kp, 20); K_ = D; N_ = DFF; WT_ = (bf16*)(ws + WS_W13); M_ = 3; I_ = r; F_ = DENSE_UP_F8; } \
        else { r -= I_UP; W_ = KIN(kp, 21); K_ = DFF; N_ = D; WT_ = (bf16*)(ws + WS_W2); M_ = 0; I_ = r; F_ = DENSE_DN_F8; } } while (0)
    for (;;) {
        unsigned k0 = 0; if (lane == 0) k0 = __hip_atomic_fetch_add(q0, 2u, RLX_AGENT);
        const int kb = (int)__builtin_amdgcn_readfirstlane(k0); if (kb >= NITEMS) break;
        const float* Wa; int Ka, Na, ma, ia; bf16* WTa; bool fa; f32x4 va[16];
        P0_DESC(kb, Wa, Ka, Na, WTa, ma, ia, fa); ti_load<true>(Wa, Na, ia, lane, va);
        const bool two = kb + 1 < NITEMS;
        const float* Wb = Wa; int Kb = Ka, Nb = Na, mb = ma, ib = ia; bf16* WTb = WTa; bool fb = fa; f32x4 vb[16];
        if (two) { P0_DESC(kb + 1, Wb, Kb, Nb, WTb, mb, ib, fb); ti_load<true>(Wb, Nb, ib, lane, vb); }
        if (fa) ti_store<false, true>(va, Ka, Na, WTa, ma, scr, ia, lane); else ti_store<false, false>(va, Ka, Na, WTa, ma, scr, ia, lane);
        if (two) { if (fb) ti_store<false, true>(vb, Kb, Nb, WTb, mb, scr, ib, lane); else ti_store<false, false>(vb, Kb, Nb, WTb, mb, scr, ib, lane); }
    }
#undef P0_DESC
}

__device__ __attribute__((noinline)) void fill_tail(unsigned char* ws, const float* w1, const float* w3, const float* w2, unsigned* done, int G, int nw) {
    extern __shared__ __attribute__((aligned(16))) unsigned char lds_fill[];
    LAS unsigned char* lds = (LAS unsigned char*)lds_fill;
    const int tid = threadIdx.x, lane = tid & 63, wave = __builtin_amdgcn_readfirstlane(tid >> 6);
    volatile LAS unsigned* flag = (volatile LAS unsigned*)(lds + FLAG_OFF);
    __syncthreads();
    if (tid == 0) { unsigned f = 0u; if (done) { const unsigned old = __hip_atomic_fetch_add(done, 1u, RLX_AGENT); f = (old + 1u >= (unsigned)G) ? 1u : 0u; } *flag = f; }
    __syncthreads();
    LAS float* scr = (LAS float*)(lds + wave * TSCR);
    unsigned* q1 = (unsigned*)(ws + WS_CTL) + CW_Q1;
    constexpr int I_UP = 32 * 88, NIT = 24 * I_UP;
#ifndef FILLW
#define FILLW 2
#endif
#ifndef FILLB
#define FILLB 4
#endif
#ifdef PROBE_BURN
    if (done && wave >= FILLW) {
        f32x16 acc; for (int r = 0; r < 16; ++r) acc[r] = 0.f; const bf16x8 a = (bf16x8){1, 2, 3, 4, 5, 6, 7, 8};
        while (!*flag) { for (int it = 0; it < 64; ++it) acc = __builtin_amdgcn_mfma_f32_32x32x16_bf16(a, a, acc, 0, 0, 0); if (__hip_atomic_load(done, RLX_AGENT) >= (unsigned)G) break; }
        if (acc[0] == 12345.f) *flag = 2u;
        return; }
#endif
    if (done && wave >= nw) return;
#define FILL_ITEM(it_) do { const int it__ = (it_); const int seg = it__ / I_UP, item = it__ % I_UP, mat = seg >> 3, e = seg & 7; \
        if (mat == 0) transpose_item<true, MOE_F8>(w1 + (size_t)e * D * DFF, D, DFF, (bf16*)(ws + WS_MW13 + (size_t)e * 2 * DFF * D * (MOE_F8 ? 1 : 2)), 2, scr, item, lane, nullptr); \
        else if (mat == 1) transpose_item<true, MOE_F8>(w3 + (size_t)e * D * DFF, D, DFF, (bf16*)(ws + WS_MW13 + (size_t)e * 2 * DFF * D * (MOE_F8 ? 1 : 2)), 3, scr, item, lane, nullptr); \
        else transpose_item<true, MOE_F8>(w2 + (size_t)e * DFF * D, DFF, D, (bf16*)(ws + WS_MW2 + (size_t)e * D * DFF * (MOE_F8 ? 1 : 2)), 0, scr, item, lane, nullptr); } while (0)
    if (!done) return;
    for (;;) {
        if (*flag) break;
        if (tid == 0) { if (__hip_atomic_load(done, RLX_AGENT) >= (unsigned)G) *flag = 1u; }
        if (*flag) break;
        unsigned k0 = 0; if (lane == 0) k0 = __hip_atomic_fetch_add(q1, (unsigned)FILLB, RLX_AGENT);
        const int kb = (int)__builtin_amdgcn_readfirstlane(k0); if (kb >= NIT) break;
        for (int it = kb; it < kb + FILLB && it < NIT; ++it) FILL_ITEM(it);
    }
#undef FILL_ITEM
}

__device__ __forceinline__ void drain_tail(unsigned char* ws, const float* w1, const float* w3, const float* w2, int G, LAS unsigned char* lds) {
    int tid = threadIdx.x; asm volatile("" : "+v"(tid));
    const int lane = tid & 63, wave = __builtin_amdgcn_readfirstlane(tid >> 6);
    __syncthreads();
    LAS float* scr = (LAS float*)(lds + wave * TSCR);
    unsigned* q1 = (unsigned*)(ws + WS_CTL) + CW_Q1;
    constexpr int I_UP = 32 * 88, NIT = 24 * I_UP;
        const int h = (int)__builtin_amdgcn_readfirstlane(__hip_atomic_load(q1, RLX_AGENT));
        const int gwv = blockIdx.x * NWAVES + wave, ngw = G * NWAVES;
#define MOE_DESC(it_, W_, K_, N_, WT_, M_, I_) do { const int seg_ = (it_) / I_UP, mat_ = seg_ >> 3, e_ = seg_ & 7; I_ = (it_) % I_UP; \
        if (mat_ == 0) { W_ = w1 + (size_t)e_ * D * DFF; K_ = D; N_ = DFF; WT_ = (bf16*)(ws + WS_MW13 + (size_t)e_ * 2 * DFF * D * (MOE_F8 ? 1 : 2)); M_ = 2; } \
        else if (mat_ == 1) { W_ = w3 + (size_t)e_ * D * DFF; K_ = D; N_ = DFF; WT_ = (bf16*)(ws + WS_MW13 + (size_t)e_ * 2 * DFF * D * (MOE_F8 ? 1 : 2)); M_ = 3; } \
        else { W_ = w2 + (size_t)e_ * DFF * D; K_ = DFF; N_ = D; WT_ = (bf16*)(ws + WS_MW2 + (size_t)e_ * D * DFF * (MOE_F8 ? 1 : 2)); M_ = 0; } } while (0)
        int it = h + gwv;
        if (it < NIT) {
            const float* W; int K, N, md, item; bf16* WT; f32x4 v[16];
            MOE_DESC(it, W, K, N, WT, md, item); ti_load<true>(W, N, item, lane, v);
            for (;;) {
                const int nx = it + ngw; const float* Wn = W; int Kn = K, Nn = N, mdn = md, itemn = item; bf16* WTn = WT; f32x4 vn[16];
                const bool more = nx < NIT;
                if (more) { MOE_DESC(nx, Wn, Kn, Nn, WTn, mdn, itemn); ti_load<true>(Wn, Nn, itemn, lane, vn); }
                ti_store<true, MOE_F8>(v, K, N, WT, md, scr, item, lane);
                if (!more) break;
#pragma unroll
                for (int i = 0; i < 16; ++i) v[i] = vn[i];
                it = nx; W = Wn; K = Kn; N = Nn; WT = WTn; md = mdn; item = itemn;
            }
        }
#undef MOE_DESC
}

template <class Epi, class Ord>
__device__ __forceinline__ void combine_tail(const Epi& E, const Ord& S, const float* slab, unsigned* tickets, LAS unsigned char* lds) {
    int tt; pg8::Unit tu;
    if (!S.tail_unit(tt, tu)) return;
    int tid = threadIdx.x; asm volatile("" : "+v"(tid));
    const int lane = tid & 63, wid = __builtin_amdgcn_readfirstlane(tid >> 6), wr = wid >> 2, wc = wid & 3, fr = lane & 15, fq = lane >> 4;
    volatile LAS unsigned* flag = (volatile LAS unsigned*)(lds + FLAG_OFF);
    asm volatile("s_waitcnt vmcnt(0)" ::: "memory");
    __syncthreads();
    if (tid == 0) {
        __builtin_amdgcn_fence(__ATOMIC_RELEASE, "agent");
        asm volatile("s_waitcnt vmcnt(0)" ::: "memory");
        const unsigned t = __hip_atomic_fetch_add(tickets + 64 * tt, 1u, RLX_AGENT);
        const bool last = (t == (unsigned)S.tp.S - 1u);
        if (last) { __builtin_amdgcn_fence(__ATOMIC_ACQUIRE, "agent"); asm volatile("s_waitcnt vmcnt(0)" ::: "memory"); }
        *flag = last ? 1u : 0u;
    }
    __syncthreads();
    if (*flag) {
        const int ns = S.tp.S;
        const GAS pg8::f32x4* sp = (const GAS pg8::f32x4*)slab + (size_t)(tt * ns) * (32 * 512) + tid;
        pg8::f32x4 acc[2][2][4][2];
#pragma unroll
        for (int ai = 0; ai < 2; ++ai)
#pragma unroll
            for (int bj = 0; bj < 2; ++bj)
#pragma unroll
                for (int m = 0; m < 4; ++m)
#pragma unroll
                    for (int n = 0; n < 2; ++n) { const int r = (((ai * 2 + bj) * 4 + m) * 2) + n; pg8::f32x4 a = sp[(size_t)r * 512];
                        for (int ks = 1; ks < ns; ++ks) a += sp[(size_t)ks * (32 * 512) + (size_t)r * 512];
                        acc[ai][bj][m][n] = a; }
        E(acc, tu, wr, wc, fr, fq);
    }
    __syncthreads();
}

template <bool ROUTE, bool F8 = false>
__device__ __forceinline__ void norm_rows(const float* srcC, const float* srcL, const float* gain, const float* shift, const float* scale, bf16* XN, int row_lo, int row_hi, int gw, int NGW, int lane,
                                          const LAS float* rt, unsigned* cnt, int* route) {
    f32x4 vn[8];
    { const int row = row_lo + gw; if (row < row_hi) { const GAS f32x4* xr = (const GAS f32x4*)((row < RC ? srcC : srcL) + (size_t)row * D) + lane;
#pragma unroll
        for (int j = 0; j < 8; ++j) vn[j] = xr[64 * j]; } }
    unsigned pk[8]; int pe1 = 0, pe2 = 0, ps1 = 0, ps2 = 0, prow = 0; float pw1 = 0.f, pw2 = 0.f; bool have = false;
#define ROUTE_FLUSH() do { if constexpr (ROUTE && F8) { \
        if (lane == 0) { int* rec = route + (size_t)(prow - RC) * 8; rec[0] = pe1; rec[1] = ps1; rec[2] = __builtin_bit_cast(int, pw1); rec[3] = pe2; rec[4] = ps2; rec[5] = __builtin_bit_cast(int, pw2); } \
        const int e1_ = __builtin_amdgcn_readfirstlane(pe1), e2_ = __builtin_amdgcn_readfirstlane(pe2), s1_ = __builtin_amdgcn_readfirstlane(ps1), s2_ = __builtin_amdgcn_readfirstlane(ps2); \
        GAS unsigned* d1 = (GAS unsigned*)((unsigned char*)XN + ((size_t)e1_ * 8192 + s1_) * D) + lane; GAS unsigned* d2 = (GAS unsigned*)((unsigned char*)XN + ((size_t)e2_ * 8192 + s2_) * D) + lane; \
        _Pragma("unroll") for (int j = 0; j < 8; ++j) { d1[64 * j] = pk[j]; d2[64 * j] = pk[j]; } } } while (0)
    for (int row = row_lo + gw; row < row_hi; row += NGW) {
        const int bidx = row < RC ? 4 : ((row - RC) >> 11);
        f32x4 v[8]; float ss = 0.f;
#pragma unroll
        for (int j = 0; j < 8; ++j) { v[j] = vn[j]; ss += (v[j].x * v[j].x + v[j].y * v[j].y) + (v[j].z * v[j].z + v[j].w * v[j].w); }
        { const int nrow = row + NGW; if (nrow < row_hi) { const GAS f32x4* xr = (const GAS f32x4*)((nrow < RC ? srcC : srcL) + (size_t)nrow * D) + lane;
#pragma unroll
            for (int j = 0; j < 8; ++j) vn[j] = xr[64 * j]; } }
        const float rstd = 1.0f / sqrtf(wave_sum(ss) * (1.0f / D) + EPS);
        const GAS f32x4* g4 = (const GAS f32x4*)gain + lane; const GAS f32x4* sh4 = (const GAS f32x4*)(shift + bidx * MODN) + lane; const GAS f32x4* sc4 = (const GAS f32x4*)(scale + bidx * MODN) + lane;
        GAS unsigned long long* o8 = (GAS unsigned long long*)(XN + (size_t)row * D) + lane; GAS unsigned* o4 = (GAS unsigned*)((unsigned char*)XN + (size_t)row * D) + lane;
#pragma unroll
        for (int j = 0; j < 8; ++j) { const f32x4 g = g4[64 * j], sh = sh4[64 * j], sc = sc4[64 * j]; v[j] = (v[j] * rstd * g) * (1.0f + sc) + sh;
            if constexpr (ROUTE) {}
            else if constexpr (F8) o4[64 * j] = pg8::cvt4_fp8(v[j].x, v[j].y, v[j].z, v[j].w);
            else o8[64 * j] = (unsigned long long)pk2(v[j].x, v[j].y) | ((unsigned long long)pk2(v[j].z, v[j].w) << 32); }
        if (ROUTE) {
            float lg[8];
#pragma unroll
            for (int e = 0; e < 8; ++e) lg[e] = 0.f;
#pragma unroll
            for (int j = 0; j < 8; ++j)
#pragma unroll
                for (int q = 0; q < 4; ++q) { const int k = 256 * j + 4 * lane + q; const LAS f32x4* rp = (const LAS f32x4*)(rt + k * 8); const f32x4 r0 = rp[0], r1 = rp[1]; const float f = v[j][q];
                    lg[0] += f * r0.x; lg[1] += f * r0.y; lg[2] += f * r0.z; lg[3] += f * r0.w; lg[4] += f * r1.x; lg[5] += f * r1.y; lg[6] += f * r1.z; lg[7] += f * r1.w;
                    if (q == 3) asm volatile("" ::: "memory"); }
#pragma unroll
            for (int e = 0; e < 8; ++e) lg[e] = wave_sum(lg[e]);
            int i1 = 0; float v1 = lg[0];
#pragma unroll
            for (int e = 1; e < 8; ++e) if (lg[e] > v1) { v1 = lg[e]; i1 = e; }
            int i2 = -1; float v2 = -INFINITY;
#pragma unroll
            for (int e = 0; e < 8; ++e) if (e != i1 && lg[e] > v2) { v2 = lg[e]; i2 = e; }
            const float w1 = 1.0f / (1.0f + expf(v2 - v1)), w2 = 1.0f - w1;
            if (have) ROUTE_FLUSH();
            ps1 = 0; ps2 = 0;
            if (lane == 0) { ps1 = (int)__hip_atomic_fetch_add(cnt + 64 * i1, 1u, RLX_AGENT); ps2 = (int)__hip_atomic_fetch_add(cnt + 64 * i2, 1u, RLX_AGENT); }
            pe1 = i1; pe2 = i2; pw1 = w1; pw2 = w2; prow = row; have = true;
#pragma unroll
            for (int j = 0; j < 8; ++j) pk[j] = pg8::cvt4_fp8(v[j].x, v[j].y, v[j].z, v[j].w);
        }
    }
    if (ROUTE) { if (have) ROUTE_FLUSH(); }
#undef ROUTE_FLUSH
}

struct TileSpec { int nband, band_row0, ctx_row0, nt; };
__device__ __forceinline__ int crow(int r, int hi) { return (r & 3) + 8 * (r >> 2) + 4 * hi; }
template <int NKC, int DVB, bool WIN>
__device__ __forceinline__ void attn_core(LAS unsigned char* lds, const bf16* P, const bf16x8 (&qr)[4], int kcol, int vcol, int kofs, const TileSpec ts, int qpos, int bandpos0,
                                          f32x16 (&o)[DVB], f32x16& ol, float& mref_out, int tid, int lane) {
    constexpr int SB = NKC * 1024 + DVB * 4096, NK = NKC / 8, NV = DVB / 2;
    constexpr float THR = 8.0f;
    const int r32 = lane & 31, hi = lane >> 5, wv = __builtin_amdgcn_readfirstlane(tid >> 6);
    int koff[NK], voff[NV];
#pragma unroll
    for (int i = 0; i < NK; ++i) { const int q = tid + 512 * i, key = q / NKC, s = q % NKC; koff[i] = key * INC + kcol + (s ^ (NKC == 16 ? (key & 15) : ((key >> 1) & 7))) * 8; }
#pragma unroll
    for (int i = 0; i < NV; ++i) { const int q = tid + 512 * i; voff[i] = (((q >> 6) & 3) * 16 + ((q >> 2) & 15)) * INC + vcol + (q >> 8) * 32 + (q & 3) * 8; }
#define ATT_DMA(t_, s_) do { const int t__ = (t_); const int rb_ = t__ < ts.nband ? ts.band_row0 + 64 * t__ : ts.ctx_row0 + 64 * (t__ - ts.nband); const bf16* tb_ = P + (size_t)rb_ * INC; \
        _Pragma("unroll") for (int i_ = 0; i_ < NK; ++i_) __builtin_amdgcn_global_load_lds((const unsigned*)(tb_ + koff[i_]), (LAS unsigned*)(lds + (s_) * SB + (wv * 64 + 512 * i_) * 16), 16, 0, 0); \
        _Pragma("unroll") for (int i_ = 0; i_ < NV; ++i_) __builtin_amdgcn_global_load_lds((const unsigned*)(tb_ + voff[i_]), (LAS unsigned*)(lds + (s_) * SB + NKC * 1024 + (wv * 64 + 512 * i_) * 16), 16, 0, 0); } while (0)
    float mref = 0.f;
    f32x16 negm;
#pragma unroll
    for (int r = 0; r < 16; ++r) { negm[r] = 0.f; ol[r] = 0.f; }
#pragma unroll
    for (int d0 = 0; d0 < DVB; ++d0)
#pragma unroll
        for (int r = 0; r < 16; ++r) o[d0][r] = 0.f;
    const short one = (r32 == 0) ? (short)0x3F80 : (short)0;
    const bf16x8 onesf = (bf16x8){one, one, one, one, one, one, one, one};
    ATT_DMA(0, 0); asm volatile("s_waitcnt vmcnt(0)" ::: "memory"); __syncthreads();
#pragma unroll 1
    for (int t = 0; t < ts.nt; ++t) {
        if (t + 1 < ts.nt) ATT_DMA(t + 1, (t + 1) & 1);
        LAS unsigned char* sb = lds + (t & 1) * SB;
        f32x16 p0, p1;
        { const LAS unsigned char* kb = sb + r32 * (NKC * 16);
#pragma unroll
          for (int d0 = 0; d0 < 4; ++d0) { const int so = ((kofs + 2 * d0 + hi) ^ (NKC == 16 ? (r32 & 15) : ((r32 >> 1) & 7))) * 16; const bf16x8 b0 = *(const LAS bf16x8*)(kb + so), b1 = *(const LAS bf16x8*)(kb + 32 * (NKC * 16) + so);
              if (d0 == 0) { p0 = __builtin_amdgcn_mfma_f32_32x32x16_bf16(b0, qr[0], negm, 0, 0, 0); p1 = __builtin_amdgcn_mfma_f32_32x32x16_bf16(b1, qr[0], negm, 0, 0, 0); }
              else { p0 = __builtin_amdgcn_mfma_f32_32x32x16_bf16(b0, qr[d0], p0, 0, 0, 0); p1 = __builtin_amdgcn_mfma_f32_32x32x16_bf16(b1, qr[d0], p1, 0, 0, 0); } } }
        if (WIN) { if (t < ts.nband) { const int kp0 = bandpos0 + 64 * t + 4 * hi;
#pragma unroll
            for (int r = 0; r < 16; ++r) { const int dlt = qpos - (kp0 + (r & 3) + 8 * (r >> 2)); if (dlt > 128 || dlt < -128) p0[r] = -1e30f; if (dlt - 32 > 128 || dlt - 32 < -128) p1[r] = -1e30f; } } }
        float rm = fmaxf(fmaxf(p0[0], p0[1]), p1[0]);
#pragma unroll
        for (int r = 1; r < 16; ++r) rm = fmaxf(fmaxf(rm, p0[r]), p1[r]);
        rm = fmaxf(rm, p0[1]);
        rm = fmaxf(rm, __shfl_xor(rm, 32));
        if (t == 0 || __any(rm > THR)) {
            const float dl = t == 0 ? rm : fmaxf(rm, 0.f);
            mref += dl;
#pragma unroll
            for (int r = 0; r < 16; ++r) { p0[r] -= dl; p1[r] -= dl; negm[r] = -mref; }
            if (t != 0) { const float f = __builtin_amdgcn_exp2f(-dl);
#pragma unroll
                for (int r = 0; r < 16; ++r) { const float fr = __shfl(f, crow(r, hi)); ol[r] *= fr;
#pragma unroll
                    for (int d0 = 0; d0 < DVB; ++d0) o[d0][r] *= fr; } }
        }
#pragma unroll
        for (int r = 0; r < 16; ++r) { p0[r] = __builtin_amdgcn_exp2f(p0[r]); p1[r] = __builtin_amdgcn_exp2f(p1[r]); }
        v4u pw[4];
#pragma unroll
        for (int i = 0; i < 4; ++i) { pw[0][i] = pg8::cvt_pk_bf16(p0[2 * i], p0[2 * i + 1]); pw[1][i] = pg8::cvt_pk_bf16(p0[8 + 2 * i], p0[8 + 2 * i + 1]); pw[2][i] = pg8::cvt_pk_bf16(p1[2 * i], p1[2 * i + 1]); pw[3][i] = pg8::cvt_pk_bf16(p1[8 + 2 * i], p1[8 + 2 * i + 1]); }
        { const LAS unsigned char* vb = sb + NKC * 1024 + ((lane >> 4) & 1) * 32 + (lane & 3) * 8 + (4 * hi + ((lane & 15) >> 2)) * 64;
#pragma unroll
          for (int d0 = 0; d0 < DVB; ++d0)
#pragma unroll
              for (int ks = 0; ks < 4; ++ks) {
                  const v4i16_t lo = __builtin_amdgcn_ds_read_tr16_b64_v4i16((LAS v4i16_t*)(vb + d0 * 4096 + ks * 1024)), hh = __builtin_amdgcn_ds_read_tr16_b64_v4i16((LAS v4i16_t*)(vb + d0 * 4096 + ks * 1024 + 512));
                  const bf16x8 vf = (bf16x8){lo[0], lo[1], lo[2], lo[3], hh[0], hh[1], hh[2], hh[3]};
                  o[d0] = __builtin_amdgcn_mfma_f32_32x32x16_bf16(__builtin_bit_cast(bf16x8, pw[ks]), vf, o[d0], 0, 0, 0);
                  if (ks == 3) asm volatile("" ::: "memory"); }
#pragma unroll
          for (int ks = 0; ks < 4; ++ks) ol = __builtin_amdgcn_mfma_f32_32x32x16_bf16(__builtin_bit_cast(bf16x8, pw[ks]), onesf, ol, 0, 0, 0); }
        asm volatile("s_waitcnt vmcnt(0)" ::: "memory");
        __syncthreads();
    }
#undef ATT_DMA
    mref_out = mref;
}
template <int DVB>
__device__ __forceinline__ void attn_normalize(f32x16 (&o)[DVB], const f32x16& ol, float extra, int hi) {
#pragma unroll
    for (int r = 0; r < 16; ++r) { const float l = __shfl(ol[r], hi << 5) + __shfl(extra, crow(r, hi)); const float ir = 1.0f / l;
#pragma unroll
        for (int d0 = 0; d0 < DVB; ++d0) o[d0][r] *= ir; }
}

__device__ __forceinline__ void win_unit(LAS unsigned char* lds, const bf16* P, bf16* MIX, const float* sink, int b, int g, int qb, bool ctxq, int tid, int lane, int wave) {
    const int r32 = lane & 31, hi = lane >> 5, hr = wave >> 1, sub = (wave & 1) * 32;
    TileSpec ts; int qrow0, qpos = 0, bandpos0 = 0;
    if (!ctxq) { const int tl = qb - 2 < 0 ? 0 : qb - 2, th = qb + 2 > 31 ? 31 : qb + 2; ts.nband = th - tl + 1; ts.band_row0 = RC + b * SEQ + tl * 64; bandpos0 = tl * 64; ts.ctx_row0 = b * CTX; ts.nt = ts.nband + 4;
        qrow0 = RC + b * SEQ + qb * 64 + sub; qpos = qb * 64 + sub + r32; }
    else { ts.nband = 0; ts.band_row0 = 0; ts.ctx_row0 = b * CTX; ts.nt = 4; qrow0 = b * CTX + qb * 64 + sub; }
    const int qcol = 3072 + g * 256 + hr * 64;
    bf16x8 qr[4];
#pragma unroll
    for (int d0 = 0; d0 < 4; ++d0) qr[d0] = *(const GAS bf16x8*)(P + (size_t)(qrow0 + r32) * INC + qcol + d0 * 16 + hi * 8);
    f32x16 o[2], ol; float mref;
    attn_core<8, 2, true>(lds, P, qr, 3584 + g * 64, 3712 + g * 64, 0, ts, qpos, bandpos0, o, ol, mref, tid, lane);
    attn_normalize<2>(o, ol, __builtin_amdgcn_exp2f(sink[g * 4 + hr] * LOG2E - mref), hi);
#pragma unroll
    for (int r = 0; r < 16; ++r) { bf16* op = MIX + (size_t)(qrow0 + crow(r, hi)) * D + 1536 + (g * 4 + hr) * 64 + r32;
#pragma unroll
        for (int d0 = 0; d0 < 2; ++d0) op[d0 * 32] = (bf16)f2bf(o[d0][r]); }
}

__device__ __forceinline__ void diff_unit(LAS unsigned char* lds, const bf16* P, bf16* MIX, const float* dlam, const float* subln, float lam_init, int b, int h, int qb, bool ctxq, int tid, int lane, int wave) {
    const int r32 = lane & 31, hi = lane >> 5, m = wave >> 2, sub = (wave & 3) * 32;
    TileSpec ts; int qrow0;
    if (!ctxq) { ts.nband = 32; ts.band_row0 = RC + b * SEQ; ts.ctx_row0 = b * CTX; ts.nt = 36; qrow0 = RC + b * SEQ + qb * 128 + sub; }
    else { ts.nband = 0; ts.band_row0 = 0; ts.ctx_row0 = b * CTX; ts.nt = 4; qrow0 = b * CTX + qb * 128 + sub; }
    const int qcol = 512 + h * 128 + m * 64;
    bf16x8 qr[4];
#pragma unroll
    for (int d0 = 0; d0 < 4; ++d0) qr[d0] = *(const GAS bf16x8*)(P + (size_t)(qrow0 + r32) * INC + qcol + d0 * 16 + hi * 8);
    const float lam = expf(wave_sum(dlam[lane] * dlam[64 + lane])) - expf(wave_sum(dlam[128 + lane] * dlam[192 + lane])) + lam_init;
    f32x16 o[4], ol; float mref;
    attn_core<16, 4, false>(lds, P, qr, 1024 + h * 128, 1536 + h * 128, m * 8, ts, 0, 0, o, ol, mref, tid, lane);
    attn_normalize<4>(o, ol, 0.f, hi);
    LAS float* ex = (LAS float*)lds + (wave & 3) * 4096;
    if (m == 1) {
#pragma unroll
        for (int d0 = 0; d0 < 4; ++d0)
#pragma unroll
            for (int r = 0; r < 16; ++r) ex[(d0 * 16 + r) * 64 + lane] = o[d0][r];
    }
    __syncthreads();
    if (m == 0) {
        float sl[4];
#pragma unroll
        for (int d0 = 0; d0 < 4; ++d0) sl[d0] = subln[d0 * 32 + r32] * (1.0f - lam_init);
#pragma unroll
        for (int r = 0; r < 16; ++r) {
            float ss = 0.f;
#pragma unroll
            for (int d0 = 0; d0 < 4; ++d0) { const float v = o[d0][r] - lam * ex[(d0 * 16 + r) * 64 + lane]; o[d0][r] = v; ss += v * v; }
            asm volatile("" ::: "memory");
#pragma unroll
            for (int off = 1; off < 32; off <<= 1) ss += __shfl_xor(ss, off);
            const float rstd = 1.0f / sqrtf(ss * (1.0f / 128.0f) + EPS);
            bf16* op = MIX + (size_t)(qrow0 + crow(r, hi)) * D + 512 + h * 128 + r32;
#pragma unroll
            for (int d0 = 0; d0 < 4; ++d0) op[d0 * 32] = (bf16)f2bf(o[d0][r] * rstd * sl[d0]);
        }
    }
    __syncthreads();
}

__device__ __forceinline__ void sgu_unit(LAS unsigned char* lds, const bf16* P, bf16* MIX, const float* ln_g, const float* ln_b, const float* Ws, const float* bs, int row0, int g, int tid, int lane, int wave) {
    constexpr int VS = 136;
    LAS bf16* VT = (LAS bf16*)lds;
    const int r32 = lane & 31, hi = lane >> 5;
    { const int tq = lane >> 4, j = lane & 15;
      v4u raws[4][4];
#pragma unroll
      for (int ps = 0; ps < 4; ++ps)
#pragma unroll
          for (int q = 0; q < 4; ++q) raws[ps][q] = *(const GAS v4u*)(P + (size_t)(row0 + wave * 16 + ps * 4 + tq) * INC + 2560 + (j + 16 * q) * 8);
      float lg8[8], lb8[8];
#pragma unroll
      for (int e = 0; e < 8; ++e) { lg8[e] = ln_g[g * 128 + 8 * j + e]; lb8[e] = ln_b[g * 128 + 8 * j + e]; }
#pragma unroll
      for (int ps = 0; ps < 4; ++ps) {
          float x[4][8]; float s = 0.f;
#pragma unroll
          for (int q = 0; q < 4; ++q)
#pragma unroll
              for (int e = 0; e < 4; ++e) { x[q][2 * e] = bf2f((unsigned short)(raws[ps][q][e] & 0xffffu)); x[q][2 * e + 1] = bf2f((unsigned short)(raws[ps][q][e] >> 16)); s += x[q][2 * e] + x[q][2 * e + 1]; }
#pragma unroll
          for (int off = 1; off < 16; off <<= 1) s += __shfl_xor(s, off);
          const float mean = s * (1.0f / 512.0f); float s2 = 0.f;
#pragma unroll
          for (int q = 0; q < 4; ++q)
#pragma unroll
              for (int e = 0; e < 8; ++e) { x[q][e] -= mean; s2 += x[q][e] * x[q][e]; }
#pragma unroll
          for (int off = 1; off < 16; off <<= 1) s2 += __shfl_xor(s2, off);
          const float rstd = 1.0f / sqrtf(s2 * (1.0f / 512.0f) + EPS);
          const int qtok = wave * 16 + ps * 4 + tq;
#pragma unroll
          for (int e = 0; e < 8; ++e) { const float xv = g == 0 ? x[0][e] : (g == 1 ? x[1][e] : (g == 2 ? x[2][e] : x[3][e])); VT[(8 * j + e) * VS + qtok] = (bf16)f2bf(xv * rstd * lg8[e] + lb8[e]); }
      }
    }
    __syncthreads();
    const int pb = wave & 3, ch = wave >> 2;
    f32x16 acc[2];
#pragma unroll
    for (int cb = 0; cb < 2; ++cb)
#pragma unroll
        for (int r = 0; r < 16; ++r) acc[cb][r] = 0.f;
    unsigned short uu[16][2]; float bias[16];
#pragma unroll
    for (int r = 0; r < 16; ++r) { const int p = pb * 32 + crow(r, hi); bias[r] = bs[g * 128 + p];
#pragma unroll
        for (int cb = 0; cb < 2; ++cb) uu[r][cb] = P[(size_t)(row0 + p) * INC + 2048 + g * 128 + ch * 64 + cb * 32 + r32]; }
    const float* wrow = Ws + (size_t)(g * 128 + pb * 32 + r32) * 128 + hi * 8;
#pragma unroll
    for (int ks = 0; ks < 8; ++ks) {
        const f32x4 w0 = *(const GAS f32x4*)(wrow + ks * 16), w1 = *(const GAS f32x4*)(wrow + ks * 16 + 4);
        v4u aw; aw.x = pk2(w0.x, w0.y); aw.y = pk2(w0.z, w0.w); aw.z = pk2(w1.x, w1.y); aw.w = pk2(w1.z, w1.w);
#pragma unroll
        for (int cb = 0; cb < 2; ++cb) { const bf16x8 bv = *(const LAS bf16x8*)(VT + (ch * 64 + cb * 32 + r32) * VS + ks * 16 + hi * 8);
            acc[cb] = __builtin_amdgcn_mfma_f32_32x32x16_bf16(__builtin_bit_cast(bf16x8, aw), bv, acc[cb], 0, 0, 0); }
    }
#pragma unroll
    for (int r = 0; r < 16; ++r) { const int p = pb * 32 + crow(r, hi);
#pragma unroll
        for (int cb = 0; cb < 2; ++cb) { const int c = g * 128 + ch * 64 + cb * 32 + r32;
            MIX[(size_t)(row0 + p) * D + 1024 + c] = (bf16)f2bf(bf2f(uu[r][cb]) * (acc[cb][r] + bias[r])); } }
    __syncthreads();
}

template <int HALF>
__device__ __forceinline__ void pool_body(const bf16* P, bf16* MIX, const float* pscale, int seq0, int T, int tk0, int cc) {
    constexpr int NR = 4 + 2 * HALF;
    v4u raw[NR];
#pragma unroll
    for (int r = 0; r < NR; ++r) { const int t = tk0 - HALF + r; raw[r] = (t >= 0 && t < T) ? *(const GAS v4u*)(P + (size_t)(seq0 + t) * INC + cc * 8) : (v4u){0u, 0u, 0u, 0u}; }
    const f32x4 s0 = *(const GAS f32x4*)(pscale + cc * 8), s1 = *(const GAS f32x4*)(pscale + cc * 8 + 4);
    const float sc[8] = {s0.x, s0.y, s0.z, s0.w, s1.x, s1.y, s1.z, s1.w};
    float w[8];
#pragma unroll
    for (int e = 0; e < 8; ++e) w[e] = 0.f;
#pragma unroll
    for (int r = 0; r < 2 * HALF - 1; ++r)
#pragma unroll
        for (int e = 0; e < 4; ++e) { w[2 * e] += bf2f((unsigned short)(raw[r][e] & 0xffffu)); w[2 * e + 1] += bf2f((unsigned short)(raw[r][e] >> 16)); }
#pragma unroll
    for (int i = 0; i < 4; ++i) {
        const int t = tk0 + i, lo = t - HALF < 0 ? 0 : t - HALF, hh = t + HALF > T ? T : t + HALF; const float rc = 1.0f / (float)(hh - lo);
        v4u o;
#pragma unroll
        for (int e = 0; e < 4; ++e) {
            w[2 * e] += bf2f((unsigned short)(raw[i + 2 * HALF - 1][e] & 0xffffu)); w[2 * e + 1] += bf2f((unsigned short)(raw[i + 2 * HALF - 1][e] >> 16));
            const float x0 = bf2f((unsigned short)(raw[HALF + i][e] & 0xffffu)), x1 = bf2f((unsigned short)(raw[HALF + i][e] >> 16));
            o[e] = pk2((w[2 * e] * rc - x0) * sc[2 * e], (w[2 * e + 1] * rc - x1) * sc[2 * e + 1]);
            w[2 * e] -= bf2f((unsigned short)(raw[i][e] & 0xffffu)); w[2 * e + 1] -= bf2f((unsigned short)(raw[i][e] >> 16));
        }
        *(GAS v4u*)(MIX + (size_t)(seq0 + t) * D + cc * 8) = o;
    }
}
__device__ __forceinline__ void pool_unit(const bf16* P, bf16* MIX, const float* pscale, int row0, int tid, int wave) {
    const int seq0 = row0 < RC ? (row0 & ~255) : RC + ((row0 - RC) & ~2047), T = row0 < RC ? CTX : SEQ, tk0 = row0 - seq0 + 4 * (tid & 7), cc = tid >> 3, g = wave >> 1;
    if (g == 0) pool_body<1>(P, MIX, pscale, seq0, T, tk0, cc); else if (g == 1) pool_body<2>(P, MIX, pscale, seq0, T, tk0, cc); else if (g == 2) pool_body<4>(P, MIX, pscale, seq0, T, tk0, cc); else pool_body<8>(P, MIX, pscale, seq0, T, tk0, cc);
}

__global__ void __launch_bounds__(NWAVES * 64, 2) fwd_kernel(Args args_unused) {
    extern __shared__ __attribute__((aligned(16))) unsigned char lds_raw[];
    LAS unsigned char* lds = (LAS unsigned char*)lds_raw;
    volatile LAS unsigned* MISC = (volatile LAS unsigned*)(lds + MISC_OFF);
    const int tid0 = threadIdx.x;
#define TID_HERE() int tid = threadIdx.x; asm volatile("" : "+v"(tid)); int G = G0, bx = bx0; asm volatile("" : "+s"(G), "+s"(bx)); const int vcu = (G % 8 == 0) ? (bx % 8) * (G / 8) + bx / 8 : bx; const int NGW = G * NWAVES; \
    const int lane = tid & 63, wave = __builtin_amdgcn_readfirstlane(tid >> 6); const int gw = vcu * NWAVES + wave; (void)lane; (void)gw; (void)NGW
    const int G0 = gridDim.x, bx0 = blockIdx.x;
    for (int u = tid0; u < (LDS_BYTES - LDSCTL_OFF) / 4; u += NWAVES * 64) ((LAS unsigned*)(lds + LDSCTL_OFF))[u] = 0u;
    __syncthreads();
    int lo, hi;
    XcdBarrier bar;
    { kaptr kp = ka_get(); lo = KLO(kp); hi = KHI(kp); unsigned* bw = (unsigned*)(KWS(kp) + WS_CTL) + CW_BAR; bar.bar = bw; bar.x = 0; bar.st = nullptr;
      if (!MK_PER_PHASE) bar = xcd_barrier_post(bw, MISC + 8); }
#ifndef SITEMASK
#define SITEMASK 0xfff
#endif
#ifndef UNITMASK
#define UNITMASK 0xf
#endif
#define UEN(s) (((UNITMASK) >> (s)) & 1)
#ifndef REPMASK
#define REPMASK 0
#endif
#ifndef REPU
#define REPU 0
#endif
#define NREPU(s) (1 + (((REPU) >> (s)) & 1))
#define NREP(s) (1 + (((REPMASK) >> (s)) & 1))
#define EN(s) (((SITEMASK) >> (s)) & 1)
#define IN(k) (lo <= (k) && (k) < hi)
#ifndef NCONV
#define NCONV 16
#endif
#ifndef FILLW
#define FILLW 2
#endif
#define CONVPH(k) ((k) == 2 || (k) == 4 || (k) == 6 || (k) == 7)
#ifndef SPLITK
#define SPLITK false
#endif
#ifndef SPLITK_FFN_DOWN
#define SPLITK_FFN_DOWN false
#endif
#ifndef SPLITK_MOE_DOWN
#define SPLITK_MOE_DOWN true
#endif
#ifndef FILLMODE
#define FILLMODE 1
#endif
#define FILL(k) do { if (FILLMODE == 1 && l == 0 && IN(k)) {     kaptr kq = ka_get(); int Gq = G0; asm volatile("" : "+s"(Gq)); fill_tail(KWS(kq), KIN(kq, 23), KIN(kq, 24), KIN(kq, 25), (unsigned*)(KWS(kq) + WS_CTL) + CW_DONE + 64 * (k), Gq, (FILLMODE == 1 && l == 0 && (int)blockIdx.x < NCONV && CONVPH(k)) ? 8 : FILLW); } } while (0)
#define DRAIN(k) do { if (((FILLMODE == 1) || (k) == 0) && IN(k)) { kaptr kq = ka_get(); int Gq = G0; asm volatile("" : "+s"(Gq)); drain_tail(KWS(kq), KIN(kq, 23), KIN(kq, 24), KIN(kq, 25), Gq, lds); } } while (0)
#define SEAM(k) do { if (IN(k) && IN((k) + 1)) { XcdBarrier b_ = bar; asm volatile("" : "+s"(b_.bar)); xcd_barrier(b_); } } while (0)
    LAS int* TB = (LAS int*)(lds + TB_OFF);

    for (int rep = 0; rep < NREP(0); ++rep) if (EN(0) && IN(0)) { kaptr kp = ka_get(); TID_HERE(); p0_prologue(kp, lds, vcu, G, tid, lane, wave); }
    if (FILLMODE == 0) DRAIN(0);
    SEAM(0);

    for (int l = 0; l < 2; ++l) {
        const int pb = l == 0 ? 1 : 8;
        const bool last = (l == 1);
        for (int rep = 0; rep < NREP(1); ++rep) if (EN(1) && IN(pb + 0)) {
            kaptr kp = ka_get(); TID_HERE(); unsigned char* ws = KWS(kp); const float* H = (const float*)(ws + WS_H); const float* mod = (const float*)(ws + WS_MOD) + l * 5 * MODN;
            const float* srcC = l == 0 ? KIN(kp, 2) : H; const float* srcL = l == 0 ? KIN(kp, 0) - (size_t)RC * D : H;
            norm_rows<false>(srcC, srcL, KIN(kp, 6) + l * D, mod + 0 * D, mod + 1 * D, (bf16*)(ws + WS_XN), 0, RT, gw, NGW, lane, nullptr, nullptr, nullptr);
        }
        SEAM(pb + 0);
        for (int rep = 0; rep < NREP(2); ++rep) if (EN(2) && IN(pb + 1)) {
            kaptr kp = ka_get(); TID_HERE(); unsigned char* ws = KWS(kp);
            pg8::Gemm g{(const bf16*)(ws + WS_XN), (const bf16*)(ws + WS_WIN) + (size_t)l * INC * D, RT, INC, D}; pg8::EpiIn E{(bf16*)(ws + WS_PALL), (const float*)(ws + WS_ROPE)};
            const int nc = (FILLMODE == 1 && l == 0) ? NCONV : 0;
            if (bx >= nc) {
            pg8::OrderSplit<pg8::MapIn> S; S.init(G - nc, bx - nc, D, last ? 20 : 60); S.plan(SPLITK);
            pg8::EpiSplit<pg8::EpiIn> ES{E, (float*)(ws + WS_SLAB)};
            { pg8::CachedOrder CS; CS.fill(S, (PG8_LAS int*)(lds + UT_OFF), tid); __syncthreads();
                  pg8::gemm_phase<pg8::EpiSplit<pg8::EpiIn>, pg8::CachedOrder, true, true>(lds, g, CS, ES); }
            combine_tail(E, S, (float*)(ws + WS_SLAB), (unsigned*)(ws + WS_CTL) + CW_TK + 4096 * (pb + 1), lds); }
        }
        FILL(pb + 1); SEAM(pb + 1);
        for (int rep = 0; rep < NREP(3); ++rep) if (EN(3) && IN(pb + 2)) {
            kaptr kp = ka_get(); TID_HERE(); unsigned char* ws = KWS(kp); const bf16* PALL = (const bf16*)(ws + WS_PALL); bf16* MIX = (bf16*)(ws + WS_MIX);
            const float lam_init = 0.8f - 0.6f * expf(-0.3f * (float)l);
            for (int ru = 0; ru < NREPU(0); ++ru) if (UEN(0)) for (int u = vcu; u < 256; u += G) diff_unit(lds, PALL, MIX, KIN(kp, 12) + l * 256, KIN(kp, 13) + l * 128, lam_init, u >> 6, (u >> 4) & 3, u & 15, false, tid, lane, wave);
            for (int ru = 0; ru < NREPU(1); ++ru) if (UEN(1)) for (int u = vcu; u < 256; u += G) win_unit(lds, PALL, MIX, KIN(kp, 18) + l * 8, u >> 6, (u >> 5) & 1, u & 31, false, tid, lane, wave);
            if (!last) {
                if (UEN(0)) for (int u = vcu; u < 32; u += G) diff_unit(lds, PALL, MIX, KIN(kp, 12) + l * 256, KIN(kp, 13) + l * 128, lam_init, u >> 3, (u >> 1) & 3, u & 1, true, tid, lane, wave);
                if (UEN(1)) for (int u = (vcu + G - (32 % G)) % G; u < 32; u += G) win_unit(lds, PALL, MIX, KIN(kp, 18) + l * 8, u >> 3, (u >> 2) & 1, u & 3, true, tid, lane, wave);
            }
            { const int ch0 = last ? 8 : 0, nu = (72 - ch0) * 4;
              for (int ru = 0; ru < NREPU(2); ++ru) if (UEN(2)) for (int u = (vcu + G - (64 % G)) % G; u < nu; u += G) sgu_unit(lds, PALL, MIX, KIN(kp, 14) + l * 512, KIN(kp, 15) + l * 512, KIN(kp, 16) + (size_t)l * 4 * 128 * 128, KIN(kp, 17) + l * 512, (ch0 + (u >> 2)) * 128, u & 3, tid, lane, wave); }
            { const int r0 = last ? RC : 0, nu = (RT - r0) / 32;
              for (int ru = 0; ru < NREPU(3); ++ru) if (UEN(3)) for (int u = (vcu + G - (96 % G)) % G; u < nu; u += G) pool_unit(PALL, MIX, KIN(kp, 11) + l * 512, r0 + 32 * u, tid, wave); }
        }
        FILL(pb + 2); SEAM(pb + 2);
        for (int rep = 0; rep < NREP(4); ++rep) if (EN(4) && IN(pb + 3)) {
            kaptr kp = ka_get(); TID_HERE(); unsigned char* ws = KWS(kp); float* H = (float*)(ws + WS_H);
            const float* srcC = l == 0 ? KIN(kp, 2) : H; const float* srcL = l == 0 ? KIN(kp, 0) - (size_t)RC * D : H;
            pg8::Gemm g{(const bf16*)(ws + WS_MIX), (const bf16*)(ws + WS_WOUT) + (size_t)l * D * D, RT, D, D}; pg8::EpiResid E{srcC, srcL, rep ? (float*)(ws + WS_Y) : H, (const float*)(ws + WS_MOD) + l * 5 * MODN + 2 * D, 1.0f};
            const int nc = (FILLMODE == 1 && l == 0) ? NCONV : 0;
            if (bx >= nc) {
            pg8::OrderSplit<pg8::MapOff> S; S.init(last ? RL : RT, D, G - nc, bx - nc, D); S.pm_off = last ? 4 : 0; S.plan(SPLITK);
            pg8::EpiSplit<pg8::EpiResid> ES{E, (float*)(ws + WS_SLAB)};
            { pg8::CachedOrder CS; CS.fill(S, (PG8_LAS int*)(lds + UT_OFF), tid); __syncthreads();
                  pg8::gemm_phase<pg8::EpiSplit<pg8::EpiResid>, pg8::CachedOrder, true, true>(lds, g, CS, ES); }
            combine_tail(E, S, (float*)(ws + WS_SLAB), (unsigned*)(ws + WS_CTL) + CW_TK + 4096 * (pb + 3), lds); }
        }
        FILL(pb + 3); SEAM(pb + 3);
        for (int rep = 0; rep < NREP(5); ++rep) if (EN(5) && IN(pb + 4)) {
            kaptr kp = ka_get(); TID_HERE(); unsigned char* ws = KWS(kp); const float* H = (const float*)(ws + WS_H); const float* mod = (const float*)(ws + WS_MOD) + l * 5 * MODN;
            if (!last || rep) norm_rows<false, DENSE_UP_F8>(H, H, KIN(kp, 7) + l * D, mod + 3 * D, mod + 4 * D, (bf16*)(ws + WS_XN), last ? RC : 0, RT, gw, NGW, lane, nullptr, nullptr, nullptr);
            else {
                LAS float* rt = (LAS float*)lds;
                for (int i = tid; i < D * NE / 4; i += NWAVES * 64) ((LAS f32x4*)rt)[i] = ((const GAS f32x4*)KIN(kp, 22))[i];
                __syncthreads();
                norm_rows<true, MOE_F8>(H, H, KIN(kp, 7) + l * D, mod + 3 * D, mod + 4 * D, (bf16*)(ws + WS_XG), RC, RT, gw, NGW, lane, rt, (unsigned*)(ws + WS_CTL) + CW_CNT, (int*)(ws + WS_ROUTE));
            }
        }
        if (last) DRAIN(pb + 4);
        SEAM(pb + 4);
        if (!last) {
            for (int rep = 0; rep < NREP(6); ++rep) if (EN(6) && IN(pb + 5)) {
                kaptr kp = ka_get(); TID_HERE(); unsigned char* ws = KWS(kp);
                constexpr int KP = DENSE_UP_F8 ? D / 2 : D;
                pg8::Gemm g{(const bf16*)(ws + WS_XN), (const bf16*)(ws + WS_W13), RT, 2 * DFF, KP}; pg8::EpiSwiglu<DENSE_DN_F8> E{(void*)(ws + WS_ACT), DFF, NTN_UP, DENSE_UP_F8 ? 1.0f / 256.0f : 1.0f};
                const int nc = (FILLMODE == 1) ? NCONV : 0;
                if (bx >= nc) {
                pg8::OrderSplit<pg8::StaticOrder> S; S.init(RT, 2 * DFF, G - nc, bx - nc, KP); S.plan(SPLITK);
                pg8::EpiSplit<pg8::EpiSwiglu<DENSE_DN_F8>> ES{E, (float*)(ws + WS_SLAB)};
                { pg8::CachedOrder CS; CS.fill(S, (PG8_LAS int*)(lds + UT_OFF), tid); __syncthreads();
                  pg8::gemm_phase<pg8::EpiSplit<pg8::EpiSwiglu<DENSE_DN_F8>>, pg8::CachedOrder, true, true, DENSE_UP_F8>(lds, g, CS, ES); }
                combine_tail(E, S, (float*)(ws + WS_SLAB), (unsigned*)(ws + WS_CTL) + CW_TK + 4096 * (pb + 5), lds); }
            }
            FILL(pb + 5); SEAM(pb + 5);
            for (int rep = 0; rep < NREP(7); ++rep) if (EN(7) && IN(pb + 6)) {
                kaptr kp = ka_get(); TID_HERE(); unsigned char* ws = KWS(kp); float* H = (float*)(ws + WS_H);
                constexpr int KP = DENSE_DN_F8 ? DFF / 2 : DFF;
                pg8::Gemm g{(const bf16*)(ws + WS_ACT), (const bf16*)(ws + WS_W2), RT, D, KP}; pg8::EpiResid E{H, H, rep ? (float*)(ws + WS_Y) : H, (const float*)(ws + WS_MOD) + l * 5 * MODN + 5 * D, DENSE_DN_F8 ? 1.0f / 256.0f : 1.0f};
                const int nc = (FILLMODE == 1) ? NCONV : 0;
                if (bx >= nc) {
                pg8::OrderSplit<pg8::MapOff> S; S.init(RT, D, G - nc, bx - nc, KP); S.pm_off = 0; S.plan(SPLITK_FFN_DOWN);
                pg8::EpiSplit<pg8::EpiResid> ES{E, (float*)(ws + WS_SLAB)};
                { pg8::CachedOrder CS; CS.fill(S, (PG8_LAS int*)(lds + UT_OFF), tid); __syncthreads();
                  pg8::gemm_phase<pg8::EpiSplit<pg8::EpiResid>, pg8::CachedOrder, true, true, DENSE_DN_F8>(lds, g, CS, ES); }
                combine_tail(E, S, (float*)(ws + WS_SLAB), (unsigned*)(ws + WS_CTL) + CW_TK + 4096 * (pb + 6), lds); }
            }
            FILL(pb + 6); SEAM(pb + 6);
        } else {
            if (IN(pb + 5) || IN(pb + 6) || IN(pb + 7) || IN(pb + 8)) {
                kaptr kp = ka_get(); TID_HERE(); const unsigned* CNT = (const unsigned*)(KWS(kp) + WS_CTL) + CW_CNT;
                if (tid == 0) { int acc = 0; TB[0] = 0;
                    for (int e = 0; e < 8; ++e) { const unsigned c = __hip_atomic_load(CNT + 64 * e, RLX_AGENT); acc += (int)((c + 255u) >> 8); TB[e + 1] = acc; } }
                __syncthreads();
            }
            for (int rep = 0; rep < NREP(9); ++rep) if (EN(9) && IN(pb + 6)) {
                kaptr kp = ka_get(); TID_HERE(); unsigned char* ws = KWS(kp);
                constexpr int KP = MOE_F8 ? D / 2 : D;
                pg8::Gemm g{(const bf16*)(ws + WS_XG), (const bf16*)(ws + WS_MW13), NE * 8192, NE * 2 * DFF, KP}; pg8::EpiSwiglu<MOE_F8> E{(void*)(ws + WS_ACT), DFF, NTN_UP, MOE_F8 ? 1.0f / 256.0f : 1.0f, (const PG8_LAS int*)TB};
                pg8::OrderSplit<pg8::MapMoe> S; S.init((const PG8_LAS int*)TB, NTN_UP, G, bx, KP, 1); S.plan(SPLITK);
                pg8::EpiSplit<pg8::EpiSwiglu<MOE_F8>> ES{E, (float*)(ws + WS_SLAB)};
                { pg8::CachedOrder CS; CS.fill(S, (PG8_LAS int*)(lds + UT_OFF), tid); __syncthreads();
                  pg8::gemm_phase<pg8::EpiSplit<pg8::EpiSwiglu<MOE_F8>>, pg8::CachedOrder, true, true, MOE_F8>(lds, g, CS, ES); }
                combine_tail(E, S, (float*)(ws + WS_SLAB), (unsigned*)(ws + WS_CTL) + CW_TK + 4096 * (pb + 6), lds);
            }
            SEAM(pb + 6);
            for (int rep = 0; rep < NREP(10); ++rep) if (EN(10) && IN(pb + 7)) {
                kaptr kp = ka_get(); TID_HERE(); unsigned char* ws = KWS(kp);
                constexpr int KP = MOE_F8 ? DFF / 2 : DFF;
                pg8::Gemm g{(const bf16*)(ws + WS_ACT), (const bf16*)(ws + WS_MW2), MAXSLOT, NE * D, KP}; pg8::EpiF32 E{(bf16*)(ws + WS_Y), D / 256, MOE_F8 ? 1.0f / 256.0f : 1.0f};
                pg8::OrderSplit<pg8::MapMoe> S; S.init((const PG8_LAS int*)TB, D / 256, G, bx, KP); S.plan(SPLITK_MOE_DOWN);
                pg8::EpiSplit<pg8::EpiF32> ES{E, (float*)(ws + WS_SLAB)};
                { pg8::CachedOrder CS; CS.fill(S, (PG8_LAS int*)(lds + UT_OFF), tid); __syncthreads();
                  pg8::gemm_phase<pg8::EpiSplit<pg8::EpiF32>, pg8::CachedOrder, true, true, MOE_F8>(lds, g, CS, ES); }
                combine_tail(E, S, (float*)(ws + WS_SLAB), (unsigned*)(ws + WS_CTL) + CW_TK + 4096 * (pb + 7), lds);
            }
            SEAM(pb + 7);
            for (int rep = 0; rep < NREP(11); ++rep) if (EN(11) && IN(pb + 8)) {
                kaptr kp = ka_get(); TID_HERE(); unsigned char* ws = KWS(kp); const int* ROUTE = (const int*)(ws + WS_ROUTE); const float* H = (const float*)(ws + WS_H); const bf16* Y = (const bf16*)(ws + WS_Y);
                const float* gate = (const float*)(ws + WS_MOD) + l * 5 * MODN + 5 * D; const float* nf = KIN(kp, 26); float* out = KOUT(kp);
                for (int t = gw; t < RL; t += NGW) {
                    const int* rec = ROUTE + (size_t)t * 8; const int e1 = rec[0], s1 = rec[1], e2 = rec[3], s2 = rec[4]; const float w1 = __builtin_bit_cast(float, rec[2]), w2 = __builtin_bit_cast(float, rec[5]);
                    const int b1 = TB[e1], b2 = TB[e2];
                    const int bidx = t >> 11;
                    const GAS f32x4* hr = (const GAS f32x4*)(H + (size_t)(RC + t) * D) + lane; const GAS v2u* y1 = (const GAS v2u*)(Y + (size_t)(b1 * 256 + s1) * D) + lane; const GAS v2u* y2 = (const GAS v2u*)(Y + (size_t)(b2 * 256 + s2) * D) + lane;
                    const GAS f32x4* g4 = (const GAS f32x4*)(gate + bidx * MODN) + lane;
                    f32x4 v[8]; float ss = 0.f;
#pragma unroll
                    for (int j = 0; j < 8; ++j) { const v2u ra = y1[64 * j], rb = y2[64 * j];
                        const f32x4 a = (f32x4){bf2f((unsigned short)(ra.x & 0xffffu)), bf2f((unsigned short)(ra.x >> 16)), bf2f((unsigned short)(ra.y & 0xffffu)), bf2f((unsigned short)(ra.y >> 16))};
                        const f32x4 b = (f32x4){bf2f((unsigned short)(rb.x & 0xffffu)), bf2f((unsigned short)(rb.x >> 16)), bf2f((unsigned short)(rb.y & 0xffffu)), bf2f((unsigned short)(rb.y >> 16))};
                        v[j] = hr[64 * j] + g4[64 * j] * (a * w1 + b * w2); ss += (v[j].x * v[j].x + v[j].y * v[j].y) + (v[j].z * v[j].z + v[j].w * v[j].w); }
                    const float rstd = 1.0f / sqrtf(wave_sum(ss) * (1.0f / D) + EPS);
                    GAS f32x4* op = (GAS f32x4*)(out + (size_t)t * D) + lane; const GAS f32x4* n4 = (const GAS f32x4*)nf + lane;
#pragma unroll
                    for (int j = 0; j < 8; ++j) op[64 * j] = v[j] * rstd * n4[64 * j];
                }
            }
        }
    }
#undef IN
#undef SEAM
}

extern "C" void kernel_launch(void* const* d_in, const int* in_sizes, int n_in, void* d_out, int out_size, void* d_ws, size_t ws_size, hipStream_t stream) {
    static int grid = 0;
    if (grid == 0) {
        if (n_in != 27 || out_size != RL * D || ws_size < WS_END) { fprintf(stderr, "kernel_launch: unexpected problem (n_in %d, out %d, ws %zu); nothing launched\n", n_in, out_size, ws_size); grid = -1; return; }
        int dev = 0, cus = 0, per_cu = 0;
        if (hipGetDevice(&dev) != hipSuccess || hipDeviceGetAttribute(&cus, hipDeviceAttributeMultiprocessorCount, dev) != hipSuccess) { grid = -1; return; }
        if (hipFuncSetAttribute((const void*)fwd_kernel, hipFuncAttributeMaxDynamicSharedMemorySize, LDS_BYTES) != hipSuccess) { fprintf(stderr, "kernel_launch: hipFuncSetAttribute failed\n"); grid = -1; return; }
        if (hipOccupancyMaxActiveBlocksPerMultiprocessor(&per_cu, (const void*)fwd_kernel, NWAVES * 64, LDS_BYTES) != hipSuccess || per_cu < 1) fprintf(stderr, "kernel_launch: occupancy query reports %d\n", per_cu);
        (void)hipGetLastError();
        grid = cus;
    }
    if (grid < 0) return;
    if (hipMemsetAsync((char*)d_ws + WS_CTL, 0, CTL_ZERO_BYTES, stream) != hipSuccess) { fprintf(stderr, "kernel_launch: memset failed\n"); return; }
    Args a{};
    for (int i = 0; i < 27; ++i) a.in[i] = (const float*)d_in[i];
    a.out = (float*)d_out; a.ws = (unsigned char*)d_ws;
#if MK_PER_PHASE
    for (int p = 0; p < NPHASE; ++p) { a.ph_lo = p; a.ph_hi = p + 1; hipLaunchKernelGGL(fwd_kernel, dim3(grid), dim3(NWAVES * 64), LDS_BYTES, stream, a); }
#else
    a.ph_lo = 0; a.ph_hi = NPHASE;
    hipLaunchKernelGGL(fwd_kernel, dim3(grid), dim3(NWAVES * 64), LDS_BYTES, stream, a);
#endif
    const hipError_t le = hipPeekAtLastError();
    if (le != hipSuccess) fprintf(stderr, "kernel_launch: launch failed: %s\n", hipGetErrorName(le));
}
```

```cpp
#include <hip/hip_runtime.h>
#include <cstdio>
#include <cstdint>
#include <cmath>

#define GAS __attribute__((address_space(1)))
#define LAS __attribute__((address_space(3)))
namespace pg8 {
#define PG8_LAS __attribute__((address_space(3)))
typedef unsigned short bf16_t;
typedef short bf16x8 __attribute__((ext_vector_type(8)));
typedef float f32x4 __attribute__((ext_vector_type(4)));
typedef unsigned u32x4 __attribute__((ext_vector_type(4)));
typedef int i32x4 __attribute__((ext_vector_type(4)));
typedef int i32x8 __attribute__((ext_vector_type(8)));
constexpr int BM = 256, BK = 64, HALF = 128, HTB = HALF * BK * 2  , STAGE_BYTES = 8 * HTB, NXCD = 8, WGM = 8;

__host__ __device__ __forceinline__ int lds_byte(int r, int c) { const int st = (r >> 4) * 2 + (c >> 5), rr = r & 15, cc = c & 31, ob = rr * 64 + cc * 2; return st * 1024 + (ob ^ (((ob >> 9) & 1) << 5)); }
__host__ __device__ __forceinline__ void stage_rc(int b, int& R, int& C) { const int st = b / 1024, sb = b % 1024, swz = sb ^ (((sb >> 9) & 1) << 5); R = (st >> 1) * 16 + swz / 64; C = (st & 1) * 32 + (swz % 64) / 2; }
__host__ __device__ __forceinline__ int perm32(int rho) { const int n = rho >> 4, i = rho & 15; return 8 * (i >> 2) + 4 * n + (i & 3); }

struct Unit { int pm, pn, k0, nkt, sid; };
struct Gemm { const bf16_t* A; const bf16_t* Bt; int M, N, K; };

struct StaticOrder {
    int nM, nN, nwg, G, c;
    __host__ __device__ void init(int M, int N, int G_, int c_, int K_) { nM = M / BM; nN = N / BM; nwg = nM * nN; G = G_; c = c_; K = K_; }
    int K;
    __host__ __device__ bool next(int i, Unit& u) const { const long L = (long)i * G + c; if (L >= nwg) return false; map(L, u); return true; }
    __host__ __device__ void map(long L, Unit& u) const {
        int wgid = (int)L; { const int q = nwg / NXCD, r = nwg % NXCD, xcd = wgid % NXCD, off = wgid / NXCD; wgid = (xcd < r ? xcd * (q + 1) : r * (q + 1) + (xcd - r) * q) + off; }
        const int nig = WGM * nN, gid = wgid / nig, fm = gid * WGM, gsz = (nM - fm) < WGM ? (nM - fm) : WGM;
        u.pm = fm + ((wgid % nig) % gsz); u.pn = (wgid % nig) / gsz; u.k0 = 0; u.nkt = K / BK; u.sid = -1;
    }
    __device__ __forceinline__ void a_ready(const Unit&) const {}
    __device__ __forceinline__ void done(const Unit&) const {}
};

__device__ __forceinline__ unsigned cvt_pk_bf16(float lo, float hi) { unsigned r; asm volatile("v_cvt_pk_bf16_f32 %0, %1, %2" : "=v"(r) : "v"(lo), "v"(hi)); return r; }
typedef unsigned u32x4 __attribute__((ext_vector_type(4)));
constexpr float QSCALE = 0.125f * 1.4426950408889634f;
__device__ __forceinline__ float gelu_tanh(float x) {
    const float y = 0.7978845608028654f * (x + 0.044715f * x * x * x);
    return x * __builtin_amdgcn_rcpf(1.0f + __builtin_amdgcn_exp2f(-2.0f * 1.4426950408889634f * y));
}
__device__ __forceinline__ float silu_f(float x) { return x * __builtin_amdgcn_rcpf(1.0f + __builtin_amdgcn_exp2f(-1.4426950408889634f * x)); }

struct EpiIn {
    static constexpr bool PERM = true, AFTER_DRAIN = false;
    bf16_t* O; const float* rope;
    __device__ __forceinline__ void operator()(const f32x4 (&acc)[2][2][4][2], const Unit& u, int wr, int wc, int fr, int fq) const {
        const int row0 = u.pm * BM + wr * 64 + fr; const bool lat = u.pm >= 4;
#pragma unroll
        for (int bj = 0; bj < 2; ++bj) {
            const int cb = u.pn * BM + bj * HALF; int role;
            if (cb < 512) role = 0; else if (cb < 1024) role = 1; else if (cb < 1536) role = 2; else if (cb < 2048) role = 0; else if (cb < 3072) role = 3; else if (cb < 3584) role = 1; else if (cb < 3712) role = 2; else role = 0;
            const int col0 = cb + wc * 32 + 8 * fq;
#pragma unroll
            for (int ai = 0; ai < 2; ++ai)
#pragma unroll
                for (int m = 0; m < 4; ++m) {
                    const int row = row0 + ai * HALF + m * 16;
                    f32x4 v0 = acc[ai][bj][m][0], v1 = acc[ai][bj][m][1];
                    if (role == 1 || role == 2) {
                        if (lat) {
                            const int t = (row - 1024) & 2047, pos = (wc & 1) ? (t & 63) : (t >> 6);
                            const f32x4 cs = *(const f32x4*)(rope + pos * 16 + 4 * fq), sn = *(const f32x4*)(rope + 1024 + pos * 16 + 4 * fq);
                            f32x4 a0, a1;
                            a0[0] = v0[0] * cs[0] - v0[1] * sn[0]; a0[1] = v0[0] * sn[0] + v0[1] * cs[0];
                            a0[2] = v0[2] * cs[1] - v0[3] * sn[1]; a0[3] = v0[2] * sn[1] + v0[3] * cs[1];
                            a1[0] = v1[0] * cs[2] - v1[1] * sn[2]; a1[1] = v1[0] * sn[2] + v1[1] * cs[2];
                            a1[2] = v1[2] * cs[3] - v1[3] * sn[3]; a1[3] = v1[2] * sn[3] + v1[3] * cs[3];
                            v0 = a0; v1 = a1;
                        }
                        if (role == 1) { v0 = v0 * QSCALE; v1 = v1 * QSCALE; }
                    } else if (role == 3) {
#pragma unroll
                        for (int e = 0; e < 4; ++e) { v0[e] = gelu_tanh(v0[e]); v1[e] = gelu_tanh(v1[e]); }
                    }
                    u32x4 w; w.x = cvt_pk_bf16(v0[0], v0[1]); w.y = cvt_pk_bf16(v0[2], v0[3]); w.z = cvt_pk_bf16(v1[0], v1[1]); w.w = cvt_pk_bf16(v1[2], v1[3]);
                    *(u32x4*)(O + (size_t)row * 3840 + col0) = w;
                }
        }
    }
};
__device__ __forceinline__ float clamp_fp8(float x) { return __builtin_amdgcn_fmed3f(x, -448.0f, 448.0f); }
__device__ __forceinline__ unsigned cvt4_fp8(float a, float b, float c, float d) { a = clamp_fp8(a); b = clamp_fp8(b); c = clamp_fp8(c); d = clamp_fp8(d); int w = 0; w = __builtin_amdgcn_cvt_pk_fp8_f32(a, b, w, false); w = __builtin_amdgcn_cvt_pk_fp8_f32(c, d, w, true); return (unsigned)w; }
template <bool F8OUT> struct EpiSwiglu {
    static constexpr bool PERM = true, AFTER_DRAIN = false;
    void* O; int ldo; int ntn; float sc;
    const PG8_LAS int* tb;
    __device__ __forceinline__ void operator()(const f32x4 (&acc)[2][2][4][2], const Unit& u, int wr, int wc, int fr, int fq) const {
        const int pmo = tb ? tb[u.pm >> 5] + (u.pm & 31) : u.pm;
        const int row0 = pmo * BM + wr * 64 + fr, col0 = (u.pn % ntn) * HALF + wc * 32 + 8 * fq;
#pragma unroll
        for (int ai = 0; ai < 2; ++ai)
#pragma unroll
            for (int m = 0; m < 4; ++m) {
                const f32x4 g0 = acc[ai][0][m][0] * sc, g1 = acc[ai][0][m][1] * sc, u0 = acc[ai][1][m][0] * sc, u1 = acc[ai][1][m][1] * sc;
                f32x4 r0, r1;
#pragma unroll
                for (int e = 0; e < 4; ++e) { r0[e] = silu_f(g0[e]) * u0[e]; r1[e] = silu_f(g1[e]) * u1[e]; }
                const size_t row = (size_t)(row0 + ai * HALF + m * 16);
                if constexpr (F8OUT) { typedef unsigned u32x2 __attribute__((ext_vector_type(2))); u32x2 w; w.x = cvt4_fp8(r0[0], r0[1], r0[2], r0[3]); w.y = cvt4_fp8(r1[0], r1[1], r1[2], r1[3]);
                    *(u32x2*)((unsigned char*)O + row * ldo + col0) = w; }
                else { u32x4 w; w.x = cvt_pk_bf16(r0[0], r0[1]); w.y = cvt_pk_bf16(r0[2], r0[3]); w.z = cvt_pk_bf16(r1[0], r1[1]); w.w = cvt_pk_bf16(r1[2], r1[3]);
                    *(u32x4*)((bf16_t*)O + row * ldo + col0) = w; }
            }
    }
};
struct EpiResid {
    static constexpr bool PERM = false, AFTER_DRAIN = false;
    const float* resC; const float* resL; float* out; const float* gate; float sc;
    __device__ __forceinline__ void operator()(const f32x4 (&acc)[2][2][4][2], const Unit& u, int wr, int wc, int fr, int fq) const {
        const int bidx = u.pm < 4 ? 4 : ((u.pm - 4) >> 3); const float* res = u.pm < 4 ? resC : resL; const float* gp = gate + bidx * 12288;
        const int row0 = u.pm * BM + wr * 64 + fr;
#pragma unroll
        for (int bj = 0; bj < 2; ++bj)
#pragma unroll
            for (int n = 0; n < 2; ++n) {
                const int col = u.pn * BM + bj * HALF + wc * 32 + 16 * n + 4 * fq; const f32x4 g4 = *(const f32x4*)(gp + col); f32x4 rr[2][4];
#pragma unroll
                for (int ai = 0; ai < 2; ++ai)
#pragma unroll
                    for (int m = 0; m < 4; ++m) rr[ai][m] = *(const f32x4*)(res + (size_t)(row0 + ai * HALF + m * 16) * 2048 + col);
                asm volatile("" ::: "memory");
#pragma unroll
                for (int ai = 0; ai < 2; ++ai)
#pragma unroll
                    for (int m = 0; m < 4; ++m) *(f32x4*)(out + (size_t)(row0 + ai * HALF + m * 16) * 2048 + col) = rr[ai][m] + g4 * (acc[ai][bj][m][n] * sc);
                asm volatile("" ::: "memory");
            }
    }
};
struct EpiF32 {
    static constexpr bool PERM = true, AFTER_DRAIN = false;
    bf16_t* O; int ntn; float sc;
    __device__ __forceinline__ void operator()(const f32x4 (&acc)[2][2][4][2], const Unit& u, int wr, int wc, int fr, int fq) const {
        const int row0 = u.pm * BM + wr * 64 + fr;
#pragma unroll
        for (int bj = 0; bj < 2; ++bj) {
            const int col0 = (u.pn % ntn) * BM + bj * HALF + wc * 32 + 8 * fq;
#pragma unroll
            for (int ai = 0; ai < 2; ++ai)
#pragma unroll
                for (int m = 0; m < 4; ++m) { const f32x4 v0 = acc[ai][bj][m][0] * sc, v1 = acc[ai][bj][m][1] * sc;
                    u32x4 w; w.x = cvt_pk_bf16(v0[0], v0[1]); w.y = cvt_pk_bf16(v0[2], v0[3]); w.z = cvt_pk_bf16(v1[0], v1[1]); w.w = cvt_pk_bf16(v1[2], v1[3]);
                    *(u32x4*)(O + (size_t)(row0 + ai * HALF + m * 16) * 2048 + col0) = w; }
        }
    }
};
template <class Epi> struct EpiSplit {
    static constexpr bool PERM = Epi::PERM, AFTER_DRAIN = false;
    Epi E; float* slab;
    __device__ __forceinline__ void operator()(const f32x4 (&acc)[2][2][4][2], const Unit& u, int wr, int wc, int fr, int fq) const {
        if (u.sid < 0) { E(acc, u, wr, wc, fr, fq); return; }
        f32x4* sp = (f32x4*)slab + (size_t)u.sid * (32 * 512) + (wr * 4 + wc) * 64 + fq * 16 + fr;
#pragma unroll
        for (int ai = 0; ai < 2; ++ai)
#pragma unroll
            for (int bj = 0; bj < 2; ++bj)
#pragma unroll
                for (int m = 0; m < 4; ++m)
#pragma unroll
                    for (int n = 0; n < 2; ++n) sp[(size_t)((((ai * 2 + bj) * 4 + m) * 2) + n) * 512] = acc[ai][bj][m][n];
    }
};
struct TailPlan { int nfull, ntail, S;
    __device__ __forceinline__ void make(int nwg, int G, bool allow, int K) { nfull = (nwg / G) * G; ntail = nwg - nfull;
        S = (!allow || ntail == 0) ? 1 : ((4 * ntail <= G && K % 512 == 0) ? 4 : ((2 * ntail <= G && K % 256 == 0) ? 2 : 1)); } };
template <class Base> struct OrderSplit : Base {
    TailPlan tp;
    __device__ __forceinline__ void plan(bool allow) { tp.make(this->nwg, this->G, allow, this->K); }
    __device__ __forceinline__ bool next(int i, Unit& u) const {
        const long L = (long)i * this->G + this->c;
        if (tp.S == 1) { if (L >= this->nwg) return false; this->map(L, u); return true; }
        if (L < tp.nfull) { this->map(L, u); return true; }
        const int j = (int)(L - tp.nfull); if (j >= tp.ntail * tp.S) return false;
        this->map(tp.nfull + j / tp.S, u); const int ks = j % tp.S, klen = this->K / tp.S; u.k0 = ks * klen; u.nkt = klen / BK; u.sid = j; return true;
    }
    __device__ __forceinline__ bool tail_unit(int& tt, Unit& u) const { if (tp.S == 1 || this->c >= tp.ntail * tp.S) return false; tt = this->c / tp.S; this->map(tp.nfull + tt, u); return true; }
};
struct CachedOrder {
    const PG8_LAS int* tab;
    template <class Ord> __device__ __forceinline__ void fill(const Ord& S, PG8_LAS int* t, int tid) {
        if (tid < 32) { Unit u; u.pm = 0; u.pn = 0; u.k0 = 0; u.nkt = 2; u.sid = -1; const bool ok = S.next(tid, u);
            t[tid * 8 + 0] = ok ? 1 : 0; t[tid * 8 + 1] = u.pm; t[tid * 8 + 2] = u.pn; t[tid * 8 + 3] = u.k0; t[tid * 8 + 4] = u.nkt; t[tid * 8 + 5] = u.sid; }
        tab = t;
    }
    __device__ __forceinline__ bool next(int i, Unit& u) const {
        if (i >= 32) return false;
        const i32x4 a = *(const PG8_LAS i32x4*)(tab + i * 8); const int b0 = tab[i * 8 + 4], b1 = tab[i * 8 + 5];
        if (!__builtin_amdgcn_readfirstlane(a[0])) return false;
        u.pm = __builtin_amdgcn_readfirstlane(a[1]); u.pn = __builtin_amdgcn_readfirstlane(a[2]); u.k0 = __builtin_amdgcn_readfirstlane(a[3]); u.nkt = __builtin_amdgcn_readfirstlane(b0); u.sid = __builtin_amdgcn_readfirstlane(b1); return true;
    }
    __device__ __forceinline__ void a_ready(const Unit&) const {}
    __device__ __forceinline__ void done(const Unit&) const {}
};
struct MapOff : StaticOrder {
    int pm_off;
    __device__ __forceinline__ void map(long L, Unit& u) const { StaticOrder::map(L, u); u.pm += pm_off; }
};
struct MapIn {
    StaticOrder lat; int nwg, G, c, K, nextra;
    __device__ __forceinline__ void init(int G_, int c_, int K_, int nextra_) { lat.init(8192, 3840, G_, c_, K_); G = G_; c = c_; K = K_; nextra = nextra_; nwg = lat.nwg + nextra_; }
    __device__ __forceinline__ void map(long L, Unit& u) const {
        if (L < lat.nwg) { lat.map(L, u); u.pm += 4; return; }
        const int e = (int)(L - lat.nwg);
        if (nextra == 60) { u.pm = e / 15; u.pn = e % 15; } else { u.pm = e / 5; const int idx = e % 5; u.pn = idx < 4 ? 4 + idx : 14; }
        u.k0 = 0; u.nkt = K / BK; u.sid = -1;
    }
    __device__ __forceinline__ void a_ready(const Unit&) const {}
    __device__ __forceinline__ void done(const Unit&) const {}
};
struct MapMoe {
    const PG8_LAS int* tb; int ntn, G, c, K, nwg, sp;
    __device__ __forceinline__ void init(const PG8_LAS int* tb_, int ntn_, int G_, int c_, int K_, int sp_ = 0) { tb = tb_; ntn = ntn_; G = G_; c = c_; K = K_; nwg = tb_[8] * ntn_; sp = sp_; }
    __device__ __forceinline__ void map(long L, Unit& u) const {
        int wgid = (int)L; { const int q = nwg / NXCD, r = nwg % NXCD, xcd = wgid % NXCD, off = wgid / NXCD; wgid = (xcd < r ? xcd * (q + 1) : r * (q + 1) + (xcd - r) * q) + off; }
        int e = 0;
#pragma unroll
        for (int k = 1; k < 8; ++k) if (wgid >= tb[k] * ntn) e = k;
        const int t0 = tb[e], Te = tb[e + 1] - t0, local = wgid - t0 * ntn;
        const int nig = WGM * ntn, gid = local / nig, fm = gid * WGM, gsz = (Te - fm) < WGM ? (Te - fm) : WGM;
        u.pm = (sp ? e * 32 : t0) + fm + ((local % nig) % gsz); u.pn = e * ntn + (local % nig) / gsz; u.k0 = 0; u.nkt = K / BK; u.sid = -1;
    }
    __device__ __forceinline__ void a_ready(const Unit&) const {}
    __device__ __forceinline__ void done(const Unit&) const {}
};

template <class Epi, class Sched, bool ALIGN_EPI = false, bool SP2 = false, bool F8 = false>
__device__ __forceinline__ void gemm_phase(PG8_LAS unsigned char* lds, const Gemm g, const Sched& S, const Epi& E) {
    int tid_o = threadIdx.x; asm volatile("" : "+v"(tid_o));
    const int tid = tid_o, wid = __builtin_amdgcn_readfirstlane(tid >> 6), lane = tid & 63, wr = wid >> 2, wc = wid & 3, fr = lane & 15, fq = lane >> 4;
    const int K = g.K;
    unsigned voffA[2], voffB[2];
#pragma unroll
    for (int i = 0; i < 2; ++i) { int R, C; stage_rc(tid * 16 + i * 8192, R, C); const int Rb = Epi::PERM ? ((R & ~31) + perm32(R & 31)) : R;
        voffA[i] = (unsigned)(R * K + C) * 2u; voffB[i] = (unsigned)(Rb * K + C) * 2u; }
    const size_t kstep = (size_t)(BK * 2);
    const size_t hstep = (size_t)HALF * K * 2;
    const size_t tstep = 2 * hstep;
    const unsigned ldsw = (unsigned)wid * 1024u;
    const int aoff = lds_byte(wr * 64 + fr, fq * 8), boff = lds_byte(wc * 32 + fr, fq * 8);
#define PG8_SA(b, h) (((b) * 2 + (h)) * HTB)
#define PG8_SB(b, h) ((4 + (b) * 2 + (h)) * HTB)
#define PG8_STAGE(bufoff, gbase, voff) do { _Pragma("unroll") for (int _i = 0; _i < 2; ++_i) \
        __builtin_amdgcn_global_load_lds((const unsigned*)((const char*)(gbase) + (voff)[_i]), (PG8_LAS unsigned*)(lds + (bufoff) + ldsw + _i * 8192), 16, 0, 0); } while (0)
#define PG8_LD32(p0_, p1_) __builtin_shufflevector(*(const PG8_LAS i32x4*)(p0_), *(const PG8_LAS i32x4*)(p1_), 0, 1, 2, 3, 4, 5, 6, 7)
#define PG8_LDA(dst, b, h) do { if constexpr (F8) { _Pragma("unroll") for (int m = 0; m < 4; ++m) dst##8[m] = PG8_LD32(lds + PG8_SA(b, h) + aoff + m * 2048, lds + PG8_SA(b, h) + aoff + m * 2048 + 1024); } else { \
        _Pragma("unroll") for (int m = 0; m < 4; ++m) _Pragma("unroll") for (int k = 0; k < 2; ++k) dst[m][k] = *(const PG8_LAS bf16x8*)(lds + PG8_SA(b, h) + aoff + m * 2048 + k * 1024); } } while (0)
#define PG8_LDB(dst, b, h) do { if constexpr (F8) { _Pragma("unroll") for (int n = 0; n < 2; ++n) dst##8[n] = PG8_LD32(lds + PG8_SB(b, h) + boff + n * 2048, lds + PG8_SB(b, h) + boff + n * 2048 + 1024); } else { \
        _Pragma("unroll") for (int n = 0; n < 2; ++n) _Pragma("unroll") for (int k = 0; k < 2; ++k) dst[n][k] = *(const PG8_LAS bf16x8*)(lds + PG8_SB(b, h) + boff + n * 2048 + k * 1024); } } while (0)
#define PG8_MMA(ai, bj, At, Bt) do { __builtin_amdgcn_s_setprio(1); if constexpr (F8) { _Pragma("unroll") for (int m = 0; m < 4; ++m) _Pragma("unroll") for (int n = 0; n < 2; ++n) \
        asm volatile("v_mfma_f32_16x16x128_f8f6f4 %0, %1, %2, %0" : "+v"(acc[ai][bj][m][n]) : "v"(Bt##8[n]), "v"(At##8[m])); } else { \
        _Pragma("unroll") for (int m = 0; m < 4; ++m) _Pragma("unroll") for (int n = 0; n < 2; ++n) _Pragma("unroll") for (int k = 0; k < 2; ++k) \
        acc[ai][bj][m][n] = __builtin_amdgcn_mfma_f32_16x16x32_bf16(Bt[n][k], At[m][k], acc[ai][bj][m][n], 0, 0, 0); } __builtin_amdgcn_s_setprio(0); } while (0)
#define PG8_WAIT_V(n) asm volatile("s_waitcnt vmcnt(" #n ")" ::: "memory")
#define PG8_WAIT_L(n) asm volatile("s_waitcnt lgkmcnt(" #n ")" ::: "memory")
#define PG8_BAR __builtin_amdgcn_s_barrier()
#define PG8_SCHED __builtin_amdgcn_sched_barrier(0)
    Unit cur, nxt; int ui = 0;
    if (!S.next(0, cur)) return;
    f32x4 acc[2][2][4][2];
#pragma unroll
    for (int a = 0; a < 2; ++a)
#pragma unroll
        for (int b = 0; b < 2; ++b)
#pragma unroll
            for (int m = 0; m < 4; ++m)
#pragma unroll
                for (int n = 0; n < 2; ++n) acc[a][b][m][n] = (f32x4){0.f, 0.f, 0.f, 0.f};
    bf16x8 At[4][2], B0[2][2], B1[2][2]; i32x8 At8[4], B08[2], B18[2];
    const char* cA = (const char*)g.A + (size_t)cur.pm * tstep + (size_t)cur.k0 * 2; const char* cB = (const char*)g.Bt + (size_t)cur.pn * tstep + (size_t)cur.k0 * 2;
    S.a_ready(cur);
    if constexpr (SP2) {
        PG8_STAGE(PG8_SB(0, 0), cB, voffB); PG8_STAGE(PG8_SB(0, 1), cB + hstep, voffB); PG8_STAGE(PG8_SA(0, 0), cA, voffA); PG8_STAGE(PG8_SA(0, 1), cA + hstep, voffA);
        if (wr == 1) PG8_BAR;
        PG8_WAIT_V(2); PG8_BAR;
        PG8_STAGE(PG8_SB(1, 0), cB + kstep, voffB); PG8_STAGE(PG8_SA(1, 0), cA + kstep, voffA); PG8_STAGE(PG8_SB(1, 1), cB + hstep + kstep, voffB);
        PG8_WAIT_V(6); PG8_BAR;
    } else {
        PG8_STAGE(PG8_SB(0, 0), cB, voffB); PG8_STAGE(PG8_SA(0, 0), cA, voffA); PG8_STAGE(PG8_SB(0, 1), cB + hstep, voffB); PG8_STAGE(PG8_SA(0, 1), cA + hstep, voffA);
        if (wr == 1) PG8_BAR;
        PG8_WAIT_V(4); PG8_BAR;
        PG8_STAGE(PG8_SB(1, 0), cB + kstep, voffB); PG8_STAGE(PG8_SA(1, 0), cA + kstep, voffA); PG8_STAGE(PG8_SB(1, 1), cB + hstep + kstep, voffB);
        PG8_WAIT_V(6); PG8_BAR;
    }
    for (;;) {
        const bool has_next = S.next(ui + 1, nxt);
        const char* nA = has_next ? (const char*)g.A + (size_t)nxt.pm * tstep + (size_t)nxt.k0 * 2 : cA; const char* nB = has_next ? (const char*)g.Bt + (size_t)nxt.pn * tstep + (size_t)nxt.k0 * 2 : cB;
        const int nt = cur.nkt;
        for (int t = 0; t < nt; t += 2) {
            const bool last = (t == nt - 2);
            const char* a1 = cA + (size_t)(t + 1) * kstep;
            const char* a2 = last ? nA : cA + (size_t)(t + 2) * kstep; const char* b2 = last ? nB : cB + (size_t)(t + 2) * kstep;
            const char* a3 = a2 + kstep; const char* b3 = b2 + kstep;
            if (last && has_next) S.a_ready(nxt);
            if constexpr (SP2) {
            PG8_LDB(B0, 0, 0); PG8_LDB(B1, 0, 1); PG8_SCHED; PG8_LDA(At, 0, 0); PG8_STAGE(PG8_SA(1, 1), a1 + hstep, voffA);
            PG8_WAIT_V(8); PG8_WAIT_L(0); PG8_BAR; PG8_MMA(0, 0, At, B0); PG8_MMA(0, 1, At, B1); PG8_BAR; PG8_SCHED;
            PG8_LDA(At, 0, 1); PG8_STAGE(PG8_SB(0, 0), b2, voffB); PG8_STAGE(PG8_SB(0, 1), b2 + hstep, voffB); PG8_STAGE(PG8_SA(0, 0), a2, voffA);
            PG8_WAIT_V(8); PG8_WAIT_L(0); PG8_BAR; PG8_MMA(1, 0, At, B0); PG8_MMA(1, 1, At, B1); PG8_BAR; PG8_SCHED;
            PG8_LDB(B0, 1, 0); PG8_LDB(B1, 1, 1); PG8_SCHED; PG8_LDA(At, 1, 0); PG8_STAGE(PG8_SA(0, 1), a2 + hstep, voffA);
            PG8_WAIT_V(8); PG8_WAIT_L(0); PG8_BAR; PG8_MMA(0, 0, At, B0); PG8_MMA(0, 1, At, B1); PG8_BAR; PG8_SCHED;
            PG8_LDA(At, 1, 1); PG8_STAGE(PG8_SB(1, 0), b3, voffB); PG8_STAGE(PG8_SB(1, 1), b3 + hstep, voffB); PG8_STAGE(PG8_SA(1, 0), a3, voffA);
            PG8_WAIT_V(8); PG8_WAIT_L(0); PG8_BAR; PG8_MMA(1, 0, At, B0); PG8_MMA(1, 1, At, B1); PG8_BAR; PG8_SCHED;
            } else {
            PG8_LDB(B0, 0, 0); PG8_SCHED; PG8_LDA(At, 0, 0); PG8_STAGE(PG8_SA(1, 1), a1 + hstep, voffA);
            PG8_WAIT_L(8); PG8_BAR; PG8_WAIT_L(0); PG8_MMA(0, 0, At, B0); PG8_BAR; PG8_SCHED;
            PG8_LDB(B1, 0, 1); PG8_STAGE(PG8_SB(0, 0), b2, voffB);
            PG8_BAR; PG8_WAIT_L(0); PG8_MMA(0, 1, At, B1); PG8_BAR;
            PG8_LDA(At, 0, 1); PG8_STAGE(PG8_SA(0, 0), a2, voffA);
            PG8_BAR; PG8_WAIT_L(0); PG8_MMA(1, 0, At, B0); PG8_BAR; PG8_SCHED;
            PG8_STAGE(PG8_SB(0, 1), b2 + hstep, voffB);
            PG8_WAIT_V(6); PG8_BAR; PG8_MMA(1, 1, At, B1); PG8_BAR;
            PG8_LDB(B0, 1, 0); PG8_SCHED; PG8_LDA(At, 1, 0); PG8_STAGE(PG8_SA(0, 1), a2 + hstep, voffA);
            PG8_WAIT_L(8); PG8_BAR; PG8_WAIT_L(0); PG8_MMA(0, 0, At, B0); PG8_BAR; PG8_SCHED;
            PG8_LDB(B1, 1, 1); PG8_STAGE(PG8_SB(1, 0), b3, voffB);
            PG8_BAR; PG8_WAIT_L(0); PG8_MMA(0, 1, At, B1); PG8_BAR;
            PG8_LDA(At, 1, 1); PG8_STAGE(PG8_SA(1, 0), a3, voffA);
            PG8_BAR; PG8_WAIT_L(0); PG8_MMA(1, 0, At, B0); PG8_BAR; PG8_SCHED;
            PG8_STAGE(PG8_SB(1, 1), b3 + hstep, voffB);
            PG8_WAIT_V(6); PG8_BAR; PG8_MMA(1, 1, At, B1); PG8_BAR;
            }
        }
        if constexpr (ALIGN_EPI) { if (wr == 0) PG8_BAR; }
        if constexpr (F8) asm volatile("s_nop 15\n\ts_nop 7" ::: "memory");
        if constexpr (!Epi::AFTER_DRAIN) { E(acc, cur, wr, wc, fr, fq); S.done(cur); }
        if (!has_next) break;
#pragma unroll
        for (int a = 0; a < 2; ++a)
#pragma unroll
            for (int b = 0; b < 2; ++b)
#pragma unroll
                for (int m = 0; m < 4; ++m)
#pragma unroll
                    for (int n = 0; n < 2; ++n) acc[a][b][m][n] = (f32x4){0.f, 0.f, 0.f, 0.f};
        cur = nxt; cA = nA; cB = nB; ++ui;
        if constexpr (ALIGN_EPI) { if (wr == 1) PG8_BAR; }
    }
    PG8_WAIT_V(0);
    if constexpr (!ALIGN_EPI) { if (wr == 0) PG8_BAR; }
    PG8_BAR;
    if constexpr (Epi::AFTER_DRAIN) { E.fused(acc, cur, wr, wc, fr, fq, lds, wid, lane); S.done(cur); }
#undef PG8_SA
#undef PG8_SB
#undef PG8_STAGE
#undef PG8_LDA
#undef PG8_LDB
#undef PG8_MMA
#undef PG8_LD32
#undef PG8_WAIT_V
#undef PG8_WAIT_L
#undef PG8_BAR
#undef PG8_SCHED
}
}

constexpr int D = 2048, NB = 4, SEQ = 2048, CTX = 256, DFF = 5632, NE = 8, INC = 3840, MODN = 12288;
constexpr int RC = NB * CTX, RL = NB * SEQ, RT = RC + RL;
constexpr int NTN_UP = DFF / 128;
constexpr int MAXSLOT = 2 * RL + NE * 256;
constexpr float EPS = 1e-6f, LOG2E = 1.4426950408889634f;
constexpr int NWAVES = 8;
#ifndef MK_PER_PHASE
#define MK_PER_PHASE 0
#endif
constexpr int NPHASE = 17;
#ifndef MOE_F8_ON
#define MOE_F8_ON 1
#endif
#ifndef DENSE_UP_F8_ON
#define DENSE_UP_F8_ON 1
#endif
#ifndef DENSE_DN_F8_ON
#define DENSE_DN_F8_ON 0
#endif
constexpr bool DENSE_UP_F8 = DENSE_UP_F8_ON != 0, DENSE_DN_F8 = DENSE_DN_F8_ON != 0;
constexpr bool MOE_F8 = MOE_F8_ON != 0;

constexpr size_t MiB = 1u << 20;
constexpr size_t WS_CTL = 0, CTL_ZERO_BYTES = 1 * MiB;
constexpr size_t WS_MOD = 1 * MiB;
constexpr size_t WS_ROPE = 1 * MiB + 512 * 1024;
constexpr size_t WS_ROUTE = 1 * MiB + 768 * 1024;
constexpr size_t WS_WIN = 2 * MiB, WS_WOUT = 32 * MiB, WS_W13 = 48 * MiB, WS_W2 = 92 * MiB, WS_MW13 = 114 * MiB, WS_MW2 = 466 * MiB;
constexpr size_t WS_H = 642 * MiB;
constexpr size_t WS_XN = 714 * MiB;
constexpr size_t WS_PALL = 750 * MiB;
constexpr size_t WS_MIX = 818 * MiB;
constexpr size_t WS_ACT = 854 * MiB;
constexpr size_t WS_XG = 1052 * MiB;
constexpr size_t WS_Y = 1180 * MiB;
static_assert(MOE_F8, "the per-expert input regions are laid out for fp8 rows");
constexpr size_t WS_SLAB = 1268 * MiB;
constexpr size_t WS_END = 1332 * MiB;
constexpr int CW_TMO = 0, CW_CODE = 1, CW_BAR = 4096, CW_CNT = 8192;
constexpr int CW_TK = 16384;
constexpr int CW_Q0 = 9216, CW_Q1 = 9280, CW_DONE = 9344;

constexpr int RING_BYTES = 131072, LDSCTL_OFF = 139264, MISC_OFF = LDSCTL_OFF + 320, TB_OFF = LDSCTL_OFF + 512, FLAG_OFF = LDSCTL_OFF + 256, UT_OFF = LDSCTL_OFF + 1024, LDS_BYTES = 147456;

typedef unsigned short bf16;
typedef unsigned v4u __attribute__((ext_vector_type(4)));
typedef unsigned v2u __attribute__((ext_vector_type(2)));
typedef float f32x4 __attribute__((ext_vector_type(4)));
typedef float f32x16 __attribute__((ext_vector_type(16)));
typedef short bf16x8 __attribute__((ext_vector_type(8)));
typedef short v4i16_t __attribute__((ext_vector_type(4)));
typedef GAS unsigned gu32;
#define RLX_AGENT __ATOMIC_RELAXED, __HIP_MEMORY_SCOPE_AGENT
#define LDS_WAIT() asm volatile("s_waitcnt lgkmcnt(0)" ::: "memory")
__device__ __forceinline__ unsigned f2bf(float f) { unsigned u = __builtin_bit_cast(unsigned, f); return (u + 0x7fffu + ((u >> 16) & 1u)) >> 16; }
__device__ __forceinline__ unsigned pk2(float lo, float hi) { return f2bf(lo) | (f2bf(hi) << 16); }
__device__ __forceinline__ float bf2f(unsigned short b) { return __builtin_bit_cast(float, (unsigned)b << 16); }
__device__ __forceinline__ float wave_sum(float v) {
#pragma unroll
    for (int o = 1; o < 64; o <<= 1) v += __shfl_xor(v, o);
    return v;
}

#define XB_TMO      128
#define XB_XCNT(j)  (256  + 64 * (j))
#define XB_XSUB(j)  (1280 + 64 * (j))
#define XB_XGEN(j)  (2304 + 64 * (j))
#define XB_TOP      3328
#define XB_TOPGEN   3392
#define XCD_BAR_WORDS 3456
#define XB_SPIN_CAP (1u << 18)

__device__ __forceinline__ unsigned xb_ld(unsigned* p)              { return __hip_atomic_load(p, __ATOMIC_RELAXED, __HIP_MEMORY_SCOPE_AGENT); }
__device__ __forceinline__ unsigned xb_add(unsigned* p, unsigned v) { return __hip_atomic_fetch_add(p, v, __ATOMIC_RELAXED, __HIP_MEMORY_SCOPE_AGENT); }
__device__ __forceinline__ unsigned xb_xcc_id() { return (unsigned)__builtin_amdgcn_s_getreg((3 << 11) | 20) & 0xFu; }
#define XB_SPIN(cond, bar) do { unsigned _sp = 0; while (cond) { __builtin_amdgcn_s_sleep(1); \
    if ((++_sp & 255u) == 0u) { if (xb_ld(&(bar)[XB_TMO])) break; if (_sp > XB_SPIN_CAP) { atomicAdd(&(bar)[XB_TMO], 1u); break; } } } } while (0)

struct XcdBarrier {
    unsigned* bar; unsigned x;
    volatile LAS unsigned* st;
};

__device__ __forceinline__ XcdBarrier xcd_barrier_post(unsigned* bar, volatile LAS unsigned* st) {
    XcdBarrier b; b.bar = bar; b.x = xb_xcc_id(); b.st = st;
    if (threadIdx.x == 0) (void)xb_add(&bar[XB_XCNT(b.x)], 1u);
    return b;
}
__device__ __forceinline__ void xcd_barrier_complete(unsigned* bar, unsigned x, unsigned& nloc, unsigned& nx) {
    const unsigned G = gridDim.x * gridDim.y * gridDim.z;
    unsigned sum, cnt, mine, sp = 0u;
    for (;;) {
        sum = 0u; cnt = 0u; mine = 0u;
#pragma unroll
        for (unsigned j = 0; j < 16; ++j) { const unsigned c = xb_ld(&bar[XB_XCNT(j)]); sum += c; cnt += (c > 0u) ? 1u : 0u; mine = (j == x) ? c : mine; }
        if (sum == G) break;
        __builtin_amdgcn_s_sleep(1);
        if ((++sp & 255u) == 0u) { if (xb_ld(&bar[XB_TMO])) break; if (sp > XB_SPIN_CAP) { atomicAdd(&bar[XB_TMO], 1u); break; } }
    }
    nloc = mine > 0u ? mine : 1u; nx = cnt > 0u ? cnt : 1u;
}

__device__ __attribute__((noinline)) void xcd_barrier(const XcdBarrier b) {
    asm volatile("s_waitcnt vmcnt(0)" ::: "memory");
    __syncthreads();
    if (threadIdx.x == 0) {
        unsigned* bar = b.bar;
        __builtin_amdgcn_s_waitcnt(0);
        unsigned nloc = b.st[0], nx = b.st[1];
        if (nloc == 0u) { xcd_barrier_complete(bar, b.x, nloc, nx); b.st[0] = nloc; b.st[1] = nx; }
        const unsigned old = xb_add(&bar[XB_XSUB(b.x)], 1u);
        const unsigned gen = old / nloc;
        if (old + 1u == (gen + 1u) * nloc) {
            __builtin_amdgcn_fence(__ATOMIC_RELEASE, "agent");
            asm volatile("s_waitcnt vmcnt(0)" ::: "memory");
            const unsigned og = xb_add(&bar[XB_TOP], 1u);
            const unsigned tg = og / nx;
            if (og + 1u == (tg + 1u) * nx) xb_add(&bar[XB_TOPGEN], 1u);
            else XB_SPIN(xb_ld(&bar[XB_TOPGEN]) == tg, bar);
            __builtin_amdgcn_fence(__ATOMIC_ACQUIRE, "agent");
            xb_add(&bar[XB_XGEN(b.x)], 1u);
            asm volatile("s_waitcnt vmcnt(0)" ::: "memory");
        } else {
            XB_SPIN(xb_ld(&bar[XB_XGEN(b.x)]) == gen, bar);
            __builtin_amdgcn_fence(__ATOMIC_ACQUIRE, "agent");
            asm volatile("s_waitcnt vmcnt(0)" ::: "memory");
        }
    }
    __syncthreads();
}

struct Args { const float* in[27]; float* out; unsigned char* ws; int ph_lo, ph_hi; };
#define CAS __attribute__((address_space(4)))
typedef const CAS unsigned char* kaptr;
__device__ __forceinline__ kaptr ka_get() { kaptr p = (kaptr)__builtin_amdgcn_kernarg_segment_ptr(); asm volatile("" : "+s"(p)); return p; }
#define KIN(kp, i) (*(const float* const CAS*)((kp) + 8 * (i)))
#define KOUT(kp) (*(float* const CAS*)((kp) + 216))
#define KWS(kp) (*(unsigned char* const CAS*)((kp) + 224))
#define KLO(kp) (*(const int CAS*)((kp) + 232))
#define KHI(kp) (*(const int CAS*)((kp) + 236))
static_assert(sizeof(Args) == 240, "Args layout");

__device__ __forceinline__ int dst_row(int mode, int n) {
    if (mode == 1) {
        const bool qk = (n >= 512 && n < 1536) || (n >= 3072 && n < 3712);
        if (qk) { const int d = n & 63; return (n & ~63) + (d < 32 ? 2 * d : 2 * (d - 32) + 1); }
        return n;
    }
    if (mode == 2) return (n >> 7) * 256 + (n & 127);
    if (mode == 3) return (n >> 7) * 256 + 128 + (n & 127);
    return n;
}
constexpr int TSCR = 64 * 65 * 4;
template <bool NTL>
__device__ __forceinline__ void ti_load(const float* W, int N, int item, int lane, f32x4 (&v)[16]) {
    const int nblk = N / 64, kb = item / nblk, nb = item % nblk, k0 = 64 * kb, n0 = 64 * nb;
    const GAS f32x4* src = (const GAS f32x4*)(W + (size_t)(k0 + (lane >> 4)) * N + n0 + 4 * (lane & 15));
#pragma unroll
    for (int i = 0; i < 16; ++i) v[i] = NTL ? __builtin_nontemporal_load(src + (size_t)i * N) : src[(size_t)i * N];
}
template <bool NTS, bool F8>
__device__ __forceinline__ void ti_store(const f32x4 (&v)[16], int K, int N, bf16* WT, int mode, LAS float* scr, int item, int lane) {
    const int nblk = N / 64, kb = item / nblk, nb = item % nblk, k0 = 64 * kb, n0 = 64 * nb;
    LAS float* wp = scr + (lane >> 4) * 65 + 4 * (lane & 15);
#pragma unroll
    for (int i = 0; i < 16; ++i) { wp[i * 4 * 65 + 0] = v[i].x; wp[i * 4 * 65 + 1] = v[i].y; wp[i * 4 * 65 + 2] = v[i].z; wp[i * 4 * 65 + 3] = v[i].w; }
    LDS_WAIT(); asm volatile("" ::: "memory");
    if constexpr (F8) {
        const int c = lane & 3;
#pragma unroll
        for (int j = 0; j < 4; ++j) { const int n = (lane >> 2) + 16 * j; const LAS float* s = scr + (16 * c) * 65 + n;
            v4u o;
#pragma unroll
            for (int q = 0; q < 4; ++q) o[q] = pg8::cvt4_fp8(256.0f * s[(4 * q) * 65], 256.0f * s[(4 * q + 1) * 65], 256.0f * s[(4 * q + 2) * 65], 256.0f * s[(4 * q + 3) * 65]);
            GAS v4u* dp = (GAS v4u*)((unsigned char*)WT + (size_t)dst_row(mode, n0 + n) * K + k0 + 16 * c); if (NTS) __builtin_nontemporal_store(o, dp); else *dp = o; }
    } else {
        const int c = lane & 7;
#pragma unroll
        for (int j = 0; j < 8; ++j) { const int n = (lane >> 3) + 8 * j; const LAS float* s = scr + (8 * c) * 65 + n;
            v4u o; o.x = pk2(s[0 * 65], s[1 * 65]); o.y = pk2(s[2 * 65], s[3 * 65]); o.z = pk2(s[4 * 65], s[5 * 65]); o.w = pk2(s[6 * 65], s[7 * 65]);
            GAS v4u* dp = (GAS v4u*)(WT + (size_t)dst_row(mode, n0 + n) * K + k0 + 8 * c); if (NTS) __builtin_nontemporal_store(o, dp); else *dp = o; }
    }
    LDS_WAIT(); asm volatile("" ::: "memory");
}
template <bool NT, bool F8 = false, bool NTL = false>
__device__ __forceinline__ void transpose_item(const float* W, int K, int N, bf16* WT, int mode, LAS float* scr, int item, int lane, const float*) {
    f32x4 v[16]; ti_load<NT || NTL>(W, N, item, lane, v); ti_store<NT, F8>(v, K, N, WT, mode, scr, item, lane);
}
__device__ __forceinline__ void p0_prologue(kaptr kp, LAS unsigned char* lds, int vcu, int G, int tid, int lane, int wave) {
    unsigned char* ws = KWS(kp);
    for (int j = vcu; j < 256; j += G) {
        const int l = j >> 7, g = (j >> 5) & 3, k0 = (j & 31) * 64;
        LAS float* As = (LAS float*)lds;
        LAS float* Ps = As + 64 * 132;
        const float* Wsrc = KIN(kp, 8) + (size_t)l * D * INC + (size_t)k0 * INC + g * 128;
        const float* Psrc = KIN(kp, 10) + ((size_t)l * 4 + g) * 128 * 128;
#pragma unroll
        for (int i = 0; i < 4; ++i) { const int idx = tid + 512 * i, r = idx >> 5, c4 = idx & 31; *(LAS f32x4*)(As + r * 132 + 4 * c4) = *(const GAS f32x4*)(Wsrc + (size_t)r * INC + 4 * c4); }
#pragma unroll
        for (int i = 0; i < 8; ++i) { const int idx = tid + 512 * i, r = idx >> 5, c4 = idx & 31; *(LAS f32x4*)(Ps + r * 132 + 4 * c4) = *(const GAS f32x4*)(Psrc + (size_t)r * 128 + 4 * c4); }
        __syncthreads();
        const int n4 = tid & 31, kq = tid >> 5;
        f32x4 acc[4];
#pragma unroll
        for (int i = 0; i < 4; ++i) acc[i] = (f32x4){0.f, 0.f, 0.f, 0.f};
#pragma unroll 4
        for (int c = 0; c < 128; ++c) { const f32x4 pv = *(const LAS f32x4*)(Ps + c * 132 + 4 * n4);
#pragma unroll
            for (int i = 0; i < 4; ++i) acc[i] += As[(4 * kq + i) * 132 + c] * pv; }
        bf16* WT = (bf16*)(ws + WS_WIN) + (size_t)l * INC * D;
#pragma unroll
        for (int e = 0; e < 4; ++e) { v2u o; o.x = pk2(acc[0][e], acc[1][e]); o.y = pk2(acc[2][e], acc[3][e]);
            *(GAS v2u*)(WT + (size_t)(g * 128 + 4 * n4 + e) * D + k0 + 4 * kq) = o; }
        __syncthreads();
    }
    for (int j = vcu; j < 192; j += G) {
        const int l = j / 96, n0 = (j % 96) * 128;
        LAS float* S = (LAS float*)lds; LAS float* red = S + 5 * 2048;
        for (int idx = tid; idx < 5 * 2048; idx += NWAVES * 64) { const int i = idx >> 11, k = idx & 2047; const float v = i < 4 ? KIN(kp, 1)[i * 2048 + k] : KIN(kp, 3)[k]; S[idx] = v / (1.0f + expf(-v)); }
        __syncthreads();
        f32x4 acc[5];
#pragma unroll
        for (int i = 0; i < 5; ++i) acc[i] = (f32x4){0.f, 0.f, 0.f, 0.f};
        const int kh = lane >> 5;
        const GAS f32x4* wp = (const GAS f32x4*)(KIN(kp, 4) + ((size_t)l * 2048 + wave * 256 + kh) * MODN + n0 + 4 * (lane & 31));
#pragma unroll 8
        for (int k = 0; k < 128; ++k) { const f32x4 w = __builtin_nontemporal_load(wp + (size_t)k * (2 * MODN / 4));
#pragma unroll
            for (int i = 0; i < 5; ++i) acc[i] += S[i * 2048 + wave * 256 + 2 * k + kh] * w; }
#pragma unroll
        for (int i = 0; i < 5; ++i) { f32x4 t = acc[i]; t.x += __shfl_xor(t.x, 32); t.y += __shfl_xor(t.y, 32); t.z += __shfl_xor(t.z, 32); t.w += __shfl_xor(t.w, 32);
            if (kh == 0) *(LAS f32x4*)(red + (wave * 5 + i) * 128 + 4 * (lane & 31)) = t; }
        __syncthreads();
        for (int idx = tid; idx < 640; idx += NWAVES * 64) { const int i = idx >> 7, n = idx & 127; float s = 0.f;
#pragma unroll
            for (int w = 0; w < 8; ++w) s += red[(w * 5 + i) * 128 + n];
            ((float*)(ws + WS_MOD))[(l * 5 + i) * MODN + n0 + n] = s + KIN(kp, 5)[l * MODN + n0 + n]; }
        __syncthreads();
    }
    if (vcu == (200 % G)) {
        for (int idx = tid; idx < 1024; idx += NWAVES * 64) { const int pos = idx >> 4, f = idx & 15; const float inv = powf(10000.0f, -(float)f / 16.0f); const float ang = (float)pos * inv;
            ((float*)(ws + WS_ROPE))[idx] = cosf(ang); ((float*)(ws + WS_ROPE))[1024 + idx] = sinf(ang); }
    }
    __syncthreads();
    LAS float* scr = (LAS float*)(lds + wave * TSCR);
    constexpr int I_IN = 32 * 52, I_OUT = 32 * 32, I_UP = 32 * 88, I_DN = 88 * 32;
    constexpr int NITEMS = 2 * I_IN + 2 * I_OUT + 2 * I_UP + I_DN;
    unsigned* q0 = (unsigned*)(ws + WS_CTL) + CW_Q0;
#define P0_DESC(it_, W_, K_, N_, WT_, M_, I_, F_) do { int r = (it_); F_ = false; \
        if (r < 2 * I_IN) { const int l = r / I_IN; W_ = KIN(kp, 8) + (size_t)l * D * INC; K_ = D; N_ = INC; WT_ = (bf16*)(ws + WS_WIN) + (size_t)l * INC * D; M_ = 1; const int q = r % I_IN; I_ = (q / 52) * 60 + 8 + (q % 52); } \
        else if ((r -= 2 * I_IN) < 2 * I_OUT) { const int l = r / I_OUT; W_ = KIN(kp, 9) + (size_t)l * D * D; K_ = D; N_ = D; WT_ = (bf16*)(ws + WS_WOUT) + (size_t)l * D * D; M_ = 0; I_ = r % I_OUT; } \
        else if ((r -= 2 * I_OUT) < I_UP) { W_ = KIN(kp, 19); K_ = D; N_ = DFF; WT_ = (bf16*)(ws + WS_W13); M_ = 2; I_ = r; F_ = DENSE_UP_F8; } \
        else if ((r -= I_UP) < I_UP) { W_ = KIN(kp, 20); K_ = D; N_ = DFF; WT_ = (bf16*)(ws + WS_W13); M_ = 3; I_ = r; F_ = DENSE_UP_F8; } \
        else { r -= I_UP; W_ = KIN(kp, 21); K_ = DFF; N_ = D; WT_ = (bf16*)(ws + WS_W2); M_ = 0; I_ = r; F_ = DENSE_DN_F8; } } while (0)
    for (;;) {
        unsigned k0 = 0; if (lane == 0) k0 = __hip_atomic_fetch_add(q0, 2u, RLX_AGENT);
        const int kb = (int)__builtin_amdgcn_readfirstlane(k0); if (kb >= NITEMS) break;
        const float* Wa; int Ka, Na, ma, ia; bf16* WTa; bool fa; f32x4 va[16];
        P0_DESC(kb, Wa, Ka, Na, WTa, ma, ia, fa); ti_load<true>(Wa, Na, ia, lane, va);
        const bool two = kb + 1 < NITEMS;
        const float* Wb = Wa; int Kb = Ka, Nb = Na, mb = ma, ib = ia; bf16* WTb = WTa; bool fb = fa; f32x4 vb[16];
        if (two) { P0_DESC(kb + 1, Wb, Kb, Nb, WTb, mb, ib, fb); ti_load<true>(Wb, Nb, ib, lane, vb); }
        if (fa) ti_store<false, true>(va, Ka, Na, WTa, ma, scr, ia, lane); else ti_store<false, false>(va, Ka, Na, WTa, ma, scr, ia, lane);
        if (two) { if (fb) ti_store<false, true>(vb, Kb, Nb, WTb, mb, scr, ib, lane); else ti_store<false, false>(vb, Kb, Nb, WTb, mb, scr, ib, lane); }
    }
#undef P0_DESC
}

__device__ __attribute__((noinline)) void fill_tail(unsigned char* ws, const float* w1, const float* w3, const float* w2, unsigned* done, int G, int nw) {
    extern __shared__ __attribute__((aligned(16))) unsigned char lds_fill[];
    LAS unsigned char* lds = (LAS unsigned char*)lds_fill;
    const int tid = threadIdx.x, lane = tid & 63, wave = __builtin_amdgcn_readfirstlane(tid >> 6);
    volatile LAS unsigned* flag = (volatile LAS unsigned*)(lds + FLAG_OFF);
    __syncthreads();
    if (tid == 0) { unsigned f = 0u; if (done) { const unsigned old = __hip_atomic_fetch_add(done, 1u, RLX_AGENT); f = (old + 1u >= (unsigned)G) ? 1u : 0u; } *flag = f; }
    __syncthreads();
    LAS float* scr = (LAS float*)(lds + wave * TSCR);
    unsigned* q1 = (unsigned*)(ws + WS_CTL) + CW_Q1;
    constexpr int I_UP = 32 * 88, NIT = 24 * I_UP;
#ifndef FILLW
#define FILLW 2
#endif
#ifndef FILLB
#define FILLB 4
#endif
#ifdef PROBE_BURN
    if (done && wave >= FILLW) {
        f32x16 acc; for (int r = 0; r < 16; ++r) acc[r] = 0.f; const bf16x8 a = (bf16x8){1, 2, 3, 4, 5, 6, 7, 8};
        while (!*flag) { for (int it = 0; it < 64; ++it) acc = __builtin_amdgcn_mfma_f32_32x32x16_bf16(a, a, acc, 0, 0, 0); if (__hip_atomic_load(done, RLX_AGENT) >= (unsigned)G) break; }
        if (acc[0] == 12345.f) *flag = 2u;
        return; }
#endif
    if (done && wave >= nw) return;
#define FILL_ITEM(it_) do { const int it__ = (it_); const int seg = it__ / I_UP, item = it__ % I_UP, mat = seg >> 3, e = seg & 7; \
        if (mat == 0) transpose_item<true, MOE_F8>(w1 + (size_t)e * D * DFF, D, DFF, (bf16*)(ws + WS_MW13 + (size_t)e * 2 * DFF * D * (MOE_F8 ? 1 : 2)), 2, scr, item, lane, nullptr); \
        else if (mat == 1) transpose_item<true, MOE_F8>(w3 + (size_t)e * D * DFF, D, DFF, (bf16*)(ws + WS_MW13 + (size_t)e * 2 * DFF * D * (MOE_F8 ? 1 : 2)), 3, scr, item, lane, nullptr); \
        else transpose_item<true, MOE_F8>(w2 + (size_t)e * DFF * D, DFF, D, (bf16*)(ws + WS_MW2 + (size_t)e * D * DFF * (MOE_F8 ? 1 : 2)), 0, scr, item, lane, nullptr); } while (0)
    if (!done) return;
    for (;;) {
        if (*flag) break;
        if (tid == 0) { if (__hip_atomic_load(done, RLX_AGENT) >= (unsigned)G) *flag = 1u; }
        if (*flag) break;
        unsigned k0 = 0; if (lane == 0) k0 = __hip_atomic_fetch_add(q1, (unsigned)FILLB, RLX_AGENT);
        const int kb = (int)__builtin_amdgcn_readfirstlane(k0); if (kb >= NIT) break;
        for (int it = kb; it < kb + FILLB && it < NIT; ++it) FILL_ITEM(it);
    }
#undef FILL_ITEM
}

__device__ __forceinline__ void drain_tail(unsigned char* ws, const float* w1, const float* w3, const float* w2, int G, LAS unsigned char* lds) {
    int tid = threadIdx.x; asm volatile("" : "+v"(tid));
    const int lane = tid & 63, wave = __builtin_amdgcn_readfirstlane(tid >> 6);
    __syncthreads();
    LAS float* scr = (LAS float*)(lds + wave * TSCR);
    unsigned* q1 = (unsigned*)(ws + WS_CTL) + CW_Q1;
    constexpr int I_UP = 32 * 88, NIT = 24 * I_UP;
        const int h = (int)__builtin_amdgcn_readfirstlane(__hip_atomic_load(q1, RLX_AGENT));
        const int gwv = blockIdx.x * NWAVES + wave, ngw = G * NWAVES;
#define MOE_DESC(it_, W_, K_, N_, WT_, M_, I_) do { const int seg_ = (it_) / I_UP, mat_ = seg_ >> 3, e_ = seg_ & 7; I_ = (it_) % I_UP; \
        if (mat_ == 0) { W_ = w1 + (size_t)e_ * D * DFF; K_ = D; N_ = DFF; WT_ = (bf16*)(ws + WS_MW13 + (size_t)e_ * 2 * DFF * D * (MOE_F8 ? 1 : 2)); M_ = 2; } \
        else if (mat_ == 1) { W_ = w3 + (size_t)e_ * D * DFF; K_ = D; N_ = DFF; WT_ = (bf16*)(ws + WS_MW13 + (size_t)e_ * 2 * DFF * D * (MOE_F8 ? 1 : 2)); M_ = 3; } \
        else { W_ = w2 + (size_t)e_ * DFF * D; K_ = DFF; N_ = D; WT_ = (bf16*)(ws + WS_MW2 + (size_t)e_ * D * DFF * (MOE_F8 ? 1 : 2)); M_ = 0; } } while (0)
        int it = h + gwv;
        if (it < NIT) {
            const float* W; int K, N, md, item; bf16* WT; f32x4 v[16];
            MOE_DESC(it, W, K, N, WT, md, item); ti_load<true>(W, N, item, lane, v);
            for (;;) {
                const int nx = it + ngw; const float* Wn = W; int Kn = K, Nn = N, mdn = md, itemn = item; bf16* WTn = WT; f32x4 vn[16];
                const bool more = nx < NIT;
                if (more) { MOE_DESC(nx, Wn, Kn, Nn, WTn, mdn, itemn); ti_load<true>(Wn, Nn, itemn, lane, vn); }
                ti_store<true, MOE_F8>(v, K, N, WT, md, scr, item, lane);
                if (!more) break;
#pragma unroll
                for (int i = 0; i < 16; ++i) v[i] = vn[i];
                it = nx; W = Wn; K = Kn; N = Nn; WT = WTn; md = mdn; item = itemn;
            }
        }
#undef MOE_DESC
}

template <class Epi, class Ord>
__device__ __forceinline__ void combine_tail(const Epi& E, const Ord& S, const float* slab, unsigned* tickets, LAS unsigned char* lds) {
    int tt; pg8::Unit tu;
    if (!S.tail_unit(tt, tu)) return;
    int tid = threadIdx.x; asm volatile("" : "+v"(tid));
    const int lane = tid & 63, wid = __builtin_amdgcn_readfirstlane(tid >> 6), wr = wid >> 2, wc = wid & 3, fr = lane & 15, fq = lane >> 4;
    volatile LAS unsigned* flag = (volatile LAS unsigned*)(lds + FLAG_OFF);
    asm volatile("s_waitcnt vmcnt(0)" ::: "memory");
    __syncthreads();
    if (tid == 0) {
        __builtin_amdgcn_fence(__ATOMIC_RELEASE, "agent");
        asm volatile("s_waitcnt vmcnt(0)" ::: "memory");
        const unsigned t = __hip_atomic_fetch_add(tickets + 64 * tt, 1u, RLX_AGENT);
        const bool last = (t == (unsigned)S.tp.S - 1u);
        if (last) { __builtin_amdgcn_fence(__ATOMIC_ACQUIRE, "agent"); asm volatile("s_waitcnt vmcnt(0)" ::: "memory"); }
        *flag = last ? 1u : 0u;
    }
    __syncthreads();
    if (*flag) {
        const int ns = S.tp.S;
        const GAS pg8::f32x4* sp = (const GAS pg8::f32x4*)slab + (size_t)(tt * ns) * (32 * 512) + tid;
        pg8::f32x4 acc[2][2][4][2];
#pragma unroll
        for (int ai = 0; ai < 2; ++ai)
#pragma unroll
            for (int bj = 0; bj < 2; ++bj)
#pragma unroll
                for (int m = 0; m < 4; ++m)
#pragma unroll
                    for (int n = 0; n < 2; ++n) { const int r = (((ai * 2 + bj) * 4 + m) * 2) + n; pg8::f32x4 a = sp[(size_t)r * 512];
                        for (int ks = 1; ks < ns; ++ks) a += sp[(size_t)ks * (32 * 512) + (size_t)r * 512];
                        acc[ai][bj][m][n] = a; }
        E(acc, tu, wr, wc, fr, fq);
    }
    __syncthreads();
}

template <bool ROUTE, bool F8 = false>
__device__ __forceinline__ void norm_rows(const float* srcC, const float* srcL, const float* gain, const float* shift, const float* scale, bf16* XN, int row_lo, int row_hi, int gw, int NGW, int lane,
                                          const LAS float* rt, unsigned* cnt, int* route) {
    f32x4 vn[8];
    { const int row = row_lo + gw; if (row < row_hi) { const GAS f32x4* xr = (const GAS f32x4*)((row < RC ? srcC : srcL) + (size_t)row * D) + lane;
#pragma unroll
        for (int j = 0; j < 8; ++j) vn[j] = xr[64 * j]; } }
    unsigned pk[8]; int pe1 = 0, pe2 = 0, ps1 = 0, ps2 = 0, prow = 0; float pw1 = 0.f, pw2 = 0.f; bool have = false;
#define ROUTE_FLUSH() do { if constexpr (ROUTE && F8) { \
        if (lane == 0) { int* rec = route + (size_t)(prow - RC) * 8; rec[0] = pe1; rec[1] = ps1; rec[2] = __builtin_bit_cast(int, pw1); rec[3] = pe2; rec[4] = ps2; rec[5] = __builtin_bit_cast(int, pw2); } \
        const int e1_ = __builtin_amdgcn_readfirstlane(pe1), e2_ = __builtin_amdgcn_readfirstlane(pe2), s1_ = __builtin_amdgcn_readfirstlane(ps1), s2_ = __builtin_amdgcn_readfirstlane(ps2); \
        GAS unsigned* d1 = (GAS unsigned*)((unsigned char*)XN + ((size_t)e1_ * 8192 + s1_) * D) + lane; GAS unsigned* d2 = (GAS unsigned*)((unsigned char*)XN + ((size_t)e2_ * 8192 + s2_) * D) + lane; \
        _Pragma("unroll") for (int j = 0; j < 8; ++j) { d1[64 * j] = pk[j]; d2[64 * j] = pk[j]; } } } while (0)
    f32x4 gg[8];
#pragma unroll
    for (int j = 0; j < 8; ++j) gg[j] = ((const GAS f32x4*)gain + lane)[64 * j];
    for (int row = row_lo + gw; row < row_hi; row += NGW) {
        const int bidx = row < RC ? 4 : ((row - RC) >> 11);
        f32x4 v[8]; float ss = 0.f;
        f32x4 shh[8], scc[8];
        { const GAS f32x4* sh4 = (const GAS f32x4*)(shift + bidx * MODN) + lane; const GAS f32x4* sc4 = (const GAS f32x4*)(scale + bidx * MODN) + lane;
#pragma unroll
          for (int j = 0; j < 8; ++j) { shh[j] = sh4[64 * j]; scc[j] = sc4[64 * j]; } }
        asm volatile("" ::: "memory");
#pragma unroll
        for (int j = 0; j < 8; ++j) { v[j] = vn[j]; ss += (v[j].x * v[j].x + v[j].y * v[j].y) + (v[j].z * v[j].z + v[j].w * v[j].w); }
        { const int nrow = row + NGW; if (nrow < row_hi) { const GAS f32x4* xr = (const GAS f32x4*)((nrow < RC ? srcC : srcL) + (size_t)nrow * D) + lane;
#pragma unroll
            for (int j = 0; j < 8; ++j) vn[j] = xr[64 * j]; } }
        const float rstd = 1.0f / sqrtf(wave_sum(ss) * (1.0f / D) + EPS);
        GAS unsigned long long* o8 = (GAS unsigned long long*)(XN + (size_t)row * D) + lane; GAS unsigned* o4 = (GAS unsigned*)((unsigned char*)XN + (size_t)row * D) + lane;
#pragma unroll
        for (int j = 0; j < 8; ++j) { v[j] = (v[j] * rstd * gg[j]) * (1.0f + scc[j]) + shh[j];
            if constexpr (ROUTE) {}
            else if constexpr (F8) o4[64 * j] = pg8::cvt4_fp8(v[j].x, v[j].y, v[j].z, v[j].w);
            else o8[64 * j] = (unsigned long long)pk2(v[j].x, v[j].y) | ((unsigned long long)pk2(v[j].z, v[j].w) << 32); }
        if (ROUTE) {
            float lg[8];
#pragma unroll
            for (int e = 0; e < 8; ++e) lg[e] = 0.f;
#pragma unroll
            for (int j = 0; j < 8; ++j)
#pragma unroll
                for (int q = 0; q < 4; ++q) { const int k = 256 * j + 4 * lane + q; const LAS f32x4* rp = (const LAS f32x4*)(rt + k * 8); const f32x4 r0 = rp[0], r1 = rp[1]; const float f = v[j][q];
                    lg[0] += f * r0.x; lg[1] += f * r0.y; lg[2] += f * r0.z; lg[3] += f * r0.w; lg[4] += f * r1.x; lg[5] += f * r1.y; lg[6] += f * r1.z; lg[7] += f * r1.w;
                    if (q == 3) asm volatile("" ::: "memory"); }
#pragma unroll
            for (int e = 0; e < 8; ++e) lg[e] = wave_sum(lg[e]);
            int i1 = 0; float v1 = lg[0];
#pragma unroll
            for (int e = 1; e < 8; ++e) if (lg[e] > v1) { v1 = lg[e]; i1 = e; }
            int i2 = -1; float v2 = -INFINITY;
#pragma unroll
            for (int e = 0; e < 8; ++e) if (e != i1 && lg[e] > v2) { v2 = lg[e]; i2 = e; }
            const float w1 = 1.0f / (1.0f + expf(v2 - v1)), w2 = 1.0f - w1;
            if (have) ROUTE_FLUSH();
            ps1 = 0; ps2 = 0;
            if (lane == 0) { ps1 = (int)__hip_atomic_fetch_add(cnt + 64 * i1, 1u, RLX_AGENT); ps2 = (int)__hip_atomic_fetch_add(cnt + 64 * i2, 1u, RLX_AGENT); }
            pe1 = i1; pe2 = i2; pw1 = w1; pw2 = w2; prow = row; have = true;
#pragma unroll
            for (int j = 0; j < 8; ++j) pk[j] = pg8::cvt4_fp8(v[j].x, v[j].y, v[j].z, v[j].w);
        }
    }
    if (ROUTE) { if (have) ROUTE_FLUSH(); }
#undef ROUTE_FLUSH
}

struct TileSpec { int nband, band_row0, ctx_row0, nt; };
__device__ __forceinline__ int crow(int r, int hi) { return (r & 3) + 8 * (r >> 2) + 4 * hi; }
template <int NKC, int DVB, bool WIN>
__device__ __forceinline__ void attn_core(LAS unsigned char* lds, const bf16* P, const bf16x8 (&qr)[4], int kcol, int vcol, int kofs, const TileSpec ts, int qpos, int bandpos0,
                                          f32x16 (&o)[DVB], f32x16& ol, float& mref_out, int tid, int lane) {
    constexpr int SB = NKC * 1024 + DVB * 4096, NK = NKC / 8, NV = DVB / 2;
    constexpr float THR = 8.0f;
    const int r32 = lane & 31, hi = lane >> 5, wv = __builtin_amdgcn_readfirstlane(tid >> 6);
    int koff[NK], voff[NV];
#pragma unroll
    for (int i = 0; i < NK; ++i) { const int q = tid + 512 * i, key = q / NKC, s = q % NKC; koff[i] = key * INC + kcol + (s ^ (NKC == 16 ? (key & 15) : ((key >> 1) & 7))) * 8; }
#pragma unroll
    for (int i = 0; i < NV; ++i) { const int q = tid + 512 * i; voff[i] = (((q >> 6) & 3) * 16 + ((q >> 2) & 15)) * INC + vcol + (q >> 8) * 32 + (q & 3) * 8; }
#define ATT_DMA(t_, s_) do { const int t__ = (t_); const int rb_ = t__ < ts.nband ? ts.band_row0 + 64 * t__ : ts.ctx_row0 + 64 * (t__ - ts.nband); const bf16* tb_ = P + (size_t)rb_ * INC; \
        _Pragma("unroll") for (int i_ = 0; i_ < NK; ++i_) __builtin_amdgcn_global_load_lds((const unsigned*)(tb_ + koff[i_]), (LAS unsigned*)(lds + (s_) * SB + (wv * 64 + 512 * i_) * 16), 16, 0, 0); \
        _Pragma("unroll") for (int i_ = 0; i_ < NV; ++i_) __builtin_amdgcn_global_load_lds((const unsigned*)(tb_ + voff[i_]), (LAS unsigned*)(lds + (s_) * SB + NKC * 1024 + (wv * 64 + 512 * i_) * 16), 16, 0, 0); } while (0)
    float mref = 0.f;
    f32x16 negm;
#pragma unroll
    for (int r = 0; r < 16; ++r) { negm[r] = 0.f; ol[r] = 0.f; }
#pragma unroll
    for (int d0 = 0; d0 < DVB; ++d0)
#pragma unroll
        for (int r = 0; r < 16; ++r) o[d0][r] = 0.f;
    const short one = (r32 == 0) ? (short)0x3F80 : (short)0;
    const bf16x8 onesf = (bf16x8){one, one, one, one, one, one, one, one};
    ATT_DMA(0, 0); asm volatile("s_waitcnt vmcnt(0)" ::: "memory"); __syncthreads();
#pragma unroll 1
    for (int t = 0; t < ts.nt; ++t) {
        if (t + 1 < ts.nt) ATT_DMA(t + 1, (t + 1) & 1);
        LAS unsigned char* sb = lds + (t & 1) * SB;
        f32x16 p0, p1;
        { const LAS unsigned char* kb = sb + r32 * (NKC * 16);
#pragma unroll
          for (int d0 = 0; d0 < 4; ++d0) { const int so = ((kofs + 2 * d0 + hi) ^ (NKC == 16 ? (r32 & 15) : ((r32 >> 1) & 7))) * 16; const bf16x8 b0 = *(const LAS bf16x8*)(kb + so), b1 = *(const LAS bf16x8*)(kb + 32 * (NKC * 16) + so);
              if (d0 == 0) { p0 = __builtin_amdgcn_mfma_f32_32x32x16_bf16(b0, qr[0], negm, 0, 0, 0); p1 = __builtin_amdgcn_mfma_f32_32x32x16_bf16(b1, qr[0], negm, 0, 0, 0); }
              else { p0 = __builtin_amdgcn_mfma_f32_32x32x16_bf16(b0, qr[d0], p0, 0, 0, 0); p1 = __builtin_amdgcn_mfma_f32_32x32x16_bf16(b1, qr[d0], p1, 0, 0, 0); } } }
        if (WIN) { if (t < ts.nband) { const int kp0 = bandpos0 + 64 * t + 4 * hi;
#pragma unroll
            for (int r = 0; r < 16; ++r) { const int dlt = qpos - (kp0 + (r & 3) + 8 * (r >> 2)); if (dlt > 128 || dlt < -128) p0[r] = -1e30f; if (dlt - 32 > 128 || dlt - 32 < -128) p1[r] = -1e30f; } } }
        float rm = fmaxf(fmaxf(p0[0], p0[1]), p1[0]);
#pragma unroll
        for (int r = 1; r < 16; ++r) rm = fmaxf(fmaxf(rm, p0[r]), p1[r]);
        rm = fmaxf(rm, p0[1]);
        rm = fmaxf(rm, __shfl_xor(rm, 32));
        if (t == 0 || __any(rm > THR)) {
            const float dl = t == 0 ? rm : fmaxf(rm, 0.f);
            mref += dl;
#pragma unroll
            for (int r = 0; r < 16; ++r) { p0[r] -= dl; p1[r] -= dl; negm[r] = -mref; }
            if (t != 0) { const float f = __builtin_amdgcn_exp2f(-dl);
#pragma unroll
                for (int r = 0; r < 16; ++r) { const float fr = __shfl(f, crow(r, hi)); ol[r] *= fr;
#pragma unroll
                    for (int d0 = 0; d0 < DVB; ++d0) o[d0][r] *= fr; } }
        }
#pragma unroll
        for (int r = 0; r < 16; ++r) { p0[r] = __builtin_amdgcn_exp2f(p0[r]); p1[r] = __builtin_amdgcn_exp2f(p1[r]); }
        v4u pw[4];
#pragma unroll
        for (int i = 0; i < 4; ++i) { pw[0][i] = pg8::cvt_pk_bf16(p0[2 * i], p0[2 * i + 1]); pw[1][i] = pg8::cvt_pk_bf16(p0[8 + 2 * i], p0[8 + 2 * i + 1]); pw[2][i] = pg8::cvt_pk_bf16(p1[2 * i], p1[2 * i + 1]); pw[3][i] = pg8::cvt_pk_bf16(p1[8 + 2 * i], p1[8 + 2 * i + 1]); }
        { const LAS unsigned char* vb = sb + NKC * 1024 + ((lane >> 4) & 1) * 32 + (lane & 3) * 8 + (4 * hi + ((lane & 15) >> 2)) * 64;
#pragma unroll
          for (int d0 = 0; d0 < DVB; ++d0)
#pragma unroll
              for (int ks = 0; ks < 4; ++ks) {
                  const v4i16_t lo = __builtin_amdgcn_ds_read_tr16_b64_v4i16((LAS v4i16_t*)(vb + d0 * 4096 + ks * 1024)), hh = __builtin_amdgcn_ds_read_tr16_b64_v4i16((LAS v4i16_t*)(vb + d0 * 4096 + ks * 1024 + 512));
                  const bf16x8 vf = (bf16x8){lo[0], lo[1], lo[2], lo[3], hh[0], hh[1], hh[2], hh[3]};
                  o[d0] = __builtin_amdgcn_mfma_f32_32x32x16_bf16(__builtin_bit_cast(bf16x8, pw[ks]), vf, o[d0], 0, 0, 0);
                  if (ks == 3) asm volatile("" ::: "memory"); }
#pragma unroll
          for (int ks = 0; ks < 4; ++ks) ol = __builtin_amdgcn_mfma_f32_32x32x16_bf16(__builtin_bit_cast(bf16x8, pw[ks]), onesf, ol, 0, 0, 0); }
        asm volatile("s_waitcnt vmcnt(0)" ::: "memory");
        __syncthreads();
    }
#undef ATT_DMA
    mref_out = mref;
}
template <int DVB>
__device__ __forceinline__ void attn_normalize(f32x16 (&o)[DVB], const f32x16& ol, float extra, int hi) {
#pragma unroll
    for (int r = 0; r < 16; ++r) { const float l = __shfl(ol[r], hi << 5) + __shfl(extra, crow(r, hi)); const float ir = 1.0f / l;
#pragma unroll
        for (int d0 = 0; d0 < DVB; ++d0) o[d0][r] *= ir; }
}

__device__ __forceinline__ void win_unit(LAS unsigned char* lds, const bf16* P, bf16* MIX, const float* sink, int b, int g, int qb, bool ctxq, int tid, int lane, int wave) {
    const int r32 = lane & 31, hi = lane >> 5, hr = wave >> 1, sub = (wave & 1) * 32;
    TileSpec ts; int qrow0, qpos = 0, bandpos0 = 0;
    if (!ctxq) { const int tl = qb - 2 < 0 ? 0 : qb - 2, th = qb + 2 > 31 ? 31 : qb + 2; ts.nband = th - tl + 1; ts.band_row0 = RC + b * SEQ + tl * 64; bandpos0 = tl * 64; ts.ctx_row0 = b * CTX; ts.nt = ts.nband + 4;
        qrow0 = RC + b * SEQ + qb * 64 + sub; qpos = qb * 64 + sub + r32; }
    else { ts.nband = 0; ts.band_row0 = 0; ts.ctx_row0 = b * CTX; ts.nt = 4; qrow0 = b * CTX + qb * 64 + sub; }
    const int qcol = 3072 + g * 256 + hr * 64;
    bf16x8 qr[4];
#pragma unroll
    for (int d0 = 0; d0 < 4; ++d0) qr[d0] = *(const GAS bf16x8*)(P + (size_t)(qrow0 + r32) * INC + qcol + d0 * 16 + hi * 8);
    f32x16 o[2], ol; float mref;
    attn_core<8, 2, true>(lds, P, qr, 3584 + g * 64, 3712 + g * 64, 0, ts, qpos, bandpos0, o, ol, mref, tid, lane);
    attn_normalize<2>(o, ol, __builtin_amdgcn_exp2f(sink[g * 4 + hr] * LOG2E - mref), hi);
#pragma unroll
    for (int r = 0; r < 16; ++r) { bf16* op = MIX + (size_t)(qrow0 + crow(r, hi)) * D + 1536 + (g * 4 + hr) * 64 + r32;
#pragma unroll
        for (int d0 = 0; d0 < 2; ++d0) op[d0 * 32] = (bf16)f2bf(o[d0][r]); }
}

__device__ __forceinline__ void diff_unit(LAS unsigned char* lds, const bf16* P, bf16* MIX, const float* dlam, const float* subln, float lam_init, int b, int h, int qb, bool ctxq, int tid, int lane, int wave) {
    const int r32 = lane & 31, hi = lane >> 5, m = wave >> 2, sub = (wave & 3) * 32;
    TileSpec ts; int qrow0;
    if (!ctxq) { ts.nband = 32; ts.band_row0 = RC + b * SEQ; ts.ctx_row0 = b * CTX; ts.nt = 36; qrow0 = RC + b * SEQ + qb * 128 + sub; }
    else { ts.nband = 0; ts.band_row0 = 0; ts.ctx_row0 = b * CTX; ts.nt = 4; qrow0 = b * CTX + qb * 128 + sub; }
    const int qcol = 512 + h * 128 + m * 64;
    bf16x8 qr[4];
#pragma unroll
    for (int d0 = 0; d0 < 4; ++d0) qr[d0] = *(const GAS bf16x8*)(P + (size_t)(qrow0 + r32) * INC + qcol + d0 * 16 + hi * 8);
    const float lam = expf(wave_sum(dlam[lane] * dlam[64 + lane])) - expf(wave_sum(dlam[128 + lane] * dlam[192 + lane])) + lam_init;
    f32x16 o[4], ol; float mref;
    attn_core<16, 4, false>(lds, P, qr, 1024 + h * 128, 1536 + h * 128, m * 8, ts, 0, 0, o, ol, mref, tid, lane);
    attn_normalize<4>(o, ol, 0.f, hi);
    LAS float* ex = (LAS float*)lds + (wave & 3) * 4096;
    if (m == 1) {
#pragma unroll
        for (int d0 = 0; d0 < 4; ++d0)
#pragma unroll
            for (int r = 0; r < 16; ++r) ex[(d0 * 16 + r) * 64 + lane] = o[d0][r];
    }
    __syncthreads();
    if (m == 0) {
        float sl[4];
#pragma unroll
        for (int d0 = 0; d0 < 4; ++d0) sl[d0] = subln[d0 * 32 + r32] * (1.0f - lam_init);
#pragma unroll
        for (int r = 0; r < 16; ++r) {
            float ss = 0.f;
#pragma unroll
            for (int d0 = 0; d0 < 4; ++d0) { const float v = o[d0][r] - lam * ex[(d0 * 16 + r) * 64 + lane]; o[d0][r] = v; ss += v * v; }
            asm volatile("" ::: "memory");
#pragma unroll
            for (int off = 1; off < 32; off <<= 1) ss += __shfl_xor(ss, off);
            const float rstd = 1.0f / sqrtf(ss * (1.0f / 128.0f) + EPS);
            bf16* op = MIX + (size_t)(qrow0 + crow(r, hi)) * D + 512 + h * 128 + r32;
#pragma unroll
            for (int d0 = 0; d0 < 4; ++d0) op[d0 * 32] = (bf16)f2bf(o[d0][r] * rstd * sl[d0]);
        }
    }
    __syncthreads();
}

__device__ __forceinline__ void sgu_unit(LAS unsigned char* lds, const bf16* P, bf16* MIX, const float* ln_g, const float* ln_b, const float* Ws, const float* bs, int row0, int g, int tid, int lane, int wave) {
    constexpr int VS = 136;
    LAS bf16* VT = (LAS bf16*)lds;
    const int r32 = lane & 31, hi = lane >> 5;
    { const int tq = lane >> 4, j = lane & 15;
      v4u raws[4][4];
#pragma unroll
      for (int ps = 0; ps < 4; ++ps)
#pragma unroll
          for (int q = 0; q < 4; ++q) raws[ps][q] = *(const GAS v4u*)(P + (size_t)(row0 + wave * 16 + ps * 4 + tq) * INC + 2560 + (j + 16 * q) * 8);
      float lg8[8], lb8[8];
#pragma unroll
      for (int e = 0; e < 8; ++e) { lg8[e] = ln_g[g * 128 + 8 * j + e]; lb8[e] = ln_b[g * 128 + 8 * j + e]; }
#pragma unroll
      for (int ps = 0; ps < 4; ++ps) {
          float x[4][8]; float s = 0.f;
#pragma unroll
          for (int q = 0; q < 4; ++q)
#pragma unroll
              for (int e = 0; e < 4; ++e) { x[q][2 * e] = bf2f((unsigned short)(raws[ps][q][e] & 0xffffu)); x[q][2 * e + 1] = bf2f((unsigned short)(raws[ps][q][e] >> 16)); s += x[q][2 * e] + x[q][2 * e + 1]; }
#pragma unroll
          for (int off = 1; off < 16; off <<= 1) s += __shfl_xor(s, off);
          const float mean = s * (1.0f / 512.0f); float s2 = 0.f;
#pragma unroll
          for (int q = 0; q < 4; ++q)
#pragma unroll
              for (int e = 0; e < 8; ++e) { x[q][e] -= mean; s2 += x[q][e] * x[q][e]; }
#pragma unroll
          for (int off = 1; off < 16; off <<= 1) s2 += __shfl_xor(s2, off);
          const float rstd = 1.0f / sqrtf(s2 * (1.0f / 512.0f) + EPS);
          const int qtok = wave * 16 + ps * 4 + tq;
#pragma unroll
          for (int e = 0; e < 8; ++e) { const float xv = g == 0 ? x[0][e] : (g == 1 ? x[1][e] : (g == 2 ? x[2][e] : x[3][e])); VT[(8 * j + e) * VS + qtok] = (bf16)f2bf(xv * rstd * lg8[e] + lb8[e]); }
      }
    }
    __syncthreads();
    const int pb = wave & 3, ch = wave >> 2;
    f32x16 acc[2];
#pragma unroll
    for (int cb = 0; cb < 2; ++cb)
#pragma unroll
        for (int r = 0; r < 16; ++r) acc[cb][r] = 0.f;
    unsigned short uu[16][2]; float bias[16];
#pragma unroll
    for (int r = 0; r < 16; ++r) { const int p = pb * 32 + crow(r, hi); bias[r] = bs[g * 128 + p];
#pragma unroll
        for (int cb = 0; cb < 2; ++cb) uu[r][cb] = P[(size_t)(row0 + p) * INC + 2048 + g * 128 + ch * 64 + cb * 32 + r32]; }
    const float* wrow = Ws + (size_t)(g * 128 + pb * 32 + r32) * 128 + hi * 8;
#pragma unroll
    for (int ks = 0; ks < 8; ++ks) {
        const f32x4 w0 = *(const GAS f32x4*)(wrow + ks * 16), w1 = *(const GAS f32x4*)(wrow + ks * 16 + 4);
        v4u aw; aw.x = pk2(w0.x, w0.y); aw.y = pk2(w0.z, w0.w); aw.z = pk2(w1.x, w1.y); aw.w = pk2(w1.z, w1.w);
#pragma unroll
        for (int cb = 0; cb < 2; ++cb) { const bf16x8 bv = *(const LAS bf16x8*)(VT + (ch * 64 + cb * 32 + r32) * VS + ks * 16 + hi * 8);
            acc[cb] = __builtin_amdgcn_mfma_f32_32x32x16_bf16(__builtin_bit_cast(bf16x8, aw), bv, acc[cb], 0, 0, 0); }
    }
#pragma unroll
    for (int r = 0; r < 16; ++r) { const int p = pb * 32 + crow(r, hi);
#pragma unroll
        for (int cb = 0; cb < 2; ++cb) { const int c = g * 128 + ch * 64 + cb * 32 + r32;
            MIX[(size_t)(row0 + p) * D + 1024 + c] = (bf16)f2bf(bf2f(uu[r][cb]) * (acc[cb][r] + bias[r])); } }
    __syncthreads();
}

template <int HALF>
__device__ __forceinline__ void pool_body(const bf16* P, bf16* MIX, const float* pscale, int seq0, int T, int tk0, int cc) {
    constexpr int NR = 4 + 2 * HALF;
    v4u raw[NR];
#pragma unroll
    for (int r = 0; r < NR; ++r) { const int t = tk0 - HALF + r; raw[r] = (t >= 0 && t < T) ? *(const GAS v4u*)(P + (size_t)(seq0 + t) * INC + cc * 8) : (v4u){0u, 0u, 0u, 0u}; }
    const f32x4 s0 = *(const GAS f32x4*)(pscale + cc * 8), s1 = *(const GAS f32x4*)(pscale + cc * 8 + 4);
    const float sc[8] = {s0.x, s0.y, s0.z, s0.w, s1.x, s1.y, s1.z, s1.w};
    float w[8];
#pragma unroll
    for (int e = 0; e < 8; ++e) w[e] = 0.f;
#pragma unroll
    for (int r = 0; r < 2 * HALF - 1; ++r)
#pragma unroll
        for (int e = 0; e < 4; ++e) { w[2 * e] += bf2f((unsigned short)(raw[r][e] & 0xffffu)); w[2 * e + 1] += bf2f((unsigned short)(raw[r][e] >> 16)); }
#pragma unroll
    for (int i = 0; i < 4; ++i) {
        const int t = tk0 + i, lo = t - HALF < 0 ? 0 : t - HALF, hh = t + HALF > T ? T : t + HALF; const float rc = 1.0f / (float)(hh - lo);
        v4u o;
#pragma unroll
        for (int e = 0; e < 4; ++e) {
            w[2 * e] += bf2f((unsigned short)(raw[i + 2 * HALF - 1][e] & 0xffffu)); w[2 * e + 1] += bf2f((unsigned short)(raw[i + 2 * HALF - 1][e] >> 16));
            const float x0 = bf2f((unsigned short)(raw[HALF + i][e] & 0xffffu)), x1 = bf2f((unsigned short)(raw[HALF + i][e] >> 16));
            o[e] = pk2((w[2 * e] * rc - x0) * sc[2 * e], (w[2 * e + 1] * rc - x1) * sc[2 * e + 1]);
            w[2 * e] -= bf2f((unsigned short)(raw[i][e] & 0xffffu)); w[2 * e + 1] -= bf2f((unsigned short)(raw[i][e] >> 16));
        }
        *(GAS v4u*)(MIX + (size_t)(seq0 + t) * D + cc * 8) = o;
    }
}
__device__ __forceinline__ void pool_unit(const bf16* P, bf16* MIX, const float* pscale, int row0, int tid, int wave) {
    const int seq0 = row0 < RC ? (row0 & ~255) : RC + ((row0 - RC) & ~2047), T = row0 < RC ? CTX : SEQ, tk0 = row0 - seq0 + 4 * (tid & 7), cc = tid >> 3, g = wave >> 1;
    if (g == 0) pool_body<1>(P, MIX, pscale, seq0, T, tk0, cc); else if (g == 1) pool_body<2>(P, MIX, pscale, seq0, T, tk0, cc); else if (g == 2) pool_body<4>(P, MIX, pscale, seq0, T, tk0, cc); else pool_body<8>(P, MIX, pscale, seq0, T, tk0, cc);
}

__global__ void __launch_bounds__(NWAVES * 64, 2) fwd_kernel(Args args_unused) {
    extern __shared__ __attribute__((aligned(16))) unsigned char lds_raw[];
    LAS unsigned char* lds = (LAS unsigned char*)lds_raw;
    volatile LAS unsigned* MISC = (volatile LAS unsigned*)(lds + MISC_OFF);
    const int tid0 = threadIdx.x;
#define TID_HERE() int tid = threadIdx.x; asm volatile("" : "+v"(tid)); int G = G0, bx = bx0; asm volatile("" : "+s"(G), "+s"(bx)); const int vcu = (G % 8 == 0) ? (bx % 8) * (G / 8) + bx / 8 : bx; const int NGW = G * NWAVES; \
    const int lane = tid & 63, wave = __builtin_amdgcn_readfirstlane(tid >> 6); const int gw = vcu * NWAVES + wave; (void)lane; (void)gw; (void)NGW
    const int G0 = gridDim.x, bx0 = blockIdx.x;
    for (int u = tid0; u < (LDS_BYTES - LDSCTL_OFF) / 4; u += NWAVES * 64) ((LAS unsigned*)(lds + LDSCTL_OFF))[u] = 0u;
    __syncthreads();
    int lo, hi;
    XcdBarrier bar;
    { kaptr kp = ka_get(); lo = KLO(kp); hi = KHI(kp); unsigned* bw = (unsigned*)(KWS(kp) + WS_CTL) + CW_BAR; bar.bar = bw; bar.x = 0; bar.st = nullptr;
      if (!MK_PER_PHASE) bar = xcd_barrier_post(bw, MISC + 8); }
#ifndef SITEMASK
#define SITEMASK 0xfff
#endif
#ifndef UNITMASK
#define UNITMASK 0xf
#endif
#define UEN(s) (((UNITMASK) >> (s)) & 1)
#ifndef REPMASK
#define REPMASK 0
#endif
#ifndef REPU
#define REPU 0
#endif
#define NREPU(s) (1 + (((REPU) >> (s)) & 1))
#define NREP(s) (1 + (((REPMASK) >> (s)) & 1))
#define EN(s) (((SITEMASK) >> (s)) & 1)
#define IN(k) (lo <= (k) && (k) < hi)
#ifndef NCONV
#define NCONV 16
#endif
#ifndef FILLW
#define FILLW 2
#endif
#define CONVPH(k) ((k) == 2 || (k) == 4 || (k) == 6 || (k) == 7)
#ifndef SPLITK
#define SPLITK false
#endif
#ifndef SPLITK_FFN_DOWN
#define SPLITK_FFN_DOWN false
#endif
#ifndef SPLITK_MOE_DOWN
#define SPLITK_MOE_DOWN true
#endif
#ifndef FILLMODE
#define FILLMODE 1
#endif
#define FILL(k) do { if (FILLMODE == 1 && l == 0 && IN(k)) {     kaptr kq = ka_get(); int Gq = G0; asm volatile("" : "+s"(Gq)); fill_tail(KWS(kq), KIN(kq, 23), KIN(kq, 24), KIN(kq, 25), (unsigned*)(KWS(kq) + WS_CTL) + CW_DONE + 64 * (k), Gq, (FILLMODE == 1 && l == 0 && (int)blockIdx.x < NCONV && CONVPH(k)) ? 8 : FILLW); } } while (0)
#define DRAIN(k) do { if (((FILLMODE == 1) || (k) == 0) && IN(k)) { kaptr kq = ka_get(); int Gq = G0; asm volatile("" : "+s"(Gq)); drain_tail(KWS(kq), KIN(kq, 23), KIN(kq, 24), KIN(kq, 25), Gq, lds); } } while (0)
#define SEAM(k) do { if (IN(k) && IN((k) + 1)) { XcdBarrier b_ = bar; asm volatile("" : "+s"(b_.bar)); xcd_barrier(b_); } } while (0)
    LAS int* TB = (LAS int*)(lds + TB_OFF);

    for (int rep = 0; rep < NREP(0); ++rep) if (EN(0) && IN(0)) { kaptr kp = ka_get(); TID_HERE(); p0_prologue(kp, lds, vcu, G, tid, lane, wave); }
    if (FILLMODE == 0) DRAIN(0);
    SEAM(0);

    for (int l = 0; l < 2; ++l) {
        const int pb = l == 0 ? 1 : 8;
        const bool last = (l == 1);
        for (int rep = 0; rep < NREP(1); ++rep) if (EN(1) && IN(pb + 0)) {
            kaptr kp = ka_get(); TID_HERE(); unsigned char* ws = KWS(kp); const float* H = (const float*)(ws + WS_H); const float* mod = (const float*)(ws + WS_MOD) + l * 5 * MODN;
            const float* srcC = l == 0 ? KIN(kp, 2) : H; const float* srcL = l == 0 ? KIN(kp, 0) - (size_t)RC * D : H;
            norm_rows<false>(srcC, srcL, KIN(kp, 6) + l * D, mod + 0 * D, mod + 1 * D, (bf16*)(ws + WS_XN), 0, RT, gw, NGW, lane, nullptr, nullptr, nullptr);
        }
        SEAM(pb + 0);
        for (int rep = 0; rep < NREP(2); ++rep) if (EN(2) && IN(pb + 1)) {
            kaptr kp = ka_get(); TID_HERE(); unsigned char* ws = KWS(kp);
            pg8::Gemm g{(const bf16*)(ws + WS_XN), (const bf16*)(ws + WS_WIN) + (size_t)l * INC * D, RT, INC, D}; pg8::EpiIn E{(bf16*)(ws + WS_PALL), (const float*)(ws + WS_ROPE)};
            const int nc = (FILLMODE == 1 && l == 0) ? NCONV : 0;
            if (bx >= nc) {
            pg8::OrderSplit<pg8::MapIn> S; S.init(G - nc, bx - nc, D, last ? 20 : 60); S.plan(SPLITK);
            pg8::EpiSplit<pg8::EpiIn> ES{E, (float*)(ws + WS_SLAB)};
            { pg8::CachedOrder CS; CS.fill(S, (PG8_LAS int*)(lds + UT_OFF), tid); __syncthreads();
                  pg8::gemm_phase<pg8::EpiSplit<pg8::EpiIn>, pg8::CachedOrder, true, true>(lds, g, CS, ES); }
            combine_tail(E, S, (float*)(ws + WS_SLAB), (unsigned*)(ws + WS_CTL) + CW_TK + 4096 * (pb + 1), lds); }
        }
        FILL(pb + 1); SEAM(pb + 1);
        for (int rep = 0; rep < NREP(3); ++rep) if (EN(3) && IN(pb + 2)) {
            kaptr kp = ka_get(); TID_HERE(); unsigned char* ws = KWS(kp); const bf16* PALL = (const bf16*)(ws + WS_PALL); bf16* MIX = (bf16*)(ws + WS_MIX);
            const float lam_init = 0.8f - 0.6f * expf(-0.3f * (float)l);
            for (int ru = 0; ru < NREPU(0); ++ru) if (UEN(0)) for (int u = vcu; u < 256; u += G) diff_unit(lds, PALL, MIX, KIN(kp, 12) + l * 256, KIN(kp, 13) + l * 128, lam_init, u >> 6, (u >> 4) & 3, u & 15, false, tid, lane, wave);
            for (int ru = 0; ru < NREPU(1); ++ru) if (UEN(1)) for (int u = vcu; u < 256; u += G) win_unit(lds, PALL, MIX, KIN(kp, 18) + l * 8, u >> 6, (u >> 5) & 1, u & 31, false, tid, lane, wave);
            if (!last) {
                if (UEN(0)) for (int u = vcu; u < 32; u += G) diff_unit(lds, PALL, MIX, KIN(kp, 12) + l * 256, KIN(kp, 13) + l * 128, lam_init, u >> 3, (u >> 1) & 3, u & 1, true, tid, lane, wave);
                if (UEN(1)) for (int u = (vcu + G - (32 % G)) % G; u < 32; u += G) win_unit(lds, PALL, MIX, KIN(kp, 18) + l * 8, u >> 3, (u >> 2) & 1, u & 3, true, tid, lane, wave);
            }
            { const int ch0 = last ? 8 : 0, nu = (72 - ch0) * 4;
              for (int ru = 0; ru < NREPU(2); ++ru) if (UEN(2)) for (int u = (vcu + G - (64 % G)) % G; u < nu; u += G) sgu_unit(lds, PALL, MIX, KIN(kp, 14) + l * 512, KIN(kp, 15) + l * 512, KIN(kp, 16) + (size_t)l * 4 * 128 * 128, KIN(kp, 17) + l * 512, (ch0 + (u >> 2)) * 128, u & 3, tid, lane, wave); }
            { const int r0 = last ? RC : 0, nu = (RT - r0) / 32;
              for (int ru = 0; ru < NREPU(3); ++ru) if (UEN(3)) for (int u = (vcu + G - (96 % G)) % G; u < nu; u += G) pool_unit(PALL, MIX, KIN(kp, 11) + l * 512, r0 + 32 * u, tid, wave); }
        }
        FILL(pb + 2); SEAM(pb + 2);
        for (int rep = 0; rep < NREP(4); ++rep) if (EN(4) && IN(pb + 3)) {
            kaptr kp = ka_get(); TID_HERE(); unsigned char* ws = KWS(kp); float* H = (float*)(ws + WS_H);
            const float* srcC = l == 0 ? KIN(kp, 2) : H; const float* srcL = l == 0 ? KIN(kp, 0) - (size_t)RC * D : H;
            pg8::Gemm g{(const bf16*)(ws + WS_MIX), (const bf16*)(ws + WS_WOUT) + (size_t)l * D * D, RT, D, D}; pg8::EpiResid E{srcC, srcL, rep ? (float*)(ws + WS_Y) : H, (const float*)(ws + WS_MOD) + l * 5 * MODN + 2 * D, 1.0f};
            const int nc = (FILLMODE == 1 && l == 0) ? NCONV : 0;
            if (bx >= nc) {
            pg8::OrderSplit<pg8::MapOff> S; S.init(last ? RL : RT, D, G - nc, bx - nc, D); S.pm_off = last ? 4 : 0; S.plan(SPLITK);
            pg8::EpiSplit<pg8::EpiResid> ES{E, (float*)(ws + WS_SLAB)};
            { pg8::CachedOrder CS; CS.fill(S, (PG8_LAS int*)(lds + UT_OFF), tid); __syncthreads();
                  pg8::gemm_phase<pg8::EpiSplit<pg8::EpiResid>, pg8::CachedOrder, true, true>(lds, g, CS, ES); }
            combine_tail(E, S, (float*)(ws + WS_SLAB), (unsigned*)(ws + WS_CTL) + CW_TK + 4096 * (pb + 3), lds); }
        }
        FILL(pb + 3); SEAM(pb + 3);
        for (int rep = 0; rep < NREP(5); ++rep) if (EN(5) && IN(pb + 4)) {
            kaptr kp = ka_get(); TID_HERE(); unsigned char* ws = KWS(kp); const float* H = (const float*)(ws + WS_H); const float* mod = (const float*)(ws + WS_MOD) + l * 5 * MODN;
            if (!last || rep) norm_rows<false, DENSE_UP_F8>(H, H, KIN(kp, 7) + l * D, mod + 3 * D, mod + 4 * D, (bf16*)(ws + WS_XN), last ? RC : 0, RT, gw, NGW, lane, nullptr, nullptr, nullptr);
            else {
                LAS float* rt = (LAS float*)lds;
                for (int i = tid; i < D * NE / 4; i += NWAVES * 64) ((LAS f32x4*)rt)[i] = ((const GAS f32x4*)KIN(kp, 22))[i];
                __syncthreads();
                norm_rows<true, MOE_F8>(H, H, KIN(kp, 7) + l * D, mod + 3 * D, mod + 4 * D, (bf16*)(ws + WS_XG), RC, RT, gw, NGW, lane, rt, (unsigned*)(ws + WS_CTL) + CW_CNT, (int*)(ws + WS_ROUTE));
            }
        }
        if (last) DRAIN(pb + 4);
        SEAM(pb + 4);
        if (!last) {
            for (int rep = 0; rep < NREP(6); ++rep) if (EN(6) && IN(pb + 5)) {
                kaptr kp = ka_get(); TID_HERE(); unsigned char* ws = KWS(kp);
                constexpr int KP = DENSE_UP_F8 ? D / 2 : D;
                pg8::Gemm g{(const bf16*)(ws + WS_XN), (const bf16*)(ws + WS_W13), RT, 2 * DFF, KP}; pg8::EpiSwiglu<DENSE_DN_F8> E{(void*)(ws + WS_ACT), DFF, NTN_UP, DENSE_UP_F8 ? 1.0f / 256.0f : 1.0f};
                const int nc = (FILLMODE == 1) ? NCONV : 0;
                if (bx >= nc) {
                pg8::OrderSplit<pg8::StaticOrder> S; S.init(RT, 2 * DFF, G - nc, bx - nc, KP); S.plan(SPLITK);
                pg8::EpiSplit<pg8::EpiSwiglu<DENSE_DN_F8>> ES{E, (float*)(ws + WS_SLAB)};
                { pg8::CachedOrder CS; CS.fill(S, (PG8_LAS int*)(lds + UT_OFF), tid); __syncthreads();
                  pg8::gemm_phase<pg8::EpiSplit<pg8::EpiSwiglu<DENSE_DN_F8>>, pg8::CachedOrder, true, true, DENSE_UP_F8>(lds, g, CS, ES); }
                combine_tail(E, S, (float*)(ws + WS_SLAB), (unsigned*)(ws + WS_CTL) + CW_TK + 4096 * (pb + 5), lds); }
            }
            FILL(pb + 5); SEAM(pb + 5);
            for (int rep = 0; rep < NREP(7); ++rep) if (EN(7) && IN(pb + 6)) {
                kaptr kp = ka_get(); TID_HERE(); unsigned char* ws = KWS(kp); float* H = (float*)(ws + WS_H);
                constexpr int KP = DENSE_DN_F8 ? DFF / 2 : DFF;
                pg8::Gemm g{(const bf16*)(ws + WS_ACT), (const bf16*)(ws + WS_W2), RT, D, KP}; pg8::EpiResid E{H, H, rep ? (float*)(ws + WS_Y) : H, (const float*)(ws + WS_MOD) + l * 5 * MODN + 5 * D, DENSE_DN_F8 ? 1.0f / 256.0f : 1.0f};
                const int nc = (FILLMODE == 1) ? NCONV : 0;
                if (bx >= nc) {
                pg8::OrderSplit<pg8::MapOff> S; S.init(RT, D, G - nc, bx - nc, KP); S.pm_off = 0; S.plan(SPLITK_FFN_DOWN);
                pg8::EpiSplit<pg8::EpiResid> ES{E, (float*)(ws + WS_SLAB)};
                { pg8::CachedOrder CS; CS.fill(S, (PG8_LAS int*)(lds + UT_OFF), tid); __syncthreads();
                  pg8::gemm_phase<pg8::EpiSplit<pg8::EpiResid>, pg8::CachedOrder, true, true, DENSE_DN_F8>(lds, g, CS, ES); }
                combine_tail(E, S, (float*)(ws + WS_SLAB), (unsigned*)(ws + WS_CTL) + CW_TK + 4096 * (pb + 6), lds); }
            }
            FILL(pb + 6); SEAM(pb + 6);
        } else {
            if (IN(pb + 5) || IN(pb + 6) || IN(pb + 7) || IN(pb + 8)) {
                kaptr kp = ka_get(); TID_HERE(); const unsigned* CNT = (const unsigned*)(KWS(kp) + WS_CTL) + CW_CNT;
                if (tid == 0) { int acc = 0; TB[0] = 0;
                    for (int e = 0; e < 8; ++e) { const unsigned c = __hip_atomic_load(CNT + 64 * e, RLX_AGENT); acc += (int)((c + 255u) >> 8); TB[e + 1] = acc; } }
                __syncthreads();
            }
            for (int rep = 0; rep < NREP(9); ++rep) if (EN(9) && IN(pb + 6)) {
                kaptr kp = ka_get(); TID_HERE(); unsigned char* ws = KWS(kp);
                constexpr int KP = MOE_F8 ? D / 2 : D;
                pg8::Gemm g{(const bf16*)(ws + WS_XG), (const bf16*)(ws + WS_MW13), NE * 8192, NE * 2 * DFF, KP}; pg8::EpiSwiglu<MOE_F8> E{(void*)(ws + WS_ACT), DFF, NTN_UP, MOE_F8 ? 1.0f / 256.0f : 1.0f, (const PG8_LAS int*)TB};
                pg8::OrderSplit<pg8::MapMoe> S; S.init((const PG8_LAS int*)TB, NTN_UP, G, bx, KP, 1); S.plan(SPLITK);
                pg8::EpiSplit<pg8::EpiSwiglu<MOE_F8>> ES{E, (float*)(ws + WS_SLAB)};
                { pg8::CachedOrder CS; CS.fill(S, (PG8_LAS int*)(lds + UT_OFF), tid); __syncthreads();
                  pg8::gemm_phase<pg8::EpiSplit<pg8::EpiSwiglu<MOE_F8>>, pg8::CachedOrder, true, true, MOE_F8>(lds, g, CS, ES); }
                combine_tail(E, S, (float*)(ws + WS_SLAB), (unsigned*)(ws + WS_CTL) + CW_TK + 4096 * (pb + 6), lds);
            }
            SEAM(pb + 6);
            for (int rep = 0; rep < NREP(10); ++rep) if (EN(10) && IN(pb + 7)) {
                kaptr kp = ka_get(); TID_HERE(); unsigned char* ws = KWS(kp);
                constexpr int KP = MOE_F8 ? DFF / 2 : DFF;
                pg8::Gemm g{(const bf16*)(ws + WS_ACT), (const bf16*)(ws + WS_MW2), MAXSLOT, NE * D, KP}; pg8::EpiF32 E{(bf16*)(ws + WS_Y), D / 256, MOE_F8 ? 1.0f / 256.0f : 1.0f};
                pg8::OrderSplit<pg8::MapMoe> S; S.init((const PG8_LAS int*)TB, D / 256, G, bx, KP); S.plan(SPLITK_MOE_DOWN);
                pg8::EpiSplit<pg8::EpiF32> ES{E, (float*)(ws + WS_SLAB)};
                { pg8::CachedOrder CS; CS.fill(S, (PG8_LAS int*)(lds + UT_OFF), tid); __syncthreads();
                  pg8::gemm_phase<pg8::EpiSplit<pg8::EpiF32>, pg8::CachedOrder, true, true, MOE_F8>(lds, g, CS, ES); }
                combine_tail(E, S, (float*)(ws + WS_SLAB), (unsigned*)(ws + WS_CTL) + CW_TK + 4096 * (pb + 7), lds);
            }
            SEAM(pb + 7);
            for (int rep = 0; rep < NREP(11); ++rep) if (EN(11) && IN(pb + 8)) {
                kaptr kp = ka_get(); TID_HERE(); unsigned char* ws = KWS(kp); const int* ROUTE = (const int*)(ws + WS_ROUTE); const float* H = (const float*)(ws + WS_H); const bf16* Y = (const bf16*)(ws + WS_Y);
                const float* gate = (const float*)(ws + WS_MOD) + l * 5 * MODN + 5 * D; const float* nf = KIN(kp, 26); float* out = KOUT(kp);
                f32x4 nw[8];
#pragma unroll
                for (int j = 0; j < 8; ++j) nw[j] = ((const GAS f32x4*)nf + lane)[64 * j];
                for (int t = gw; t < RL; t += NGW) {
                    const int* rec = ROUTE + (size_t)t * 8; const int e1 = rec[0], s1 = rec[1], e2 = rec[3], s2 = rec[4]; const float w1 = __builtin_bit_cast(float, rec[2]), w2 = __builtin_bit_cast(float, rec[5]);
                    const int b1 = TB[e1], b2 = TB[e2];
                    const int bidx = t >> 11;
                    const GAS f32x4* hr = (const GAS f32x4*)(H + (size_t)(RC + t) * D) + lane; const GAS v2u* y1 = (const GAS v2u*)(Y + (size_t)(b1 * 256 + s1) * D) + lane; const GAS v2u* y2 = (const GAS v2u*)(Y + (size_t)(b2 * 256 + s2) * D) + lane;
                    const GAS f32x4* g4 = (const GAS f32x4*)(gate + bidx * MODN) + lane;
                    f32x4 v[8]; float ss = 0.f;
#pragma unroll
                    for (int j = 0; j < 8; ++j) { const v2u ra = y1[64 * j], rb = y2[64 * j];
                        const f32x4 a = (f32x4){bf2f((unsigned short)(ra.x & 0xffffu)), bf2f((unsigned short)(ra.x >> 16)), bf2f((unsigned short)(ra.y & 0xffffu)), bf2f((unsigned short)(ra.y >> 16))};
                        const f32x4 b = (f32x4){bf2f((unsigned short)(rb.x & 0xffffu)), bf2f((unsigned short)(rb.x >> 16)), bf2f((unsigned short)(rb.y & 0xffffu)), bf2f((unsigned short)(rb.y >> 16))};
                        v[j] = hr[64 * j] + g4[64 * j] * (a * w1 + b * w2); ss += (v[j].x * v[j].x + v[j].y * v[j].y) + (v[j].z * v[j].z + v[j].w * v[j].w); }
                    const float rstd = 1.0f / sqrtf(wave_sum(ss) * (1.0f / D) + EPS);
                    GAS f32x4* op = (GAS f32x4*)(out + (size_t)t * D) + lane;
#pragma unroll
                    for (int j = 0; j < 8; ++j) op[64 * j] = v[j] * rstd * nw[j];
                }
            }
        }
    }
#undef IN
#undef SEAM
}

extern "C" void kernel_launch(void* const* d_in, const int* in_sizes, int n_in, void* d_out, int out_size, void* d_ws, size_t ws_size, hipStream_t stream) {
    static int grid = 0;
    if (grid == 0) {
        if (n_in != 27 || out_size != RL * D || ws_size < WS_END) { fprintf(stderr, "kernel_launch: unexpected problem (n_in %d, out %d, ws %zu); nothing launched\n", n_in, out_size, ws_size); grid = -1; return; }
        int dev = 0, cus = 0, per_cu = 0;
        if (hipGetDevice(&dev) != hipSuccess || hipDeviceGetAttribute(&cus, hipDeviceAttributeMultiprocessorCount, dev) != hipSuccess) { grid = -1; return; }
        if (hipFuncSetAttribute((const void*)fwd_kernel, hipFuncAttributeMaxDynamicSharedMemorySize, LDS_BYTES) != hipSuccess) { fprintf(stderr, "kernel_launch: hipFuncSetAttribute failed\n"); grid = -1; return; }
        if (hipOccupancyMaxActiveBlocksPerMultiprocessor(&per_cu, (const void*)fwd_kernel, NWAVES * 64, LDS_BYTES) != hipSuccess || per_cu < 1) fprintf(stderr, "kernel_launch: occupancy query reports %d\n", per_cu);
        (void)hipGetLastError();
        grid = cus;
    }
    if (grid < 0) return;
    if (hipMemsetAsync((char*)d_ws + WS_CTL, 0, CTL_ZERO_BYTES, stream) != hipSuccess) { fprintf(stderr, "kernel_launch: memset failed\n"); return; }
    Args a{};
    for (int i = 0; i < 27; ++i) a.in[i] = (const float*)d_in[i];
    a.out = (float*)d_out; a.ws = (unsigned char*)d_ws;
#if MK_PER_PHASE
    for (int p = 0; p < NPHASE; ++p) { a.ph_lo = p; a.ph_hi = p + 1; hipLaunchKernelGGL(fwd_kernel, dim3(grid), dim3(NWAVES * 64), LDS_BYTES, stream, a); }
#else
    a.ph_lo = 0; a.ph_hi = NPHASE;
    hipLaunchKernelGGL(fwd_kernel, dim3(grid), dim3(NWAVES * 64), LDS_BYTES, stream, a);
#endif
    const hipError_t le = hipPeekAtLastError();
    if (le != hipSuccess) fprintf(stderr, "kernel_launch: launch failed: %s\n", hipGetErrorName(le));
}
```

```cpp
#include <hip/hip_runtime.h>
#include <cstdio>
#include <cstdint>
#include <cmath>

#define GAS __attribute__((address_space(1)))
#define LAS __attribute__((address_space(3)))
namespace pg8 {
#define PG8_LAS __attribute__((address_space(3)))
typedef unsigned short bf16_t;
typedef short bf16x8 __attribute__((ext_vector_type(8)));
typedef float f32x4 __attribute__((ext_vector_type(4)));
typedef unsigned u32x4 __attribute__((ext_vector_type(4)));
typedef int i32x4 __attribute__((ext_vector_type(4)));
typedef int i32x8 __attribute__((ext_vector_type(8)));
constexpr int BM = 256, BK = 64, HALF = 128, HTB = HALF * BK * 2  , STAGE_BYTES = 8 * HTB, NXCD = 8, WGM = 8;

__host__ __device__ __forceinline__ int lds_byte(int r, int c) { const int st = (r >> 4) * 2 + (c >> 5), rr = r & 15, cc = c & 31, ob = rr * 64 + cc * 2; return st * 1024 + (ob ^ (((ob >> 9) & 1) << 5)); }
__host__ __device__ __forceinline__ void stage_rc(int b, int& R, int& C) { const int st = b / 1024, sb = b % 1024, swz = sb ^ (((sb >> 9) & 1) << 5); R = (st >> 1) * 16 + swz / 64; C = (st & 1) * 32 + (swz % 64) / 2; }
__host__ __device__ __forceinline__ int perm32(int rho) { const int n = rho >> 4, i = rho & 15; return 8 * (i >> 2) + 4 * n + (i & 3); }

struct Unit { int pm, pn, k0, nkt, sid; };
struct Gemm { const bf16_t* A; const bf16_t* Bt; int M, N, K; };

struct StaticOrder {
    int nM, nN, nwg, G, c;
    __host__ __device__ void init(int M, int N, int G_, int c_, int K_) { nM = M / BM; nN = N / BM; nwg = nM * nN; G = G_; c = c_; K = K_; }
    int K;
    __host__ __device__ bool next(int i, Unit& u) const { const long L = (long)i * G + c; if (L >= nwg) return false; map(L, u); return true; }
    __host__ __device__ void map(long L, Unit& u) const {
        int wgid = (int)L; { const int q = nwg / NXCD, r = nwg % NXCD, xcd = wgid % NXCD, off = wgid / NXCD; wgid = (xcd < r ? xcd * (q + 1) : r * (q + 1) + (xcd - r) * q) + off; }
        const int nig = WGM * nN, gid = wgid / nig, fm = gid * WGM, gsz = (nM - fm) < WGM ? (nM - fm) : WGM;
        u.pm = fm + ((wgid % nig) % gsz); u.pn = (wgid % nig) / gsz; u.k0 = 0; u.nkt = K / BK; u.sid = -1;
    }
    __device__ __forceinline__ void a_ready(const Unit&) const {}
    __device__ __forceinline__ void done(const Unit&) const {}
};

__device__ __forceinline__ unsigned cvt_pk_bf16(float lo, float hi) { unsigned r; asm volatile("v_cvt_pk_bf16_f32 %0, %1, %2" : "=v"(r) : "v"(lo), "v"(hi)); return r; }
typedef unsigned u32x4 __attribute__((ext_vector_type(4)));
constexpr float QSCALE = 0.125f * 1.4426950408889634f;
__device__ __forceinline__ float gelu_tanh(float x) {
    const float y = 0.7978845608028654f * (x + 0.044715f * x * x * x);
    return x * __builtin_amdgcn_rcpf(1.0f + __builtin_amdgcn_exp2f(-2.0f * 1.4426950408889634f * y));
}
__device__ __forceinline__ float silu_f(float x) { return x * __builtin_amdgcn_rcpf(1.0f + __builtin_amdgcn_exp2f(-1.4426950408889634f * x)); }

struct EpiIn {
    static constexpr bool PERM = true, AFTER_DRAIN = false;
    bf16_t* O; const PG8_LAS float* rope;
    __device__ __forceinline__ void operator()(const f32x4 (&acc)[2][2][4][2], const Unit& u, int wr, int wc, int fr, int fq) const {
        const int row0 = u.pm * BM + wr * 64 + fr; const bool lat = u.pm >= 4;
#pragma unroll
        for (int bj = 0; bj < 2; ++bj) {
            const int cb = u.pn * BM + bj * HALF; int role;
            if (cb < 512) role = 0; else if (cb < 1024) role = 1; else if (cb < 1536) role = 2; else if (cb < 2048) role = 0; else if (cb < 3072) role = 3; else if (cb < 3584) role = 1; else if (cb < 3712) role = 2; else role = 0;
            const int col0 = cb + wc * 32 + 8 * fq;
#pragma unroll
            for (int ai = 0; ai < 2; ++ai)
#pragma unroll
                for (int m = 0; m < 4; ++m) {
                    const int row = row0 + ai * HALF + m * 16;
                    f32x4 v0 = acc[ai][bj][m][0], v1 = acc[ai][bj][m][1];
                    if (role == 1 || role == 2) {
                        if (lat) {
                            const int t = (row - 1024) & 2047, pos = (wc & 1) ? (t & 63) : (t >> 6);
                            const f32x4 cs = *(const PG8_LAS f32x4*)(rope + pos * 16 + 4 * fq), sn = *(const PG8_LAS f32x4*)(rope + 1024 + pos * 16 + 4 * fq);
                            f32x4 a0, a1;
                            a0[0] = v0[0] * cs[0] - v0[1] * sn[0]; a0[1] = v0[0] * sn[0] + v0[1] * cs[0];
                            a0[2] = v0[2] * cs[1] - v0[3] * sn[1]; a0[3] = v0[2] * sn[1] + v0[3] * cs[1];
                            a1[0] = v1[0] * cs[2] - v1[1] * sn[2]; a1[1] = v1[0] * sn[2] + v1[1] * cs[2];
                            a1[2] = v1[2] * cs[3] - v1[3] * sn[3]; a1[3] = v1[2] * sn[3] + v1[3] * cs[3];
                            v0 = a0; v1 = a1;
                        }
                        if (role == 1) { v0 = v0 * QSCALE; v1 = v1 * QSCALE; }
                    } else if (role == 3) {
#pragma unroll
                        for (int e = 0; e < 4; ++e) { v0[e] = gelu_tanh(v0[e]); v1[e] = gelu_tanh(v1[e]); }
                    }
                    u32x4 w; w.x = cvt_pk_bf16(v0[0], v0[1]); w.y = cvt_pk_bf16(v0[2], v0[3]); w.z = cvt_pk_bf16(v1[0], v1[1]); w.w = cvt_pk_bf16(v1[2], v1[3]);
                    *(u32x4*)(O + (size_t)row * 3840 + col0) = w;
                }
        }
    }
};
__device__ __forceinline__ float clamp_fp8(float x) { return __builtin_amdgcn_fmed3f(x, -448.0f, 448.0f); }
__device__ __forceinline__ unsigned cvt4_fp8(float a, float b, float c, float d) { a = clamp_fp8(a); b = clamp_fp8(b); c = clamp_fp8(c); d = clamp_fp8(d); int w = 0; w = __builtin_amdgcn_cvt_pk_fp8_f32(a, b, w, false); w = __builtin_amdgcn_cvt_pk_fp8_f32(c, d, w, true); return (unsigned)w; }
template <bool F8OUT> struct EpiSwiglu {
    static constexpr bool PERM = true, AFTER_DRAIN = false;
    void* O; int ldo; int ntn; float sc;
    const PG8_LAS int* tb;
    __device__ __forceinline__ void operator()(const f32x4 (&acc)[2][2][4][2], const Unit& u, int wr, int wc, int fr, int fq) const {
        const int pmo = tb ? tb[u.pm >> 5] + (u.pm & 31) : u.pm;
        const int row0 = pmo * BM + wr * 64 + fr, col0 = (u.pn % ntn) * HALF + wc * 32 + 8 * fq;
#pragma unroll
        for (int ai = 0; ai < 2; ++ai)
#pragma unroll
            for (int m = 0; m < 4; ++m) {
                const f32x4 g0 = acc[ai][0][m][0] * sc, g1 = acc[ai][0][m][1] * sc, u0 = acc[ai][1][m][0] * sc, u1 = acc[ai][1][m][1] * sc;
                f32x4 r0, r1;
#pragma unroll
                for (int e = 0; e < 4; ++e) { r0[e] = silu_f(g0[e]) * u0[e]; r1[e] = silu_f(g1[e]) * u1[e]; }
                const size_t row = (size_t)(row0 + ai * HALF + m * 16);
                if constexpr (F8OUT) { typedef unsigned u32x2 __attribute__((ext_vector_type(2))); u32x2 w; w.x = cvt4_fp8(r0[0], r0[1], r0[2], r0[3]); w.y = cvt4_fp8(r1[0], r1[1], r1[2], r1[3]);
                    *(u32x2*)((unsigned char*)O + row * ldo + col0) = w; }
                else { u32x4 w; w.x = cvt_pk_bf16(r0[0], r0[1]); w.y = cvt_pk_bf16(r0[2], r0[3]); w.z = cvt_pk_bf16(r1[0], r1[1]); w.w = cvt_pk_bf16(r1[2], r1[3]);
                    *(u32x4*)((bf16_t*)O + row * ldo + col0) = w; }
            }
    }
};
struct EpiResid {
    static constexpr bool PERM = false, AFTER_DRAIN = false;
    const float* resC; const float* resL; float* out; const float* gate; float sc;
    __device__ __forceinline__ void operator()(const f32x4 (&acc)[2][2][4][2], const Unit& u, int wr, int wc, int fr, int fq) const {
        const int bidx = u.pm < 4 ? 4 : ((u.pm - 4) >> 3); const float* res = u.pm < 4 ? resC : resL; const float* gp = gate + bidx * 12288;
        const int row0 = u.pm * BM + wr * 64 + fr;
#pragma unroll
        for (int bj = 0; bj < 2; ++bj)
#pragma unroll
            for (int n = 0; n < 2; ++n) {
                const int col = u.pn * BM + bj * HALF + wc * 32 + 16 * n + 4 * fq; const f32x4 g4 = *(const f32x4*)(gp + col); f32x4 rr[2][4];
#pragma unroll
                for (int ai = 0; ai < 2; ++ai)
#pragma unroll
                    for (int m = 0; m < 4; ++m) rr[ai][m] = *(const f32x4*)(res + (size_t)(row0 + ai * HALF + m * 16) * 2048 + col);
                asm volatile("" ::: "memory");
#pragma unroll
                for (int ai = 0; ai < 2; ++ai)
#pragma unroll
                    for (int m = 0; m < 4; ++m) *(f32x4*)(out + (size_t)(row0 + ai * HALF + m * 16) * 2048 + col) = rr[ai][m] + g4 * (acc[ai][bj][m][n] * sc);
                asm volatile("" ::: "memory");
            }
    }
};
struct EpiF32 {
    static constexpr bool PERM = true, AFTER_DRAIN = false;
    bf16_t* O; int ntn; float sc;
    __device__ __forceinline__ void operator()(const f32x4 (&acc)[2][2][4][2], const Unit& u, int wr, int wc, int fr, int fq) const {
        const int row0 = u.pm * BM + wr * 64 + fr;
#pragma unroll
        for (int bj = 0; bj < 2; ++bj) {
            const int col0 = (u.pn % ntn) * BM + bj * HALF + wc * 32 + 8 * fq;
#pragma unroll
            for (int ai = 0; ai < 2; ++ai)
#pragma unroll
                for (int m = 0; m < 4; ++m) { const f32x4 v0 = acc[ai][bj][m][0] * sc, v1 = acc[ai][bj][m][1] * sc;
                    u32x4 w; w.x = cvt_pk_bf16(v0[0], v0[1]); w.y = cvt_pk_bf16(v0[2], v0[3]); w.z = cvt_pk_bf16(v1[0], v1[1]); w.w = cvt_pk_bf16(v1[2], v1[3]);
                    *(u32x4*)(O + (size_t)(row0 + ai * HALF + m * 16) * 2048 + col0) = w; }
        }
    }
};
template <class Epi> struct EpiSplit {
    static constexpr bool PERM = Epi::PERM, AFTER_DRAIN = false;
    Epi E; float* slab;
    __device__ __forceinline__ void operator()(const f32x4 (&acc)[2][2][4][2], const Unit& u, int wr, int wc, int fr, int fq) const {
        if (u.sid < 0) { E(acc, u, wr, wc, fr, fq); return; }
        f32x4* sp = (f32x4*)slab + (size_t)u.sid * (32 * 512) + (wr * 4 + wc) * 64 + fq * 16 + fr;
#pragma unroll
        for (int ai = 0; ai < 2; ++ai)
#pragma unroll
            for (int bj = 0; bj < 2; ++bj)
#pragma unroll
                for (int m = 0; m < 4; ++m)
#pragma unroll
                    for (int n = 0; n < 2; ++n) sp[(size_t)((((ai * 2 + bj) * 4 + m) * 2) + n) * 512] = acc[ai][bj][m][n];
    }
};
struct TailPlan { int nfull, ntail, S;
    __device__ __forceinline__ void make(int nwg, int G, bool allow, int K) { nfull = (nwg / G) * G; ntail = nwg - nfull;
        S = (!allow || ntail == 0) ? 1 : ((4 * ntail <= G && K % 512 == 0) ? 4 : ((2 * ntail <= G && K % 256 == 0) ? 2 : 1)); } };
template <class Base> struct OrderSplit : Base {
    TailPlan tp;
    __device__ __forceinline__ void plan(bool allow) { tp.make(this->nwg, this->G, allow, this->K); }
    __device__ __forceinline__ bool next(int i, Unit& u) const {
        const long L = (long)i * this->G + this->c;
        if (tp.S == 1) { if (L >= this->nwg) return false; this->map(L, u); return true; }
        if (L < tp.nfull) { this->map(L, u); return true; }
        const int j = (int)(L - tp.nfull); if (j >= tp.ntail * tp.S) return false;
        this->map(tp.nfull + j / tp.S, u); const int ks = j % tp.S, klen = this->K / tp.S; u.k0 = ks * klen; u.nkt = klen / BK; u.sid = j; return true;
    }
    __device__ __forceinline__ bool tail_unit(int& tt, Unit& u) const { if (tp.S == 1 || this->c >= tp.ntail * tp.S) return false; tt = this->c / tp.S; this->map(tp.nfull + tt, u); return true; }
};
struct CachedOrder {
    const PG8_LAS int* tab;
    template <class Ord> __device__ __forceinline__ void fill(const Ord& S, PG8_LAS int* t, int tid) {
        if (tid < 32) { Unit u; u.pm = 0; u.pn = 0; u.k0 = 0; u.nkt = 2; u.sid = -1; const bool ok = S.next(tid, u);
            t[tid * 8 + 0] = ok ? 1 : 0; t[tid * 8 + 1] = u.pm; t[tid * 8 + 2] = u.pn; t[tid * 8 + 3] = u.k0; t[tid * 8 + 4] = u.nkt; t[tid * 8 + 5] = u.sid; }
        tab = t;
    }
    __device__ __forceinline__ bool next(int i, Unit& u) const {
        if (i >= 32) return false;
        const i32x4 a = *(const PG8_LAS i32x4*)(tab + i * 8); const int b0 = tab[i * 8 + 4], b1 = tab[i * 8 + 5];
        if (!__builtin_amdgcn_readfirstlane(a[0])) return false;
        u.pm = __builtin_amdgcn_readfirstlane(a[1]); u.pn = __builtin_amdgcn_readfirstlane(a[2]); u.k0 = __builtin_amdgcn_readfirstlane(a[3]); u.nkt = __builtin_amdgcn_readfirstlane(b0); u.sid = __builtin_amdgcn_readfirstlane(b1); return true;
    }
    __device__ __forceinline__ void a_ready(const Unit&) const {}
    __device__ __forceinline__ void done(const Unit&) const {}
};
struct MapOff : StaticOrder {
    int pm_off;
    __device__ __forceinline__ void map(long L, Unit& u) const { StaticOrder::map(L, u); u.pm += pm_off; }
};
struct MapIn {
    StaticOrder lat; int nwg, G, c, K, nextra;
    __device__ __forceinline__ void init(int G_, int c_, int K_, int nextra_) { lat.init(8192, 3840, G_, c_, K_); G = G_; c = c_; K = K_; nextra = nextra_; nwg = lat.nwg + nextra_; }
    __device__ __forceinline__ void map(long L, Unit& u) const {
        if (L < lat.nwg) { lat.map(L, u); u.pm += 4; return; }
        const int e = (int)(L - lat.nwg);
        if (nextra == 60) { u.pm = e / 15; u.pn = e % 15; } else { u.pm = e / 5; const int idx = e % 5; u.pn = idx < 4 ? 4 + idx : 14; }
        u.k0 = 0; u.nkt = K / BK; u.sid = -1;
    }
    __device__ __forceinline__ void a_ready(const Unit&) const {}
    __device__ __forceinline__ void done(const Unit&) const {}
};
struct MapMoe {
    const PG8_LAS int* tb; int ntn, G, c, K, nwg, sp;
    __device__ __forceinline__ void init(const PG8_LAS int* tb_, int ntn_, int G_, int c_, int K_, int sp_ = 0) { tb = tb_; ntn = ntn_; G = G_; c = c_; K = K_; nwg = tb_[8] * ntn_; sp = sp_; }
    __device__ __forceinline__ void map(long L, Unit& u) const {
        int wgid = (int)L; { const int q = nwg / NXCD, r = nwg % NXCD, xcd = wgid % NXCD, off = wgid / NXCD; wgid = (xcd < r ? xcd * (q + 1) : r * (q + 1) + (xcd - r) * q) + off; }
        int e = 0;
#pragma unroll
        for (int k = 1; k < 8; ++k) if (wgid >= tb[k] * ntn) e = k;
        const int t0 = tb[e], Te = tb[e + 1] - t0, local = wgid - t0 * ntn;
        const int nig = WGM * ntn, gid = local / nig, fm = gid * WGM, gsz = (Te - fm) < WGM ? (Te - fm) : WGM;
        u.pm = (sp ? e * 32 : t0) + fm + ((local % nig) % gsz); u.pn = e * ntn + (local % nig) / gsz; u.k0 = 0; u.nkt = K / BK; u.sid = -1;
    }
    __device__ __forceinline__ void a_ready(const Unit&) const {}
    __device__ __forceinline__ void done(const Unit&) const {}
};

template <class Epi, class Sched, bool ALIGN_EPI = false, bool SP2 = false, bool F8 = false>
__device__ __forceinline__ void gemm_phase(PG8_LAS unsigned char* lds, const Gemm g, const Sched& S, const Epi& E) {
    int tid_o = threadIdx.x; asm volatile("" : "+v"(tid_o));
    const int tid = tid_o, wid = __builtin_amdgcn_readfirstlane(tid >> 6), lane = tid & 63, wr = wid >> 2, wc = wid & 3, fr = lane & 15, fq = lane >> 4;
    const int K = g.K;
    unsigned voffA[2], voffB[2];
#pragma unroll
    for (int i = 0; i < 2; ++i) { int R, C; stage_rc(tid * 16 + i * 8192, R, C); const int Rb = Epi::PERM ? ((R & ~31) + perm32(R & 31)) : R;
        voffA[i] = (unsigned)(R * K + C) * 2u; voffB[i] = (unsigned)(Rb * K + C) * 2u; }
    const size_t kstep = (size_t)(BK * 2);
    const size_t hstep = (size_t)HALF * K * 2;
    const size_t tstep = 2 * hstep;
    const unsigned ldsw = (unsigned)wid * 1024u;
    const int aoff = lds_byte(wr * 64 + fr, fq * 8), boff = lds_byte(wc * 32 + fr, fq * 8);
#define PG8_SA(b, h) (((b) * 2 + (h)) * HTB)
#define PG8_SB(b, h) ((4 + (b) * 2 + (h)) * HTB)
#define PG8_STAGE(bufoff, gbase, voff) do { _Pragma("unroll") for (int _i = 0; _i < 2; ++_i) \
        __builtin_amdgcn_global_load_lds((const unsigned*)((const char*)(gbase) + (voff)[_i]), (PG8_LAS unsigned*)(lds + (bufoff) + ldsw + _i * 8192), 16, 0, 0); } while (0)
#define PG8_LD32(p0_, p1_) __builtin_shufflevector(*(const PG8_LAS i32x4*)(p0_), *(const PG8_LAS i32x4*)(p1_), 0, 1, 2, 3, 4, 5, 6, 7)
#define PG8_LDA(dst, b, h) do { if constexpr (F8) { _Pragma("unroll") for (int m = 0; m < 4; ++m) dst##8[m] = PG8_LD32(lds + PG8_SA(b, h) + aoff + m * 2048, lds + PG8_SA(b, h) + aoff + m * 2048 + 1024); } else { \
        _Pragma("unroll") for (int m = 0; m < 4; ++m) _Pragma("unroll") for (int k = 0; k < 2; ++k) dst[m][k] = *(const PG8_LAS bf16x8*)(lds + PG8_SA(b, h) + aoff + m * 2048 + k * 1024); } } while (0)
#define PG8_LDB(dst, b, h) do { if constexpr (F8) { _Pragma("unroll") for (int n = 0; n < 2; ++n) dst##8[n] = PG8_LD32(lds + PG8_SB(b, h) + boff + n * 2048, lds + PG8_SB(b, h) + boff + n * 2048 + 1024); } else { \
        _Pragma("unroll") for (int n = 0; n < 2; ++n) _Pragma("unroll") for (int k = 0; k < 2; ++k) dst[n][k] = *(const PG8_LAS bf16x8*)(lds + PG8_SB(b, h) + boff + n * 2048 + k * 1024); } } while (0)
#define PG8_MMA(ai, bj, At, Bt) do { __builtin_amdgcn_s_setprio(1); if constexpr (F8) { _Pragma("unroll") for (int m = 0; m < 4; ++m) _Pragma("unroll") for (int n = 0; n < 2; ++n) \
        asm volatile("v_mfma_f32_16x16x128_f8f6f4 %0, %1, %2, %0" : "+v"(acc[ai][bj][m][n]) : "v"(Bt##8[n]), "v"(At##8[m])); } else { \
        _Pragma("unroll") for (int m = 0; m < 4; ++m) _Pragma("unroll") for (int n = 0; n < 2; ++n) _Pragma("unroll") for (int k = 0; k < 2; ++k) \
        acc[ai][bj][m][n] = __builtin_amdgcn_mfma_f32_16x16x32_bf16(Bt[n][k], At[m][k], acc[ai][bj][m][n], 0, 0, 0); } __builtin_amdgcn_s_setprio(0); } while (0)
#define PG8_WAIT_V(n) asm volatile("s_waitcnt vmcnt(" #n ")" ::: "memory")
#define PG8_WAIT_L(n) asm volatile("s_waitcnt lgkmcnt(" #n ")" ::: "memory")
#define PG8_BAR __builtin_amdgcn_s_barrier()
#define PG8_SCHED __builtin_amdgcn_sched_barrier(0)
    Unit cur, nxt; int ui = 0;
    if (!S.next(0, cur)) return;
    f32x4 acc[2][2][4][2];
#pragma unroll
    for (int a = 0; a < 2; ++a)
#pragma unroll
        for (int b = 0; b < 2; ++b)
#pragma unroll
            for (int m = 0; m < 4; ++m)
#pragma unroll
                for (int n = 0; n < 2; ++n) acc[a][b][m][n] = (f32x4){0.f, 0.f, 0.f, 0.f};
    bf16x8 At[4][2], B0[2][2], B1[2][2]; i32x8 At8[4], B08[2], B18[2];
    const char* cA = (const char*)g.A + (size_t)cur.pm * tstep + (size_t)cur.k0 * 2; const char* cB = (const char*)g.Bt + (size_t)cur.pn * tstep + (size_t)cur.k0 * 2;
    S.a_ready(cur);
    if constexpr (SP2) {
        PG8_STAGE(PG8_SB(0, 0), cB, voffB); PG8_STAGE(PG8_SB(0, 1), cB + hstep, voffB); PG8_STAGE(PG8_SA(0, 0), cA, voffA); PG8_STAGE(PG8_SA(0, 1), cA + hstep, voffA);
        if (wr == 1) PG8_BAR;
        PG8_WAIT_V(2); PG8_BAR;
        PG8_STAGE(PG8_SB(1, 0), cB + kstep, voffB); PG8_STAGE(PG8_SA(1, 0), cA + kstep, voffA); PG8_STAGE(PG8_SB(1, 1), cB + hstep + kstep, voffB);
        PG8_WAIT_V(6); PG8_BAR;
    } else {
        PG8_STAGE(PG8_SB(0, 0), cB, voffB); PG8_STAGE(PG8_SA(0, 0), cA, voffA); PG8_STAGE(PG8_SB(0, 1), cB + hstep, voffB); PG8_STAGE(PG8_SA(0, 1), cA + hstep, voffA);
        if (wr == 1) PG8_BAR;
        PG8_WAIT_V(4); PG8_BAR;
        PG8_STAGE(PG8_SB(1, 0), cB + kstep, voffB); PG8_STAGE(PG8_SA(1, 0), cA + kstep, voffA); PG8_STAGE(PG8_SB(1, 1), cB + hstep + kstep, voffB);
        PG8_WAIT_V(6); PG8_BAR;
    }
    for (;;) {
        const bool has_next = S.next(ui + 1, nxt);
        const char* nA = has_next ? (const char*)g.A + (size_t)nxt.pm * tstep + (size_t)nxt.k0 * 2 : cA; const char* nB = has_next ? (const char*)g.Bt + (size_t)nxt.pn * tstep + (size_t)nxt.k0 * 2 : cB;
        const int nt = cur.nkt;
        for (int t = 0; t < nt; t += 2) {
            const bool last = (t == nt - 2);
            const char* a1 = cA + (size_t)(t + 1) * kstep;
            const char* a2 = last ? nA : cA + (size_t)(t + 2) * kstep; const char* b2 = last ? nB : cB + (size_t)(t + 2) * kstep;
            const char* a3 = a2 + kstep; const char* b3 = b2 + kstep;
            if (last && has_next) S.a_ready(nxt);
            if constexpr (SP2) {
            PG8_LDB(B0, 0, 0); PG8_LDB(B1, 0, 1); PG8_SCHED; PG8_LDA(At, 0, 0); PG8_STAGE(PG8_SA(1, 1), a1 + hstep, voffA);
            PG8_WAIT_V(8); PG8_WAIT_L(0); PG8_BAR; PG8_MMA(0, 0, At, B0); PG8_MMA(0, 1, At, B1); PG8_BAR; PG8_SCHED;
            PG8_LDA(At, 0, 1); PG8_STAGE(PG8_SB(0, 0), b2, voffB); PG8_STAGE(PG8_SB(0, 1), b2 + hstep, voffB); PG8_STAGE(PG8_SA(0, 0), a2, voffA);
            PG8_WAIT_V(8); PG8_WAIT_L(0); PG8_BAR; PG8_MMA(1, 0, At, B0); PG8_MMA(1, 1, At, B1); PG8_BAR; PG8_SCHED;
            PG8_LDB(B0, 1, 0); PG8_LDB(B1, 1, 1); PG8_SCHED; PG8_LDA(At, 1, 0); PG8_STAGE(PG8_SA(0, 1), a2 + hstep, voffA);
            PG8_WAIT_V(8); PG8_WAIT_L(0); PG8_BAR; PG8_MMA(0, 0, At, B0); PG8_MMA(0, 1, At, B1); PG8_BAR; PG8_SCHED;
            PG8_LDA(At, 1, 1); PG8_STAGE(PG8_SB(1, 0), b3, voffB); PG8_STAGE(PG8_SB(1, 1), b3 + hstep, voffB); PG8_STAGE(PG8_SA(1, 0), a3, voffA);
            PG8_WAIT_V(8); PG8_WAIT_L(0); PG8_BAR; PG8_MMA(1, 0, At, B0); PG8_MMA(1, 1, At, B1); PG8_BAR; PG8_SCHED;
            } else {
            PG8_LDB(B0, 0, 0); PG8_SCHED; PG8_LDA(At, 0, 0); PG8_STAGE(PG8_SA(1, 1), a1 + hstep, voffA);
            PG8_WAIT_L(8); PG8_BAR; PG8_WAIT_L(0); PG8_MMA(0, 0, At, B0); PG8_BAR; PG8_SCHED;
            PG8_LDB(B1, 0, 1); PG8_STAGE(PG8_SB(0, 0), b2, voffB);
            PG8_BAR; PG8_WAIT_L(0); PG8_MMA(0, 1, At, B1); PG8_BAR;
            PG8_LDA(At, 0, 1); PG8_STAGE(PG8_SA(0, 0), a2, voffA);
            PG8_BAR; PG8_WAIT_L(0); PG8_MMA(1, 0, At, B0); PG8_BAR; PG8_SCHED;
            PG8_STAGE(PG8_SB(0, 1), b2 + hstep, voffB);
            PG8_WAIT_V(6); PG8_BAR; PG8_MMA(1, 1, At, B1); PG8_BAR;
            PG8_LDB(B0, 1, 0); PG8_SCHED; PG8_LDA(At, 1, 0); PG8_STAGE(PG8_SA(0, 1), a2 + hstep, voffA);
            PG8_WAIT_L(8); PG8_BAR; PG8_WAIT_L(0); PG8_MMA(0, 0, At, B0); PG8_BAR; PG8_SCHED;
            PG8_LDB(B1, 1, 1); PG8_STAGE(PG8_SB(1, 0), b3, voffB);
            PG8_BAR; PG8_WAIT_L(0); PG8_MMA(0, 1, At, B1); PG8_BAR;
            PG8_LDA(At, 1, 1); PG8_STAGE(PG8_SA(1, 0), a3, voffA);
            PG8_BAR; PG8_WAIT_L(0); PG8_MMA(1, 0, At, B0); PG8_BAR; PG8_SCHED;
            PG8_STAGE(PG8_SB(1, 1), b3 + hstep, voffB);
            PG8_WAIT_V(6); PG8_BAR; PG8_MMA(1, 1, At, B1); PG8_BAR;
            }
        }
        if constexpr (ALIGN_EPI) { if (wr == 0) PG8_BAR; }
        if constexpr (F8) asm volatile("s_nop 15\n\ts_nop 7" ::: "memory");
        if constexpr (!Epi::AFTER_DRAIN) { E(acc, cur, wr, wc, fr, fq); S.done(cur); }
        if (!has_next) break;
#pragma unroll
        for (int a = 0; a < 2; ++a)
#pragma unroll
            for (int b = 0; b < 2; ++b)
#pragma unroll
                for (int m = 0; m < 4; ++m)
#pragma unroll
                    for (int n = 0; n < 2; ++n) acc[a][b][m][n] = (f32x4){0.f, 0.f, 0.f, 0.f};
        cur = nxt; cA = nA; cB = nB; ++ui;
        if constexpr (ALIGN_EPI) { if (wr == 1) PG8_BAR; }
    }
    PG8_WAIT_V(0);
    if constexpr (!ALIGN_EPI) { if (wr == 0) PG8_BAR; }
    PG8_BAR;
    if constexpr (Epi::AFTER_DRAIN) { E.fused(acc, cur, wr, wc, fr, fq, lds, wid, lane); S.done(cur); }
#undef PG8_SA
#undef PG8_SB
#undef PG8_STAGE
#undef PG8_LDA
#undef PG8_LDB
#undef PG8_MMA
#undef PG8_LD32
#undef PG8_WAIT_V
#undef PG8_WAIT_L
#undef PG8_BAR
#undef PG8_SCHED
}
}

constexpr int D = 2048, NB = 4, SEQ = 2048, CTX = 256, DFF = 5632, NE = 8, INC = 3840, MODN = 12288;
constexpr int RC = NB * CTX, RL = NB * SEQ, RT = RC + RL;
constexpr int NTN_UP = DFF / 128;
constexpr int MAXSLOT = 2 * RL + NE * 256;
constexpr float EPS = 1e-6f, LOG2E = 1.4426950408889634f;
constexpr int NWAVES = 8;
#ifndef MK_PER_PHASE
#define MK_PER_PHASE 0
#endif
constexpr int NPHASE = 17;
#ifndef MOE_F8_ON
#define MOE_F8_ON 1
#endif
#ifndef DENSE_UP_F8_ON
#define DENSE_UP_F8_ON 1
#endif
#ifndef DENSE_DN_F8_ON
#define DENSE_DN_F8_ON 0
#endif
constexpr bool DENSE_UP_F8 = DENSE_UP_F8_ON != 0, DENSE_DN_F8 = DENSE_DN_F8_ON != 0;
constexpr bool MOE_F8 = MOE_F8_ON != 0;

constexpr size_t MiB = 1u << 20;
constexpr size_t WS_CTL = 0, CTL_ZERO_BYTES = 1 * MiB;
constexpr size_t WS_MOD = 1 * MiB;
constexpr size_t WS_ROPE = 1 * MiB + 512 * 1024;
constexpr size_t WS_ROUTE = 1 * MiB + 768 * 1024;
constexpr size_t WS_WIN = 2 * MiB, WS_WOUT = 32 * MiB, WS_W13 = 48 * MiB, WS_W2 = 92 * MiB, WS_MW13 = 114 * MiB, WS_MW2 = 466 * MiB;
constexpr size_t WS_H = 642 * MiB;
constexpr size_t WS_XN = 714 * MiB;
constexpr size_t WS_PALL = 750 * MiB;
constexpr size_t WS_MIX = 818 * MiB;
constexpr size_t WS_ACT = 854 * MiB;
constexpr size_t WS_XG = 1052 * MiB;
constexpr size_t WS_Y = 1180 * MiB;
static_assert(MOE_F8, "the per-expert input regions are laid out for fp8 rows");
constexpr size_t WS_SLAB = 1268 * MiB;
constexpr size_t WS_END = 1332 * MiB;
constexpr int CW_TMO = 0, CW_CODE = 1, CW_BAR = 4096, CW_CNT = 8192;
constexpr int CW_TK = 16384;
constexpr int CW_Q0 = 9216, CW_Q1 = 9280, CW_DONE = 9344;

constexpr int RING_BYTES = 131072, LDSCTL_OFF = 139264, MISC_OFF = LDSCTL_OFF + 320, TB_OFF = LDSCTL_OFF + 512, FLAG_OFF = LDSCTL_OFF + 256, UT_OFF = LDSCTL_OFF + 1024, LDS_BYTES = 147456;

typedef unsigned short bf16;
typedef unsigned v4u __attribute__((ext_vector_type(4)));
typedef unsigned v2u __attribute__((ext_vector_type(2)));
typedef float f32x4 __attribute__((ext_vector_type(4)));
typedef float f32x16 __attribute__((ext_vector_type(16)));
typedef short bf16x8 __attribute__((ext_vector_type(8)));
typedef short v4i16_t __attribute__((ext_vector_type(4)));
typedef GAS unsigned gu32;
#define RLX_AGENT __ATOMIC_RELAXED, __HIP_MEMORY_SCOPE_AGENT
#define LDS_WAIT() asm volatile("s_waitcnt lgkmcnt(0)" ::: "memory")
__device__ __forceinline__ unsigned f2bf(float f) { unsigned u = __builtin_bit_cast(unsigned, f); return (u + 0x7fffu + ((u >> 16) & 1u)) >> 16; }
__device__ __forceinline__ unsigned pk2(float lo, float hi) { return f2bf(lo) | (f2bf(hi) << 16); }
__device__ __forceinline__ float bf2f(unsigned short b) { return __builtin_bit_cast(float, (unsigned)b << 16); }
__device__ __forceinline__ float wave_sum(float v) {
#pragma unroll
    for (int o = 1; o < 64; o <<= 1) v += __shfl_xor(v, o);
    return v;
}

#define XB_TMO      128
#define XB_XCNT(j)  (256  + 64 * (j))
#define XB_XSUB(j)  (1280 + 64 * (j))
#define XB_XGEN(j)  (2304 + 64 * (j))
#define XB_TOP      3328
#define XB_TOPGEN   3392
#define XCD_BAR_WORDS 3456
#define XB_SPIN_CAP (1u << 18)

__device__ __forceinline__ unsigned xb_ld(unsigned* p)              { return __hip_atomic_load(p, __ATOMIC_RELAXED, __HIP_MEMORY_SCOPE_AGENT); }
__device__ __forceinline__ unsigned xb_add(unsigned* p, unsigned v) { return __hip_atomic_fetch_add(p, v, __ATOMIC_RELAXED, __HIP_MEMORY_SCOPE_AGENT); }
__device__ __forceinline__ unsigned xb_xcc_id() { return (unsigned)__builtin_amdgcn_s_getreg((3 << 11) | 20) & 0xFu; }
#define XB_SPIN(cond, bar) do { unsigned _sp = 0; while (cond) { __builtin_amdgcn_s_sleep(1); \
    if ((++_sp & 255u) == 0u) { if (xb_ld(&(bar)[XB_TMO])) break; if (_sp > XB_SPIN_CAP) { atomicAdd(&(bar)[XB_TMO], 1u); break; } } } } while (0)

struct XcdBarrier {
    unsigned* bar; unsigned x;
    volatile LAS unsigned* st;
};

__device__ __forceinline__ XcdBarrier xcd_barrier_post(unsigned* bar, volatile LAS unsigned* st) {
    XcdBarrier b; b.bar = bar; b.x = xb_xcc_id(); b.st = st;
    if (threadIdx.x == 0) (void)xb_add(&bar[XB_XCNT(b.x)], 1u);
    return b;
}
__device__ __forceinline__ void xcd_barrier_complete(unsigned* bar, unsigned x, unsigned& nloc, unsigned& nx) {
    const unsigned G = gridDim.x * gridDim.y * gridDim.z;
    unsigned sum, cnt, mine, sp = 0u;
    for (;;) {
        sum = 0u; cnt = 0u; mine = 0u;
#pragma unroll
        for (unsigned j = 0; j < 16; ++j) { const unsigned c = xb_ld(&bar[XB_XCNT(j)]); sum += c; cnt += (c > 0u) ? 1u : 0u; mine = (j == x) ? c : mine; }
        if (sum == G) break;
        __builtin_amdgcn_s_sleep(1);
        if ((++sp & 255u) == 0u) { if (xb_ld(&bar[XB_TMO])) break; if (sp > XB_SPIN_CAP) { atomicAdd(&bar[XB_TMO], 1u); break; } }
    }
    nloc = mine > 0u ? mine : 1u; nx = cnt > 0u ? cnt : 1u;
}

__device__ __attribute__((noinline)) void xcd_barrier(const XcdBarrier b) {
    asm volatile("s_waitcnt vmcnt(0)" ::: "memory");
    __syncthreads();
    if (threadIdx.x == 0) {
        unsigned* bar = b.bar;
        __builtin_amdgcn_s_waitcnt(0);
        unsigned nloc = b.st[0], nx = b.st[1];
        if (nloc == 0u) { xcd_barrier_complete(bar, b.x, nloc, nx); b.st[0] = nloc; b.st[1] = nx; }
        const unsigned old = xb_add(&bar[XB_XSUB(b.x)], 1u);
        const unsigned gen = old / nloc;
        if (old + 1u == (gen + 1u) * nloc) {
            __builtin_amdgcn_fence(__ATOMIC_RELEASE, "agent");
            asm volatile("s_waitcnt vmcnt(0)" ::: "memory");
            const unsigned og = xb_add(&bar[XB_TOP], 1u);
            const unsigned tg = og / nx;
            if (og + 1u == (tg + 1u) * nx) xb_add(&bar[XB_TOPGEN], 1u);
            else XB_SPIN(xb_ld(&bar[XB_TOPGEN]) == tg, bar);
            __builtin_amdgcn_fence(__ATOMIC_ACQUIRE, "agent");
            xb_add(&bar[XB_XGEN(b.x)], 1u);
            asm volatile("s_waitcnt vmcnt(0)" ::: "memory");
        } else {
            XB_SPIN(xb_ld(&bar[XB_XGEN(b.x)]) == gen, bar);
            __builtin_amdgcn_fence(__ATOMIC_ACQUIRE, "agent");
            asm volatile("s_waitcnt vmcnt(0)" ::: "memory");
        }
    }
    __syncthreads();
}

struct Args { const float* in[27]; float* out; unsigned char* ws; int ph_lo, ph_hi; };
#define CAS __attribute__((address_space(4)))
typedef const CAS unsigned char* kaptr;
__device__ __forceinline__ kaptr ka_get() { kaptr p = (kaptr)__builtin_amdgcn_kernarg_segment_ptr(); asm volatile("" : "+s"(p)); return p; }
#define KIN(kp, i) (*(const float* const CAS*)((kp) + 8 * (i)))
#define KOUT(kp) (*(float* const CAS*)((kp) + 216))
#define KWS(kp) (*(unsigned char* const CAS*)((kp) + 224))
#define KLO(kp) (*(const int CAS*)((kp) + 232))
#define KHI(kp) (*(const int CAS*)((kp) + 236))
static_assert(sizeof(Args) == 240, "Args layout");

__device__ __forceinline__ int dst_row(int mode, int n) {
    if (mode == 1) {
        const bool qk = (n >= 512 && n < 1536) || (n >= 3072 && n < 3712);
        if (qk) { const int d = n & 63; return (n & ~63) + (d < 32 ? 2 * d : 2 * (d - 32) + 1); }
        return n;
    }
    if (mode == 2) return (n >> 7) * 256 + (n & 127);
    if (mode == 3) return (n >> 7) * 256 + 128 + (n & 127);
    return n;
}
constexpr int TSCR = 64 * 65 * 4;
template <bool NTL>
__device__ __forceinline__ void ti_load(const float* W, int N, int item, int lane, f32x4 (&v)[16]) {
    const int nblk = N / 64, kb = item / nblk, nb = item % nblk, k0 = 64 * kb, n0 = 64 * nb;
    const GAS f32x4* src = (const GAS f32x4*)(W + (size_t)(k0 + (lane >> 4)) * N + n0 + 4 * (lane & 15));
#pragma unroll
    for (int i = 0; i < 16; ++i) v[i] = NTL ? __builtin_nontemporal_load(src + (size_t)i * N) : src[(size_t)i * N];
}
template <bool NTS, bool F8>
__device__ __forceinline__ void ti_store(const f32x4 (&v)[16], int K, int N, bf16* WT, int mode, LAS float* scr, int item, int lane) {
    const int nblk = N / 64, kb = item / nblk, nb = item % nblk, k0 = 64 * kb, n0 = 64 * nb;
    LAS float* wp = scr + (lane >> 4) * 65 + 4 * (lane & 15);
#pragma unroll
    for (int i = 0; i < 16; ++i) { wp[i * 4 * 65 + 0] = v[i].x; wp[i * 4 * 65 + 1] = v[i].y; wp[i * 4 * 65 + 2] = v[i].z; wp[i * 4 * 65 + 3] = v[i].w; }
    LDS_WAIT(); asm volatile("" ::: "memory");
    if constexpr (F8) {
        const int c = lane & 3;
#pragma unroll
        for (int j = 0; j < 4; ++j) { const int n = (lane >> 2) + 16 * j; const LAS float* s = scr + (16 * c) * 65 + n;
            v4u o;
#pragma unroll
            for (int q = 0; q < 4; ++q) o[q] = pg8::cvt4_fp8(256.0f * s[(4 * q) * 65], 256.0f * s[(4 * q + 1) * 65], 256.0f * s[(4 * q + 2) * 65], 256.0f * s[(4 * q + 3) * 65]);
            GAS v4u* dp = (GAS v4u*)((unsigned char*)WT + (size_t)dst_row(mode, n0 + n) * K + k0 + 16 * c); if (NTS) __builtin_nontemporal_store(o, dp); else *dp = o; }
    } else {
        const int c = lane & 7;
#pragma unroll
        for (int j = 0; j < 8; ++j) { const int n = (lane >> 3) + 8 * j; const LAS float* s = scr + (8 * c) * 65 + n;
            v4u o; o.x = pk2(s[0 * 65], s[1 * 65]); o.y = pk2(s[2 * 65], s[3 * 65]); o.z = pk2(s[4 * 65], s[5 * 65]); o.w = pk2(s[6 * 65], s[7 * 65]);
            GAS v4u* dp = (GAS v4u*)(WT + (size_t)dst_row(mode, n0 + n) * K + k0 + 8 * c); if (NTS) __builtin_nontemporal_store(o, dp); else *dp = o; }
    }
    LDS_WAIT(); asm volatile("" ::: "memory");
}
template <bool NT, bool F8 = false, bool NTL = false>
__device__ __forceinline__ void transpose_item(const float* W, int K, int N, bf16* WT, int mode, LAS float* scr, int item, int lane, const float*) {
    f32x4 v[16]; ti_load<NT || NTL>(W, N, item, lane, v); ti_store<NT, F8>(v, K, N, WT, mode, scr, item, lane);
}
__device__ __forceinline__ void p0_prologue(kaptr kp, LAS unsigned char* lds, int vcu, int G, int tid, int lane, int wave) {
    unsigned char* ws = KWS(kp);
    for (int j = vcu; j < 256; j += G) {
        const int l = j >> 7, g = (j >> 5) & 3, k0 = (j & 31) * 64;
        LAS float* As = (LAS float*)lds;
        LAS float* Ps = As + 64 * 132;
        const float* Wsrc = KIN(kp, 8) + (size_t)l * D * INC + (size_t)k0 * INC + g * 128;
        const float* Psrc = KIN(kp, 10) + ((size_t)l * 4 + g) * 128 * 128;
#pragma unroll
        for (int i = 0; i < 4; ++i) { const int idx = tid + 512 * i, r = idx >> 5, c4 = idx & 31; *(LAS f32x4*)(As + r * 132 + 4 * c4) = *(const GAS f32x4*)(Wsrc + (size_t)r * INC + 4 * c4); }
#pragma unroll
        for (int i = 0; i < 8; ++i) { const int idx = tid + 512 * i, r = idx >> 5, c4 = idx & 31; *(LAS f32x4*)(Ps + r * 132 + 4 * c4) = *(const GAS f32x4*)(Psrc + (size_t)r * 128 + 4 * c4); }
        __syncthreads();
        const int n4 = tid & 31, kq = tid >> 5;
        f32x4 acc[4];
#pragma unroll
        for (int i = 0; i < 4; ++i) acc[i] = (f32x4){0.f, 0.f, 0.f, 0.f};
#pragma unroll 4
        for (int c = 0; c < 128; ++c) { const f32x4 pv = *(const LAS f32x4*)(Ps + c * 132 + 4 * n4);
#pragma unroll
            for (int i = 0; i < 4; ++i) acc[i] += As[(4 * kq + i) * 132 + c] * pv; }
        bf16* WT = (bf16*)(ws + WS_WIN) + (size_t)l * INC * D;
#pragma unroll
        for (int e = 0; e < 4; ++e) { v2u o; o.x = pk2(acc[0][e], acc[1][e]); o.y = pk2(acc[2][e], acc[3][e]);
            *(GAS v2u*)(WT + (size_t)(g * 128 + 4 * n4 + e) * D + k0 + 4 * kq) = o; }
        __syncthreads();
    }
    for (int j = vcu; j < 192; j += G) {
        const int l = j / 96, n0 = (j % 96) * 128;
        LAS float* S = (LAS float*)lds; LAS float* red = S + 5 * 2048;
        for (int idx = tid; idx < 5 * 2048; idx += NWAVES * 64) { const int i = idx >> 11, k = idx & 2047; const float v = i < 4 ? KIN(kp, 1)[i * 2048 + k] : KIN(kp, 3)[k]; S[idx] = v / (1.0f + expf(-v)); }
        __syncthreads();
        f32x4 acc[5];
#pragma unroll
        for (int i = 0; i < 5; ++i) acc[i] = (f32x4){0.f, 0.f, 0.f, 0.f};
        const int kh = lane >> 5;
        const GAS f32x4* wp = (const GAS f32x4*)(KIN(kp, 4) + ((size_t)l * 2048 + wave * 256 + kh) * MODN + n0 + 4 * (lane & 31));
#pragma unroll 8
        for (int k = 0; k < 128; ++k) { const f32x4 w = __builtin_nontemporal_load(wp + (size_t)k * (2 * MODN / 4));
#pragma unroll
            for (int i = 0; i < 5; ++i) acc[i] += S[i * 2048 + wave * 256 + 2 * k + kh] * w; }
#pragma unroll
        for (int i = 0; i < 5; ++i) { f32x4 t = acc[i]; t.x += __shfl_xor(t.x, 32); t.y += __shfl_xor(t.y, 32); t.z += __shfl_xor(t.z, 32); t.w += __shfl_xor(t.w, 32);
            if (kh == 0) *(LAS f32x4*)(red + (wave * 5 + i) * 128 + 4 * (lane & 31)) = t; }
        __syncthreads();
        for (int idx = tid; idx < 640; idx += NWAVES * 64) { const int i = idx >> 7, n = idx & 127; float s = 0.f;
#pragma unroll
            for (int w = 0; w < 8; ++w) s += red[(w * 5 + i) * 128 + n];
            ((float*)(ws + WS_MOD))[(l * 5 + i) * MODN + n0 + n] = s + KIN(kp, 5)[l * MODN + n0 + n]; }
        __syncthreads();
    }
    if (vcu == (200 % G)) {
        for (int idx = tid; idx < 1024; idx += NWAVES * 64) { const int pos = idx >> 4, f = idx & 15; const float inv = powf(10000.0f, -(float)f / 16.0f); const float ang = (float)pos * inv;
            ((float*)(ws + WS_ROPE))[idx] = cosf(ang); ((float*)(ws + WS_ROPE))[1024 + idx] = sinf(ang); }
    }
    __syncthreads();
    LAS float* scr = (LAS float*)(lds + wave * TSCR);
    constexpr int I_IN = 32 * 52, I_OUT = 32 * 32, I_UP = 32 * 88, I_DN = 88 * 32;
    constexpr int NITEMS = 2 * I_IN + 2 * I_OUT + 2 * I_UP + I_DN;
    unsigned* q0 = (unsigned*)(ws + WS_CTL) + CW_Q0;
#define P0_DESC(it_, W_, K_, N_, WT_, M_, I_, F_) do { int r = (it_); F_ = false; \
        if (r < 2 * I_IN) { const int l = r / I_IN; W_ = KIN(kp, 8) + (size_t)l * D * INC; K_ = D; N_ = INC; WT_ = (bf16*)(ws + WS_WIN) + (size_t)l * INC * D; M_ = 1; const int q = r % I_IN; I_ = (q / 52) * 60 + 8 + (q % 52); } \
        else if ((r -= 2 * I_IN) < 2 * I_OUT) { const int l = r / I_OUT; W_ = KIN(kp, 9) + (size_t)l * D * D; K_ = D; N_ = D; WT_ = (bf16*)(ws + WS_WOUT) + (size_t)l * D * D; M_ = 0; I_ = r % I_OUT; } \
        else if ((r -= 2 * I_OUT) < I_UP) { W_ = KIN(kp, 19); K_ = D; N_ = DFF; WT_ = (bf16*)(ws + WS_W13); M_ = 2; I_ = r; F_ = DENSE_UP_F8; } \
        else if ((r -= I_UP) < I_UP) { W_ = KIN(kp, 20); K_ = D; N_ = DFF; WT_ = (bf16*)(ws + WS_W13); M_ = 3; I_ = r; F_ = DENSE_UP_F8; } \
        else { r -= I_UP; W_ = KIN(kp, 21); K_ = DFF; N_ = D; WT_ = (bf16*)(ws + WS_W2); M_ = 0; I_ = r; F_ = DENSE_DN_F8; } } while (0)
    for (;;) {
        unsigned k0 = 0; if (lane == 0) k0 = __hip_atomic_fetch_add(q0, 2u, RLX_AGENT);
        const int kb = (int)__builtin_amdgcn_readfirstlane(k0); if (kb >= NITEMS) break;
        const float* Wa; int Ka, Na, ma, ia; bf16* WTa; bool fa; f32x4 va[16];
        P0_DESC(kb, Wa, Ka, Na, WTa, ma, ia, fa); ti_load<true>(Wa, Na, ia, lane, va);
        const bool two = kb + 1 < NITEMS;
        const float* Wb = Wa; int Kb = Ka, Nb = Na, mb = ma, ib = ia; bf16* WTb = WTa; bool fb = fa; f32x4 vb[16];
        if (two) { P0_DESC(kb + 1, Wb, Kb, Nb, WTb, mb, ib, fb); ti_load<true>(Wb, Nb, ib, lane, vb); }
        if (fa) ti_store<false, true>(va, Ka, Na, WTa, ma, scr, ia, lane); else ti_store<false, false>(va, Ka, Na, WTa, ma, scr, ia, lane);
        if (two) { if (fb) ti_store<false, true>(vb, Kb, Nb, WTb, mb, scr, ib, lane); else ti_store<false, false>(vb, Kb, Nb, WTb, mb, scr, ib, lane); }
    }
#undef P0_DESC
}

__device__ __attribute__((noinline)) void fill_tail(unsigned char* ws, const float* w1, const float* w3, const float* w2, unsigned* done, int G, int nw) {
    extern __shared__ __attribute__((aligned(16))) unsigned char lds_fill[];
    LAS unsigned char* lds = (LAS unsigned char*)lds_fill;
    const int tid = threadIdx.x, lane = tid & 63, wave = __builtin_amdgcn_readfirstlane(tid >> 6);
    volatile LAS unsigned* flag = (volatile LAS unsigned*)(lds + FLAG_OFF);
    __syncthreads();
    if (tid == 0) { unsigned f = 0u; if (done) { const unsigned old = __hip_atomic_fetch_add(done, 1u, RLX_AGENT); f = (old + 1u >= (unsigned)G) ? 1u : 0u; } *flag = f; }
    __syncthreads();
    LAS float* scr = (LAS float*)(lds + wave * TSCR);
    unsigned* q1 = (unsigned*)(ws + WS_CTL) + CW_Q1;
    constexpr int I_UP = 32 * 88, NIT = 24 * I_UP;
#ifndef FILLW
#define FILLW 2
#endif
#ifndef FILLB
#define FILLB 4
#endif
#ifdef PROBE_BURN
    if (done && wave >= FILLW) {
        f32x16 acc; for (int r = 0; r < 16; ++r) acc[r] = 0.f; const bf16x8 a = (bf16x8){1, 2, 3, 4, 5, 6, 7, 8};
        while (!*flag) { for (int it = 0; it < 64; ++it) acc = __builtin_amdgcn_mfma_f32_32x32x16_bf16(a, a, acc, 0, 0, 0); if (__hip_atomic_load(done, RLX_AGENT) >= (unsigned)G) break; }
        if (acc[0] == 12345.f) *flag = 2u;
        return; }
#endif
    if (done && wave >= nw) return;
#define FILL_ITEM(it_) do { const int it__ = (it_); const int seg = it__ / I_UP, item = it__ % I_UP, mat = seg >> 3, e = seg & 7; \
        if (mat == 0) transpose_item<true, MOE_F8>(w1 + (size_t)e * D * DFF, D, DFF, (bf16*)(ws + WS_MW13 + (size_t)e * 2 * DFF * D * (MOE_F8 ? 1 : 2)), 2, scr, item, lane, nullptr); \
        else if (mat == 1) transpose_item<true, MOE_F8>(w3 + (size_t)e * D * DFF, D, DFF, (bf16*)(ws + WS_MW13 + (size_t)e * 2 * DFF * D * (MOE_F8 ? 1 : 2)), 3, scr, item, lane, nullptr); \
        else transpose_item<true, MOE_F8>(w2 + (size_t)e * DFF * D, DFF, D, (bf16*)(ws + WS_MW2 + (size_t)e * D * DFF * (MOE_F8 ? 1 : 2)), 0, scr, item, lane, nullptr); } while (0)
    if (!done) return;
    for (;;) {
        if (*flag) break;
        if (tid == 0) { if (__hip_atomic_load(done, RLX_AGENT) >= (unsigned)G) *flag = 1u; }
        if (*flag) break;
        unsigned k0 = 0; if (lane == 0) k0 = __hip_atomic_fetch_add(q1, (unsigned)FILLB, RLX_AGENT);
        const int kb = (int)__builtin_amdgcn_readfirstlane(k0); if (kb >= NIT) break;
        for (int it = kb; it < kb + FILLB && it < NIT; ++it) FILL_ITEM(it);
    }
#undef FILL_ITEM
}

__device__ __forceinline__ void drain_tail(unsigned char* ws, const float* w1, const float* w3, const float* w2, int G, LAS unsigned char* lds) {
    int tid = threadIdx.x; asm volatile("" : "+v"(tid));
    const int lane = tid & 63, wave = __builtin_amdgcn_readfirstlane(tid >> 6);
    __syncthreads();
    LAS float* scr = (LAS float*)(lds + wave * TSCR);
    unsigned* q1 = (unsigned*)(ws + WS_CTL) + CW_Q1;
    constexpr int I_UP = 32 * 88, NIT = 24 * I_UP;
        const int h = (int)__builtin_amdgcn_readfirstlane(__hip_atomic_load(q1, RLX_AGENT));
        const int gwv = blockIdx.x * NWAVES + wave, ngw = G * NWAVES;
#define MOE_DESC(it_, W_, K_, N_, WT_, M_, I_) do { const int seg_ = (it_) / I_UP, mat_ = seg_ >> 3, e_ = seg_ & 7; I_ = (it_) % I_UP; \
        if (mat_ == 0) { W_ = w1 + (size_t)e_ * D * DFF; K_ = D; N_ = DFF; WT_ = (bf16*)(ws + WS_MW13 + (size_t)e_ * 2 * DFF * D * (MOE_F8 ? 1 : 2)); M_ = 2; } \
        else if (mat_ == 1) { W_ = w3 + (size_t)e_ * D * DFF; K_ = D; N_ = DFF; WT_ = (bf16*)(ws + WS_MW13 + (size_t)e_ * 2 * DFF * D * (MOE_F8 ? 1 : 2)); M_ = 3; } \
        else { W_ = w2 + (size_t)e_ * DFF * D; K_ = DFF; N_ = D; WT_ = (bf16*)(ws + WS_MW2 + (size_t)e_ * D * DFF * (MOE_F8 ? 1 : 2)); M_ = 0; } } while (0)
        int it = h + gwv;
        if (it < NIT) {
            const float* W; int K, N, md, item; bf16* WT; f32x4 v[16];
            MOE_DESC(it, W, K, N, WT, md, item); ti_load<true>(W, N, item, lane, v);
            for (;;) {
                const int nx = it + ngw; const float* Wn = W; int Kn = K, Nn = N, mdn = md, itemn = item; bf16* WTn = WT; f32x4 vn[16];
                const bool more = nx < NIT;
                if (more) { MOE_DESC(nx, Wn, Kn, Nn, WTn, mdn, itemn); ti_load<true>(Wn, Nn, itemn, lane, vn); }
                ti_store<true, MOE_F8>(v, K, N, WT, md, scr, item, lane);
                if (!more) break;
#pragma unroll
                for (int i = 0; i < 16; ++i) v[i] = vn[i];
                it = nx; W = Wn; K = Kn; N = Nn; WT = WTn; md = mdn; item = itemn;
            }
        }
#undef MOE_DESC
}

template <class Epi, class Ord>
__device__ __forceinline__ void combine_tail(const Epi& E, const Ord& S, const float* slab, unsigned* tickets, LAS unsigned char* lds) {
    int tt; pg8::Unit tu;
    if (!S.tail_unit(tt, tu)) return;
    int tid = threadIdx.x; asm volatile("" : "+v"(tid));
    const int lane = tid & 63, wid = __builtin_amdgcn_readfirstlane(tid >> 6), wr = wid >> 2, wc = wid & 3, fr = lane & 15, fq = lane >> 4;
    volatile LAS unsigned* flag = (volatile LAS unsigned*)(lds + FLAG_OFF);
    asm volatile("s_waitcnt vmcnt(0)" ::: "memory");
    __syncthreads();
    if (tid == 0) {
        __builtin_amdgcn_fence(__ATOMIC_RELEASE, "agent");
        asm volatile("s_waitcnt vmcnt(0)" ::: "memory");
        const unsigned t = __hip_atomic_fetch_add(tickets + 64 * tt, 1u, RLX_AGENT);
        const bool last = (t == (unsigned)S.tp.S - 1u);
        if (last) { __builtin_amdgcn_fence(__ATOMIC_ACQUIRE, "agent"); asm volatile("s_waitcnt vmcnt(0)" ::: "memory"); }
        *flag = last ? 1u : 0u;
    }
    __syncthreads();
    if (*flag) {
        const int ns = S.tp.S;
        const GAS pg8::f32x4* sp = (const GAS pg8::f32x4*)slab + (size_t)(tt * ns) * (32 * 512) + tid;
        pg8::f32x4 acc[2][2][4][2];
#pragma unroll
        for (int ai = 0; ai < 2; ++ai)
#pragma unroll
            for (int bj = 0; bj < 2; ++bj)
#pragma unroll
                for (int m = 0; m < 4; ++m)
#pragma unroll
                    for (int n = 0; n < 2; ++n) { const int r = (((ai * 2 + bj) * 4 + m) * 2) + n; pg8::f32x4 a = sp[(size_t)r * 512];
                        for (int ks = 1; ks < ns; ++ks) a += sp[(size_t)ks * (32 * 512) + (size_t)r * 512];
                        acc[ai][bj][m][n] = a; }
        E(acc, tu, wr, wc, fr, fq);
    }
    __syncthreads();
}

template <bool ROUTE, bool F8 = false>
__device__ __forceinline__ void norm_rows(const float* srcC, const float* srcL, const float* gain, const float* shift, const float* scale, bf16* XN, int row_lo, int row_hi, int gw, int NGW, int lane,
                                          const LAS float* rt, unsigned* cnt, int* route) {
    f32x4 vn[8];
    { const int row = row_lo + gw; if (row < row_hi) { const GAS f32x4* xr = (const GAS f32x4*)((row < RC ? srcC : srcL) + (size_t)row * D) + lane;
#pragma unroll
        for (int j = 0; j < 8; ++j) vn[j] = xr[64 * j]; } }
    unsigned pk[8]; int pe1 = 0, pe2 = 0, ps1 = 0, ps2 = 0, prow = 0; float pw1 = 0.f, pw2 = 0.f; bool have = false;
#define ROUTE_FLUSH() do { if constexpr (ROUTE && F8) { \
        if (lane == 0) { int* rec = route + (size_t)(prow - RC) * 8; rec[0] = pe1; rec[1] = ps1; rec[2] = __builtin_bit_cast(int, pw1); rec[3] = pe2; rec[4] = ps2; rec[5] = __builtin_bit_cast(int, pw2); } \
        const int e1_ = __builtin_amdgcn_readfirstlane(pe1), e2_ = __builtin_amdgcn_readfirstlane(pe2), s1_ = __builtin_amdgcn_readfirstlane(ps1), s2_ = __builtin_amdgcn_readfirstlane(ps2); \
        GAS unsigned* d1 = (GAS unsigned*)((unsigned char*)XN + ((size_t)e1_ * 8192 + s1_) * D) + lane; GAS unsigned* d2 = (GAS unsigned*)((unsigned char*)XN + ((size_t)e2_ * 8192 + s2_) * D) + lane; \
        _Pragma("unroll") for (int j = 0; j < 8; ++j) { d1[64 * j] = pk[j]; d2[64 * j] = pk[j]; } } } while (0)
    f32x4 gg[8];
#pragma unroll
    for (int j = 0; j < 8; ++j) gg[j] = ((const GAS f32x4*)gain + lane)[64 * j];
    for (int row = row_lo + gw; row < row_hi; row += NGW) {
        const int bidx = row < RC ? 4 : ((row - RC) >> 11);
        f32x4 v[8]; float ss = 0.f;
        f32x4 shh[8], scc[8];
        { const GAS f32x4* sh4 = (const GAS f32x4*)(shift + bidx * MODN) + lane; const GAS f32x4* sc4 = (const GAS f32x4*)(scale + bidx * MODN) + lane;
#pragma unroll
          for (int j = 0; j < 8; ++j) { shh[j] = sh4[64 * j]; scc[j] = sc4[64 * j]; } }
        asm volatile("" ::: "memory");
#pragma unroll
        for (int j = 0; j < 8; ++j) { v[j] = vn[j]; ss += (v[j].x * v[j].x + v[j].y * v[j].y) + (v[j].z * v[j].z + v[j].w * v[j].w); }
        { const int nrow = row + NGW; if (nrow < row_hi) { const GAS f32x4* xr = (const GAS f32x4*)((nrow < RC ? srcC : srcL) + (size_t)nrow * D) + lane;
#pragma unroll
            for (int j = 0; j < 8; ++j) vn[j] = xr[64 * j]; } }
        const float rstd = 1.0f / sqrtf(wave_sum(ss) * (1.0f / D) + EPS);
        GAS unsigned long long* o8 = (GAS unsigned long long*)(XN + (size_t)row * D) + lane; GAS unsigned* o4 = (GAS unsigned*)((unsigned char*)XN + (size_t)row * D) + lane;
#pragma unroll
        for (int j = 0; j < 8; ++j) { v[j] = (v[j] * rstd * gg[j]) * (1.0f + scc[j]) + shh[j];
            if constexpr (ROUTE) {}
            else if constexpr (F8) o4[64 * j] = pg8::cvt4_fp8(v[j].x, v[j].y, v[j].z, v[j].w);
            else o8[64 * j] = (unsigned long long)pk2(v[j].x, v[j].y) | ((unsigned long long)pk2(v[j].z, v[j].w) << 32); }
        if (ROUTE) {
            float lg[8];
#pragma unroll
            for (int e = 0; e < 8; ++e) lg[e] = 0.f;
#pragma unroll
            for (int j = 0; j < 8; ++j)
#pragma unroll
                for (int q = 0; q < 4; ++q) { const int k = 256 * j + 4 * lane + q; const LAS f32x4* rp = (const LAS f32x4*)(rt + k * 8); const f32x4 r0 = rp[0], r1 = rp[1]; const float f = v[j][q];
                    lg[0] += f * r0.x; lg[1] += f * r0.y; lg[2] += f * r0.z; lg[3] += f * r0.w; lg[4] += f * r1.x; lg[5] += f * r1.y; lg[6] += f * r1.z; lg[7] += f * r1.w;
                    if (q == 3) asm volatile("" ::: "memory"); }
#pragma unroll
            for (int e = 0; e < 8; ++e) lg[e] = wave_sum(lg[e]);
            int i1 = 0; float v1 = lg[0];
#pragma unroll
            for (int e = 1; e < 8; ++e) if (lg[e] > v1) { v1 = lg[e]; i1 = e; }
            int i2 = -1; float v2 = -INFINITY;
#pragma unroll
            for (int e = 0; e < 8; ++e) if (e != i1 && lg[e] > v2) { v2 = lg[e]; i2 = e; }
            const float w1 = 1.0f / (1.0f + expf(v2 - v1)), w2 = 1.0f - w1;
            if (have) ROUTE_FLUSH();
            ps1 = 0; ps2 = 0;
            if (lane == 0) { ps1 = (int)__hip_atomic_fetch_add(cnt + 64 * i1, 1u, RLX_AGENT); ps2 = (int)__hip_atomic_fetch_add(cnt + 64 * i2, 1u, RLX_AGENT); }
            pe1 = i1; pe2 = i2; pw1 = w1; pw2 = w2; prow = row; have = true;
#pragma unroll
            for (int j = 0; j < 8; ++j) pk[j] = pg8::cvt4_fp8(v[j].x, v[j].y, v[j].z, v[j].w);
        }
    }
    if (ROUTE) { if (have) ROUTE_FLUSH(); }
#undef ROUTE_FLUSH
}

struct TileSpec { int nband, band_row0, ctx_row0, nt; };
__device__ __forceinline__ int crow(int r, int hi) { return (r & 3) + 8 * (r >> 2) + 4 * hi; }
template <int NKC, int DVB, bool WIN>
__device__ __forceinline__ void attn_core(LAS unsigned char* lds, const bf16* P, const bf16x8 (&qr)[4], int kcol, int vcol, int kofs, const TileSpec ts, int qpos, int bandpos0,
                                          f32x16 (&o)[DVB], f32x16& ol, float& mref_out, int tid, int lane) {
    constexpr int SB = NKC * 1024 + DVB * 4096, NK = NKC / 8, NV = DVB / 2;
    constexpr float THR = 8.0f;
    const int r32 = lane & 31, hi = lane >> 5, wv = __builtin_amdgcn_readfirstlane(tid >> 6);
    int koff[NK], voff[NV];
#pragma unroll
    for (int i = 0; i < NK; ++i) { const int q = tid + 512 * i, key = q / NKC, s = q % NKC; koff[i] = key * INC + kcol + (s ^ (NKC == 16 ? (key & 15) : ((key >> 1) & 7))) * 8; }
#pragma unroll
    for (int i = 0; i < NV; ++i) { const int q = tid + 512 * i; voff[i] = (((q >> 6) & 3) * 16 + ((q >> 2) & 15)) * INC + vcol + (q >> 8) * 32 + (q & 3) * 8; }
#define ATT_DMA(t_, s_) do { const int t__ = (t_); const int rb_ = t__ < ts.nband ? ts.band_row0 + 64 * t__ : ts.ctx_row0 + 64 * (t__ - ts.nband); const bf16* tb_ = P + (size_t)rb_ * INC; \
        _Pragma("unroll") for (int i_ = 0; i_ < NK; ++i_) __builtin_amdgcn_global_load_lds((const unsigned*)(tb_ + koff[i_]), (LAS unsigned*)(lds + (s_) * SB + (wv * 64 + 512 * i_) * 16), 16, 0, 0); \
        _Pragma("unroll") for (int i_ = 0; i_ < NV; ++i_) __builtin_amdgcn_global_load_lds((const unsigned*)(tb_ + voff[i_]), (LAS unsigned*)(lds + (s_) * SB + NKC * 1024 + (wv * 64 + 512 * i_) * 16), 16, 0, 0); } while (0)
    float mref = 0.f;
    f32x16 negm;
#pragma unroll
    for (int r = 0; r < 16; ++r) { negm[r] = 0.f; ol[r] = 0.f; }
#pragma unroll
    for (int d0 = 0; d0 < DVB; ++d0)
#pragma unroll
        for (int r = 0; r < 16; ++r) o[d0][r] = 0.f;
    const short one = (r32 == 0) ? (short)0x3F80 : (short)0;
    const bf16x8 onesf = (bf16x8){one, one, one, one, one, one, one, one};
    ATT_DMA(0, 0); asm volatile("s_waitcnt vmcnt(0)" ::: "memory"); __syncthreads();
#pragma unroll 1
    for (int t = 0; t < ts.nt; ++t) {
        if (t + 1 < ts.nt) ATT_DMA(t + 1, (t + 1) & 1);
        LAS unsigned char* sb = lds + (t & 1) * SB;
        f32x16 p0, p1;
        { const LAS unsigned char* kb = sb + r32 * (NKC * 16);
#pragma unroll
          for (int d0 = 0; d0 < 4; ++d0) { const int so = ((kofs + 2 * d0 + hi) ^ (NKC == 16 ? (r32 & 15) : ((r32 >> 1) & 7))) * 16; const bf16x8 b0 = *(const LAS bf16x8*)(kb + so), b1 = *(const LAS bf16x8*)(kb + 32 * (NKC * 16) + so);
              if (d0 == 0) { p0 = __builtin_amdgcn_mfma_f32_32x32x16_bf16(b0, qr[0], negm, 0, 0, 0); p1 = __builtin_amdgcn_mfma_f32_32x32x16_bf16(b1, qr[0], negm, 0, 0, 0); }
              else { p0 = __builtin_amdgcn_mfma_f32_32x32x16_bf16(b0, qr[d0], p0, 0, 0, 0); p1 = __builtin_amdgcn_mfma_f32_32x32x16_bf16(b1, qr[d0], p1, 0, 0, 0); } } }
        if (WIN) { if (t < ts.nband) { const int kp0 = bandpos0 + 64 * t + 4 * hi;
#pragma unroll
            for (int r = 0; r < 16; ++r) { const int dlt = qpos - (kp0 + (r & 3) + 8 * (r >> 2)); if (dlt > 128 || dlt < -128) p0[r] = -1e30f; if (dlt - 32 > 128 || dlt - 32 < -128) p1[r] = -1e30f; } } }
        float rm = fmaxf(fmaxf(p0[0], p0[1]), p1[0]);
#pragma unroll
        for (int r = 1; r < 16; ++r) rm = fmaxf(fmaxf(rm, p0[r]), p1[r]);
        rm = fmaxf(rm, p0[1]);
        rm = fmaxf(rm, __shfl_xor(rm, 32));
        if (t == 0 || __any(rm > THR)) {
            const float dl = t == 0 ? rm : fmaxf(rm, 0.f);
            mref += dl;
#pragma unroll
            for (int r = 0; r < 16; ++r) { p0[r] -= dl; p1[r] -= dl; negm[r] = -mref; }
            if (t != 0) { const float f = __builtin_amdgcn_exp2f(-dl);
#pragma unroll
                for (int r = 0; r < 16; ++r) { const float fr = __shfl(f, crow(r, hi)); ol[r] *= fr;
#pragma unroll
                    for (int d0 = 0; d0 < DVB; ++d0) o[d0][r] *= fr; } }
        }
#pragma unroll
        for (int r = 0; r < 16; ++r) { p0[r] = __builtin_amdgcn_exp2f(p0[r]); p1[r] = __builtin_amdgcn_exp2f(p1[r]); }
        v4u pw[4];
#pragma unroll
        for (int i = 0; i < 4; ++i) { pw[0][i] = pg8::cvt_pk_bf16(p0[2 * i], p0[2 * i + 1]); pw[1][i] = pg8::cvt_pk_bf16(p0[8 + 2 * i], p0[8 + 2 * i + 1]); pw[2][i] = pg8::cvt_pk_bf16(p1[2 * i], p1[2 * i + 1]); pw[3][i] = pg8::cvt_pk_bf16(p1[8 + 2 * i], p1[8 + 2 * i + 1]); }
        { const LAS unsigned char* vb = sb + NKC * 1024 + ((lane >> 4) & 1) * 32 + (lane & 3) * 8 + (4 * hi + ((lane & 15) >> 2)) * 64;
#pragma unroll
          for (int d0 = 0; d0 < DVB; ++d0)
#pragma unroll
              for (int ks = 0; ks < 4; ++ks) {
                  const v4i16_t lo = __builtin_amdgcn_ds_read_tr16_b64_v4i16((LAS v4i16_t*)(vb + d0 * 4096 + ks * 1024)), hh = __builtin_amdgcn_ds_read_tr16_b64_v4i16((LAS v4i16_t*)(vb + d0 * 4096 + ks * 1024 + 512));
                  const bf16x8 vf = (bf16x8){lo[0], lo[1], lo[2], lo[3], hh[0], hh[1], hh[2], hh[3]};
                  o[d0] = __builtin_amdgcn_mfma_f32_32x32x16_bf16(__builtin_bit_cast(bf16x8, pw[ks]), vf, o[d0], 0, 0, 0);
                  if (ks == 3) asm volatile("" ::: "memory"); }
#pragma unroll
          for (int ks = 0; ks < 4; ++ks) ol = __builtin_amdgcn_mfma_f32_32x32x16_bf16(__builtin_bit_cast(bf16x8, pw[ks]), onesf, ol, 0, 0, 0); }
        asm volatile("s_waitcnt vmcnt(0)" ::: "memory");
        __syncthreads();
    }
#undef ATT_DMA
    mref_out = mref;
}
template <int DVB>
__device__ __forceinline__ void attn_normalize(f32x16 (&o)[DVB], const f32x16& ol, float extra, int hi) {
#pragma unroll
    for (int r = 0; r < 16; ++r) { const float l = __shfl(ol[r], hi << 5) + __shfl(extra, crow(r, hi)); const float ir = 1.0f / l;
#pragma unroll
        for (int d0 = 0; d0 < DVB; ++d0) o[d0][r] *= ir; }
}

__device__ __forceinline__ void win_unit(LAS unsigned char* lds, const bf16* P, bf16* MIX, const float* sink, int b, int g, int qb, bool ctxq, int tid, int lane, int wave) {
    const int r32 = lane & 31, hi = lane >> 5, hr = wave >> 1, sub = (wave & 1) * 32;
    TileSpec ts; int qrow0, qpos = 0, bandpos0 = 0;
    if (!ctxq) { const int tl = qb - 2 < 0 ? 0 : qb - 2, th = qb + 2 > 31 ? 31 : qb + 2; ts.nband = th - tl + 1; ts.band_row0 = RC + b * SEQ + tl * 64; bandpos0 = tl * 64; ts.ctx_row0 = b * CTX; ts.nt = ts.nband + 4;
        qrow0 = RC + b * SEQ + qb * 64 + sub; qpos = qb * 64 + sub + r32; }
    else { ts.nband = 0; ts.band_row0 = 0; ts.ctx_row0 = b * CTX; ts.nt = 4; qrow0 = b * CTX + qb * 64 + sub; }
    const int qcol = 3072 + g * 256 + hr * 64;
    bf16x8 qr[4];
#pragma unroll
    for (int d0 = 0; d0 < 4; ++d0) qr[d0] = *(const GAS bf16x8*)(P + (size_t)(qrow0 + r32) * INC + qcol + d0 * 16 + hi * 8);
    f32x16 o[2], ol; float mref;
    attn_core<8, 2, true>(lds, P, qr, 3584 + g * 64, 3712 + g * 64, 0, ts, qpos, bandpos0, o, ol, mref, tid, lane);
    attn_normalize<2>(o, ol, __builtin_amdgcn_exp2f(sink[g * 4 + hr] * LOG2E - mref), hi);
#pragma unroll
    for (int r = 0; r < 16; ++r) { bf16* op = MIX + (size_t)(qrow0 + crow(r, hi)) * D + 1536 + (g * 4 + hr) * 64 + r32;
#pragma unroll
        for (int d0 = 0; d0 < 2; ++d0) op[d0 * 32] = (bf16)f2bf(o[d0][r]); }
}

__device__ __forceinline__ void diff_unit(LAS unsigned char* lds, const bf16* P, bf16* MIX, const float* dlam, const float* subln, float lam_init, int b, int h, int qb, bool ctxq, int tid, int lane, int wave) {
    const int r32 = lane & 31, hi = lane >> 5, m = wave >> 2, sub = (wave & 3) * 32;
    TileSpec ts; int qrow0;
    if (!ctxq) { ts.nband = 32; ts.band_row0 = RC + b * SEQ; ts.ctx_row0 = b * CTX; ts.nt = 36; qrow0 = RC + b * SEQ + qb * 128 + sub; }
    else { ts.nband = 0; ts.band_row0 = 0; ts.ctx_row0 = b * CTX; ts.nt = 4; qrow0 = b * CTX + qb * 128 + sub; }
    const int qcol = 512 + h * 128 + m * 64;
    bf16x8 qr[4];
#pragma unroll
    for (int d0 = 0; d0 < 4; ++d0) qr[d0] = *(const GAS bf16x8*)(P + (size_t)(qrow0 + r32) * INC + qcol + d0 * 16 + hi * 8);
    const float lam = expf(wave_sum(dlam[lane] * dlam[64 + lane])) - expf(wave_sum(dlam[128 + lane] * dlam[192 + lane])) + lam_init;
    f32x16 o[4], ol; float mref;
    attn_core<16, 4, false>(lds, P, qr, 1024 + h * 128, 1536 + h * 128, m * 8, ts, 0, 0, o, ol, mref, tid, lane);
    attn_normalize<4>(o, ol, 0.f, hi);
    LAS float* ex = (LAS float*)lds + (wave & 3) * 4096;
    if (m == 1) {
#pragma unroll
        for (int d0 = 0; d0 < 4; ++d0)
#pragma unroll
            for (int r = 0; r < 16; ++r) ex[(d0 * 16 + r) * 64 + lane] = o[d0][r];
    }
    __syncthreads();
    if (m == 0) {
        float sl[4];
#pragma unroll
        for (int d0 = 0; d0 < 4; ++d0) sl[d0] = subln[d0 * 32 + r32] * (1.0f - lam_init);
#pragma unroll
        for (int r = 0; r < 16; ++r) {
            float ss = 0.f;
#pragma unroll
            for (int d0 = 0; d0 < 4; ++d0) { const float v = o[d0][r] - lam * ex[(d0 * 16 + r) * 64 + lane]; o[d0][r] = v; ss += v * v; }
            asm volatile("" ::: "memory");
#pragma unroll
            for (int off = 1; off < 32; off <<= 1) ss += __shfl_xor(ss, off);
            const float rstd = 1.0f / sqrtf(ss * (1.0f / 128.0f) + EPS);
            bf16* op = MIX + (size_t)(qrow0 + crow(r, hi)) * D + 512 + h * 128 + r32;
#pragma unroll
            for (int d0 = 0; d0 < 4; ++d0) op[d0 * 32] = (bf16)f2bf(o[d0][r] * rstd * sl[d0]);
        }
    }
    __syncthreads();
}

__device__ __forceinline__ void sgu_unit(LAS unsigned char* lds, const bf16* P, bf16* MIX, const float* ln_g, const float* ln_b, const float* Ws, const float* bs, int row0, int g, int tid, int lane, int wave) {
    constexpr int VS = 136;
    LAS bf16* VT = (LAS bf16*)lds;
    const int r32 = lane & 31, hi = lane >> 5;
    { const int tq = lane >> 4, j = lane & 15;
      v4u raws[4][4];
#pragma unroll
      for (int ps = 0; ps < 4; ++ps)
#pragma unroll
          for (int q = 0; q < 4; ++q) raws[ps][q] = *(const GAS v4u*)(P + (size_t)(row0 + wave * 16 + ps * 4 + tq) * INC + 2560 + (j + 16 * q) * 8);
      float lg8[8], lb8[8];
#pragma unroll
      for (int e = 0; e < 8; ++e) { lg8[e] = ln_g[g * 128 + 8 * j + e]; lb8[e] = ln_b[g * 128 + 8 * j + e]; }
#pragma unroll
      for (int ps = 0; ps < 4; ++ps) {
          float x[4][8]; float s = 0.f;
#pragma unroll
          for (int q = 0; q < 4; ++q)
#pragma unroll
              for (int e = 0; e < 4; ++e) { x[q][2 * e] = bf2f((unsigned short)(raws[ps][q][e] & 0xffffu)); x[q][2 * e + 1] = bf2f((unsigned short)(raws[ps][q][e] >> 16)); s += x[q][2 * e] + x[q][2 * e + 1]; }
#pragma unroll
          for (int off = 1; off < 16; off <<= 1) s += __shfl_xor(s, off);
          const float mean = s * (1.0f / 512.0f); float s2 = 0.f;
#pragma unroll
          for (int q = 0; q < 4; ++q)
#pragma unroll
              for (int e = 0; e < 8; ++e) { x[q][e] -= mean; s2 += x[q][e] * x[q][e]; }
#pragma unroll
          for (int off = 1; off < 16; off <<= 1) s2 += __shfl_xor(s2, off);
          const float rstd = 1.0f / sqrtf(s2 * (1.0f / 512.0f) + EPS);
          const int qtok = wave * 16 + ps * 4 + tq;
#pragma unroll
          for (int e = 0; e < 8; ++e) { const float xv = g == 0 ? x[0][e] : (g == 1 ? x[1][e] : (g == 2 ? x[2][e] : x[3][e])); VT[(8 * j + e) * VS + qtok] = (bf16)f2bf(xv * rstd * lg8[e] + lb8[e]); }
      }
    }
    __syncthreads();
    const int pb = wave & 3, ch = wave >> 2;
    f32x16 acc[2];
#pragma unroll
    for (int cb = 0; cb < 2; ++cb)
#pragma unroll
        for (int r = 0; r < 16; ++r) acc[cb][r] = 0.f;
    unsigned short uu[16][2]; float bias[16];
#pragma unroll
    for (int r = 0; r < 16; ++r) { const int p = pb * 32 + crow(r, hi); bias[r] = bs[g * 128 + p];
#pragma unroll
        for (int cb = 0; cb < 2; ++cb) uu[r][cb] = P[(size_t)(row0 + p) * INC + 2048 + g * 128 + ch * 64 + cb * 32 + r32]; }
    const float* wrow = Ws + (size_t)(g * 128 + pb * 32 + r32) * 128 + hi * 8;
#pragma unroll
    for (int ks = 0; ks < 8; ++ks) {
        const f32x4 w0 = *(const GAS f32x4*)(wrow + ks * 16), w1 = *(const GAS f32x4*)(wrow + ks * 16 + 4);
        v4u aw; aw.x = pk2(w0.x, w0.y); aw.y = pk2(w0.z, w0.w); aw.z = pk2(w1.x, w1.y); aw.w = pk2(w1.z, w1.w);
#pragma unroll
        for (int cb = 0; cb < 2; ++cb) { const bf16x8 bv = *(const LAS bf16x8*)(VT + (ch * 64 + cb * 32 + r32) * VS + ks * 16 + hi * 8);
            acc[cb] = __builtin_amdgcn_mfma_f32_32x32x16_bf16(__builtin_bit_cast(bf16x8, aw), bv, acc[cb], 0, 0, 0); }
    }
#pragma unroll
    for (int r = 0; r < 16; ++r) { const int p = pb * 32 + crow(r, hi);
#pragma unroll
        for (int cb = 0; cb < 2; ++cb) { const int c = g * 128 + ch * 64 + cb * 32 + r32;
            MIX[(size_t)(row0 + p) * D + 1024 + c] = (bf16)f2bf(bf2f(uu[r][cb]) * (acc[cb][r] + bias[r])); } }
    __syncthreads();
}

template <int HALF>
__device__ __forceinline__ void pool_body(const bf16* P, bf16* MIX, const float* pscale, int seq0, int T, int tk0, int cc) {
    constexpr int NR = 4 + 2 * HALF;
    v4u raw[NR];
#pragma unroll
    for (int r = 0; r < NR; ++r) { const int t = tk0 - HALF + r; raw[r] = (t >= 0 && t < T) ? *(const GAS v4u*)(P + (size_t)(seq0 + t) * INC + cc * 8) : (v4u){0u, 0u, 0u, 0u}; }
    const f32x4 s0 = *(const GAS f32x4*)(pscale + cc * 8), s1 = *(const GAS f32x4*)(pscale + cc * 8 + 4);
    const float sc[8] = {s0.x, s0.y, s0.z, s0.w, s1.x, s1.y, s1.z, s1.w};
    float w[8];
#pragma unroll
    for (int e = 0; e < 8; ++e) w[e] = 0.f;
#pragma unroll
    for (int r = 0; r < 2 * HALF - 1; ++r)
#pragma unroll
        for (int e = 0; e < 4; ++e) { w[2 * e] += bf2f((unsigned short)(raw[r][e] & 0xffffu)); w[2 * e + 1] += bf2f((unsigned short)(raw[r][e] >> 16)); }
#pragma unroll
    for (int i = 0; i < 4; ++i) {
        const int t = tk0 + i, lo = t - HALF < 0 ? 0 : t - HALF, hh = t + HALF > T ? T : t + HALF; const float rc = 1.0f / (float)(hh - lo);
        v4u o;
#pragma unroll
        for (int e = 0; e < 4; ++e) {
            w[2 * e] += bf2f((unsigned short)(raw[i + 2 * HALF - 1][e] & 0xffffu)); w[2 * e + 1] += bf2f((unsigned short)(raw[i + 2 * HALF - 1][e] >> 16));
            const float x0 = bf2f((unsigned short)(raw[HALF + i][e] & 0xffffu)), x1 = bf2f((unsigned short)(raw[HALF + i][e] >> 16));
            o[e] = pk2((w[2 * e] * rc - x0) * sc[2 * e], (w[2 * e + 1] * rc - x1) * sc[2 * e + 1]);
            w[2 * e] -= bf2f((unsigned short)(raw[i][e] & 0xffffu)); w[2 * e + 1] -= bf2f((unsigned short)(raw[i][e] >> 16));
        }
        *(GAS v4u*)(MIX + (size_t)(seq0 + t) * D + cc * 8) = o;
    }
}
__device__ __forceinline__ void pool_unit(const bf16* P, bf16* MIX, const float* pscale, int row0, int tid, int wave) {
    const int seq0 = row0 < RC ? (row0 & ~255) : RC + ((row0 - RC) & ~2047), T = row0 < RC ? CTX : SEQ, tk0 = row0 - seq0 + 4 * (tid & 7), cc = tid >> 3, g = wave >> 1;
    if (g == 0) pool_body<1>(P, MIX, pscale, seq0, T, tk0, cc); else if (g == 1) pool_body<2>(P, MIX, pscale, seq0, T, tk0, cc); else if (g == 2) pool_body<4>(P, MIX, pscale, seq0, T, tk0, cc); else pool_body<8>(P, MIX, pscale, seq0, T, tk0, cc);
}

__global__ void __launch_bounds__(NWAVES * 64, 2) fwd_kernel(Args args_unused) {
    extern __shared__ __attribute__((aligned(16))) unsigned char lds_raw[];
    LAS unsigned char* lds = (LAS unsigned char*)lds_raw;
    volatile LAS unsigned* MISC = (volatile LAS unsigned*)(lds + MISC_OFF);
    const int tid0 = threadIdx.x;
#define TID_HERE() int tid = threadIdx.x; asm volatile("" : "+v"(tid)); int G = G0, bx = bx0; asm volatile("" : "+s"(G), "+s"(bx)); const int vcu = (G % 8 == 0) ? (bx % 8) * (G / 8) + bx / 8 : bx; const int NGW = G * NWAVES; \
    const int lane = tid & 63, wave = __builtin_amdgcn_readfirstlane(tid >> 6); const int gw = vcu * NWAVES + wave; (void)lane; (void)gw; (void)NGW
    const int G0 = gridDim.x, bx0 = blockIdx.x;
    for (int u = tid0; u < (LDS_BYTES - LDSCTL_OFF) / 4; u += NWAVES * 64) ((LAS unsigned*)(lds + LDSCTL_OFF))[u] = 0u;
    __syncthreads();
    int lo, hi;
    XcdBarrier bar;
    { kaptr kp = ka_get(); lo = KLO(kp); hi = KHI(kp); unsigned* bw = (unsigned*)(KWS(kp) + WS_CTL) + CW_BAR; bar.bar = bw; bar.x = 0; bar.st = nullptr;
      if (!MK_PER_PHASE) bar = xcd_barrier_post(bw, MISC + 8); }
#ifndef SITEMASK
#define SITEMASK 0xfff
#endif
#ifndef UNITMASK
#define UNITMASK 0xf
#endif
#define UEN(s) (((UNITMASK) >> (s)) & 1)
#ifndef REPMASK
#define REPMASK 0
#endif
#ifndef REPU
#define REPU 0
#endif
#define NREPU(s) (1 + (((REPU) >> (s)) & 1))
#define NREP(s) (1 + (((REPMASK) >> (s)) & 1))
#define EN(s) (((SITEMASK) >> (s)) & 1)
#define IN(k) (lo <= (k) && (k) < hi)
#ifndef NCONV
#define NCONV 16
#endif
#ifndef FILLW
#define FILLW 2
#endif
#define CONVPH(k) ((k) == 2 || (k) == 4 || (k) == 6 || (k) == 7)
#ifndef SPLITK
#define SPLITK false
#endif
#ifndef SPLITK_FFN_DOWN
#define SPLITK_FFN_DOWN false
#endif
#ifndef SPLITK_MOE_DOWN
#define SPLITK_MOE_DOWN true
#endif
#ifndef FILLMODE
#define FILLMODE 1
#endif
#define FILL(k) do { if (FILLMODE == 1 && l == 0 && IN(k)) {     kaptr kq = ka_get(); int Gq = G0; asm volatile("" : "+s"(Gq)); fill_tail(KWS(kq), KIN(kq, 23), KIN(kq, 24), KIN(kq, 25), (unsigned*)(KWS(kq) + WS_CTL) + CW_DONE + 64 * (k), Gq, (FILLMODE == 1 && l == 0 && (int)blockIdx.x < NCONV && CONVPH(k)) ? 8 : FILLW); } } while (0)
#define DRAIN(k) do { if (((FILLMODE == 1) || (k) == 0) && IN(k)) { kaptr kq = ka_get(); int Gq = G0; asm volatile("" : "+s"(Gq)); drain_tail(KWS(kq), KIN(kq, 23), KIN(kq, 24), KIN(kq, 25), Gq, lds); } } while (0)
#define SEAM(k) do { if (IN(k) && IN((k) + 1)) { XcdBarrier b_ = bar; asm volatile("" : "+s"(b_.bar)); xcd_barrier(b_); } } while (0)
    LAS int* TB = (LAS int*)(lds + TB_OFF);

    for (int rep = 0; rep < NREP(0); ++rep) if (EN(0) && IN(0)) { kaptr kp = ka_get(); TID_HERE(); p0_prologue(kp, lds, vcu, G, tid, lane, wave); }
    if (FILLMODE == 0) DRAIN(0);
    SEAM(0);

    for (int l = 0; l < 2; ++l) {
        const int pb = l == 0 ? 1 : 8;
        const bool last = (l == 1);
        for (int rep = 0; rep < NREP(1); ++rep) if (EN(1) && IN(pb + 0)) {
            kaptr kp = ka_get(); TID_HERE(); unsigned char* ws = KWS(kp); const float* H = (const float*)(ws + WS_H); const float* mod = (const float*)(ws + WS_MOD) + l * 5 * MODN;
            const float* srcC = l == 0 ? KIN(kp, 2) : H; const float* srcL = l == 0 ? KIN(kp, 0) - (size_t)RC * D : H;
            norm_rows<false>(srcC, srcL, KIN(kp, 6) + l * D, mod + 0 * D, mod + 1 * D, (bf16*)(ws + WS_XN), 0, RT, gw, NGW, lane, nullptr, nullptr, nullptr);
        }
        SEAM(pb + 0);
        for (int rep = 0; rep < NREP(2); ++rep) if (EN(2) && IN(pb + 1)) {
            kaptr kp = ka_get(); TID_HERE(); unsigned char* ws = KWS(kp);
            pg8::Gemm g{(const bf16*)(ws + WS_XN), (const bf16*)(ws + WS_WIN) + (size_t)l * INC * D, RT, INC, D}; pg8::EpiIn E{(bf16*)(ws + WS_PALL), (const PG8_LAS float*)(lds + RING_BYTES)};
            ((LAS f32x4*)(lds + RING_BYTES))[tid] = ((const GAS f32x4*)(ws + WS_ROPE))[tid];
            const int nc = (FILLMODE == 1 && l == 0) ? NCONV : 0;
            if (bx >= nc) {
            pg8::OrderSplit<pg8::MapIn> S; S.init(G - nc, bx - nc, D, last ? 20 : 60); S.plan(SPLITK);
            pg8::EpiSplit<pg8::EpiIn> ES{E, (float*)(ws + WS_SLAB)};
            { pg8::CachedOrder CS; CS.fill(S, (PG8_LAS int*)(lds + UT_OFF), tid); __syncthreads();
                  pg8::gemm_phase<pg8::EpiSplit<pg8::EpiIn>, pg8::CachedOrder, true, true>(lds, g, CS, ES); }
            combine_tail(E, S, (float*)(ws + WS_SLAB), (unsigned*)(ws + WS_CTL) + CW_TK + 4096 * (pb + 1), lds); }
        }
        FILL(pb + 1); SEAM(pb + 1);
        for (int rep = 0; rep < NREP(3); ++rep) if (EN(3) && IN(pb + 2)) {
            kaptr kp = ka_get(); TID_HERE(); unsigned char* ws = KWS(kp); const bf16* PALL = (const bf16*)(ws + WS_PALL); bf16* MIX = (bf16*)(ws + WS_MIX);
            const float lam_init = 0.8f - 0.6f * expf(-0.3f * (float)l);
            for (int ru = 0; ru < NREPU(0); ++ru) if (UEN(0)) for (int u = vcu; u < 256; u += G) diff_unit(lds, PALL, MIX, KIN(kp, 12) + l * 256, KIN(kp, 13) + l * 128, lam_init, u >> 6, (u >> 4) & 3, u & 15, false, tid, lane, wave);
            for (int ru = 0; ru < NREPU(1); ++ru) if (UEN(1)) for (int u = vcu; u < 256; u += G) win_unit(lds, PALL, MIX, KIN(kp, 18) + l * 8, u >> 6, (u >> 5) & 1, u & 31, false, tid, lane, wave);
            if (!last) {
                if (UEN(0)) for (int u = vcu; u < 32; u += G) diff_unit(lds, PALL, MIX, KIN(kp, 12) + l * 256, KIN(kp, 13) + l * 128, lam_init, u >> 3, (u >> 1) & 3, u & 1, true, tid, lane, wave);
                if (UEN(1)) for (int u = (vcu + G - (32 % G)) % G; u < 32; u += G) win_unit(lds, PALL, MIX, KIN(kp, 18) + l * 8, u >> 3, (u >> 2) & 1, u & 3, true, tid, lane, wave);
            }
            { const int ch0 = last ? 8 : 0, nu = (72 - ch0) * 4;
              for (int ru = 0; ru < NREPU(2); ++ru) if (UEN(2)) for (int u = (vcu + G - (64 % G)) % G; u < nu; u += G) sgu_unit(lds, PALL, MIX, KIN(kp, 14) + l * 512, KIN(kp, 15) + l * 512, KIN(kp, 16) + (size_t)l * 4 * 128 * 128, KIN(kp, 17) + l * 512, (ch0 + (u >> 2)) * 128, u & 3, tid, lane, wave); }
            { const int r0 = last ? RC : 0, nu = (RT - r0) / 32;
              for (int ru = 0; ru < NREPU(3); ++ru) if (UEN(3)) for (int u = (vcu + G - (96 % G)) % G; u < nu; u += G) pool_unit(PALL, MIX, KIN(kp, 11) + l * 512, r0 + 32 * u, tid, wave); }
        }
        FILL(pb + 2); SEAM(pb + 2);
        for (int rep = 0; rep < NREP(4); ++rep) if (EN(4) && IN(pb + 3)) {
            kaptr kp = ka_get(); TID_HERE(); unsigned char* ws = KWS(kp); float* H = (float*)(ws + WS_H);
            const float* srcC = l == 0 ? KIN(kp, 2) : H; const float* srcL = l == 0 ? KIN(kp, 0) - (size_t)RC * D : H;
            pg8::Gemm g{(const bf16*)(ws + WS_MIX), (const bf16*)(ws + WS_WOUT) + (size_t)l * D * D, RT, D, D}; pg8::EpiResid E{srcC, srcL, rep ? (float*)(ws + WS_Y) : H, (const float*)(ws + WS_MOD) + l * 5 * MODN + 2 * D, 1.0f};
            const int nc = (FILLMODE == 1 && l == 0) ? NCONV : 0;
            if (bx >= nc) {
            pg8::OrderSplit<pg8::MapOff> S; S.init(last ? RL : RT, D, G - nc, bx - nc, D); S.pm_off = last ? 4 : 0; S.plan(SPLITK);
            pg8::EpiSplit<pg8::EpiResid> ES{E, (float*)(ws + WS_SLAB)};
            { pg8::CachedOrder CS; CS.fill(S, (PG8_LAS int*)(lds + UT_OFF), tid); __syncthreads();
                  pg8::gemm_phase<pg8::EpiSplit<pg8::EpiResid>, pg8::CachedOrder, true, true>(lds, g, CS, ES); }
            combine_tail(E, S, (float*)(ws + WS_SLAB), (unsigned*)(ws + WS_CTL) + CW_TK + 4096 * (pb + 3), lds); }
        }
        FILL(pb + 3); SEAM(pb + 3);
        for (int rep = 0; rep < NREP(5); ++rep) if (EN(5) && IN(pb + 4)) {
            kaptr kp = ka_get(); TID_HERE(); unsigned char* ws = KWS(kp); const float* H = (const float*)(ws + WS_H); const float* mod = (const float*)(ws + WS_MOD) + l * 5 * MODN;
            if (!last || rep) norm_rows<false, DENSE_UP_F8>(H, H, KIN(kp, 7) + l * D, mod + 3 * D, mod + 4 * D, (bf16*)(ws + WS_XN), last ? RC : 0, RT, gw, NGW, lane, nullptr, nullptr, nullptr);
            else {
                LAS float* rt = (LAS float*)lds;
                for (int i = tid; i < D * NE / 4; i += NWAVES * 64) ((LAS f32x4*)rt)[i] = ((const GAS f32x4*)KIN(kp, 22))[i];
                __syncthreads();
                norm_rows<true, MOE_F8>(H, H, KIN(kp, 7) + l * D, mod + 3 * D, mod + 4 * D, (bf16*)(ws + WS_XG), RC, RT, gw, NGW, lane, rt, (unsigned*)(ws + WS_CTL) + CW_CNT, (int*)(ws + WS_ROUTE));
            }
        }
        if (last) DRAIN(pb + 4);
        SEAM(pb + 4);
        if (!last) {
            for (int rep = 0; rep < NREP(6); ++rep) if (EN(6) && IN(pb + 5)) {
                kaptr kp = ka_get(); TID_HERE(); unsigned char* ws = KWS(kp);
                constexpr int KP = DENSE_UP_F8 ? D / 2 : D;
                pg8::Gemm g{(const bf16*)(ws + WS_XN), (const bf16*)(ws + WS_W13), RT, 2 * DFF, KP}; pg8::EpiSwiglu<DENSE_DN_F8> E{(void*)(ws + WS_ACT), DFF, NTN_UP, DENSE_UP_F8 ? 1.0f / 256.0f : 1.0f};
                const int nc = (FILLMODE == 1) ? NCONV : 0;
                if (bx >= nc) {
                pg8::OrderSplit<pg8::StaticOrder> S; S.init(RT, 2 * DFF, G - nc, bx - nc, KP); S.plan(SPLITK);
                pg8::EpiSplit<pg8::EpiSwiglu<DENSE_DN_F8>> ES{E, (float*)(ws + WS_SLAB)};
                { pg8::CachedOrder CS; CS.fill(S, (PG8_LAS int*)(lds + UT_OFF), tid); __syncthreads();
                  pg8::gemm_phase<pg8::EpiSplit<pg8::EpiSwiglu<DENSE_DN_F8>>, pg8::CachedOrder, true, true, DENSE_UP_F8>(lds, g, CS, ES); }
                combine_tail(E, S, (float*)(ws + WS_SLAB), (unsigned*)(ws + WS_CTL) + CW_TK + 4096 * (pb + 5), lds); }
            }
            FILL(pb + 5); SEAM(pb + 5);
            for (int rep = 0; rep < NREP(7); ++rep) if (EN(7) && IN(pb + 6)) {
                kaptr kp = ka_get(); TID_HERE(); unsigned char* ws = KWS(kp); float* H = (float*)(ws + WS_H);
                constexpr int KP = DENSE_DN_F8 ? DFF / 2 : DFF;
                pg8::Gemm g{(const bf16*)(ws + WS_ACT), (const bf16*)(ws + WS_W2), RT, D, KP}; pg8::EpiResid E{H, H, rep ? (float*)(ws + WS_Y) : H, (const float*)(ws + WS_MOD) + l * 5 * MODN + 5 * D, DENSE_DN_F8 ? 1.0f / 256.0f : 1.0f};
                const int nc = (FILLMODE == 1) ? NCONV : 0;
                if (bx >= nc) {
                pg8::OrderSplit<pg8::MapOff> S; S.init(RT, D, G - nc, bx - nc, KP); S.pm_off = 0; S.plan(SPLITK_FFN_DOWN);
                pg8::EpiSplit<pg8::EpiResid> ES{E, (float*)(ws + WS_SLAB)};
                { pg8::CachedOrder CS; CS.fill(S, (PG8_LAS int*)(lds + UT_OFF), tid); __syncthreads();
                  pg8::gemm_phase<pg8::EpiSplit<pg8::EpiResid>, pg8::CachedOrder, true, true, DENSE_DN_F8>(lds, g, CS, ES); }
                combine_tail(E, S, (float*)(ws + WS_SLAB), (unsigned*)(ws + WS_CTL) + CW_TK + 4096 * (pb + 6), lds); }
            }
            FILL(pb + 6); SEAM(pb + 6);
        } else {
            if (IN(pb + 5) || IN(pb + 6) || IN(pb + 7) || IN(pb + 8)) {
                kaptr kp = ka_get(); TID_HERE(); const unsigned* CNT = (const unsigned*)(KWS(kp) + WS_CTL) + CW_CNT;
                if (tid == 0) { int acc = 0; TB[0] = 0;
                    for (int e = 0; e < 8; ++e) { const unsigned c = __hip_atomic_load(CNT + 64 * e, RLX_AGENT); acc += (int)((c + 255u) >> 8); TB[e + 1] = acc; } }
                __syncthreads();
            }
            for (int rep = 0; rep < NREP(9); ++rep) if (EN(9) && IN(pb + 6)) {
                kaptr kp = ka_get(); TID_HERE(); unsigned char* ws = KWS(kp);
                constexpr int KP = MOE_F8 ? D / 2 : D;
                pg8::Gemm g{(const bf16*)(ws + WS_XG), (const bf16*)(ws + WS_MW13), NE * 8192, NE * 2 * DFF, KP}; pg8::EpiSwiglu<MOE_F8> E{(void*)(ws + WS_ACT), DFF, NTN_UP, MOE_F8 ? 1.0f / 256.0f : 1.0f, (const PG8_LAS int*)TB};
                pg8::OrderSplit<pg8::MapMoe> S; S.init((const PG8_LAS int*)TB, NTN_UP, G, bx, KP, 1); S.plan(SPLITK);
                pg8::EpiSplit<pg8::EpiSwiglu<MOE_F8>> ES{E, (float*)(ws + WS_SLAB)};
                { pg8::CachedOrder CS; CS.fill(S, (PG8_LAS int*)(lds + UT_OFF), tid); __syncthreads();
                  pg8::gemm_phase<pg8::EpiSplit<pg8::EpiSwiglu<MOE_F8>>, pg8::CachedOrder, true, true, MOE_F8>(lds, g, CS, ES); }
                combine_tail(E, S, (float*)(ws + WS_SLAB), (unsigned*)(ws + WS_CTL) + CW_TK + 4096 * (pb + 6), lds);
            }
            SEAM(pb + 6);
            for (int rep = 0; rep < NREP(10); ++rep) if (EN(10) && IN(pb + 7)) {
                kaptr kp = ka_get(); TID_HERE(); unsigned char* ws = KWS(kp);
                constexpr int KP = MOE_F8 ? DFF / 2 : DFF;
                pg8::Gemm g{(const bf16*)(ws + WS_ACT), (const bf16*)(ws + WS_MW2), MAXSLOT, NE * D, KP}; pg8::EpiF32 E{(bf16*)(ws + WS_Y), D / 256, MOE_F8 ? 1.0f / 256.0f : 1.0f};
                pg8::OrderSplit<pg8::MapMoe> S; S.init((const PG8_LAS int*)TB, D / 256, G, bx, KP); S.plan(SPLITK_MOE_DOWN);
                pg8::EpiSplit<pg8::EpiF32> ES{E, (float*)(ws + WS_SLAB)};
                { pg8::CachedOrder CS; CS.fill(S, (PG8_LAS int*)(lds + UT_OFF), tid); __syncthreads();
                  pg8::gemm_phase<pg8::EpiSplit<pg8::EpiF32>, pg8::CachedOrder, true, true, MOE_F8>(lds, g, CS, ES); }
                combine_tail(E, S, (float*)(ws + WS_SLAB), (unsigned*)(ws + WS_CTL) + CW_TK + 4096 * (pb + 7), lds);
            }
            SEAM(pb + 7);
            for (int rep = 0; rep < NREP(11); ++rep) if (EN(11) && IN(pb + 8)) {
                kaptr kp = ka_get(); TID_HERE(); unsigned char* ws = KWS(kp); const int* ROUTE = (const int*)(ws + WS_ROUTE); const float* H = (const float*)(ws + WS_H); const bf16* Y = (const bf16*)(ws + WS_Y);
                const float* gate = (const float*)(ws + WS_MOD) + l * 5 * MODN + 5 * D; const float* nf = KIN(kp, 26); float* out = KOUT(kp);
                f32x4 nw[8];
#pragma unroll
                for (int j = 0; j < 8; ++j) nw[j] = ((const GAS f32x4*)nf + lane)[64 * j];
                for (int t = gw; t < RL; t += NGW) {
                    const int* rec = ROUTE + (size_t)t * 8; const int e1 = rec[0], s1 = rec[1], e2 = rec[3], s2 = rec[4]; const float w1 = __builtin_bit_cast(float, rec[2]), w2 = __builtin_bit_cast(float, rec[5]);
                    const int b1 = TB[e1], b2 = TB[e2];
                    const int bidx = t >> 11;
                    const GAS f32x4* hr = (const GAS f32x4*)(H + (size_t)(RC + t) * D) + lane; const GAS v2u* y1 = (const GAS v2u*)(Y + (size_t)(b1 * 256 + s1) * D) + lane; const GAS v2u* y2 = (const GAS v2u*)(Y + (size_t)(b2 * 256 + s2) * D) + lane;
                    const GAS f32x4* g4 = (const GAS f32x4*)(gate + bidx * MODN) + lane;
                    f32x4 v[8]; float ss = 0.f;
#pragma unroll
                    for (int j = 0; j < 8; ++j) { const v2u ra = y1[64 * j], rb = y2[64 * j];
                        const f32x4 a = (f32x4){bf2f((unsigned short)(ra.x & 0xffffu)), bf2f((unsigned short)(ra.x >> 16)), bf2f((unsigned short)(ra.y & 0xffffu)), bf2f((unsigned short)(ra.y >> 16))};
                        const f32x4 b = (f32x4){bf2f((unsigned short)(rb.x & 0xffffu)), bf2f((unsigned short)(rb.x >> 16)), bf2f((unsigned short)(rb.y & 0xffffu)), bf2f((unsigned short)(rb.y >> 16))};
                        v[j] = hr[64 * j] + g4[64 * j] * (a * w1 + b * w2); ss += (v[j].x * v[j].x + v[j].y * v[j].y) + (v[j].z * v[j].z + v[j].w * v[j].w); }
                    const float rstd = 1.0f / sqrtf(wave_sum(ss) * (1.0f / D) + EPS);
                    GAS f32x4* op = (GAS f32x4*)(out + (size_t)t * D) + lane;
#pragma unroll
                    for (int j = 0; j < 8; ++j) op[64 * j] = v[j] * rstd * nw[j];
                }
            }
        }
    }
#undef IN
#undef SEAM
}

extern "C" void kernel_launch(void* const* d_in, const int* in_sizes, int n_in, void* d_out, int out_size, void* d_ws, size_t ws_size, hipStream_t stream) {
    static int grid = 0;
    if (grid == 0) {
        if (n_in != 27 || out_size != RL * D || ws_size < WS_END) { fprintf(stderr, "kernel_launch: unexpected problem (n_in %d, out %d, ws %zu); nothing launched\n", n_in, out_size, ws_size); grid = -1; return; }
        int dev = 0, cus = 0, per_cu = 0;
        if (hipGetDevice(&dev) != hipSuccess || hipDeviceGetAttribute(&cus, hipDeviceAttributeMultiprocessorCount, dev) != hipSuccess) { grid = -1; return; }
        if (hipFuncSetAttribute((const void*)fwd_kernel, hipFuncAttributeMaxDynamicSharedMemorySize, LDS_BYTES) != hipSuccess) { fprintf(stderr, "kernel_launch: hipFuncSetAttribute failed\n"); grid = -1; return; }
        if (hipOccupancyMaxActiveBlocksPerMultiprocessor(&per_cu, (const void*)fwd_kernel, NWAVES * 64, LDS_BYTES) != hipSuccess || per_cu < 1) fprintf(stderr, "kernel_launch: occupancy query reports %d\n", per_cu);
        (void)hipGetLastError();
        grid = cus;
    }
    if (grid < 0) return;
    if (hipMemsetAsync((char*)d_ws + WS_CTL, 0, CTL_ZERO_BYTES, stream) != hipSuccess) { fprintf(stderr, "kernel_launch: memset failed\n"); return; }
    Args a{};
    for (int i = 0; i < 27; ++i) a.in[i] = (const float*)d_in[i];
    a.out = (float*)d_out; a.ws = (unsigned char*)d_ws;
#if MK_PER_PHASE
    for (int p = 0; p < NPHASE; ++p) { a.ph_lo = p; a.ph_hi = p + 1; hipLaunchKernelGGL(fwd_kernel, dim3(grid), dim3(NWAVES * 64), LDS_BYTES, stream, a); }
#else
    a.ph_lo = 0; a.ph_hi = NPHASE;
    hipLaunchKernelGGL(fwd_kernel, dim3(grid), dim3(NWAVES * 64), LDS_BYTES, stream, a);
#endif
    const hipError_t le = hipPeekAtLastError();
    if (le != hipSuccess) fprintf(stderr, "kernel_launch: launch failed: %s\n", hipGetErrorName(le));
}
```

```cpp
#include <hip/hip_runtime.h>
#include <cstdio>
#include <cstdint>
#include <cmath>

#define GAS __attribute__((address_space(1)))
#define LAS __attribute__((address_space(3)))
namespace pg8 {
#define PG8_LAS __attribute__((address_space(3)))
typedef unsigned short bf16_t;
typedef short bf16x8 __attribute__((ext_vector_type(8)));
typedef float f32x4 __attribute__((ext_vector_type(4)));
typedef unsigned u32x4 __attribute__((ext_vector_type(4)));
typedef int i32x4 __attribute__((ext_vector_type(4)));
typedef int i32x8 __attribute__((ext_vector_type(8)));
constexpr int BM = 256, BK = 64, HALF = 128, HTB = HALF * BK * 2  , STAGE_BYTES = 8 * HTB, NXCD = 8, WGM = 8;

__host__ __device__ __forceinline__ int lds_byte(int r, int c) { const int st = (r >> 4) * 2 + (c >> 5), rr = r & 15, cc = c & 31, ob = rr * 64 + cc * 2; return st * 1024 + (ob ^ (((ob >> 9) & 1) << 5)); }
__host__ __device__ __forceinline__ void stage_rc(int b, int& R, int& C) { const int st = b / 1024, sb = b % 1024, swz = sb ^ (((sb >> 9) & 1) << 5); R = (st >> 1) * 16 + swz / 64; C = (st & 1) * 32 + (swz % 64) / 2; }
__host__ __device__ __forceinline__ int perm32(int rho) { const int n = rho >> 4, i = rho & 15; return 8 * (i >> 2) + 4 * n + (i & 3); }

struct Unit { int pm, pn, k0, nkt, sid; };
struct Gemm { const bf16_t* A; const bf16_t* Bt; int M, N, K; };

struct StaticOrder {
    int nM, nN, nwg, G, c;
    __host__ __device__ void init(int M, int N, int G_, int c_, int K_) { nM = M / BM; nN = N / BM; nwg = nM * nN; G = G_; c = c_; K = K_; }
    int K;
    __host__ __device__ bool next(int i, Unit& u) const { const long L = (long)i * G + c; if (L >= nwg) return false; map(L, u); return true; }
    __host__ __device__ void map(long L, Unit& u) const {
        int wgid = (int)L; { const int q = nwg / NXCD, r = nwg % NXCD, xcd = wgid % NXCD, off = wgid / NXCD; wgid = (xcd < r ? xcd * (q + 1) : r * (q + 1) + (xcd - r) * q) + off; }
        const int nig = WGM * nN, gid = wgid / nig, fm = gid * WGM, gsz = (nM - fm) < WGM ? (nM - fm) : WGM;
        u.pm = fm + ((wgid % nig) % gsz); u.pn = (wgid % nig) / gsz; u.k0 = 0; u.nkt = K / BK; u.sid = -1;
    }
    __device__ __forceinline__ void a_ready(const Unit&) const {}
    __device__ __forceinline__ void done(const Unit&) const {}
};

__device__ __forceinline__ unsigned cvt_pk_bf16(float lo, float hi) { unsigned r; asm volatile("v_cvt_pk_bf16_f32 %0, %1, %2" : "=v"(r) : "v"(lo), "v"(hi)); return r; }
typedef unsigned u32x4 __attribute__((ext_vector_type(4)));
constexpr float QSCALE = 0.125f * 1.4426950408889634f;
__device__ __forceinline__ float gelu_tanh(float x) {
    const float y = 0.7978845608028654f * (x + 0.044715f * x * x * x);
    return x * __builtin_amdgcn_rcpf(1.0f + __builtin_amdgcn_exp2f(-2.0f * 1.4426950408889634f * y));
}
__device__ __forceinline__ float silu_f(float x) { return x * __builtin_amdgcn_rcpf(1.0f + __builtin_amdgcn_exp2f(-1.4426950408889634f * x)); }

struct EpiIn {
    static constexpr bool PERM = true, AFTER_DRAIN = false;
    bf16_t* O; const PG8_LAS float* rope;
    __device__ __forceinline__ void operator()(const f32x4 (&acc)[2][2][4][2], const Unit& u, int wr, int wc, int fr, int fq) const {
        const int row0 = u.pm * BM + wr * 64 + fr; const bool lat = u.pm >= 4;
#pragma unroll
        for (int bj = 0; bj < 2; ++bj) {
            const int cb = u.pn * BM + bj * HALF; int role;
            if (cb < 512) role = 0; else if (cb < 1024) role = 1; else if (cb < 1536) role = 2; else if (cb < 2048) role = 0; else if (cb < 3072) role = 3; else if (cb < 3584) role = 1; else if (cb < 3712) role = 2; else role = 0;
            const int col0 = cb + wc * 32 + 8 * fq;
#pragma unroll
            for (int ai = 0; ai < 2; ++ai)
#pragma unroll
                for (int m = 0; m < 4; ++m) {
                    const int row = row0 + ai * HALF + m * 16;
                    f32x4 v0 = acc[ai][bj][m][0], v1 = acc[ai][bj][m][1];
                    if (role == 1 || role == 2) {
                        if (lat) {
                            const int t = (row - 1024) & 2047, pos = (wc & 1) ? (t & 63) : (t >> 6);
                            const f32x4 cs = *(const PG8_LAS f32x4*)(rope + pos * 16 + 4 * fq), sn = *(const PG8_LAS f32x4*)(rope + 1024 + pos * 16 + 4 * fq);
                            f32x4 a0, a1;
                            a0[0] = v0[0] * cs[0] - v0[1] * sn[0]; a0[1] = v0[0] * sn[0] + v0[1] * cs[0];
                            a0[2] = v0[2] * cs[1] - v0[3] * sn[1]; a0[3] = v0[2] * sn[1] + v0[3] * cs[1];
                            a1[0] = v1[0] * cs[2] - v1[1] * sn[2]; a1[1] = v1[0] * sn[2] + v1[1] * cs[2];
                            a1[2] = v1[2] * cs[3] - v1[3] * sn[3]; a1[3] = v1[2] * sn[3] + v1[3] * cs[3];
                            v0 = a0; v1 = a1;
                        }
                        if (role == 1) { v0 = v0 * QSCALE; v1 = v1 * QSCALE; }
                    } else if (role == 3) {
#pragma unroll
                        for (int e = 0; e < 4; ++e) { v0[e] = gelu_tanh(v0[e]); v1[e] = gelu_tanh(v1[e]); }
                    }
                    u32x4 w; w.x = cvt_pk_bf16(v0[0], v0[1]); w.y = cvt_pk_bf16(v0[2], v0[3]); w.z = cvt_pk_bf16(v1[0], v1[1]); w.w = cvt_pk_bf16(v1[2], v1[3]);
                    *(u32x4*)(O + (size_t)row * 3840 + col0) = w;
                }
        }
    }
};
__device__ __forceinline__ float clamp_fp8(float x) { return __builtin_amdgcn_fmed3f(x, -448.0f, 448.0f); }
__device__ __forceinline__ unsigned cvt4_fp8(float a, float b, float c, float d) { a = clamp_fp8(a); b = clamp_fp8(b); c = clamp_fp8(c); d = clamp_fp8(d); int w = 0; w = __builtin_amdgcn_cvt_pk_fp8_f32(a, b, w, false); w = __builtin_amdgcn_cvt_pk_fp8_f32(c, d, w, true); return (unsigned)w; }
template <bool F8OUT> struct EpiSwiglu {
    static constexpr bool PERM = true, AFTER_DRAIN = false;
    void* O; int ldo; int ntn; float sc;
    const PG8_LAS int* tb;
    __device__ __forceinline__ void operator()(const f32x4 (&acc)[2][2][4][2], const Unit& u, int wr, int wc, int fr, int fq) const {
        const int pmo = tb ? tb[u.pm >> 5] + (u.pm & 31) : u.pm;
        const int row0 = pmo * BM + wr * 64 + fr, col0 = (u.pn % ntn) * HALF + wc * 32 + 8 * fq;
#pragma unroll
        for (int ai = 0; ai < 2; ++ai)
#pragma unroll
            for (int m = 0; m < 4; ++m) {
                const f32x4 g0 = acc[ai][0][m][0] * sc, g1 = acc[ai][0][m][1] * sc, u0 = acc[ai][1][m][0] * sc, u1 = acc[ai][1][m][1] * sc;
                f32x4 r0, r1;
#pragma unroll
                for (int e = 0; e < 4; ++e) { r0[e] = silu_f(g0[e]) * u0[e]; r1[e] = silu_f(g1[e]) * u1[e]; }
                const size_t row = (size_t)(row0 + ai * HALF + m * 16);
                if constexpr (F8OUT) { typedef unsigned u32x2 __attribute__((ext_vector_type(2))); u32x2 w; w.x = cvt4_fp8(r0[0], r0[1], r0[2], r0[3]); w.y = cvt4_fp8(r1[0], r1[1], r1[2], r1[3]);
                    *(u32x2*)((unsigned char*)O + row * ldo + col0) = w; }
                else { u32x4 w; w.x = cvt_pk_bf16(r0[0], r0[1]); w.y = cvt_pk_bf16(r0[2], r0[3]); w.z = cvt_pk_bf16(r1[0], r1[1]); w.w = cvt_pk_bf16(r1[2], r1[3]);
                    *(u32x4*)((bf16_t*)O + row * ldo + col0) = w; }
            }
    }
};
struct EpiResid {
    static constexpr bool PERM = false, AFTER_DRAIN = false;
    const float* resC; const float* resL; float* out; const float* gate; float sc;
    __device__ __forceinline__ void operator()(const f32x4 (&acc)[2][2][4][2], const Unit& u, int wr, int wc, int fr, int fq) const {
        const int bidx = u.pm < 4 ? 4 : ((u.pm - 4) >> 3); const float* res = u.pm < 4 ? resC : resL; const float* gp = gate + bidx * 12288;
        const int row0 = u.pm * BM + wr * 64 + fr;
#pragma unroll
        for (int bj = 0; bj < 2; ++bj)
#pragma unroll
            for (int n = 0; n < 2; ++n) {
                const int col = u.pn * BM + bj * HALF + wc * 32 + 16 * n + 4 * fq; const f32x4 g4 = *(const f32x4*)(gp + col); f32x4 rr[2][4];
#pragma unroll
                for (int ai = 0; ai < 2; ++ai)
#pragma unroll
                    for (int m = 0; m < 4; ++m) rr[ai][m] = *(const f32x4*)(res + (size_t)(row0 + ai * HALF + m * 16) * 2048 + col);
                asm volatile("" ::: "memory");
#pragma unroll
                for (int ai = 0; ai < 2; ++ai)
#pragma unroll
                    for (int m = 0; m < 4; ++m) *(f32x4*)(out + (size_t)(row0 + ai * HALF + m * 16) * 2048 + col) = rr[ai][m] + g4 * (acc[ai][bj][m][n] * sc);
                asm volatile("" ::: "memory");
            }
    }
};
struct EpiF32 {
    static constexpr bool PERM = true, AFTER_DRAIN = false;
    bf16_t* O; int ntn; float sc;
    __device__ __forceinline__ void operator()(const f32x4 (&acc)[2][2][4][2], const Unit& u, int wr, int wc, int fr, int fq) const {
        const int row0 = u.pm * BM + wr * 64 + fr;
#pragma unroll
        for (int bj = 0; bj < 2; ++bj) {
            const int col0 = (u.pn % ntn) * BM + bj * HALF + wc * 32 + 8 * fq;
#pragma unroll
            for (int ai = 0; ai < 2; ++ai)
#pragma unroll
                for (int m = 0; m < 4; ++m) { const f32x4 v0 = acc[ai][bj][m][0] * sc, v1 = acc[ai][bj][m][1] * sc;
                    u32x4 w; w.x = cvt_pk_bf16(v0[0], v0[1]); w.y = cvt_pk_bf16(v0[2], v0[3]); w.z = cvt_pk_bf16(v1[0], v1[1]); w.w = cvt_pk_bf16(v1[2], v1[3]);
                    *(u32x4*)(O + (size_t)(row0 + ai * HALF + m * 16) * 2048 + col0) = w; }
        }
    }
};
template <class Epi> struct EpiSplit {
    static constexpr bool PERM = Epi::PERM, AFTER_DRAIN = false;
    Epi E; float* slab;
    __device__ __forceinline__ void operator()(const f32x4 (&acc)[2][2][4][2], const Unit& u, int wr, int wc, int fr, int fq) const {
        if (u.sid < 0) { E(acc, u, wr, wc, fr, fq); return; }
        f32x4* sp = (f32x4*)slab + (size_t)u.sid * (32 * 512) + (wr * 4 + wc) * 64 + fq * 16 + fr;
#pragma unroll
        for (int ai = 0; ai < 2; ++ai)
#pragma unroll
            for (int bj = 0; bj < 2; ++bj)
#pragma unroll
                for (int m = 0; m < 4; ++m)
#pragma unroll
                    for (int n = 0; n < 2; ++n) sp[(size_t)((((ai * 2 + bj) * 4 + m) * 2) + n) * 512] = acc[ai][bj][m][n];
    }
};
struct TailPlan { int nfull, ntail, S;
    __device__ __forceinline__ void make(int nwg, int G, bool allow, int K) { nfull = (nwg / G) * G; ntail = nwg - nfull;
        S = (!allow || ntail == 0) ? 1 : ((4 * ntail <= G && K % 512 == 0) ? 4 : ((2 * ntail <= G && K % 256 == 0) ? 2 : 1)); } };
template <class Base> struct OrderSplit : Base {
    TailPlan tp;
    __device__ __forceinline__ void plan(bool allow) { tp.make(this->nwg, this->G, allow, this->K); }
    __device__ __forceinline__ bool next(int i, Unit& u) const {
        const long L = (long)i * this->G + this->c;
        if (tp.S == 1) { if (L >= this->nwg) return false; this->map(L, u); return true; }
        if (L < tp.nfull) { this->map(L, u); return true; }
        const int j = (int)(L - tp.nfull); if (j >= tp.ntail * tp.S) return false;
        this->map(tp.nfull + j / tp.S, u); const int ks = j % tp.S, klen = this->K / tp.S; u.k0 = ks * klen; u.nkt = klen / BK; u.sid = j; return true;
    }
    __device__ __forceinline__ bool tail_unit(int& tt, Unit& u) const { if (tp.S == 1 || this->c >= tp.ntail * tp.S) return false; tt = this->c / tp.S; this->map(tp.nfull + tt, u); return true; }
};
struct CachedOrder {
    const PG8_LAS int* tab;
    template <class Ord> __device__ __forceinline__ void fill(const Ord& S, PG8_LAS int* t, int tid) {
        if (tid < 32) { Unit u; u.pm = 0; u.pn = 0; u.k0 = 0; u.nkt = 2; u.sid = -1; const bool ok = S.next(tid, u);
            t[tid * 8 + 0] = ok ? 1 : 0; t[tid * 8 + 1] = u.pm; t[tid * 8 + 2] = u.pn; t[tid * 8 + 3] = u.k0; t[tid * 8 + 4] = u.nkt; t[tid * 8 + 5] = u.sid; }
        tab = t;
    }
    __device__ __forceinline__ bool next(int i, Unit& u) const {
        if (i >= 32) return false;
        const i32x4 a = *(const PG8_LAS i32x4*)(tab + i * 8); const int b0 = tab[i * 8 + 4], b1 = tab[i * 8 + 5];
        if (!__builtin_amdgcn_readfirstlane(a[0])) return false;
        u.pm = __builtin_amdgcn_readfirstlane(a[1]); u.pn = __builtin_amdgcn_readfirstlane(a[2]); u.k0 = __builtin_amdgcn_readfirstlane(a[3]); u.nkt = __builtin_amdgcn_readfirstlane(b0); u.sid = __builtin_amdgcn_readfirstlane(b1); return true;
    }
    __device__ __forceinline__ void a_ready(const Unit&) const {}
    __device__ __forceinline__ void done(const Unit&) const {}
};
struct MapOff : StaticOrder {
    int pm_off;
    __device__ __forceinline__ void map(long L, Unit& u) const { StaticOrder::map(L, u); u.pm += pm_off; }
};
struct MapIn {
    StaticOrder lat; int nwg, G, c, K, nextra;
    __device__ __forceinline__ void init(int G_, int c_, int K_, int nextra_) { lat.init(8192, 3840, G_, c_, K_); G = G_; c = c_; K = K_; nextra = nextra_; nwg = lat.nwg + nextra_; }
    __device__ __forceinline__ void map(long L, Unit& u) const {
        if (L < lat.nwg) { lat.map(L, u); u.pm += 4; return; }
        const int e = (int)(L - lat.nwg);
        if (nextra == 60) { u.pm = e / 15; u.pn = e % 15; } else { u.pm = e / 5; const int idx = e % 5; u.pn = idx < 4 ? 4 + idx : 14; }
        u.k0 = 0; u.nkt = K / BK; u.sid = -1;
    }
    __device__ __forceinline__ void a_ready(const Unit&) const {}
    __device__ __forceinline__ void done(const Unit&) const {}
};
struct MapMoe {
    const PG8_LAS int* tb; int ntn, G, c, K, nwg, sp;
    __device__ __forceinline__ void init(const PG8_LAS int* tb_, int ntn_, int G_, int c_, int K_, int sp_ = 0) { tb = tb_; ntn = ntn_; G = G_; c = c_; K = K_; nwg = tb_[8] * ntn_; sp = sp_; }
    __device__ __forceinline__ void map(long L, Unit& u) const {
        int wgid = (int)L; { const int q = nwg / NXCD, r = nwg % NXCD, xcd = wgid % NXCD, off = wgid / NXCD; wgid = (xcd < r ? xcd * (q + 1) : r * (q + 1) + (xcd - r) * q) + off; }
        int e = 0;
#pragma unroll
        for (int k = 1; k < 8; ++k) if (wgid >= tb[k] * ntn) e = k;
        const int t0 = tb[e], Te = tb[e + 1] - t0, local = wgid - t0 * ntn;
        const int nig = WGM * ntn, gid = local / nig, fm = gid * WGM, gsz = (Te - fm) < WGM ? (Te - fm) : WGM;
        u.pm = (sp ? e * 32 : t0) + fm + ((local % nig) % gsz); u.pn = e * ntn + (local % nig) / gsz; u.k0 = 0; u.nkt = K / BK; u.sid = -1;
    }
    __device__ __forceinline__ void a_ready(const Unit&) const {}
    __device__ __forceinline__ void done(const Unit&) const {}
};

template <class Epi, class Sched, bool ALIGN_EPI = false, bool SP2 = false, bool F8 = false>
__device__ __forceinline__ void gemm_phase(PG8_LAS unsigned char* lds, const Gemm g, const Sched& S, const Epi& E) {
    int tid_o = threadIdx.x; asm volatile("" : "+v"(tid_o));
    const int tid = tid_o, wid = __builtin_amdgcn_readfirstlane(tid >> 6), lane = tid & 63, wr = wid >> 2, wc = wid & 3, fr = lane & 15, fq = lane >> 4;
    const int K = g.K;
    unsigned voffA[2], voffB[2];
#pragma unroll
    for (int i = 0; i < 2; ++i) { int R, C; stage_rc(tid * 16 + i * 8192, R, C); const int Rb = Epi::PERM ? ((R & ~31) + perm32(R & 31)) : R;
        voffA[i] = (unsigned)(R * K + C) * 2u; voffB[i] = (unsigned)(Rb * K + C) * 2u; }
    const size_t kstep = (size_t)(BK * 2);
    const size_t hstep = (size_t)HALF * K * 2;
    const size_t tstep = 2 * hstep;
    const unsigned ldsw = (unsigned)wid * 1024u;
    const int aoff = lds_byte(wr * 64 + fr, fq * 8), boff = lds_byte(wc * 32 + fr, fq * 8);
#define PG8_SA(b, h) (((b) * 2 + (h)) * HTB)
#define PG8_SB(b, h) ((4 + (b) * 2 + (h)) * HTB)
#define PG8_STAGE(bufoff, gbase, voff) do { _Pragma("unroll") for (int _i = 0; _i < 2; ++_i) \
        __builtin_amdgcn_global_load_lds((const unsigned*)((const char*)(gbase) + (voff)[_i]), (PG8_LAS unsigned*)(lds + (bufoff) + ldsw + _i * 8192), 16, 0, 0); } while (0)
#define PG8_LD32(p0_, p1_) __builtin_shufflevector(*(const PG8_LAS i32x4*)(p0_), *(const PG8_LAS i32x4*)(p1_), 0, 1, 2, 3, 4, 5, 6, 7)
#define PG8_LDA(dst, b, h) do { if constexpr (F8) { _Pragma("unroll") for (int m = 0; m < 4; ++m) dst##8[m] = PG8_LD32(lds + PG8_SA(b, h) + aoff + m * 2048, lds + PG8_SA(b, h) + aoff + m * 2048 + 1024); } else { \
        _Pragma("unroll") for (int m = 0; m < 4; ++m) _Pragma("unroll") for (int k = 0; k < 2; ++k) dst[m][k] = *(const PG8_LAS bf16x8*)(lds + PG8_SA(b, h) + aoff + m * 2048 + k * 1024); } } while (0)
#define PG8_LDB(dst, b, h) do { if constexpr (F8) { _Pragma("unroll") for (int n = 0; n < 2; ++n) dst##8[n] = PG8_LD32(lds + PG8_SB(b, h) + boff + n * 2048, lds + PG8_SB(b, h) + boff + n * 2048 + 1024); } else { \
        _Pragma("unroll") for (int n = 0; n < 2; ++n) _Pragma("unroll") for (int k = 0; k < 2; ++k) dst[n][k] = *(const PG8_LAS bf16x8*)(lds + PG8_SB(b, h) + boff + n * 2048 + k * 1024); } } while (0)
#define PG8_MMA(ai, bj, At, Bt) do { __builtin_amdgcn_s_setprio(1); if constexpr (F8) { _Pragma("unroll") for (int m = 0; m < 4; ++m) _Pragma("unroll") for (int n = 0; n < 2; ++n) \
        asm volatile("v_mfma_f32_16x16x128_f8f6f4 %0, %1, %2, %0" : "+v"(acc[ai][bj][m][n]) : "v"(Bt##8[n]), "v"(At##8[m])); } else { \
        _Pragma("unroll") for (int m = 0; m < 4; ++m) _Pragma("unroll") for (int n = 0; n < 2; ++n) _Pragma("unroll") for (int k = 0; k < 2; ++k) \
        acc[ai][bj][m][n] = __builtin_amdgcn_mfma_f32_16x16x32_bf16(Bt[n][k], At[m][k], acc[ai][bj][m][n], 0, 0, 0); } __builtin_amdgcn_s_setprio(0); } while (0)
#define PG8_WAIT_V(n) asm volatile("s_waitcnt vmcnt(" #n ")" ::: "memory")
#define PG8_WAIT_L(n) asm volatile("s_waitcnt lgkmcnt(" #n ")" ::: "memory")
#define PG8_BAR __builtin_amdgcn_s_barrier()
#define PG8_SCHED __builtin_amdgcn_sched_barrier(0)
    Unit cur, nxt; int ui = 0;
    if (!S.next(0, cur)) return;
    f32x4 acc[2][2][4][2];
#pragma unroll
    for (int a = 0; a < 2; ++a)
#pragma unroll
        for (int b = 0; b < 2; ++b)
#pragma unroll
            for (int m = 0; m < 4; ++m)
#pragma unroll
                for (int n = 0; n < 2; ++n) acc[a][b][m][n] = (f32x4){0.f, 0.f, 0.f, 0.f};
    bf16x8 At[4][2], B0[2][2], B1[2][2]; i32x8 At8[4], B08[2], B18[2];
    const char* cA = (const char*)g.A + (size_t)cur.pm * tstep + (size_t)cur.k0 * 2; const char* cB = (const char*)g.Bt + (size_t)cur.pn * tstep + (size_t)cur.k0 * 2;
    S.a_ready(cur);
    if constexpr (SP2) {
        PG8_STAGE(PG8_SB(0, 0), cB, voffB); PG8_STAGE(PG8_SB(0, 1), cB + hstep, voffB); PG8_STAGE(PG8_SA(0, 0), cA, voffA); PG8_STAGE(PG8_SA(0, 1), cA + hstep, voffA);
        if (wr == 1) PG8_BAR;
        PG8_WAIT_V(2); PG8_BAR;
        PG8_STAGE(PG8_SB(1, 0), cB + kstep, voffB); PG8_STAGE(PG8_SA(1, 0), cA + kstep, voffA); PG8_STAGE(PG8_SB(1, 1), cB + hstep + kstep, voffB);
        PG8_WAIT_V(6); PG8_BAR;
    } else {
        PG8_STAGE(PG8_SB(0, 0), cB, voffB); PG8_STAGE(PG8_SA(0, 0), cA, voffA); PG8_STAGE(PG8_SB(0, 1), cB + hstep, voffB); PG8_STAGE(PG8_SA(0, 1), cA + hstep, voffA);
        if (wr == 1) PG8_BAR;
        PG8_WAIT_V(4); PG8_BAR;
        PG8_STAGE(PG8_SB(1, 0), cB + kstep, voffB); PG8_STAGE(PG8_SA(1, 0), cA + kstep, voffA); PG8_STAGE(PG8_SB(1, 1), cB + hstep + kstep, voffB);
        PG8_WAIT_V(6); PG8_BAR;
    }
    for (;;) {
        const bool has_next = S.next(ui + 1, nxt);
        const char* nA = has_next ? (const char*)g.A + (size_t)nxt.pm * tstep + (size_t)nxt.k0 * 2 : cA; const char* nB = has_next ? (const char*)g.Bt + (size_t)nxt.pn * tstep + (size_t)nxt.k0 * 2 : cB;
        const int nt = cur.nkt;
        for (int t = 0; t < nt; t += 2) {
            const bool last = (t == nt - 2);
            const char* a1 = cA + (size_t)(t + 1) * kstep;
            const char* a2 = last ? nA : cA + (size_t)(t + 2) * kstep; const char* b2 = last ? nB : cB + (size_t)(t + 2) * kstep;
            const char* a3 = a2 + kstep; const char* b3 = b2 + kstep;
            if (last && has_next) S.a_ready(nxt);
            if constexpr (SP2) {
            PG8_LDB(B0, 0, 0); PG8_LDB(B1, 0, 1); PG8_SCHED; PG8_LDA(At, 0, 0); PG8_STAGE(PG8_SA(1, 1), a1 + hstep, voffA);
            PG8_WAIT_V(8); PG8_WAIT_L(0); PG8_BAR; PG8_MMA(0, 0, At, B0); PG8_MMA(0, 1, At, B1); PG8_BAR; PG8_SCHED;
            PG8_LDA(At, 0, 1); PG8_STAGE(PG8_SB(0, 0), b2, voffB); PG8_STAGE(PG8_SB(0, 1), b2 + hstep, voffB); PG8_STAGE(PG8_SA(0, 0), a2, voffA);
            PG8_WAIT_V(8); PG8_WAIT_L(0); PG8_BAR; PG8_MMA(1, 0, At, B0); PG8_MMA(1, 1, At, B1); PG8_BAR; PG8_SCHED;
            PG8_LDB(B0, 1, 0); PG8_LDB(B1, 1, 1); PG8_SCHED; PG8_LDA(At, 1, 0); PG8_STAGE(PG8_SA(0, 1), a2 + hstep, voffA);
            PG8_WAIT_V(8); PG8_WAIT_L(0); PG8_BAR; PG8_MMA(0, 0, At, B0); PG8_MMA(0, 1, At, B1); PG8_BAR; PG8_SCHED;
            PG8_LDA(At, 1, 1); PG8_STAGE(PG8_SB(1, 0), b3, voffB); PG8_STAGE(PG8_SB(1, 1), b3 + hstep, voffB); PG8_STAGE(PG8_SA(1, 0), a3, voffA);
            PG8_WAIT_V(8); PG8_WAIT_L(0); PG8_BAR; PG8_MMA(1, 0, At, B0); PG8_MMA(1, 1, At, B1); PG8_BAR; PG8_SCHED;
            } else {
            PG8_LDB(B0, 0, 0); PG8_SCHED; PG8_LDA(At, 0, 0); PG8_STAGE(PG8_SA(1, 1), a1 + hstep, voffA);
            PG8_WAIT_L(8); PG8_BAR; PG8_WAIT_L(0); PG8_MMA(0, 0, At, B0); PG8_BAR; PG8_SCHED;
            PG8_LDB(B1, 0, 1); PG8_STAGE(PG8_SB(0, 0), b2, voffB);
            PG8_BAR; PG8_WAIT_L(0); PG8_MMA(0, 1, At, B1); PG8_BAR;
            PG8_LDA(At, 0, 1); PG8_STAGE(PG8_SA(0, 0), a2, voffA);
            PG8_BAR; PG8_WAIT_L(0); PG8_MMA(1, 0, At, B0); PG8_BAR; PG8_SCHED;
            PG8_STAGE(PG8_SB(0, 1), b2 + hstep, voffB);
            PG8_WAIT_V(6); PG8_BAR; PG8_MMA(1, 1, At, B1); PG8_BAR;
            PG8_LDB(B0, 1, 0); PG8_SCHED; PG8_LDA(At, 1, 0); PG8_STAGE(PG8_SA(0, 1), a2 + hstep, voffA);
            PG8_WAIT_L(8); PG8_BAR; PG8_WAIT_L(0); PG8_MMA(0, 0, At, B0); PG8_BAR; PG8_SCHED;
            PG8_LDB(B1, 1, 1); PG8_STAGE(PG8_SB(1, 0), b3, voffB);
            PG8_BAR; PG8_WAIT_L(0); PG8_MMA(0, 1, At, B1); PG8_BAR;
            PG8_LDA(At, 1, 1); PG8_STAGE(PG8_SA(1, 0), a3, voffA);
            PG8_BAR; PG8_WAIT_L(0); PG8_MMA(1, 0, At, B0); PG8_BAR; PG8_SCHED;
            PG8_STAGE(PG8_SB(1, 1), b3 + hstep, voffB);
            PG8_WAIT_V(6); PG8_BAR; PG8_MMA(1, 1, At, B1); PG8_BAR;
            }
        }
        if constexpr (ALIGN_EPI) { if (wr == 0) PG8_BAR; }
        if constexpr (F8) asm volatile("s_nop 15\n\ts_nop 7" ::: "memory");
        if constexpr (!Epi::AFTER_DRAIN) { E(acc, cur, wr, wc, fr, fq); S.done(cur); }
        if (!has_next) break;
#pragma unroll
        for (int a = 0; a < 2; ++a)
#pragma unroll
            for (int b = 0; b < 2; ++b)
#pragma unroll
                for (int m = 0; m < 4; ++m)
#pragma unroll
                    for (int n = 0; n < 2; ++n) acc[a][b][m][n] = (f32x4){0.f, 0.f, 0.f, 0.f};
        cur = nxt; cA = nA; cB = nB; ++ui;
        if constexpr (ALIGN_EPI) { if (wr == 1) PG8_BAR; }
    }
    PG8_WAIT_V(0);
    if constexpr (!ALIGN_EPI) { if (wr == 0) PG8_BAR; }
    PG8_BAR;
    if constexpr (Epi::AFTER_DRAIN) { E.fused(acc, cur, wr, wc, fr, fq, lds, wid, lane); S.done(cur); }
#undef PG8_SA
#undef PG8_SB
#undef PG8_STAGE
#undef PG8_LDA
#undef PG8_LDB
#undef PG8_MMA
#undef PG8_LD32
#undef PG8_WAIT_V
#undef PG8_WAIT_L
#undef PG8_BAR
#undef PG8_SCHED
}
}

constexpr int D = 2048, NB = 4, SEQ = 2048, CTX = 256, DFF = 5632, NE = 8, INC = 3840, MODN = 12288;
constexpr int RC = NB * CTX, RL = NB * SEQ, RT = RC + RL;
constexpr int NTN_UP = DFF / 128;
constexpr int MAXSLOT = 2 * RL + NE * 256;
constexpr float EPS = 1e-6f, LOG2E = 1.4426950408889634f;
constexpr int NWAVES = 8;
#ifndef MK_PER_PHASE
#define MK_PER_PHASE 0
#endif
constexpr int NPHASE = 17;
#ifndef MOE_F8_ON
#define MOE_F8_ON 1
#endif
#ifndef DENSE_UP_F8_ON
#define DENSE_UP_F8_ON 1
#endif
#ifndef DENSE_DN_F8_ON
#define DENSE_DN_F8_ON 0
#endif
constexpr bool DENSE_UP_F8 = DENSE_UP_F8_ON != 0, DENSE_DN_F8 = DENSE_DN_F8_ON != 0;
constexpr bool MOE_F8 = MOE_F8_ON != 0;

constexpr size_t MiB = 1u << 20;
constexpr size_t WS_CTL = 0, CTL_ZERO_BYTES = 1 * MiB;
constexpr size_t WS_MOD = 1 * MiB;
constexpr size_t WS_ROPE = 1 * MiB + 512 * 1024;
constexpr size_t WS_ROUTE = 1 * MiB + 768 * 1024;
constexpr size_t WS_WIN = 2 * MiB, WS_WOUT = 32 * MiB, WS_W13 = 48 * MiB, WS_W2 = 92 * MiB, WS_MW13 = 114 * MiB, WS_MW2 = 466 * MiB;
constexpr size_t WS_H = 642 * MiB;
constexpr size_t WS_XN = 714 * MiB;
constexpr size_t WS_PALL = 750 * MiB;
constexpr size_t WS_MIX = 818 * MiB;
constexpr size_t WS_ACT = 854 * MiB;
constexpr size_t WS_XG = 1052 * MiB;
constexpr size_t WS_Y = 1180 * MiB;
static_assert(MOE_F8, "the per-expert input regions are laid out for fp8 rows");
constexpr size_t WS_SLAB = 1268 * MiB;
constexpr size_t WS_END = 1332 * MiB;
constexpr int CW_TMO = 0, CW_CODE = 1, CW_BAR = 4096, CW_CNT = 8192;
constexpr int CW_TK = 16384;
constexpr int CW_Q0 = 9216, CW_Q1 = 9280, CW_DONE = 9344;

constexpr int RING_BYTES = 131072, LDSCTL_OFF = 139264, MISC_OFF = LDSCTL_OFF + 320, TB_OFF = LDSCTL_OFF + 512, FLAG_OFF = LDSCTL_OFF + 256, UT_OFF = LDSCTL_OFF + 1024, LDS_BYTES = 147456;

typedef unsigned short bf16;
typedef unsigned v4u __attribute__((ext_vector_type(4)));
typedef unsigned v2u __attribute__((ext_vector_type(2)));
typedef float f32x4 __attribute__((ext_vector_type(4)));
typedef float f32x16 __attribute__((ext_vector_type(16)));
typedef short bf16x8 __attribute__((ext_vector_type(8)));
typedef short v4i16_t __attribute__((ext_vector_type(4)));
typedef GAS unsigned gu32;
#define RLX_AGENT __ATOMIC_RELAXED, __HIP_MEMORY_SCOPE_AGENT
#define LDS_WAIT() asm volatile("s_waitcnt lgkmcnt(0)" ::: "memory")
__device__ __forceinline__ unsigned f2bf(float f) { unsigned u = __builtin_bit_cast(unsigned, f); return (u + 0x7fffu + ((u >> 16) & 1u)) >> 16; }
__device__ __forceinline__ unsigned pk2(float lo, float hi) { return f2bf(lo) | (f2bf(hi) << 16); }
__device__ __forceinline__ float bf2f(unsigned short b) { return __builtin_bit_cast(float, (unsigned)b << 16); }
__device__ __forceinline__ float wave_sum(float v) {
#pragma unroll
    for (int o = 1; o < 64; o <<= 1) v += __shfl_xor(v, o);
    return v;
}

#define XB_TMO      128
#define XB_XCNT(j)  (256  + 64 * (j))
#define XB_XSUB(j)  (1280 + 64 * (j))
#define XB_XGEN(j)  (2304 + 64 * (j))
#define XB_TOP      3328
#define XB_TOPGEN   3392
#define XCD_BAR_WORDS 3456
#define XB_SPIN_CAP (1u << 18)

__device__ __forceinline__ unsigned xb_ld(unsigned* p)              { return __hip_atomic_load(p, __ATOMIC_RELAXED, __HIP_MEMORY_SCOPE_AGENT); }
__device__ __forceinline__ unsigned xb_add(unsigned* p, unsigned v) { return __hip_atomic_fetch_add(p, v, __ATOMIC_RELAXED, __HIP_MEMORY_SCOPE_AGENT); }
__device__ __forceinline__ unsigned xb_xcc_id() { return (unsigned)__builtin_amdgcn_s_getreg((3 << 11) | 20) & 0xFu; }
#define XB_SPIN(cond, bar) do { unsigned _sp = 0; while (cond) { __builtin_amdgcn_s_sleep(1); \
    if ((++_sp & 255u) == 0u) { if (xb_ld(&(bar)[XB_TMO])) break; if (_sp > XB_SPIN_CAP) { atomicAdd(&(bar)[XB_TMO], 1u); break; } } } } while (0)

struct XcdBarrier {
    unsigned* bar; unsigned x;
    volatile LAS unsigned* st;
};

__device__ __forceinline__ XcdBarrier xcd_barrier_post(unsigned* bar, volatile LAS unsigned* st) {
    XcdBarrier b; b.bar = bar; b.x = xb_xcc_id(); b.st = st;
    if (threadIdx.x == 0) (void)xb_add(&bar[XB_XCNT(b.x)], 1u);
    return b;
}
__device__ __forceinline__ void xcd_barrier_complete(unsigned* bar, unsigned x, unsigned& nloc, unsigned& nx) {
    const unsigned G = gridDim.x * gridDim.y * gridDim.z;
    unsigned sum, cnt, mine, sp = 0u;
    for (;;) {
        sum = 0u; cnt = 0u; mine = 0u;
#pragma unroll
        for (unsigned j = 0; j < 16; ++j) { const unsigned c = xb_ld(&bar[XB_XCNT(j)]); sum += c; cnt += (c > 0u) ? 1u : 0u; mine = (j == x) ? c : mine; }
        if (sum == G) break;
        __builtin_amdgcn_s_sleep(1);
        if ((++sp & 255u) == 0u) { if (xb_ld(&bar[XB_TMO])) break; if (sp > XB_SPIN_CAP) { atomicAdd(&bar[XB_TMO], 1u); break; } }
    }
    nloc = mine > 0u ? mine : 1u; nx = cnt > 0u ? cnt : 1u;
}

__device__ __attribute__((noinline)) void xcd_barrier(const XcdBarrier b) {
    asm volatile("s_waitcnt vmcnt(0)" ::: "memory");
    __syncthreads();
    if (threadIdx.x == 0) {
        unsigned* bar = b.bar;
        __builtin_amdgcn_s_waitcnt(0);
        unsigned nloc = b.st[0], nx = b.st[1];
        if (nloc == 0u) { xcd_barrier_complete(bar, b.x, nloc, nx); b.st[0] = nloc; b.st[1] = nx; }
        const unsigned old = xb_add(&bar[XB_XSUB(b.x)], 1u);
        const unsigned gen = old / nloc;
        if (old + 1u == (gen + 1u) * nloc) {
            __builtin_amdgcn_fence(__ATOMIC_RELEASE, "agent");
            asm volatile("s_waitcnt vmcnt(0)" ::: "memory");
            const unsigned og = xb_add(&bar[XB_TOP], 1u);
            const unsigned tg = og / nx;
            if (og + 1u == (tg + 1u) * nx) xb_add(&bar[XB_TOPGEN], 1u);
            else XB_SPIN(xb_ld(&bar[XB_TOPGEN]) == tg, bar);
            __builtin_amdgcn_fence(__ATOMIC_ACQUIRE, "agent");
            xb_add(&bar[XB_XGEN(b.x)], 1u);
            asm volatile("s_waitcnt vmcnt(0)" ::: "memory");
        } else {
            XB_SPIN(xb_ld(&bar[XB_XGEN(b.x)]) == gen, bar);
            __builtin_amdgcn_fence(__ATOMIC_ACQUIRE, "agent");
            asm volatile("s_waitcnt vmcnt(0)" ::: "memory");
        }
    }
    __syncthreads();
}

struct Args { const float* in[27]; float* out; unsigned char* ws; int ph_lo, ph_hi; };
#define CAS __attribute__((address_space(4)))
typedef const CAS unsigned char* kaptr;
__device__ __forceinline__ kaptr ka_get() { kaptr p = (kaptr)__builtin_amdgcn_kernarg_segment_ptr(); asm volatile("" : "+s"(p)); return p; }
#define KIN(kp, i) (*(const float* const CAS*)((kp) + 8 * (i)))
#define KOUT(kp) (*(float* const CAS*)((kp) + 216))
#define KWS(kp) (*(unsigned char* const CAS*)((kp) + 224))
#define KLO(kp) (*(const int CAS*)((kp) + 232))
#define KHI(kp) (*(const int CAS*)((kp) + 236))
static_assert(sizeof(Args) == 240, "Args layout");

__device__ __forceinline__ int dst_row(int mode, int n) {
    if (mode == 1) {
        const bool qk = (n >= 512 && n < 1536) || (n >= 3072 && n < 3712);
        if (qk) { const int d = n & 63; return (n & ~63) + (d < 32 ? 2 * d : 2 * (d - 32) + 1); }
        return n;
    }
    if (mode == 2) return (n >> 7) * 256 + (n & 127);
    if (mode == 3) return (n >> 7) * 256 + 128 + (n & 127);
    return n;
}
constexpr int TSCR = 64 * 65 * 4;
template <bool NTL>
__device__ __forceinline__ void ti_load(const float* W, int N, int item, int lane, f32x4 (&v)[16]) {
    const int nblk = N / 64, kb = item / nblk, nb = item % nblk, k0 = 64 * kb, n0 = 64 * nb;
    const GAS f32x4* src = (const GAS f32x4*)(W + (size_t)(k0 + (lane >> 4)) * N + n0 + 4 * (lane & 15));
#pragma unroll
    for (int i = 0; i < 16; ++i) v[i] = NTL ? __builtin_nontemporal_load(src + (size_t)i * N) : src[(size_t)i * N];
}
template <bool NTS, bool F8>
__device__ __forceinline__ void ti_store(const f32x4 (&v)[16], int K, int N, bf16* WT, int mode, LAS float* scr, int item, int lane) {
    const int nblk = N / 64, kb = item / nblk, nb = item % nblk, k0 = 64 * kb, n0 = 64 * nb;
    LAS float* wp = scr + (lane >> 4) * 65 + 4 * (lane & 15);
#pragma unroll
    for (int i = 0; i < 16; ++i) { wp[i * 4 * 65 + 0] = v[i].x; wp[i * 4 * 65 + 1] = v[i].y; wp[i * 4 * 65 + 2] = v[i].z; wp[i * 4 * 65 + 3] = v[i].w; }
    LDS_WAIT(); asm volatile("" ::: "memory");
    if constexpr (F8) {
        const int c = lane & 3;
#pragma unroll
        for (int j = 0; j < 4; ++j) { const int n = (lane >> 2) + 16 * j; const LAS float* s = scr + (16 * c) * 65 + n;
            v4u o;
#pragma unroll
            for (int q = 0; q < 4; ++q) o[q] = pg8::cvt4_fp8(256.0f * s[(4 * q) * 65], 256.0f * s[(4 * q + 1) * 65], 256.0f * s[(4 * q + 2) * 65], 256.0f * s[(4 * q + 3) * 65]);
            GAS v4u* dp = (GAS v4u*)((unsigned char*)WT + (size_t)dst_row(mode, n0 + n) * K + k0 + 16 * c); if (NTS) __builtin_nontemporal_store(o, dp); else *dp = o; }
    } else {
        const int c = lane & 7;
#pragma unroll
        for (int j = 0; j < 8; ++j) { const int n = (lane >> 3) + 8 * j; const LAS float* s = scr + (8 * c) * 65 + n;
            v4u o; o.x = pk2(s[0 * 65], s[1 * 65]); o.y = pk2(s[2 * 65], s[3 * 65]); o.z = pk2(s[4 * 65], s[5 * 65]); o.w = pk2(s[6 * 65], s[7 * 65]);
            GAS v4u* dp = (GAS v4u*)(WT + (size_t)dst_row(mode, n0 + n) * K + k0 + 8 * c); if (NTS) __builtin_nontemporal_store(o, dp); else *dp = o; }
    }
    LDS_WAIT(); asm volatile("" ::: "memory");
}
template <bool NT, bool F8 = false, bool NTL = false>
__device__ __forceinline__ void transpose_item(const float* W, int K, int N, bf16* WT, int mode, LAS float* scr, int item, int lane, const float*) {
    f32x4 v[16]; ti_load<NT || NTL>(W, N, item, lane, v); ti_store<NT, F8>(v, K, N, WT, mode, scr, item, lane);
}
__device__ __forceinline__ void p0_prologue(kaptr kp, LAS unsigned char* lds, int vcu, int G, int tid, int lane, int wave) {
    unsigned char* ws = KWS(kp);
    for (int j = vcu; j < 256; j += G) {
        const int l = j >> 7, g = (j >> 5) & 3, k0 = (j & 31) * 64;
        LAS float* As = (LAS float*)lds;
        LAS float* Ps = As + 64 * 132;
        const float* Wsrc = KIN(kp, 8) + (size_t)l * D * INC + (size_t)k0 * INC + g * 128;
        const float* Psrc = KIN(kp, 10) + ((size_t)l * 4 + g) * 128 * 128;
#pragma unroll
        for (int i = 0; i < 4; ++i) { const int idx = tid + 512 * i, r = idx >> 5, c4 = idx & 31; *(LAS f32x4*)(As + r * 132 + 4 * c4) = *(const GAS f32x4*)(Wsrc + (size_t)r * INC + 4 * c4); }
#pragma unroll
        for (int i = 0; i < 8; ++i) { const int idx = tid + 512 * i, r = idx >> 5, c4 = idx & 31; *(LAS f32x4*)(Ps + r * 132 + 4 * c4) = *(const GAS f32x4*)(Psrc + (size_t)r * 128 + 4 * c4); }
        __syncthreads();
        const int n4 = tid & 31, kq = tid >> 5;
        f32x4 acc[4];
#pragma unroll
        for (int i = 0; i < 4; ++i) acc[i] = (f32x4){0.f, 0.f, 0.f, 0.f};
#pragma unroll 4
        for (int c = 0; c < 128; ++c) { const f32x4 pv = *(const LAS f32x4*)(Ps + c * 132 + 4 * n4);
#pragma unroll
            for (int i = 0; i < 4; ++i) acc[i] += As[(4 * kq + i) * 132 + c] * pv; }
        bf16* WT = (bf16*)(ws + WS_WIN) + (size_t)l * INC * D;
#pragma unroll
        for (int e = 0; e < 4; ++e) { v2u o; o.x = pk2(acc[0][e], acc[1][e]); o.y = pk2(acc[2][e], acc[3][e]);
            *(GAS v2u*)(WT + (size_t)(g * 128 + 4 * n4 + e) * D + k0 + 4 * kq) = o; }
        __syncthreads();
    }
    for (int j = vcu; j < 192; j += G) {
        const int l = j / 96, n0 = (j % 96) * 128;
        LAS float* S = (LAS float*)lds; LAS float* red = S + 5 * 2048;
        for (int idx = tid; idx < 5 * 2048; idx += NWAVES * 64) { const int i = idx >> 11, k = idx & 2047; const float v = i < 4 ? KIN(kp, 1)[i * 2048 + k] : KIN(kp, 3)[k]; S[idx] = v / (1.0f + expf(-v)); }
        __syncthreads();
        f32x4 acc[5];
#pragma unroll
        for (int i = 0; i < 5; ++i) acc[i] = (f32x4){0.f, 0.f, 0.f, 0.f};
        const int kh = lane >> 5;
        const GAS f32x4* wp = (const GAS f32x4*)(KIN(kp, 4) + ((size_t)l * 2048 + wave * 256 + kh) * MODN + n0 + 4 * (lane & 31));
#pragma unroll 8
        for (int k = 0; k < 128; ++k) { const f32x4 w = __builtin_nontemporal_load(wp + (size_t)k * (2 * MODN / 4));
#pragma unroll
            for (int i = 0; i < 5; ++i) acc[i] += S[i * 2048 + wave * 256 + 2 * k + kh] * w; }
#pragma unroll
        for (int i = 0; i < 5; ++i) { f32x4 t = acc[i]; t.x += __shfl_xor(t.x, 32); t.y += __shfl_xor(t.y, 32); t.z += __shfl_xor(t.z, 32); t.w += __shfl_xor(t.w, 32);
            if (kh == 0) *(LAS f32x4*)(red + (wave * 5 + i) * 128 + 4 * (lane & 31)) = t; }
        __syncthreads();
        for (int idx = tid; idx < 640; idx += NWAVES * 64) { const int i = idx >> 7, n = idx & 127; float s = 0.f;
#pragma unroll
            for (int w = 0; w < 8; ++w) s += red[(w * 5 + i) * 128 + n];
            ((float*)(ws + WS_MOD))[(l * 5 + i) * MODN + n0 + n] = s + KIN(kp, 5)[l * MODN + n0 + n]; }
        __syncthreads();
    }
    if (vcu == (200 % G)) {
        for (int idx = tid; idx < 1024; idx += NWAVES * 64) { const int pos = idx >> 4, f = idx & 15; const float inv = powf(10000.0f, -(float)f / 16.0f); const float ang = (float)pos * inv;
            ((float*)(ws + WS_ROPE))[idx] = cosf(ang); ((float*)(ws + WS_ROPE))[1024 + idx] = sinf(ang); }
    }
    __syncthreads();
    LAS float* scr = (LAS float*)(lds + wave * TSCR);
    constexpr int I_IN = 32 * 52, I_OUT = 32 * 32, I_UP = 32 * 88, I_DN = 88 * 32;
    constexpr int NITEMS = 2 * I_IN + 2 * I_OUT + 2 * I_UP + I_DN;
    unsigned* q0 = (unsigned*)(ws + WS_CTL) + CW_Q0;
#define P0_DESC(it_, W_, K_, N_, WT_, M_, I_, F_) do { int r = (it_); F_ = false; \
        if (r < 2 * I_IN) { const int l = r / I_IN; W_ = KIN(kp, 8) + (size_t)l * D * INC; K_ = D; N_ = INC; WT_ = (bf16*)(ws + WS_WIN) + (size_t)l * INC * D; M_ = 1; const int q = r % I_IN; I_ = (q / 52) * 60 + 8 + (q % 52); } \
        else if ((r -= 2 * I_IN) < 2 * I_OUT) { const int l = r / I_OUT; W_ = KIN(kp, 9) + (size_t)l * D * D; K_ = D; N_ = D; WT_ = (bf16*)(ws + WS_WOUT) + (size_t)l * D * D; M_ = 0; I_ = r % I_OUT; } \
        else if ((r -= 2 * I_OUT) < I_UP) { W_ = KIN(kp, 19); K_ = D; N_ = DFF; WT_ = (bf16*)(ws + WS_W13); M_ = 2; I_ = r; F_ = DENSE_UP_F8; } \
        else if ((r -= I_UP) < I_UP) { W_ = KIN(kp, 20); K_ = D; N_ = DFF; WT_ = (bf16*)(ws + WS_W13); M_ = 3; I_ = r; F_ = DENSE_UP_F8; } \
        else { r -= I_UP; W_ = KIN(kp, 21); K_ = DFF; N_ = D; WT_ = (bf16*)(ws + WS_W2); M_ = 0; I_ = r; F_ = DENSE_DN_F8; } } while (0)
    for (;;) {
        unsigned k0 = 0; if (lane == 0) k0 = __hip_atomic_fetch_add(q0, 2u, RLX_AGENT);
        const int kb = (int)__builtin_amdgcn_readfirstlane(k0); if (kb >= NITEMS) break;
        const float* Wa; int Ka, Na, ma, ia; bf16* WTa; bool fa; f32x4 va[16];
        P0_DESC(kb, Wa, Ka, Na, WTa, ma, ia, fa); ti_load<true>(Wa, Na, ia, lane, va);
        const bool two = kb + 1 < NITEMS;
        const float* Wb = Wa; int Kb = Ka, Nb = Na, mb = ma, ib = ia; bf16* WTb = WTa; bool fb = fa; f32x4 vb[16];
        if (two) { P0_DESC(kb + 1, Wb, Kb, Nb, WTb, mb, ib, fb); ti_load<true>(Wb, Nb, ib, lane, vb); }
        if (fa) ti_store<false, true>(va, Ka, Na, WTa, ma, scr, ia, lane); else ti_store<false, false>(va, Ka, Na, WTa, ma, scr, ia, lane);
        if (two) { if (fb) ti_store<false, true>(vb, Kb, Nb, WTb, mb, scr, ib, lane); else ti_store<false, false>(vb, Kb, Nb, WTb, mb, scr, ib, lane); }
    }
#undef P0_DESC
}

__device__ __attribute__((noinline)) void fill_tail(unsigned char* ws, const float* w1, const float* w3, const float* w2, unsigned* done, int G, int nw) {
    extern __shared__ __attribute__((aligned(16))) unsigned char lds_fill[];
    LAS unsigned char* lds = (LAS unsigned char*)lds_fill;
    const int tid = threadIdx.x, lane = tid & 63, wave = __builtin_amdgcn_readfirstlane(tid >> 6);
    volatile LAS unsigned* flag = (volatile LAS unsigned*)(lds + FLAG_OFF);
    __syncthreads();
    if (tid == 0) { unsigned f = 0u; if (done) { const unsigned old = __hip_atomic_fetch_add(done, 1u, RLX_AGENT); f = (old + 1u >= (unsigned)G) ? 1u : 0u; } *flag = f; }
    __syncthreads();
    LAS float* scr = (LAS float*)(lds + wave * TSCR);
    unsigned* q1 = (unsigned*)(ws + WS_CTL) + CW_Q1;
    constexpr int I_UP = 32 * 88, NIT = 24 * I_UP;
#ifndef FILLW
#define FILLW 2
#endif
#ifndef FILLB
#define FILLB 4
#endif
#ifdef PROBE_BURN
    if (done && wave >= FILLW) {
        f32x16 acc; for (int r = 0; r < 16; ++r) acc[r] = 0.f; const bf16x8 a = (bf16x8){1, 2, 3, 4, 5, 6, 7, 8};
        while (!*flag) { for (int it = 0; it < 64; ++it) acc = __builtin_amdgcn_mfma_f32_32x32x16_bf16(a, a, acc, 0, 0, 0); if (__hip_atomic_load(done, RLX_AGENT) >= (unsigned)G) break; }
        if (acc[0] == 12345.f) *flag = 2u;
        return; }
#endif
    if (done && wave >= nw) return;
#define FILL_ITEM(it_) do { const int it__ = (it_); const int seg = it__ / I_UP, item = it__ % I_UP, mat = seg >> 3, e = seg & 7; \
        if (mat == 0) transpose_item<true, MOE_F8>(w1 + (size_t)e * D * DFF, D, DFF, (bf16*)(ws + WS_MW13 + (size_t)e * 2 * DFF * D * (MOE_F8 ? 1 : 2)), 2, scr, item, lane, nullptr); \
        else if (mat == 1) transpose_item<true, MOE_F8>(w3 + (size_t)e * D * DFF, D, DFF, (bf16*)(ws + WS_MW13 + (size_t)e * 2 * DFF * D * (MOE_F8 ? 1 : 2)), 3, scr, item, lane, nullptr); \
        else transpose_item<true, MOE_F8>(w2 + (size_t)e * DFF * D, DFF, D, (bf16*)(ws + WS_MW2 + (size_t)e * D * DFF * (MOE_F8 ? 1 : 2)), 0, scr, item, lane, nullptr); } while (0)
    if (!done) return;
    for (;;) {
        if (*flag) break;
        if (tid == 0) { if (__hip_atomic_load(done, RLX_AGENT) >= (unsigned)G) *flag = 1u; }
        if (*flag) break;
        unsigned k0 = 0; if (lane == 0) k0 = __hip_atomic_fetch_add(q1, (unsigned)FILLB, RLX_AGENT);
        const int kb = (int)__builtin_amdgcn_readfirstlane(k0); if (kb >= NIT) break;
        for (int it = kb; it < kb + FILLB && it < NIT; ++it) FILL_ITEM(it);
    }
#undef FILL_ITEM
}

__device__ __forceinline__ void drain_tail(unsigned char* ws, const float* w1, const float* w3, const float* w2, int G, LAS unsigned char* lds) {
    int tid = threadIdx.x; asm volatile("" : "+v"(tid));
    const int lane = tid & 63, wave = __builtin_amdgcn_readfirstlane(tid >> 6);
    __syncthreads();
    LAS float* scr = (LAS float*)(lds + wave * TSCR);
    unsigned* q1 = (unsigned*)(ws + WS_CTL) + CW_Q1;
    constexpr int I_UP = 32 * 88, NIT = 24 * I_UP;
        const int h = (int)__builtin_amdgcn_readfirstlane(__hip_atomic_load(q1, RLX_AGENT));
        const int gwv = blockIdx.x * NWAVES + wave, ngw = G * NWAVES;
#define MOE_DESC(it_, W_, K_, N_, WT_, M_, I_) do { const int seg_ = (it_) / I_UP, mat_ = seg_ >> 3, e_ = seg_ & 7; I_ = (it_) % I_UP; \
        if (mat_ == 0) { W_ = w1 + (size_t)e_ * D * DFF; K_ = D; N_ = DFF; WT_ = (bf16*)(ws + WS_MW13 + (size_t)e_ * 2 * DFF * D * (MOE_F8 ? 1 : 2)); M_ = 2; } \
        else if (mat_ == 1) { W_ = w3 + (size_t)e_ * D * DFF; K_ = D; N_ = DFF; WT_ = (bf16*)(ws + WS_MW13 + (size_t)e_ * 2 * DFF * D * (MOE_F8 ? 1 : 2)); M_ = 3; } \
        else { W_ = w2 + (size_t)e_ * DFF * D; K_ = DFF; N_ = D; WT_ = (bf16*)(ws + WS_MW2 + (size_t)e_ * D * DFF * (MOE_F8 ? 1 : 2)); M_ = 0; } } while (0)
        int it = h + gwv;
        if (it < NIT) {
            const float* W; int K, N, md, item; bf16* WT; f32x4 v[16];
            MOE_DESC(it, W, K, N, WT, md, item); ti_load<true>(W, N, item, lane, v);
            for (;;) {
                const int nx = it + ngw; const float* Wn = W; int Kn = K, Nn = N, mdn = md, itemn = item; bf16* WTn = WT; f32x4 vn[16];
                const bool more = nx < NIT;
                if (more) { MOE_DESC(nx, Wn, Kn, Nn, WTn, mdn, itemn); ti_load<true>(Wn, Nn, itemn, lane, vn); }
                ti_store<true, MOE_F8>(v, K, N, WT, md, scr, item, lane);
                if (!more) break;
#pragma unroll
                for (int i = 0; i < 16; ++i) v[i] = vn[i];
                it = nx; W = Wn; K = Kn; N = Nn; WT = WTn; md = mdn; item = itemn;
            }
        }
#undef MOE_DESC
}

template <class Epi, class Ord>
__device__ __forceinline__ void combine_tail(const Epi& E, const Ord& S, const float* slab, unsigned* tickets, LAS unsigned char* lds) {
    int tt; pg8::Unit tu;
    if (!S.tail_unit(tt, tu)) return;
    int tid = threadIdx.x; asm volatile("" : "+v"(tid));
    const int lane = tid & 63, wid = __builtin_amdgcn_readfirstlane(tid >> 6), wr = wid >> 2, wc = wid & 3, fr = lane & 15, fq = lane >> 4;
    volatile LAS unsigned* flag = (volatile LAS unsigned*)(lds + FLAG_OFF);
    asm volatile("s_waitcnt vmcnt(0)" ::: "memory");
    __syncthreads();
    if (tid == 0) {
        __builtin_amdgcn_fence(__ATOMIC_RELEASE, "agent");
        asm volatile("s_waitcnt vmcnt(0)" ::: "memory");
        const unsigned t = __hip_atomic_fetch_add(tickets + 64 * tt, 1u, RLX_AGENT);
        const bool last = (t == (unsigned)S.tp.S - 1u);
        if (last) { __builtin_amdgcn_fence(__ATOMIC_ACQUIRE, "agent"); asm volatile("s_waitcnt vmcnt(0)" ::: "memory"); }
        *flag = last ? 1u : 0u;
    }
    __syncthreads();
    if (*flag) {
        const int ns = S.tp.S;
        const GAS pg8::f32x4* sp = (const GAS pg8::f32x4*)slab + (size_t)(tt * ns) * (32 * 512) + tid;
        pg8::f32x4 acc[2][2][4][2];
#pragma unroll
        for (int ai = 0; ai < 2; ++ai)
#pragma unroll
            for (int bj = 0; bj < 2; ++bj)
#pragma unroll
                for (int m = 0; m < 4; ++m)
#pragma unroll
                    for (int n = 0; n < 2; ++n) { const int r = (((ai * 2 + bj) * 4 + m) * 2) + n; pg8::f32x4 a = sp[(size_t)r * 512];
                        for (int ks = 1; ks < ns; ++ks) a += sp[(size_t)ks * (32 * 512) + (size_t)r * 512];
                        acc[ai][bj][m][n] = a; }
        E(acc, tu, wr, wc, fr, fq);
    }
    __syncthreads();
}

template <bool ROUTE, bool F8 = false>
__device__ __forceinline__ void norm_rows(const float* srcC, const float* srcL, const float* gain, const float* shift, const float* scale, bf16* XN, int row_lo, int row_hi, int gw, int NGW, int lane,
                                          const LAS float* rt, unsigned* cnt, int* route) {
    f32x4 vn[8];
    { const int row = row_lo + gw; if (row < row_hi) { const GAS f32x4* xr = (const GAS f32x4*)((row < RC ? srcC : srcL) + (size_t)row * D) + lane;
#pragma unroll
        for (int j = 0; j < 8; ++j) vn[j] = xr[64 * j]; } }
    unsigned pk[8]; int pe1 = 0, pe2 = 0, ps1 = 0, ps2 = 0, prow = 0; float pw1 = 0.f, pw2 = 0.f; bool have = false;
#define ROUTE_FLUSH() do { if constexpr (ROUTE && F8) { \
        if (lane == 0) { int* rec = route + (size_t)(prow - RC) * 8; rec[0] = pe1; rec[1] = ps1; rec[2] = __builtin_bit_cast(int, pw1); rec[3] = pe2; rec[4] = ps2; rec[5] = __builtin_bit_cast(int, pw2); } \
        const int e1_ = __builtin_amdgcn_readfirstlane(pe1), e2_ = __builtin_amdgcn_readfirstlane(pe2), s1_ = __builtin_amdgcn_readfirstlane(ps1), s2_ = __builtin_amdgcn_readfirstlane(ps2); \
        GAS unsigned* d1 = (GAS unsigned*)((unsigned char*)XN + ((size_t)e1_ * 8192 + s1_) * D) + lane; GAS unsigned* d2 = (GAS unsigned*)((unsigned char*)XN + ((size_t)e2_ * 8192 + s2_) * D) + lane; \
        _Pragma("unroll") for (int j = 0; j < 8; ++j) { d1[64 * j] = pk[j]; d2[64 * j] = pk[j]; } } } while (0)
    f32x4 gg[8];
#pragma unroll
    for (int j = 0; j < 8; ++j) gg[j] = ((const GAS f32x4*)gain + lane)[64 * j];
    for (int row = row_lo + gw; row < row_hi; row += NGW) {
        const int bidx = row < RC ? 4 : ((row - RC) >> 11);
        f32x4 v[8]; float ss = 0.f;
        f32x4 shh[8], scc[8];
        { const GAS f32x4* sh4 = (const GAS f32x4*)(shift + bidx * MODN) + lane; const GAS f32x4* sc4 = (const GAS f32x4*)(scale + bidx * MODN) + lane;
#pragma unroll
          for (int j = 0; j < 8; ++j) { shh[j] = sh4[64 * j]; scc[j] = sc4[64 * j]; } }
        asm volatile("" ::: "memory");
#pragma unroll
        for (int j = 0; j < 8; ++j) { v[j] = vn[j]; ss += (v[j].x * v[j].x + v[j].y * v[j].y) + (v[j].z * v[j].z + v[j].w * v[j].w); }
        { const int nrow = row + NGW; if (nrow < row_hi) { const GAS f32x4* xr = (const GAS f32x4*)((nrow < RC ? srcC : srcL) + (size_t)nrow * D) + lane;
#pragma unroll
            for (int j = 0; j < 8; ++j) vn[j] = xr[64 * j]; } }
        const float rstd = 1.0f / sqrtf(wave_sum(ss) * (1.0f / D) + EPS);
        GAS unsigned long long* o8 = (GAS unsigned long long*)(XN + (size_t)row * D) + lane; GAS unsigned* o4 = (GAS unsigned*)((unsigned char*)XN + (size_t)row * D) + lane;
#pragma unroll
        for (int j = 0; j < 8; ++j) { v[j] = (v[j] * rstd * gg[j]) * (1.0f + scc[j]) + shh[j];
            if constexpr (ROUTE) {}
            else if constexpr (F8) o4[64 * j] = pg8::cvt4_fp8(v[j].x, v[j].y, v[j].z, v[j].w);
            else o8[64 * j] = (unsigned long long)pk2(v[j].x, v[j].y) | ((unsigned long long)pk2(v[j].z, v[j].w) << 32); }
        if (ROUTE) {
            float lg[8];
#pragma unroll
            for (int e = 0; e < 8; ++e) lg[e] = 0.f;
#pragma unroll
            for (int j = 0; j < 8; ++j)
#pragma unroll
                for (int q = 0; q < 4; ++q) { const int k = 256 * j + 4 * lane + q; const LAS f32x4* rp = (const LAS f32x4*)(rt + k * 8); const f32x4 r0 = rp[0], r1 = rp[1]; const float f = v[j][q];
                    lg[0] += f * r0.x; lg[1] += f * r0.y; lg[2] += f * r0.z; lg[3] += f * r0.w; lg[4] += f * r1.x; lg[5] += f * r1.y; lg[6] += f * r1.z; lg[7] += f * r1.w;
                    if (q == 3) asm volatile("" ::: "memory"); }
#pragma unroll
            for (int e = 0; e < 8; ++e) lg[e] = wave_sum(lg[e]);
            int i1 = 0; float v1 = lg[0];
#pragma unroll
            for (int e = 1; e < 8; ++e) if (lg[e] > v1) { v1 = lg[e]; i1 = e; }
            int i2 = -1; float v2 = -INFINITY;
#pragma unroll
            for (int e = 0; e < 8; ++e) if (e != i1 && lg[e] > v2) { v2 = lg[e]; i2 = e; }
            const float w1 = 1.0f / (1.0f + expf(v2 - v1)), w2 = 1.0f - w1;
            if (have) ROUTE_FLUSH();
            ps1 = 0; ps2 = 0;
            if (lane == 0) { ps1 = (int)__hip_atomic_fetch_add(cnt + 64 * i1, 1u, RLX_AGENT); ps2 = (int)__hip_atomic_fetch_add(cnt + 64 * i2, 1u, RLX_AGENT); }
            pe1 = i1; pe2 = i2; pw1 = w1; pw2 = w2; prow = row; have = true;
#pragma unroll
            for (int j = 0; j < 8; ++j) pk[j] = pg8::cvt4_fp8(v[j].x, v[j].y, v[j].z, v[j].w);
        }
    }
    if (ROUTE) { if (have) ROUTE_FLUSH(); }
#undef ROUTE_FLUSH
}

struct TileSpec { int nband, band_row0, ctx_row0, nt; };
__device__ __forceinline__ int crow(int r, int hi) { return (r & 3) + 8 * (r >> 2) + 4 * hi; }
template <int NKC, int DVB, bool WIN>
__device__ __forceinline__ void attn_core(LAS unsigned char* lds, const bf16* P, const bf16x8 (&qr)[4], int kcol, int vcol, int kofs, const TileSpec ts, int qpos, int bandpos0,
                                          f32x16 (&o)[DVB], f32x16& ol, float& mref_out, int tid, int lane) {
    constexpr int SB = NKC * 1024 + DVB * 4096, NK = NKC / 8, NV = DVB / 2;
    constexpr float THR = 8.0f;
    const int r32 = lane & 31, hi = lane >> 5, wv = __builtin_amdgcn_readfirstlane(tid >> 6);
    int koff[NK], voff[NV];
#pragma unroll
    for (int i = 0; i < NK; ++i) { const int q = tid + 512 * i, key = q / NKC, s = q % NKC; koff[i] = key * INC + kcol + (s ^ (NKC == 16 ? (key & 15) : ((key >> 1) & 7))) * 8; }
#pragma unroll
    for (int i = 0; i < NV; ++i) { const int q = tid + 512 * i; voff[i] = (((q >> 6) & 3) * 16 + ((q >> 2) & 15)) * INC + vcol + (q >> 8) * 32 + (q & 3) * 8; }
#define ATT_DMA(t_, s_) do { const int t__ = (t_); const int rb_ = t__ < ts.nband ? ts.band_row0 + 64 * t__ : ts.ctx_row0 + 64 * (t__ - ts.nband); const bf16* tb_ = P + (size_t)rb_ * INC; \
        _Pragma("unroll") for (int i_ = 0; i_ < NK; ++i_) __builtin_amdgcn_global_load_lds((const unsigned*)(tb_ + koff[i_]), (LAS unsigned*)(lds + (s_) * SB + (wv * 64 + 512 * i_) * 16), 16, 0, 0); \
        _Pragma("unroll") for (int i_ = 0; i_ < NV; ++i_) __builtin_amdgcn_global_load_lds((const unsigned*)(tb_ + voff[i_]), (LAS unsigned*)(lds + (s_) * SB + NKC * 1024 + (wv * 64 + 512 * i_) * 16), 16, 0, 0); } while (0)
    float mref = 0.f;
    f32x16 negm;
#pragma unroll
    for (int r = 0; r < 16; ++r) { negm[r] = 0.f; ol[r] = 0.f; }
#pragma unroll
    for (int d0 = 0; d0 < DVB; ++d0)
#pragma unroll
        for (int r = 0; r < 16; ++r) o[d0][r] = 0.f;
    const short one = (r32 == 0) ? (short)0x3F80 : (short)0;
    const bf16x8 onesf = (bf16x8){one, one, one, one, one, one, one, one};
    const int q0w = WIN ? __builtin_amdgcn_readfirstlane(qpos - r32) : 0;
    ATT_DMA(0, 0); asm volatile("s_waitcnt vmcnt(0)" ::: "memory"); __syncthreads();
#pragma unroll 1
    for (int t = 0; t < ts.nt; ++t) {
        if (t + 1 < ts.nt) ATT_DMA(t + 1, (t + 1) & 1);
        LAS unsigned char* sb = lds + (t & 1) * SB;
        f32x16 p0, p1;
        { const LAS unsigned char* kb = sb + r32 * (NKC * 16);
#pragma unroll
          for (int d0 = 0; d0 < 4; ++d0) { const int so = ((kofs + 2 * d0 + hi) ^ (NKC == 16 ? (r32 & 15) : ((r32 >> 1) & 7))) * 16; const bf16x8 b0 = *(const LAS bf16x8*)(kb + so), b1 = *(const LAS bf16x8*)(kb + 32 * (NKC * 16) + so);
              if (d0 == 0) { p0 = __builtin_amdgcn_mfma_f32_32x32x16_bf16(b0, qr[0], negm, 0, 0, 0); p1 = __builtin_amdgcn_mfma_f32_32x32x16_bf16(b1, qr[0], negm, 0, 0, 0); }
              else { p0 = __builtin_amdgcn_mfma_f32_32x32x16_bf16(b0, qr[d0], p0, 0, 0, 0); p1 = __builtin_amdgcn_mfma_f32_32x32x16_bf16(b1, qr[d0], p1, 0, 0, 0); } } }
        if (WIN) { const int kt0 = bandpos0 + 64 * t;
          if (t < ts.nband && (q0w + 31 - kt0 > 128 || kt0 + 63 - q0w > 128)) { const int kp0 = kt0 + 4 * hi;
#pragma unroll
            for (int r = 0; r < 16; ++r) { const int dlt = qpos - (kp0 + (r & 3) + 8 * (r >> 2)); if (dlt > 128 || dlt < -128) p0[r] = -1e30f; if (dlt - 32 > 128 || dlt - 32 < -128) p1[r] = -1e30f; } } }
        float rm = fmaxf(fmaxf(p0[0], p0[1]), p1[0]);
#pragma unroll
        for (int r = 1; r < 16; ++r) rm = fmaxf(fmaxf(rm, p0[r]), p1[r]);
        rm = fmaxf(rm, p0[1]);
        rm = fmaxf(rm, __shfl_xor(rm, 32));
        if (t == 0 || __any(rm > THR)) {
            const float dl = t == 0 ? rm : fmaxf(rm, 0.f);
            mref += dl;
#pragma unroll
            for (int r = 0; r < 16; ++r) { p0[r] -= dl; p1[r] -= dl; negm[r] = -mref; }
            if (t != 0) { const float f = __builtin_amdgcn_exp2f(-dl);
#pragma unroll
                for (int r = 0; r < 16; ++r) { const float fr = __shfl(f, crow(r, hi)); ol[r] *= fr;
#pragma unroll
                    for (int d0 = 0; d0 < DVB; ++d0) o[d0][r] *= fr; } }
        }
#pragma unroll
        for (int r = 0; r < 16; ++r) { p0[r] = __builtin_amdgcn_exp2f(p0[r]); p1[r] = __builtin_amdgcn_exp2f(p1[r]); }
        v4u pw[4];
#pragma unroll
        for (int i = 0; i < 4; ++i) { pw[0][i] = pg8::cvt_pk_bf16(p0[2 * i], p0[2 * i + 1]); pw[1][i] = pg8::cvt_pk_bf16(p0[8 + 2 * i], p0[8 + 2 * i + 1]); pw[2][i] = pg8::cvt_pk_bf16(p1[2 * i], p1[2 * i + 1]); pw[3][i] = pg8::cvt_pk_bf16(p1[8 + 2 * i], p1[8 + 2 * i + 1]); }
        { const LAS unsigned char* vb = sb + NKC * 1024 + ((lane >> 4) & 1) * 32 + (lane & 3) * 8 + (4 * hi + ((lane & 15) >> 2)) * 64;
#pragma unroll
          for (int d0 = 0; d0 < DVB; ++d0)
#pragma unroll
              for (int ks = 0; ks < 4; ++ks) {
                  const v4i16_t lo = __builtin_amdgcn_ds_read_tr16_b64_v4i16((LAS v4i16_t*)(vb + d0 * 4096 + ks * 1024)), hh = __builtin_amdgcn_ds_read_tr16_b64_v4i16((LAS v4i16_t*)(vb + d0 * 4096 + ks * 1024 + 512));
                  const bf16x8 vf = (bf16x8){lo[0], lo[1], lo[2], lo[3], hh[0], hh[1], hh[2], hh[3]};
                  o[d0] = __builtin_amdgcn_mfma_f32_32x32x16_bf16(__builtin_bit_cast(bf16x8, pw[ks]), vf, o[d0], 0, 0, 0);
                  if (ks == 3) asm volatile("" ::: "memory"); }
#pragma unroll
          for (int ks = 0; ks < 4; ++ks) ol = __builtin_amdgcn_mfma_f32_32x32x16_bf16(__builtin_bit_cast(bf16x8, pw[ks]), onesf, ol, 0, 0, 0); }
        asm volatile("s_waitcnt vmcnt(0)" ::: "memory");
        __syncthreads();
    }
#undef ATT_DMA
    mref_out = mref;
}
template <int DVB>
__device__ __forceinline__ void attn_normalize(f32x16 (&o)[DVB], const f32x16& ol, float extra, int hi) {
#pragma unroll
    for (int r = 0; r < 16; ++r) { const float l = __shfl(ol[r], hi << 5) + __shfl(extra, crow(r, hi)); const float ir = 1.0f / l;
#pragma unroll
        for (int d0 = 0; d0 < DVB; ++d0) o[d0][r] *= ir; }
}

__device__ __forceinline__ void win_unit(LAS unsigned char* lds, const bf16* P, bf16* MIX, const float* sink, int b, int g, int qb, bool ctxq, int tid, int lane, int wave) {
    const int r32 = lane & 31, hi = lane >> 5, hr = wave >> 1, sub = (wave & 1) * 32;
    TileSpec ts; int qrow0, qpos = 0, bandpos0 = 0;
    if (!ctxq) { const int tl = qb - 2 < 0 ? 0 : qb - 2, th = qb + 2 > 31 ? 31 : qb + 2; ts.nband = th - tl + 1; ts.band_row0 = RC + b * SEQ + tl * 64; bandpos0 = tl * 64; ts.ctx_row0 = b * CTX; ts.nt = ts.nband + 4;
        qrow0 = RC + b * SEQ + qb * 64 + sub; qpos = qb * 64 + sub + r32; }
    else { ts.nband = 0; ts.band_row0 = 0; ts.ctx_row0 = b * CTX; ts.nt = 4; qrow0 = b * CTX + qb * 64 + sub; }
    const int qcol = 3072 + g * 256 + hr * 64;
    bf16x8 qr[4];
#pragma unroll
    for (int d0 = 0; d0 < 4; ++d0) qr[d0] = *(const GAS bf16x8*)(P + (size_t)(qrow0 + r32) * INC + qcol + d0 * 16 + hi * 8);
    f32x16 o[2], ol; float mref;
    attn_core<8, 2, true>(lds, P, qr, 3584 + g * 64, 3712 + g * 64, 0, ts, qpos, bandpos0, o, ol, mref, tid, lane);
    attn_normalize<2>(o, ol, __builtin_amdgcn_exp2f(sink[g * 4 + hr] * LOG2E - mref), hi);
#pragma unroll
    for (int r = 0; r < 16; ++r) { bf16* op = MIX + (size_t)(qrow0 + crow(r, hi)) * D + 1536 + (g * 4 + hr) * 64 + r32;
#pragma unroll
        for (int d0 = 0; d0 < 2; ++d0) op[d0 * 32] = (bf16)f2bf(o[d0][r]); }
}

__device__ __forceinline__ void diff_unit(LAS unsigned char* lds, const bf16* P, bf16* MIX, const float* dlam, const float* subln, float lam_init, int b, int h, int qb, bool ctxq, int tid, int lane, int wave) {
    const int r32 = lane & 31, hi = lane >> 5, m = wave >> 2, sub = (wave & 3) * 32;
    TileSpec ts; int qrow0;
    if (!ctxq) { ts.nband = 32; ts.band_row0 = RC + b * SEQ; ts.ctx_row0 = b * CTX; ts.nt = 36; qrow0 = RC + b * SEQ + qb * 128 + sub; }
    else { ts.nband = 0; ts.band_row0 = 0; ts.ctx_row0 = b * CTX; ts.nt = 4; qrow0 = b * CTX + qb * 128 + sub; }
    const int qcol = 512 + h * 128 + m * 64;
    bf16x8 qr[4];
#pragma unroll
    for (int d0 = 0; d0 < 4; ++d0) qr[d0] = *(const GAS bf16x8*)(P + (size_t)(qrow0 + r32) * INC + qcol + d0 * 16 + hi * 8);
    const float lam = expf(wave_sum(dlam[lane] * dlam[64 + lane])) - expf(wave_sum(dlam[128 + lane] * dlam[192 + lane])) + lam_init;
    f32x16 o[4], ol; float mref;
    attn_core<16, 4, false>(lds, P, qr, 1024 + h * 128, 1536 + h * 128, m * 8, ts, 0, 0, o, ol, mref, tid, lane);
    attn_normalize<4>(o, ol, 0.f, hi);
    LAS float* ex = (LAS float*)lds + (wave & 3) * 4096;
    if (m == 1) {
#pragma unroll
        for (int d0 = 0; d0 < 4; ++d0)
#pragma unroll
            for (int r = 0; r < 16; ++r) ex[(d0 * 16 + r) * 64 + lane] = o[d0][r];
    }
    __syncthreads();
    if (m == 0) {
        float sl[4];
#pragma unroll
        for (int d0 = 0; d0 < 4; ++d0) sl[d0] = subln[d0 * 32 + r32] * (1.0f - lam_init);
#pragma unroll
        for (int r = 0; r < 16; ++r) {
            float ss = 0.f;
#pragma unroll
            for (int d0 = 0; d0 < 4; ++d0) { const float v = o[d0][r] - lam * ex[(d0 * 16 + r) * 64 + lane]; o[d0][r] = v; ss += v * v; }
            asm volatile("" ::: "memory");
#pragma unroll
            for (int off = 1; off < 32; off <<= 1) ss += __shfl_xor(ss, off);
            const float rstd = 1.0f / sqrtf(ss * (1.0f / 128.0f) + EPS);
            bf16* op = MIX + (size_t)(qrow0 + crow(r, hi)) * D + 512 + h * 128 + r32;
#pragma unroll
            for (int d0 = 0; d0 < 4; ++d0) op[d0 * 32] = (bf16)f2bf(o[d0][r] * rstd * sl[d0]);
        }
    }
    __syncthreads();
}

__device__ __forceinline__ void sgu_unit(LAS unsigned char* lds, const bf16* P, bf16* MIX, const float* ln_g, const float* ln_b, const float* Ws, const float* bs, int row0, int g, int tid, int lane, int wave) {
    constexpr int VS = 136;
    LAS bf16* VT = (LAS bf16*)lds;
    const int r32 = lane & 31, hi = lane >> 5;
    { const int tq = lane >> 4, j = lane & 15;
      v4u raws[4][4];
#pragma unroll
      for (int ps = 0; ps < 4; ++ps)
#pragma unroll
          for (int q = 0; q < 4; ++q) raws[ps][q] = *(const GAS v4u*)(P + (size_t)(row0 + wave * 16 + ps * 4 + tq) * INC + 2560 + (j + 16 * q) * 8);
      float lg8[8], lb8[8];
#pragma unroll
      for (int e = 0; e < 8; ++e) { lg8[e] = ln_g[g * 128 + 8 * j + e]; lb8[e] = ln_b[g * 128 + 8 * j + e]; }
#pragma unroll
      for (int ps = 0; ps < 4; ++ps) {
          float x[4][8]; float s = 0.f;
#pragma unroll
          for (int q = 0; q < 4; ++q)
#pragma unroll
              for (int e = 0; e < 4; ++e) { x[q][2 * e] = bf2f((unsigned short)(raws[ps][q][e] & 0xffffu)); x[q][2 * e + 1] = bf2f((unsigned short)(raws[ps][q][e] >> 16)); s += x[q][2 * e] + x[q][2 * e + 1]; }
#pragma unroll
          for (int off = 1; off < 16; off <<= 1) s += __shfl_xor(s, off);
          const float mean = s * (1.0f / 512.0f); float s2 = 0.f;
#pragma unroll
          for (int q = 0; q < 4; ++q)
#pragma unroll
              for (int e = 0; e < 8; ++e) { x[q][e] -= mean; s2 += x[q][e] * x[q][e]; }
#pragma unroll
          for (int off = 1; off < 16; off <<= 1) s2 += __shfl_xor(s2, off);
          const float rstd = 1.0f / sqrtf(s2 * (1.0f / 512.0f) + EPS);
          const int qtok = wave * 16 + ps * 4 + tq;
#pragma unroll
          for (int e = 0; e < 8; ++e) { const float xv = g == 0 ? x[0][e] : (g == 1 ? x[1][e] : (g == 2 ? x[2][e] : x[3][e])); VT[(8 * j + e) * VS + qtok] = (bf16)f2bf(xv * rstd * lg8[e] + lb8[e]); }
      }
    }
    __syncthreads();
    const int pb = wave & 3, ch = wave >> 2;
    f32x16 acc[2];
#pragma unroll
    for (int cb = 0; cb < 2; ++cb)
#pragma unroll
        for (int r = 0; r < 16; ++r) acc[cb][r] = 0.f;
    unsigned short uu[16][2]; float bias[16];
#pragma unroll
    for (int r = 0; r < 16; ++r) { const int p = pb * 32 + crow(r, hi); bias[r] = bs[g * 128 + p];
#pragma unroll
        for (int cb = 0; cb < 2; ++cb) uu[r][cb] = P[(size_t)(row0 + p) * INC + 2048 + g * 128 + ch * 64 + cb * 32 + r32]; }
    const float* wrow = Ws + (size_t)(g * 128 + pb * 32 + r32) * 128 + hi * 8;
#pragma unroll
    for (int ks = 0; ks < 8; ++ks) {
        const f32x4 w0 = *(const GAS f32x4*)(wrow + ks * 16), w1 = *(const GAS f32x4*)(wrow + ks * 16 + 4);
        v4u aw; aw.x = pk2(w0.x, w0.y); aw.y = pk2(w0.z, w0.w); aw.z = pk2(w1.x, w1.y); aw.w = pk2(w1.z, w1.w);
#pragma unroll
        for (int cb = 0; cb < 2; ++cb) { const bf16x8 bv = *(const LAS bf16x8*)(VT + (ch * 64 + cb * 32 + r32) * VS + ks * 16 + hi * 8);
            acc[cb] = __builtin_amdgcn_mfma_f32_32x32x16_bf16(__builtin_bit_cast(bf16x8, aw), bv, acc[cb], 0, 0, 0); }
    }
#pragma unroll
    for (int r = 0; r < 16; ++r) { const int p = pb * 32 + crow(r, hi);
#pragma unroll
        for (int cb = 0; cb < 2; ++cb) { const int c = g * 128 + ch * 64 + cb * 32 + r32;
            MIX[(size_t)(row0 + p) * D + 1024 + c] = (bf16)f2bf(bf2f(uu[r][cb]) * (acc[cb][r] + bias[r])); } }
    __syncthreads();
}

template <int HALF>
__device__ __forceinline__ void pool_body(const bf16* P, bf16* MIX, const float* pscale, int seq0, int T, int tk0, int cc) {
    constexpr int NR = 4 + 2 * HALF;
    v4u raw[NR];
#pragma unroll
    for (int r = 0; r < NR; ++r) { const int t = tk0 - HALF + r; raw[r] = (t >= 0 && t < T) ? *(const GAS v4u*)(P + (size_t)(seq0 + t) * INC + cc * 8) : (v4u){0u, 0u, 0u, 0u}; }
    const f32x4 s0 = *(const GAS f32x4*)(pscale + cc * 8), s1 = *(const GAS f32x4*)(pscale + cc * 8 + 4);
    const float sc[8] = {s0.x, s0.y, s0.z, s0.w, s1.x, s1.y, s1.z, s1.w};
    float w[8];
#pragma unroll
    for (int e = 0; e < 8; ++e) w[e] = 0.f;
#pragma unroll
    for (int r = 0; r < 2 * HALF - 1; ++r)
#pragma unroll
        for (int e = 0; e < 4; ++e) { w[2 * e] += bf2f((unsigned short)(raw[r][e] & 0xffffu)); w[2 * e + 1] += bf2f((unsigned short)(raw[r][e] >> 16)); }
#pragma unroll
    for (int i = 0; i < 4; ++i) {
        const int t = tk0 + i, lo = t - HALF < 0 ? 0 : t - HALF, hh = t + HALF > T ? T : t + HALF; const float rc = 1.0f / (float)(hh - lo);
        v4u o;
#pragma unroll
        for (int e = 0; e < 4; ++e) {
            w[2 * e] += bf2f((unsigned short)(raw[i + 2 * HALF - 1][e] & 0xffffu)); w[2 * e + 1] += bf2f((unsigned short)(raw[i + 2 * HALF - 1][e] >> 16));
            const float x0 = bf2f((unsigned short)(raw[HALF + i][e] & 0xffffu)), x1 = bf2f((unsigned short)(raw[HALF + i][e] >> 16));
            o[e] = pk2((w[2 * e] * rc - x0) * sc[2 * e], (w[2 * e + 1] * rc - x1) * sc[2 * e + 1]);
            w[2 * e] -= bf2f((unsigned short)(raw[i][e] & 0xffffu)); w[2 * e + 1] -= bf2f((unsigned short)(raw[i][e] >> 16));
        }
        *(GAS v4u*)(MIX + (size_t)(seq0 + t) * D + cc * 8) = o;
    }
}
__device__ __forceinline__ void pool_unit(const bf16* P, bf16* MIX, const float* pscale, int row0, int tid, int wave) {
    const int seq0 = row0 < RC ? (row0 & ~255) : RC + ((row0 - RC) & ~2047), T = row0 < RC ? CTX : SEQ, tk0 = row0 - seq0 + 4 * (tid & 7), cc = tid >> 3, g = wave >> 1;
    if (g == 0) pool_body<1>(P, MIX, pscale, seq0, T, tk0, cc); else if (g == 1) pool_body<2>(P, MIX, pscale, seq0, T, tk0, cc); else if (g == 2) pool_body<4>(P, MIX, pscale, seq0, T, tk0, cc); else pool_body<8>(P, MIX, pscale, seq0, T, tk0, cc);
}

__global__ void __launch_bounds__(NWAVES * 64, 2) fwd_kernel(Args args_unused) {
    extern __shared__ __attribute__((aligned(16))) unsigned char lds_raw[];
    LAS unsigned char* lds = (LAS unsigned char*)lds_raw;
    volatile LAS unsigned* MISC = (volatile LAS unsigned*)(lds + MISC_OFF);
    const int tid0 = threadIdx.x;
#define TID_HERE() int tid = threadIdx.x; asm volatile("" : "+v"(tid)); int G = G0, bx = bx0; asm volatile("" : "+s"(G), "+s"(bx)); const int vcu = (G % 8 == 0) ? (bx % 8) * (G / 8) + bx / 8 : bx; const int NGW = G * NWAVES; \
    const int lane = tid & 63, wave = __builtin_amdgcn_readfirstlane(tid >> 6); const int gw = vcu * NWAVES + wave; (void)lane; (void)gw; (void)NGW
    const int G0 = gridDim.x, bx0 = blockIdx.x;
    for (int u = tid0; u < (LDS_BYTES - LDSCTL_OFF) / 4; u += NWAVES * 64) ((LAS unsigned*)(lds + LDSCTL_OFF))[u] = 0u;
    __syncthreads();
    int lo, hi;
    XcdBarrier bar;
    { kaptr kp = ka_get(); lo = KLO(kp); hi = KHI(kp); unsigned* bw = (unsigned*)(KWS(kp) + WS_CTL) + CW_BAR; bar.bar = bw; bar.x = 0; bar.st = nullptr;
      if (!MK_PER_PHASE) bar = xcd_barrier_post(bw, MISC + 8); }
#ifndef SITEMASK
#define SITEMASK 0xfff
#endif
#ifndef UNITMASK
#define UNITMASK 0xf
#endif
#define UEN(s) (((UNITMASK) >> (s)) & 1)
#ifndef REPMASK
#define REPMASK 0
#endif
#ifndef REPU
#define REPU 0
#endif
#define NREPU(s) (1 + (((REPU) >> (s)) & 1))
#define NREP(s) (1 + (((REPMASK) >> (s)) & 1))
#define EN(s) (((SITEMASK) >> (s)) & 1)
#define IN(k) (lo <= (k) && (k) < hi)
#ifndef NCONV
#define NCONV 16
#endif
#ifndef FILLW
#define FILLW 2
#endif
#define CONVPH(k) ((k) == 2 || (k) == 4 || (k) == 6 || (k) == 7)
#ifndef SPLITK
#define SPLITK false
#endif
#ifndef SPLITK_FFN_DOWN
#define SPLITK_FFN_DOWN false
#endif
#ifndef SPLITK_MOE_DOWN
#define SPLITK_MOE_DOWN true
#endif
#ifndef FILLMODE
#define FILLMODE 1
#endif
#define FILL(k) do { if (FILLMODE == 1 && l == 0 && IN(k)) {     kaptr kq = ka_get(); int Gq = G0; asm volatile("" : "+s"(Gq)); fill_tail(KWS(kq), KIN(kq, 23), KIN(kq, 24), KIN(kq, 25), (unsigned*)(KWS(kq) + WS_CTL) + CW_DONE + 64 * (k), Gq, (FILLMODE == 1 && l == 0 && (int)blockIdx.x < NCONV && CONVPH(k)) ? 8 : FILLW); } } while (0)
#define DRAIN(k) do { if (((FILLMODE == 1) || (k) == 0) && IN(k)) { kaptr kq = ka_get(); int Gq = G0; asm volatile("" : "+s"(Gq)); drain_tail(KWS(kq), KIN(kq, 23), KIN(kq, 24), KIN(kq, 25), Gq, lds); } } while (0)
#define SEAM(k) do { if (IN(k) && IN((k) + 1)) { XcdBarrier b_ = bar; asm volatile("" : "+s"(b_.bar)); xcd_barrier(b_); } } while (0)
    LAS int* TB = (LAS int*)(lds + TB_OFF);

    for (int rep = 0; rep < NREP(0); ++rep) if (EN(0) && IN(0)) { kaptr kp = ka_get(); TID_HERE(); p0_prologue(kp, lds, vcu, G, tid, lane, wave); }
    if (FILLMODE == 0) DRAIN(0);
    SEAM(0);

    for (int l = 0; l < 2; ++l) {
        const int pb = l == 0 ? 1 : 8;
        const bool last = (l == 1);
        for (int rep = 0; rep < NREP(1); ++rep) if (EN(1) && IN(pb + 0)) {
            kaptr kp = ka_get(); TID_HERE(); unsigned char* ws = KWS(kp); const float* H = (const float*)(ws + WS_H); const float* mod = (const float*)(ws + WS_MOD) + l * 5 * MODN;
            const float* srcC = l == 0 ? KIN(kp, 2) : H; const float* srcL = l == 0 ? KIN(kp, 0) - (size_t)RC * D : H;
            norm_rows<false>(srcC, srcL, KIN(kp, 6) + l * D, mod + 0 * D, mod + 1 * D, (bf16*)(ws + WS_XN), 0, RT, gw, NGW, lane, nullptr, nullptr, nullptr);
        }
        SEAM(pb + 0);
        for (int rep = 0; rep < NREP(2); ++rep) if (EN(2) && IN(pb + 1)) {
            kaptr kp = ka_get(); TID_HERE(); unsigned char* ws = KWS(kp);
            pg8::Gemm g{(const bf16*)(ws + WS_XN), (const bf16*)(ws + WS_WIN) + (size_t)l * INC * D, RT, INC, D}; pg8::EpiIn E{(bf16*)(ws + WS_PALL), (const PG8_LAS float*)(lds + RING_BYTES)};
            ((LAS f32x4*)(lds + RING_BYTES))[tid] = ((const GAS f32x4*)(ws + WS_ROPE))[tid];
            const int nc = (FILLMODE == 1 && l == 0) ? NCONV : 0;
            if (bx >= nc) {
            pg8::OrderSplit<pg8::MapIn> S; S.init(G - nc, bx - nc, D, last ? 20 : 60); S.plan(SPLITK);
            pg8::EpiSplit<pg8::EpiIn> ES{E, (float*)(ws + WS_SLAB)};
            { pg8::CachedOrder CS; CS.fill(S, (PG8_LAS int*)(lds + UT_OFF), tid); __syncthreads();
                  pg8::gemm_phase<pg8::EpiSplit<pg8::EpiIn>, pg8::CachedOrder, true, true>(lds, g, CS, ES); }
            combine_tail(E, S, (float*)(ws + WS_SLAB), (unsigned*)(ws + WS_CTL) + CW_TK + 4096 * (pb + 1), lds); }
        }
        FILL(pb + 1); SEAM(pb + 1);
        for (int rep = 0; rep < NREP(3); ++rep) if (EN(3) && IN(pb + 2)) {
            kaptr kp = ka_get(); TID_HERE(); unsigned char* ws = KWS(kp); const bf16* PALL = (const bf16*)(ws + WS_PALL); bf16* MIX = (bf16*)(ws + WS_MIX);
            const float lam_init = 0.8f - 0.6f * expf(-0.3f * (float)l);
            for (int ru = 0; ru < NREPU(0); ++ru) if (UEN(0)) for (int u = vcu; u < 256; u += G) diff_unit(lds, PALL, MIX, KIN(kp, 12) + l * 256, KIN(kp, 13) + l * 128, lam_init, u >> 6, (u >> 4) & 3, u & 15, false, tid, lane, wave);
            for (int ru = 0; ru < NREPU(1); ++ru) if (UEN(1)) for (int u = vcu; u < 256; u += G) win_unit(lds, PALL, MIX, KIN(kp, 18) + l * 8, u >> 6, (u >> 5) & 1, u & 31, false, tid, lane, wave);
            if (!last) {
                if (UEN(0)) for (int u = vcu; u < 32; u += G) diff_unit(lds, PALL, MIX, KIN(kp, 12) + l * 256, KIN(kp, 13) + l * 128, lam_init, u >> 3, (u >> 1) & 3, u & 1, true, tid, lane, wave);
                if (UEN(1)) for (int u = (vcu + G - (32 % G)) % G; u < 32; u += G) win_unit(lds, PALL, MIX, KIN(kp, 18) + l * 8, u >> 3, (u >> 2) & 1, u & 3, true, tid, lane, wave);
            }
            { const int ch0 = last ? 8 : 0, nu = (72 - ch0) * 4;
              for (int ru = 0; ru < NREPU(2); ++ru) if (UEN(2)) for (int u = (vcu + G - (64 % G)) % G; u < nu; u += G) sgu_unit(lds, PALL, MIX, KIN(kp, 14) + l * 512, KIN(kp, 15) + l * 512, KIN(kp, 16) + (size_t)l * 4 * 128 * 128, KIN(kp, 17) + l * 512, (ch0 + (u >> 2)) * 128, u & 3, tid, lane, wave); }
            { const int r0 = last ? RC : 0, nu = (RT - r0) / 32;
              for (int ru = 0; ru < NREPU(3); ++ru) if (UEN(3)) for (int u = (vcu + G - (96 % G)) % G; u < nu; u += G) pool_unit(PALL, MIX, KIN(kp, 11) + l * 512, r0 + 32 * u, tid, wave); }
        }
        FILL(pb + 2); SEAM(pb + 2);
        for (int rep = 0; rep < NREP(4); ++rep) if (EN(4) && IN(pb + 3)) {
            kaptr kp = ka_get(); TID_HERE(); unsigned char* ws = KWS(kp); float* H = (float*)(ws + WS_H);
            const float* srcC = l == 0 ? KIN(kp, 2) : H; const float* srcL = l == 0 ? KIN(kp, 0) - (size_t)RC * D : H;
            pg8::Gemm g{(const bf16*)(ws + WS_MIX), (const bf16*)(ws + WS_WOUT) + (size_t)l * D * D, RT, D, D}; pg8::EpiResid E{srcC, srcL, rep ? (float*)(ws + WS_Y) : H, (const float*)(ws + WS_MOD) + l * 5 * MODN + 2 * D, 1.0f};
            const int nc = (FILLMODE == 1 && l == 0) ? NCONV : 0;
            if (bx >= nc) {
            pg8::OrderSplit<pg8::MapOff> S; S.init(last ? RL : RT, D, G - nc, bx - nc, D); S.pm_off = last ? 4 : 0; S.plan(SPLITK);
            pg8::EpiSplit<pg8::EpiResid> ES{E, (float*)(ws + WS_SLAB)};
            { pg8::CachedOrder CS; CS.fill(S, (PG8_LAS int*)(lds + UT_OFF), tid); __syncthreads();
                  pg8::gemm_phase<pg8::EpiSplit<pg8::EpiResid>, pg8::CachedOrder, true, true>(lds, g, CS, ES); }
            combine_tail(E, S, (float*)(ws + WS_SLAB), (unsigned*)(ws + WS_CTL) + CW_TK + 4096 * (pb + 3), lds); }
        }
        FILL(pb + 3); SEAM(pb + 3);
        for (int rep = 0; rep < NREP(5); ++rep) if (EN(5) && IN(pb + 4)) {
            kaptr kp = ka_get(); TID_HERE(); unsigned char* ws = KWS(kp); const float* H = (const float*)(ws + WS_H); const float* mod = (const float*)(ws + WS_MOD) + l * 5 * MODN;
            if (!last || rep) norm_rows<false, DENSE_UP_F8>(H, H, KIN(kp, 7) + l * D, mod + 3 * D, mod + 4 * D, (bf16*)(ws + WS_XN), last ? RC : 0, RT, gw, NGW, lane, nullptr, nullptr, nullptr);
            else {
                LAS float* rt = (LAS float*)lds;
                for (int i = tid; i < D * NE / 4; i += NWAVES * 64) ((LAS f32x4*)rt)[i] = ((const GAS f32x4*)KIN(kp, 22))[i];
                __syncthreads();
                norm_rows<true, MOE_F8>(H, H, KIN(kp, 7) + l * D, mod + 3 * D, mod + 4 * D, (bf16*)(ws + WS_XG), RC, RT, gw, NGW, lane, rt, (unsigned*)(ws + WS_CTL) + CW_CNT, (int*)(ws + WS_ROUTE));
            }
        }
        if (last) DRAIN(pb + 4);
        SEAM(pb + 4);
        if (!last) {
            for (int rep = 0; rep < NREP(6); ++rep) if (EN(6) && IN(pb + 5)) {
                kaptr kp = ka_get(); TID_HERE(); unsigned char* ws = KWS(kp);
                constexpr int KP = DENSE_UP_F8 ? D / 2 : D;
                pg8::Gemm g{(const bf16*)(ws + WS_XN), (const bf16*)(ws + WS_W13), RT, 2 * DFF, KP}; pg8::EpiSwiglu<DENSE_DN_F8> E{(void*)(ws + WS_ACT), DFF, NTN_UP, DENSE_UP_F8 ? 1.0f / 256.0f : 1.0f};
                const int nc = (FILLMODE == 1) ? NCONV : 0;
                if (bx >= nc) {
                pg8::OrderSplit<pg8::StaticOrder> S; S.init(RT, 2 * DFF, G - nc, bx - nc, KP); S.plan(SPLITK);
                pg8::EpiSplit<pg8::EpiSwiglu<DENSE_DN_F8>> ES{E, (float*)(ws + WS_SLAB)};
                { pg8::CachedOrder CS; CS.fill(S, (PG8_LAS int*)(lds + UT_OFF), tid); __syncthreads();
                  pg8::gemm_phase<pg8::EpiSplit<pg8::EpiSwiglu<DENSE_DN_F8>>, pg8::CachedOrder, true, true, DENSE_UP_F8>(lds, g, CS, ES); }
                combine_tail(E, S, (float*)(ws + WS_SLAB), (unsigned*)(ws + WS_CTL) + CW_TK + 4096 * (pb + 5), lds); }
            }
            FILL(pb + 5); SEAM(pb + 5);
            for (int rep = 0; rep < NREP(7); ++rep) if (EN(7) && IN(pb + 6)) {
                kaptr kp = ka_get(); TID_HERE(); unsigned char* ws = KWS(kp); float* H = (float*)(ws + WS_H);
                constexpr int KP = DENSE_DN_F8 ? DFF / 2 : DFF;
                pg8::Gemm g{(const bf16*)(ws + WS_ACT), (const bf16*)(ws + WS_W2), RT, D, KP}; pg8::EpiResid E{H, H, rep ? (float*)(ws + WS_Y) : H, (const float*)(ws + WS_MOD) + l * 5 * MODN + 5 * D, DENSE_DN_F8 ? 1.0f / 256.0f : 1.0f};
                const int nc = (FILLMODE == 1) ? NCONV : 0;
                if (bx >= nc) {
                pg8::OrderSplit<pg8::MapOff> S; S.init(RT, D, G - nc, bx - nc, KP); S.pm_off = 0; S.plan(SPLITK_FFN_DOWN);
                pg8::EpiSplit<pg8::EpiResid> ES{E, (float*)(ws + WS_SLAB)};
                { pg8::CachedOrder CS; CS.fill(S, (PG8_LAS int*)(lds + UT_OFF), tid); __syncthreads();
                  pg8::gemm_phase<pg8::EpiSplit<pg8::EpiResid>, pg8::CachedOrder, true, true, DENSE_DN_F8>(lds, g, CS, ES); }
                combine_tail(E, S, (float*)(ws + WS_SLAB), (unsigned*)(ws + WS_CTL) + CW_TK + 4096 * (pb + 6), lds); }
            }
            FILL(pb + 6); SEAM(pb + 6);
        } else {
            if (IN(pb + 5) || IN(pb + 6) || IN(pb + 7) || IN(pb + 8)) {
                kaptr kp = ka_get(); TID_HERE(); const unsigned* CNT = (const unsigned*)(KWS(kp) + WS_CTL) + CW_CNT;
                if (tid == 0) { int acc = 0; TB[0] = 0;
                    for (int e = 0; e < 8; ++e) { const unsigned c = __hip_atomic_load(CNT + 64 * e, RLX_AGENT); acc += (int)((c + 255u) >> 8); TB[e + 1] = acc; } }
                __syncthreads();
            }
            for (int rep = 0; rep < NREP(9); ++rep) if (EN(9) && IN(pb + 6)) {
                kaptr kp = ka_get(); TID_HERE(); unsigned char* ws = KWS(kp);
                constexpr int KP = MOE_F8 ? D / 2 : D;
                pg8::Gemm g{(const bf16*)(ws + WS_XG), (const bf16*)(ws + WS_MW13), NE * 8192, NE * 2 * DFF, KP}; pg8::EpiSwiglu<MOE_F8> E{(void*)(ws + WS_ACT), DFF, NTN_UP, MOE_F8 ? 1.0f / 256.0f : 1.0f, (const PG8_LAS int*)TB};
                pg8::OrderSplit<pg8::MapMoe> S; S.init((const PG8_LAS int*)TB, NTN_UP, G, bx, KP, 1); S.plan(SPLITK);
                pg8::EpiSplit<pg8::EpiSwiglu<MOE_F8>> ES{E, (float*)(ws + WS_SLAB)};
                { pg8::CachedOrder CS; CS.fill(S, (PG8_LAS int*)(lds + UT_OFF), tid); __syncthreads();
                  pg8::gemm_phase<pg8::EpiSplit<pg8::EpiSwiglu<MOE_F8>>, pg8::CachedOrder, true, true, MOE_F8>(lds, g, CS, ES); }
                combine_tail(E, S, (float*)(ws + WS_SLAB), (unsigned*)(ws + WS_CTL) + CW_TK + 4096 * (pb + 6), lds);
            }
            SEAM(pb + 6);
            for (int rep = 0; rep < NREP(10); ++rep) if (EN(10) && IN(pb + 7)) {
                kaptr kp = ka_get(); TID_HERE(); unsigned char* ws = KWS(kp);
                constexpr int KP = MOE_F8 ? DFF / 2 : DFF;
                pg8::Gemm g{(const bf16*)(ws + WS_ACT), (const bf16*)(ws + WS_MW2), MAXSLOT, NE * D, KP}; pg8::EpiF32 E{(bf16*)(ws + WS_Y), D / 256, MOE_F8 ? 1.0f / 256.0f : 1.0f};
                pg8::OrderSplit<pg8::MapMoe> S; S.init((const PG8_LAS int*)TB, D / 256, G, bx, KP); S.plan(SPLITK_MOE_DOWN);
                pg8::EpiSplit<pg8::EpiF32> ES{E, (float*)(ws + WS_SLAB)};
                { pg8::CachedOrder CS; CS.fill(S, (PG8_LAS int*)(lds + UT_OFF), tid); __syncthreads();
                  pg8::gemm_phase<pg8::EpiSplit<pg8::EpiF32>, pg8::CachedOrder, true, true, MOE_F8>(lds, g, CS, ES); }
                combine_tail(E, S, (float*)(ws + WS_SLAB), (unsigned*)(ws + WS_CTL) + CW_TK + 4096 * (pb + 7), lds);
            }
            SEAM(pb + 7);
            for (int rep = 0; rep < NREP(11); ++rep) if (EN(11) && IN(pb + 8)) {
                kaptr kp = ka_get(); TID_HERE(); unsigned char* ws = KWS(kp); const int* ROUTE = (const int*)(ws + WS_ROUTE); const float* H = (const float*)(ws + WS_H); const bf16* Y = (const bf16*)(ws + WS_Y);
                const float* gate = (const float*)(ws + WS_MOD) + l * 5 * MODN + 5 * D; const float* nf = KIN(kp, 26); float* out = KOUT(kp);
                f32x4 nw[8];
#pragma unroll
                for (int j = 0; j < 8; ++j) nw[j] = ((const GAS f32x4*)nf + lane)[64 * j];
                for (int t = gw; t < RL; t += NGW) {
                    const int* rec = ROUTE + (size_t)t * 8; const int e1 = rec[0], s1 = rec[1], e2 = rec[3], s2 = rec[4]; const float w1 = __builtin_bit_cast(float, rec[2]), w2 = __builtin_bit_cast(float, rec[5]);
                    const int b1 = TB[e1], b2 = TB[e2];
                    const int bidx = t >> 11;
                    const GAS f32x4* hr = (const GAS f32x4*)(H + (size_t)(RC + t) * D) + lane; const GAS v2u* y1 = (const GAS v2u*)(Y + (size_t)(b1 * 256 + s1) * D) + lane; const GAS v2u* y2 = (const GAS v2u*)(Y + (size_t)(b2 * 256 + s2) * D) + lane;
                    const GAS f32x4* g4 = (const GAS f32x4*)(gate + bidx * MODN) + lane;
                    f32x4 v[8]; float ss = 0.f;
#pragma unroll
                    for (int j = 0; j < 8; ++j) { const v2u ra = y1[64 * j], rb = y2[64 * j];
                        const f32x4 a = (f32x4){bf2f((unsigned short)(ra.x & 0xffffu)), bf2f((unsigned short)(ra.x >> 16)), bf2f((unsigned short)(ra.y & 0xffffu)), bf2f((unsigned short)(ra.y >> 16))};
                        const f32x4 b = (f32x4){bf2f((unsigned short)(rb.x & 0xffffu)), bf2f((unsigned short)(rb.x >> 16)), bf2f((unsigned short)(rb.y & 0xffffu)), bf2f((unsigned short)(rb.y >> 16))};
                        v[j] = hr[64 * j] + g4[64 * j] * (a * w1 + b * w2); ss += (v[j].x * v[j].x + v[j].y * v[j].y) + (v[j].z * v[j].z + v[j].w * v[j].w); }
                    const float rstd = 1.0f / sqrtf(wave_sum(ss) * (1.0f / D) + EPS);
                    GAS f32x4* op = (GAS f32x4*)(out + (size_t)t * D) + lane;
#pragma unroll
                    for (int j = 0; j < 8; ++j) op[64 * j] = v[j] * rstd * nw[j];
                }
            }
        }
    }
#undef IN
#undef SEAM
}

extern "C" void kernel_launch(void* const* d_in, const int* in_sizes, int n_in, void* d_out, int out_size, void* d_ws, size_t ws_size, hipStream_t stream) {
    static int grid = 0;
    if (grid == 0) {
        if (n_in != 27 || out_size != RL * D || ws_size < WS_END) { fprintf(stderr, "kernel_launch: unexpected problem (n_in %d, out %d, ws %zu); nothing launched\n", n_in, out_size, ws_size); grid = -1; return; }
        int dev = 0, cus = 0, per_cu = 0;
        if (hipGetDevice(&dev) != hipSuccess || hipDeviceGetAttribute(&cus, hipDeviceAttributeMultiprocessorCount, dev) != hipSuccess) { grid = -1; return; }
        if (hipFuncSetAttribute((const void*)fwd_kernel, hipFuncAttributeMaxDynamicSharedMemorySize, LDS_BYTES) != hipSuccess) { fprintf(stderr, "kernel_launch: hipFuncSetAttribute failed\n"); grid = -1; return; }
        if (hipOccupancyMaxActiveBlocksPerMultiprocessor(&per_cu, (const void*)fwd_kernel, NWAVES * 64, LDS_BYTES) != hipSuccess || per_cu < 1) fprintf(stderr, "kernel_launch: occupancy query reports %d\n", per_cu);
        (void)hipGetLastError();
        grid = cus;
    }
    if (grid < 0) return;
    if (hipMemsetAsync((char*)d_ws + WS_CTL, 0, CTL_ZERO_BYTES, stream) != hipSuccess) { fprintf(stderr, "kernel_launch: memset failed\n"); return; }
    Args a{};
    for (int i = 0; i < 27; ++i) a.in[i] = (const float*)d_in[i];
    a.out = (float*)d_out; a.ws = (unsigned char*)d_ws;
#if MK_PER_PHASE
    for (int p = 0; p < NPHASE; ++p) { a.ph_lo = p; a.ph_hi = p + 1; hipLaunchKernelGGL(fwd_kernel, dim3(grid), dim3(NWAVES * 64), LDS_BYTES, stream, a); }
#else
    a.ph_lo = 0; a.ph_hi = NPHASE;
    hipLaunchKernelGGL(fwd_kernel, dim3(grid), dim3(NWAVES * 64), LDS_BYTES, stream, a);
#endif
    const hipError_t le = hipPeekAtLastError();
    if (le != hipSuccess) fprintf(stderr, "kernel_launch: launch failed: %s\n", hipGetErrorName(le));
}
```
